# Optimizing an MI355X kernel written in HIP

```python
import math
import jax
import jax.numpy as jnp
from jax import lax
import numpy as np

D_MODEL = 1024
BATCH = 4
SEQ = 8192
DEPTH = 2

CTX_LEN = 256
GRID_W = 64
EPS = 1e-6
D_MIX = D_MODEL
GLA_V = 3 * D_MIX // 8
GLA_DV = 64
GLA_HEADS = GLA_V // GLA_DV
GLA_DK = GLA_DV // 2
GLA_QK = GLA_HEADS * GLA_DK
GLA_LOWRANK = 16
GLA_TAU = 16.0
GLA_CHUNK = 64
HY_WIDTH = D_MIX // 4
HY_SHORT = 3
HY_BANDS = 16
HY_EMB = 1 + 2 * HY_BANDS
HY_FILTER_ORDER = 64
HY_TARGET = 1e-2
HY_FAST_PCT = 0.3
HY_SLOW_PCT = 1.5
SSD_INNER = D_MIX - GLA_V - HY_WIDTH
SSD_HEAD_DIM = 64
SSD_HEADS = SSD_INNER // SSD_HEAD_DIM
SSD_GROUPS = 2
SSD_HG = SSD_HEADS // SSD_GROUPS
SSD_STATE = 128
SSD_CONV = 3
SSD_CONV_DIM = SSD_INNER + 2 * SSD_GROUPS * SSD_STATE
SSD_CHUNK = 128
D_FF = -(-8 * D_MODEL // (3 * 256)) * 256
IN_SIZES = (GLA_QK, GLA_QK, GLA_V, GLA_V, GLA_LOWRANK, GLA_LOWRANK, 3 * HY_WIDTH,
            SSD_INNER, SSD_CONV_DIM, SSD_HEADS, SSD_HEADS)
IN_OFFSETS = tuple(int(v) for v in np.cumsum(IN_SIZES)[:-1])
D_IN = int(sum(IN_SIZES))

kernel_name = 'hybrid_gla_hyena_ssd_dit_block'


def rmsnorm(x, g):
    xf = x.astype(jnp.float32)
    y = xf * lax.rsqrt(jnp.mean(xf * xf, axis=-1, keepdims=True) + EPS)
    return (y * g.astype(jnp.float32)).astype(x.dtype)


def modulate(h, shift, scale):
    return h * (1.0 + scale) + shift


def flip(t):
    return jnp.flip(t, axis=1)


def dwconv(x, w, b):
    K = w.shape[0]
    y = lax.conv_general_dilated(x, w.astype(x.dtype)[:, None, :], window_strides=(1,),
                                 padding=[(K // 2, K // 2)],
                                 dimension_numbers=('NWC', 'WIO', 'NWC'),
                                 feature_group_count=x.shape[-1])
    return y + b


def to_col_major(t):
    bsz, L, C = t.shape
    rows = L // GRID_W
    return t.reshape(bsz, rows, GRID_W, C).transpose(0, 2, 1, 3).reshape(bsz, L, C)


def from_col_major(t):
    bsz, L, C = t.shape
    rows = L // GRID_W
    return t.reshape(bsz, GRID_W, rows, C).transpose(0, 2, 1, 3).reshape(bsz, L, C)


def gla_scan(q, k, v, log_a, s0):
    bsz, L, H, _ = q.shape
    dv = v.shape[-1]
    nc = L // GLA_CHUNK

    def chunks(t):
        return t.astype(jnp.float32).reshape(bsz, nc, GLA_CHUNK, H, t.shape[-1])

    q, k, v, log_a = chunks(q), chunks(k), chunks(v), chunks(log_a)
    b = jnp.cumsum(log_a, axis=2)
    b_last = b[:, :, -1:]
    q_dec = q * jnp.exp(b)
    scores = jnp.einsum('bcihd,bcjhd->bchij', q_dec, k * jnp.exp(-b))
    lower = jnp.tril(jnp.ones((GLA_CHUNK, GLA_CHUNK), dtype=bool))
    scores = jnp.where(lower, scores, 0.0)
    o = jnp.einsum('bchij,bcjhe->bcihe', scores, v)
    ds = jnp.einsum('bcjhd,bcjhe->bchde', k * jnp.exp(b_last - b), v)
    chunk_decay = jnp.exp(b_last[:, :, 0])

    def step(s, inp):
        dec, d = inp
        return dec[..., None] * s + d, s

    s_final, s_start = lax.scan(step, s0.astype(jnp.float32),
                                (jnp.moveaxis(chunk_decay, 1, 0), jnp.moveaxis(ds, 1, 0)))
    o = o + jnp.einsum('bcihd,bchde->bcihe', q_dec, jnp.moveaxis(s_start, 0, 1))
    return o.reshape(bsz, L, H, dv), s_final


def ssd_scan(x, log_a, bm, cm, s0):
    bsz, L, G, HG, P = x.shape
    N = bm.shape[-1]
    nc = L // SSD_CHUNK
    Q = SSD_CHUNK
    x = x.astype(jnp.float32).reshape(bsz, nc, Q, G, HG, P)
    bm = bm.astype(jnp.float32).reshape(bsz, nc, Q, G, N)
    cm = cm.astype(jnp.float32).reshape(bsz, nc, Q, G, N)
    cs = jnp.cumsum(log_a.astype(jnp.float32).reshape(bsz, nc, Q, G, HG), axis=2)
    cs = jnp.moveaxis(cs, 2, -1)
    lower = jnp.tril(jnp.ones((Q, Q), dtype=bool))
    seg = cs[..., :, None] - cs[..., None, :]
    decay = jnp.exp(jnp.where(lower, seg, -jnp.inf))
    cb = jnp.einsum('bcign,bcjgn->bcgij', cm, bm)
    y = jnp.einsum('bcgij,bcghij,bcjghp->bcighp', cb, decay, x)
    ds = jnp.einsum('bcjgn,bcghj,bcjghp->bcghpn', bm, jnp.exp(cs[..., -1:] - cs), x)
    chunk_decay = jnp.exp(cs[..., -1])

    def step(s, inp):
        dec, d = inp
        return dec[..., None, None] * s + d, s

    s_final, s_start = lax.scan(step, s0.astype(jnp.float32),
                                (jnp.moveaxis(chunk_decay, 1, 0), jnp.moveaxis(ds, 1, 0)))
    y = y + jnp.einsum('bcign,bcghi,bcghpn->bcighp', cm, jnp.exp(cs), jnp.moveaxis(s_start, 0, 1))
    return y.reshape(bsz, L, G, HG, P), s_final


def gla_mixer(q, k, v, g, gkf, gkb, lp, s_f, s_b):
    bsz, L, _ = q.shape
    q = q.reshape(bsz, L, GLA_HEADS, GLA_DK) * (GLA_DK ** -0.5)
    k = k.reshape(bsz, L, GLA_HEADS, GLA_DK)
    v = v.reshape(bsz, L, GLA_HEADS, GLA_DV)
    pre_f = (gkf @ lp['gla_gk_w_f'] + lp['gla_gk_b_f']).astype(jnp.float32)
    pre_b = (gkb @ lp['gla_gk_w_b'] + lp['gla_gk_b_b']).astype(jnp.float32)
    log_f = (jax.nn.log_sigmoid(pre_f) / GLA_TAU).reshape(bsz, L, GLA_HEADS, GLA_DK)
    log_b = (jax.nn.log_sigmoid(pre_b) / GLA_TAU).reshape(bsz, L, GLA_HEADS, GLA_DK)
    o_f, s_f = gla_scan(q, k, v, log_f, s_f)
    o_b, s_b = gla_scan(flip(q), flip(k), flip(v), flip(log_b), s_b)
    o = (o_f + flip(o_b)).astype(v.dtype)
    o = rmsnorm(o, lp['gla_norm_w']).reshape(bsz, L, GLA_V) * jax.nn.silu(g)
    return o, (s_f, s_b)


def hyena_filter(L, lp):
    t = jnp.arange(L, dtype=jnp.float32)
    rel = (t - (L // 2)) / L
    bands = jnp.linspace(1e-4, HY_BANDS - 1, HY_BANDS, dtype=jnp.float32)
    ang = 2.0 * math.pi * rel[:, None] * bands
    z = jnp.concatenate([rel[:, None], jnp.cos(ang), -jnp.sin(ang)], axis=-1)
    freq = lp['hy_freq']
    hdn = jnp.sin(freq * (z @ lp['hy_w1'] + lp['hy_b1']))
    hdn = jnp.sin(freq * (hdn @ lp['hy_w2'] + lp['hy_b2']))
    h = hdn @ lp['hy_w3']
    window = jnp.exp(-2.0 * jnp.abs(rel)[:, None] * lp['hy_decay'])
    return h * window


def fft_conv_centred(u, h):
    L = u.shape[1]
    n = 2 * L
    uf = jnp.fft.rfft(u.astype(jnp.float32), n=n, axis=1)
    hf = jnp.fft.rfft(h.astype(jnp.float32), n=n, axis=0)
    y = jnp.fft.irfft(uf * hf[None], n=n, axis=1)[:, L // 2: L // 2 + L]
    return y.astype(u.dtype)


def hyena_mixer(u, lp):
    L = u.shape[1]
    u = dwconv(u, lp['hy_short_w'], lp['hy_short_b'])
    x0, x1, v = jnp.split(u, 3, axis=-1)
    h = hyena_filter(L, lp)
    v = v * x1
    v = fft_conv_centred(v, h) + v * lp['hy_bias']
    return v * x0


def ssd_mixer(z, xbc, dtf, dtb, lp, s_f, s_b, col_major):
    bsz, L, _ = z.shape
    if col_major:
        xbc, dtf, dtb = to_col_major(xbc), to_col_major(dtf), to_col_major(dtb)
    xbc = jax.nn.silu(dwconv(xbc, lp['ssd_conv_w'], lp['ssd_conv_b']))
    xs, bm, cm = jnp.split(xbc, [SSD_INNER, SSD_INNER + SSD_GROUPS * SSD_STATE], axis=-1)
    xs = xs.reshape(bsz, L, SSD_GROUPS, SSD_HG, SSD_HEAD_DIM)
    bm = bm.reshape(bsz, L, SSD_GROUPS, SSD_STATE)
    cm = cm.reshape(bsz, L, SSD_GROUPS, SSD_STATE)
    dt_f = jax.nn.softplus(dtf.astype(jnp.float32) + lp['ssd_dt_bias_f']).reshape(bsz, L, SSD_GROUPS, SSD_HG)
    dt_b = jax.nn.softplus(dtb.astype(jnp.float32) + lp['ssd_dt_bias_b']).reshape(bsz, L, SSD_GROUPS, SSD_HG)
    a_f = -jnp.exp(lp['ssd_a_log_f'].astype(jnp.float32)).reshape(SSD_GROUPS, SSD_HG) * dt_f
    a_b = -jnp.exp(lp['ssd_a_log_b'].astype(jnp.float32)).reshape(SSD_GROUPS, SSD_HG) * dt_b
    y_f, s_f = ssd_scan(xs * dt_f[..., None], a_f, bm, cm, s_f)
    y_b, s_b = ssd_scan(flip(xs * dt_b[..., None]), flip(a_b), flip(bm), flip(cm), s_b)
    y = y_f + flip(y_b) + lp['ssd_d'].reshape(SSD_GROUPS, SSD_HG, 1) * xs
    y = y.reshape(bsz, L, SSD_INNER).astype(z.dtype)
    if col_major:
        y = from_col_major(y)
    yz = (y * jax.nn.silu(z)).reshape(bsz, L, SSD_GROUPS, SSD_INNER // SSD_GROUPS)
    y = rmsnorm(yz, lp['ssd_norm_w'].reshape(SSD_GROUPS, SSD_INNER // SSD_GROUPS))
    return y.reshape(bsz, L, SSD_INNER), (s_f, s_b)


def mixers(p, lp, states, col_major):
    q, k, v, g, gkf, gkb, hy_u, z, xbc, dtf, dtb = jnp.split(p, IN_OFFSETS, axis=-1)
    gla_y, (g_f, g_b) = gla_mixer(q, k, v, g, gkf, gkb, lp, states[0], states[1])
    hy_y = hyena_mixer(hy_u, lp)
    ssd_y, (m_f, m_b) = ssd_mixer(z, xbc, dtf, dtb, lp, states[2], states[3], col_major)
    return jnp.concatenate([gla_y, hy_y, ssd_y], axis=-1), (g_f, g_b, m_f, m_b)


def zero_states(bsz):
    gla = jnp.zeros((bsz, GLA_HEADS, GLA_DK, GLA_DV), jnp.float32)
    ssd = jnp.zeros((bsz, SSD_GROUPS, SSD_HG, SSD_HEAD_DIM, SSD_STATE), jnp.float32)
    return (gla, gla, ssd, ssd)


def swiglu(h, w1, w3, w2):
    return (jax.nn.silu(h @ w1) * (h @ w3)) @ w2


def setup_inputs(seed: int = 0) -> dict:
    key = jax.random.key(seed)
    ks = iter(jax.random.split(key, 48))

    def nrm(shape, scale):
        return scale * jax.random.normal(next(ks), shape, jnp.float32)

    def unif(shape, lo, hi):
        return jax.random.uniform(next(ks), shape, jnp.float32, lo, hi)

    x = nrm((BATCH, SEQ, D_MODEL), 1.0)
    c = nrm((BATCH, D_MODEL), 1.0)
    ctx = nrm((BATCH, CTX_LEN, D_MODEL), 1.0)
    c_ctx = nrm((D_MODEL,), 1.0)
    mod_w = nrm((DEPTH, D_MODEL, 6 * D_MODEL), 0.2 * D_MODEL ** -0.5)
    mod_b = nrm((DEPTH, 6 * D_MODEL), 0.02)
    norm1_g = 1.0 + nrm((DEPTH, D_MODEL), 0.02)
    norm2_g = 1.0 + nrm((DEPTH, D_MODEL), 0.02)
    w_in = nrm((DEPTH, D_MODEL, D_IN), D_MODEL ** -0.5)
    gla_gk_w_f = nrm((DEPTH, GLA_LOWRANK, GLA_QK), GLA_LOWRANK ** -0.5)
    gla_gk_b_f = nrm((DEPTH, GLA_QK), 0.1)
    gla_gk_w_b = nrm((DEPTH, GLA_LOWRANK, GLA_QK), GLA_LOWRANK ** -0.5)
    gla_gk_b_b = nrm((DEPTH, GLA_QK), 0.1)
    gla_norm_w = 1.0 + nrm((DEPTH, GLA_DV), 0.02)
    hy_short_w = nrm((DEPTH, HY_SHORT, 3 * HY_WIDTH), HY_SHORT ** -0.5)
    hy_short_b = nrm((DEPTH, 3 * HY_WIDTH), 0.02)
    hy_w1 = nrm((DEPTH, HY_EMB, HY_FILTER_ORDER), HY_EMB ** -0.5)
    hy_b1 = nrm((DEPTH, HY_FILTER_ORDER), 0.1)
    hy_w2 = nrm((DEPTH, HY_FILTER_ORDER, HY_FILTER_ORDER), HY_FILTER_ORDER ** -0.5)
    hy_b2 = nrm((DEPTH, HY_FILTER_ORDER), 0.1)
    hy_w3 = nrm((DEPTH, HY_FILTER_ORDER, HY_WIDTH), 0.005)
    hy_freq = 1.0 + nrm((DEPTH, HY_FILTER_ORDER), 0.05)
    base_decay = jnp.abs(jnp.linspace(math.log(HY_TARGET) / HY_FAST_PCT,
                                      math.log(HY_TARGET) / HY_SLOW_PCT, HY_WIDTH, dtype=jnp.float32))
    hy_decay = base_decay[None] * (1.0 + nrm((DEPTH, HY_WIDTH), 0.05))
    hy_bias = nrm((DEPTH, HY_WIDTH), 1.0)
    ssd_conv_w = nrm((DEPTH, SSD_CONV, SSD_CONV_DIM), SSD_CONV ** -0.5)
    ssd_conv_b = nrm((DEPTH, SSD_CONV_DIM), 0.02)
    dt_f0 = jnp.exp(unif((DEPTH, SSD_HEADS), math.log(1e-3), math.log(1e-1)))
    dt_b0 = jnp.exp(unif((DEPTH, SSD_HEADS), math.log(1e-3), math.log(1e-1)))
    ssd_dt_bias_f = dt_f0 + jnp.log(-jnp.expm1(-dt_f0))
    ssd_dt_bias_b = dt_b0 + jnp.log(-jnp.expm1(-dt_b0))
    ssd_a_log_f = jnp.log(unif((DEPTH, SSD_HEADS), 1.0, 16.0))
    ssd_a_log_b = jnp.log(unif((DEPTH, SSD_HEADS), 1.0, 16.0))
    ssd_d = 1.0 + nrm((DEPTH, SSD_HEADS), 0.02)
    ssd_norm_w = 1.0 + nrm((DEPTH, SSD_INNER), 0.02)
    w_out = nrm((DEPTH, D_MIX, D_MODEL), D_MIX ** -0.5)
    ffn_w1 = nrm((DEPTH, D_MODEL, D_FF), D_MODEL ** -0.5)
    ffn_w3 = nrm((DEPTH, D_MODEL, D_FF), D_MODEL ** -0.5)
    ffn_w2 = nrm((DEPTH, D_FF, D_MODEL), D_FF ** -0.5)
    final_g = 1.0 + nrm((D_MODEL,), 0.02)
    return {'x': x, 'c': c, 'ctx': ctx, 'c_ctx': c_ctx, 'mod_w': mod_w, 'mod_b': mod_b,
            'norm1_g': norm1_g, 'norm2_g': norm2_g, 'w_in': w_in,
            'gla_gk_w_f': gla_gk_w_f, 'gla_gk_b_f': gla_gk_b_f, 'gla_gk_w_b': gla_gk_w_b,
            'gla_gk_b_b': gla_gk_b_b, 'gla_norm_w': gla_norm_w,
            'hy_short_w': hy_short_w, 'hy_short_b': hy_short_b, 'hy_w1': hy_w1, 'hy_b1': hy_b1,
            'hy_w2': hy_w2, 'hy_b2': hy_b2, 'hy_w3': hy_w3, 'hy_freq': hy_freq,
            'hy_decay': hy_decay, 'hy_bias': hy_bias,
            'ssd_conv_w': ssd_conv_w, 'ssd_conv_b': ssd_conv_b, 'ssd_dt_bias_f': ssd_dt_bias_f,
            'ssd_dt_bias_b': ssd_dt_bias_b, 'ssd_a_log_f': ssd_a_log_f, 'ssd_a_log_b': ssd_a_log_b,
            'ssd_d': ssd_d, 'ssd_norm_w': ssd_norm_w, 'w_out': w_out,
            'ffn_w1': ffn_w1, 'ffn_w3': ffn_w3, 'ffn_w2': ffn_w2, 'final_g': final_g}


def reference(x, c, ctx, c_ctx, mod_w, mod_b, norm1_g, norm2_g, w_in,
              gla_gk_w_f, gla_gk_b_f, gla_gk_w_b, gla_gk_b_b, gla_norm_w,
              hy_short_w, hy_short_b, hy_w1, hy_b1, hy_w2, hy_b2, hy_w3, hy_freq, hy_decay, hy_bias,
              ssd_conv_w, ssd_conv_b, ssd_dt_bias_f, ssd_dt_bias_b, ssd_a_log_f, ssd_a_log_b,
              ssd_d, ssd_norm_w, w_out, ffn_w1, ffn_w3, ffn_w2, final_g):
    bsz = x.shape[0]
    c_act = jax.nn.silu(c)
    cc_act = jax.nn.silu(c_ctx)
    for l in range(DEPTH):
        lp = {'gla_gk_w_f': gla_gk_w_f[l], 'gla_gk_b_f': gla_gk_b_f[l],
              'gla_gk_w_b': gla_gk_w_b[l], 'gla_gk_b_b': gla_gk_b_b[l], 'gla_norm_w': gla_norm_w[l],
              'hy_short_w': hy_short_w[l], 'hy_short_b': hy_short_b[l], 'hy_w1': hy_w1[l],
              'hy_b1': hy_b1[l], 'hy_w2': hy_w2[l], 'hy_b2': hy_b2[l], 'hy_w3': hy_w3[l],
              'hy_freq': hy_freq[l], 'hy_decay': hy_decay[l], 'hy_bias': hy_bias[l],
              'ssd_conv_w': ssd_conv_w[l], 'ssd_conv_b': ssd_conv_b[l],
              'ssd_dt_bias_f': ssd_dt_bias_f[l], 'ssd_dt_bias_b': ssd_dt_bias_b[l],
              'ssd_a_log_f': ssd_a_log_f[l], 'ssd_a_log_b': ssd_a_log_b[l],
              'ssd_d': ssd_d[l], 'ssd_norm_w': ssd_norm_w[l]}
        mx = jnp.split(c_act @ mod_w[l] + mod_b[l], 6, axis=-1)
        mc = jnp.split(cc_act @ mod_w[l] + mod_b[l], 6, axis=-1)
        hx = modulate(rmsnorm(x, norm1_g[l]), mx[0][:, None], mx[1][:, None])
        hc = modulate(rmsnorm(ctx, norm1_g[l]), mc[0], mc[1])
        yc, ctx_states = mixers(hc @ w_in[l], lp, zero_states(bsz), False)
        yx, _ = mixers(hx @ w_in[l], lp, ctx_states, True)
        x = x + mx[2][:, None] * (yx @ w_out[l])
        hx2 = modulate(rmsnorm(x, norm2_g[l]), mx[3][:, None], mx[4][:, None])
        x = x + mx[5][:, None] * swiglu(hx2, ffn_w1[l], ffn_w3[l], ffn_w2[l])
        if l < DEPTH - 1:
            ctx = ctx + mc[2] * (yc @ w_out[l])
            hc2 = modulate(rmsnorm(ctx, norm2_g[l]), mc[3], mc[4])
            ctx = ctx + mc[5] * swiglu(hc2, ffn_w1[l], ffn_w3[l], ffn_w2[l])
    return rmsnorm(x, final_g)
```

```cpp
#ifndef CPU_EMU
#include <hip/hip_runtime.h>
#else
#include <cmath>
#include <cstring>
#include <cstdio>
#include <cstdlib>
#define __device__
#define __global__
#define __forceinline__ inline
#define __host__
#endif
#include <stdint.h>
#include <stddef.h>

#ifndef NB
#define NB 4
#endif
#ifndef SEQ
#define SEQ 8192
#endif
#ifndef CTX
#define CTX 256
#endif
#define DEPTH 2
#define DM 1024
#define GRID_W 64
#define ROWS_G (SEQ / GRID_W)
#define BL (NB * SEQ)
#define BC (NB * CTX)
#define NT (BL + BC)
#define NSEQ (2 * NB)
#define DIN 3244
#define OFF_Q 0
#define OFF_K 192
#define OFF_V 384
#define OFF_G 768
#define OFF_GKF 1152
#define OFF_GKB 1168
#define OFF_HY 1184
#define OFF_Z 1952
#define OFF_XBC 2336
#define OFF_DTF 3232
#define OFF_DTB 3238
#define DFF 2816
#define TF (SEQ + CTX)
#define EPSV 1e-6f

#ifdef ACT_FP32
typedef float act_t;
__device__ __forceinline__ float ldact(const act_t* p) { return *p; }
__device__ __forceinline__ void stact(act_t* p, float v) { *p = v; }
#else
typedef unsigned short act_t;
__device__ __forceinline__ float ldact(const act_t* p) {
    union { unsigned u; float f; } x; x.u = ((unsigned)*p) << 16; return x.f;
}
__device__ __forceinline__ void stact(act_t* p, float v) {
    union { float f; unsigned u; } x; x.f = v;
    unsigned r = x.u + 0x7FFFu + ((x.u >> 16) & 1u);
    *p = (unsigned short)(r >> 16);
}
#endif

struct Params {
    const float *x, *c, *ctx, *c_ctx, *mod_w, *mod_b, *norm1_g, *norm2_g, *w_in;
    const float *gk_w_f, *gk_b_f, *gk_w_b, *gk_b_b, *gla_norm_w;
    const float *hy_short_w, *hy_short_b, *hy_w1, *hy_b1, *hy_w2, *hy_b2, *hy_w3, *hy_freq, *hy_decay, *hy_bias;
    const float *ssd_conv_w, *ssd_conv_b, *ssd_dt_bias_f, *ssd_dt_bias_b, *ssd_a_log_f, *ssd_a_log_b, *ssd_d, *ssd_norm_w;
    const float *w_out, *ffn_w1, *ffn_w3, *ffn_w2, *final_g;
    float* XL;
    float* XC;
    float* MOD;
    float* HF;
    float* H1;
    float* H2;
    float* RSTD;
    act_t* P;
    act_t* Y;
    float* LG;
    float* O;
    act_t* XBC;
    float* YS;
    float* DT;
    float* VX;
};

__device__ __forceinline__ float siluf(float x) { return x / (1.0f + expf(-x)); }
__device__ __forceinline__ float softplusf(float x) { return fmaxf(x, 0.0f) + log1pf(expf(-fabsf(x))); }
__device__ __forceinline__ float logsigmoidf(float x) { return -softplusf(-x); }

__device__ __forceinline__ float* xrow(const Params& p, int r) {
    return r < BL ? p.XL + (size_t)r * DM : p.XC + (size_t)(r - BL) * DM;
}
__device__ __forceinline__ int row_bb(int r) { return r < BL ? r / SEQ : NB; }
__device__ __forceinline__ int seq_len(int s) { return s < NB ? SEQ : CTX; }
__device__ __forceinline__ int seq_row0(int s) { return s < NB ? s * SEQ : BL + (s - NB) * CTX; }
__device__ __forceinline__ int colmajor_tok(int s, int pos) {
    return s < NB ? (pos % ROWS_G) * GRID_W + pos / ROWS_G : pos;
}

__device__ void st_init(const Params& p, long tid, long nth) {
    for (long i = tid; i < (long)BL * DM; i += nth) p.XL[i] = p.x[i];
    for (long i = tid; i < (long)BC * DM; i += nth) p.XC[i] = p.ctx[i];
}
__device__ void st_mod(const Params& p, long tid, long nth) {
    const long total = (long)DEPTH * (NB + 1) * 6 * DM;
    for (long i = tid; i < total; i += nth) {
        int n = (int)(i % (6 * DM));
        int bb = (int)((i / (6 * DM)) % (NB + 1));
        int l = (int)(i / ((long)6 * DM * (NB + 1)));
        const float* cv = bb < NB ? p.c + (size_t)bb * DM : p.c_ctx;
        const float* w = p.mod_w + (size_t)l * DM * 6 * DM + n;
        float acc = 0.f;
        for (int k = 0; k < DM; ++k) acc += siluf(cv[k]) * w[(size_t)k * 6 * DM];
        p.MOD[i] = acc + p.mod_b[(size_t)l * 6 * DM + n];
    }
}
__device__ __forceinline__ void filt_pos(int tt, float& rel) {
    int L = tt < SEQ ? SEQ : CTX; int t = tt < SEQ ? tt : tt - SEQ;
    rel = ((float)t - (float)(L / 2)) / (float)L;
}
__device__ void st_filt1(const Params& p, long tid, long nth) {
    const long total = (long)DEPTH * TF * 64;
    for (long i = tid; i < total; i += nth) {
        int o = (int)(i % 64); int tt = (int)((i / 64) % TF); int l = (int)(i / (64L * TF));
        float rel; filt_pos(tt, rel);
        const float* w1 = p.hy_w1 + (size_t)l * 33 * 64 + o;
        float acc = rel * w1[0];
        const float tw = 2.0f * 3.14159265358979323846f * rel;
        for (int j = 0; j < 16; ++j) {
            float band = 1e-4f + (float)j * ((15.0f - 1e-4f) / 15.0f);
            float ang = tw * band;
            acc += cosf(ang) * w1[(size_t)(1 + j) * 64];
            acc += -sinf(ang) * w1[(size_t)(17 + j) * 64];
        }
        p.H1[i] = sinf(p.hy_freq[l * 64 + o] * (acc + p.hy_b1[l * 64 + o]));
    }
}
__device__ void st_filt2(const Params& p, long tid, long nth) {
    const long total = (long)DEPTH * TF * 64;
    for (long i = tid; i < total; i += nth) {
        int o = (int)(i % 64); int l = (int)(i / (64L * TF));
        const float* h1 = p.H1 + (i - o);
        const float* w2 = p.hy_w2 + (size_t)l * 64 * 64 + o;
        float acc = 0.f;
        for (int j = 0; j < 64; ++j) acc += h1[j] * w2[(size_t)j * 64];
        p.H2[i] = sinf(p.hy_freq[l * 64 + o] * (acc + p.hy_b2[l * 64 + o]));
    }
}
__device__ void st_filt3(const Params& p, long tid, long nth) {
    const long total = (long)DEPTH * TF * 256;
    for (long i = tid; i < total; i += nth) {
        int c = (int)(i % 256); int tt = (int)((i / 256) % TF); int l = (int)(i / (256L * TF));
        float rel; filt_pos(tt, rel);
        const float* h2 = p.H2 + ((size_t)l * TF + tt) * 64;
        const float* w3 = p.hy_w3 + (size_t)l * 64 * 256 + c;
        float acc = 0.f;
        for (int j = 0; j < 64; ++j) acc += h2[j] * w3[(size_t)j * 256];
        p.HF[i] = acc * expf(-2.0f * fabsf(rel) * p.hy_decay[l * 256 + c]);
    }
}
__device__ void st_rstd(const Params& p, long tid, long nth) {
    for (long r = tid; r < NT; r += nth) {
        const float* xr = xrow(p, (int)r);
        float ss = 0.f;
        for (int k = 0; k < DM; ++k) ss += xr[k] * xr[k];
        p.RSTD[r] = 1.0f / sqrtf(ss / (float)DM + EPSV);
    }
}
__device__ void st_hx(const Params& p, int l, int which, long tid, long nth) {
    const float* g = (which ? p.norm2_g : p.norm1_g) + (size_t)l * DM;
    for (long i = tid; i < (long)NT * DM; i += nth) {
        int k = (int)(i % DM); int r = (int)(i / DM);
        const float* m = p.MOD + ((size_t)l * (NB + 1) + row_bb(r)) * 6 * DM;
        float sh = m[(which ? 3 : 0) * DM + k], sc = m[(which ? 4 : 1) * DM + k];
        float v = xrow(p, r)[k] * p.RSTD[r] * g[k];
        stact(p.Y + i, v * (1.0f + sc) + sh);
    }
}
template <int MODE>
__device__ void st_gemm(const Params& p, int l, int nrows, long tid, long nth) {
    const int N = MODE == 0 ? DIN : (MODE == 2 ? DFF : DM);
    const int K = MODE == 3 ? DFF : DM;
    const act_t* A = MODE == 3 ? p.P : p.Y;
    const int lda = MODE == 3 ? DFF : DM;
    const float* W = MODE == 0 ? p.w_in + (size_t)l * DM * DIN
                   : MODE == 1 ? p.w_out + (size_t)l * DM * DM
                   : MODE == 2 ? p.ffn_w1 + (size_t)l * DM * DFF
                               : p.ffn_w2 + (size_t)l * DFF * DM;
    const float* W3 = p.ffn_w3 + (size_t)l * DM * DFF;
    const int NQ = N / 4;
    const long total = (long)(nrows / 8) * NQ;
    for (long i = tid; i < total; i += nth) {
        const int cq = (int)(i % NQ); const int r0 = (int)(i / NQ) * 8; const int n0 = cq * 4;
        float acc[8][4]; float acc3[8][4];
#pragma unroll
        for (int a = 0; a < 8; ++a)
#pragma unroll
            for (int b = 0; b < 4; ++b) { acc[a][b] = 0.f; acc3[a][b] = 0.f; }
        for (int k = 0; k < K; ++k) {
            const float* wr = W + (size_t)k * N + n0;
            float w0 = wr[0], w1 = wr[1], w2 = wr[2], w3 = wr[3];
            float v0 = 0, v1 = 0, v2 = 0, v3 = 0;
            if (MODE == 2) { const float* w3r = W3 + (size_t)k * N + n0; v0 = w3r[0]; v1 = w3r[1]; v2 = w3r[2]; v3 = w3r[3]; }
#pragma unroll
            for (int a = 0; a < 8; ++a) {
                float av = ldact(A + (size_t)(r0 + a) * lda + k);
                acc[a][0] += av * w0; acc[a][1] += av * w1; acc[a][2] += av * w2; acc[a][3] += av * w3;
                if (MODE == 2) { acc3[a][0] += av * v0; acc3[a][1] += av * v1; acc3[a][2] += av * v2; acc3[a][3] += av * v3; }
            }
        }
        const int bb = row_bb(r0);
        const float* m = p.MOD + ((size_t)l * (NB + 1) + bb) * 6 * DM;
#pragma unroll
        for (int a = 0; a < 8; ++a) {
            const int r = r0 + a;
#pragma unroll
            for (int b = 0; b < 4; ++b) {
                const int n = n0 + b;
                if (MODE == 0) stact(p.P + (size_t)r * DIN + n, acc[a][b]);
                else if (MODE == 1) xrow(p, r)[n] += m[2 * DM + n] * acc[a][b];
                else if (MODE == 2) stact(p.P + (size_t)r * DFF + n, siluf(acc[a][b]) * acc3[a][b]);
                else xrow(p, r)[n] += m[5 * DM + n] * acc[a][b];
            }
        }
    }
}
__device__ void st_gla_logs(const Params& p, int l, long tid, long nth) {
    const long total = 2L * NT * 192;
    for (long i = tid; i < total; i += nth) {
        int col = (int)(i % 192); int r = (int)((i / 192) % NT); int dir = (int)(i / (192L * NT));
        const act_t* gk = p.P + (size_t)r * DIN + (dir ? OFF_GKB : OFF_GKF);
        const float* w = (dir ? p.gk_w_b : p.gk_w_f) + (size_t)l * 16 * 192 + col;
        float acc = (dir ? p.gk_b_b : p.gk_b_f)[l * 192 + col];
        for (int j = 0; j < 16; ++j) acc += ldact(gk + j) * w[j * 192];
        p.LG[i] = logsigmoidf(acc) * (1.0f / 16.0f);
    }
}
__device__ void st_gla_scan(const Params& p, long tid, long nth) {
    const long total = (long)NB * 6 * 64;
    for (long i = tid; i < total; i += nth) {
        const int e = (int)(i % 64); const int h = (int)((i / 64) % 6); const int b = (int)(i / 384);
        for (int dir = 0; dir < 2; ++dir) {
            float S[32];
#pragma unroll
            for (int d = 0; d < 32; ++d) S[d] = 0.f;
            const float* lg = p.LG + (size_t)dir * NT * 192;
            for (int part = 0; part < 2; ++part) {
                const int s = part == 0 ? NB + b : b;
                const int L = seq_len(s), r0 = seq_row0(s);
                for (int st = 0; st < L; ++st) {
                    const int t = dir == 0 ? st : L - 1 - st;
                    const int r = r0 + t;
                    const act_t* pr = p.P + (size_t)r * DIN;
                    const float* lr = lg + (size_t)r * 192 + h * 32;
                    const float v = ldact(pr + OFF_V + h * 64 + e);
                    float o = 0.f;
#pragma unroll
                    for (int d = 0; d < 32; ++d) {
                        S[d] = expf(lr[d]) * S[d] + ldact(pr + OFF_K + h * 32 + d) * v;
                        o += ldact(pr + OFF_Q + h * 32 + d) * S[d];
                    }
                    o *= 0.17677669529663687f;
                    float* op = p.O + (size_t)r * 384 + h * 64 + e;
                    if (dir == 0) *op = o; else *op += o;
                }
            }
        }
    }
}
__device__ void st_gla_out(const Params& p, int l, long tid, long nth) {
    const long total = (long)NT * 6;
    for (long i = tid; i < total; i += nth) {
        const int h = (int)(i % 6); const int r = (int)(i / 6);
        const float* o = p.O + (size_t)r * 384 + h * 64;
        float ss = 0.f;
        for (int e = 0; e < 64; ++e) ss += o[e] * o[e];
        const float rs = 1.0f / sqrtf(ss / 64.0f + EPSV);
        for (int e = 0; e < 64; ++e) {
            float g = ldact(p.P + (size_t)r * DIN + OFF_G + h * 64 + e);
            stact(p.Y + (size_t)r * DM + h * 64 + e, o[e] * rs * p.gla_norm_w[l * 64 + e] * siluf(g));
        }
    }
}
__device__ __forceinline__ float hy_u(const Params& p, int l, int s, int t, int j) {
    const int L = seq_len(s), r0 = seq_row0(s);
    const float* w = p.hy_short_w + (size_t)l * 3 * 768 + j;
    float acc = p.hy_short_b[l * 768 + j];
#pragma unroll
    for (int k = 0; k < 3; ++k) {
        int tt = t + k - 1;
        if (tt >= 0 && tt < L) acc += w[k * 768] * ldact(p.P + (size_t)(r0 + tt) * DIN + OFF_HY + j);
    }
    return acc;
}
__device__ void st_hy_pre(const Params& p, int l, long tid, long nth) {
    const long total = (long)NT * 256;
    for (long i = tid; i < total; i += nth) {
        const int c = (int)(i % 256); const int r = (int)(i / 256);
        const int s = r < BL ? r / SEQ : NB + (r - BL) / CTX;
        const int t = r - seq_row0(s);
        p.VX[i] = hy_u(p, l, s, t, 512 + c) * hy_u(p, l, s, t, 256 + c);
    }
}
__device__ void st_hy_conv(const Params& p, int l, long tid, long nth) {
    const long total = (long)NT * 256;
    for (long i = tid; i < total; i += nth) {
        const int c = (int)(i % 256); const int r = (int)(i / 256);
        const int s = r < BL ? r / SEQ : NB + (r - BL) / CTX;
        const int L = seq_len(s), r0 = seq_row0(s);
        const int t = r - r0;
        const float* hf = p.HF + ((size_t)l * TF + (s < NB ? 0 : SEQ)) * 256 + c;
        int jlo = t + L / 2 - (L - 1); if (jlo < 0) jlo = 0;
        int jhi = t + L / 2; if (jhi > L - 1) jhi = L - 1;
        float acc = 0.f;
        for (int j = jlo; j <= jhi; ++j)
            acc += hf[(size_t)(t - j + L / 2) * 256] * p.VX[(size_t)(r0 + j) * 256 + c];
        const float x0 = hy_u(p, l, s, t, c);
        const float y = (acc + p.VX[(size_t)r * 256 + c] * p.hy_bias[l * 256 + c]) * x0;
        stact(p.Y + (size_t)r * DM + 384 + c, y);
    }
}
__device__ void st_ssd_pre(const Params& p, int l, long tid, long nth) {
    const long total = (long)NT * 896;
    for (long i = tid; i < total; i += nth) {
        const int j = (int)(i % 896); const int q = (int)(i / 896);
        const int s = q < BL ? q / SEQ : NB + (q - BL) / CTX;
        const int L = seq_len(s), r0 = seq_row0(s);
        const int pos = q - r0;
        const float* w = p.ssd_conv_w + (size_t)l * 3 * 896 + j;
        float acc = p.ssd_conv_b[l * 896 + j];
#pragma unroll
        for (int k = 0; k < 3; ++k) {
            int pp = pos + k - 1;
            if (pp >= 0 && pp < L) acc += w[k * 896] * ldact(p.P + (size_t)(r0 + colmajor_tok(s, pp)) * DIN + OFF_XBC + j);
        }
        stact(p.XBC + (size_t)(r0 + colmajor_tok(s, pos)) * 896 + j, siluf(acc));
    }
    const long total2 = 2L * NT * 6;
    for (long i = tid; i < total2; i += nth) {
        const int hd = (int)(i % 6); const int r = (int)((i / 6) % NT); const int dir = (int)(i / (6L * NT));
        float v = ldact(p.P + (size_t)r * DIN + (dir ? OFF_DTB : OFF_DTF) + hd) + (dir ? p.ssd_dt_bias_b : p.ssd_dt_bias_f)[l * 6 + hd];
        p.DT[i] = softplusf(v);
    }
}
__device__ void st_ssd_scan(const Params& p, int l, long tid, long nth) {
    const long total = (long)NB * 6 * 64;
    for (long i = tid; i < total; i += nth) {
        const int pp = (int)(i % 64); const int hd = (int)((i / 64) % 6); const int b = (int)(i / 384);
        const int g = hd / 3;
        const float dcoef = p.ssd_d[l * 6 + hd];
        for (int dir = 0; dir < 2; ++dir) {
            const float A = -expf((dir ? p.ssd_a_log_b : p.ssd_a_log_f)[l * 6 + hd]);
            float h[128];
#pragma unroll
            for (int n = 0; n < 128; ++n) h[n] = 0.f;
            for (int part = 0; part < 2; ++part) {
                const int s = part == 0 ? NB + b : b;
                const int L = seq_len(s), r0 = seq_row0(s);
                for (int st = 0; st < L; ++st) {
                    const int pos = dir == 0 ? st : L - 1 - st;
                    const int r = r0 + colmajor_tok(s, pos);
                    const act_t* xr = p.XBC + (size_t)r * 896;
                    const float dt = p.DT[((size_t)dir * NT + r) * 6 + hd];
                    const float xs = ldact(xr + hd * 64 + pp);
                    const float ea = expf(A * dt);
                    const float xd = xs * dt;
                    float y = 0.f;
#pragma unroll
                    for (int n = 0; n < 128; ++n) {
                        h[n] = ea * h[n] + xd * ldact(xr + 384 + g * 128 + n);
                        y += h[n] * ldact(xr + 640 + g * 128 + n);
                    }
                    float* yp = p.YS + (size_t)r * 384 + hd * 64 + pp;
                    if (dir == 0) *yp = y + dcoef * xs; else *yp += y;
                }
            }
        }
    }
}
__device__ void st_ssd_out(const Params& p, int l, long tid, long nth) {
    const long total = (long)NT * 2;
    for (long i = tid; i < total; i += nth) {
        const int g = (int)(i % 2); const int r = (int)(i / 2);
        const float* ys = p.YS + (size_t)r * 384 + g * 192;
        const act_t* z = p.P + (size_t)r * DIN + OFF_Z + g * 192;
        float ss = 0.f;
        for (int j = 0; j < 192; ++j) { float v = ys[j] * siluf(ldact(z + j)); ss += v * v; }
        const float rs = 1.0f / sqrtf(ss / 192.0f + EPSV);
        for (int j = 0; j < 192; ++j) {
            float v = ys[j] * siluf(ldact(z + j));
            stact(p.Y + (size_t)r * DM + 640 + g * 192 + j, v * rs * p.ssd_norm_w[l * 384 + g * 192 + j]);
        }
    }
}
__device__ void st_final(const Params& p, long tid, long nth) {
    for (long i = tid; i < (long)BL * DM; i += nth) {
        int k = (int)(i % DM); int r = (int)(i / DM);
        p.XL[i] = p.XL[i] * p.RSTD[r] * p.final_g[k];
    }
}

enum { S_INIT, S_MOD, S_F1, S_F2, S_F3, S_RSTD, S_HX1, S_GIN, S_GLOG, S_GSCAN, S_GOUT,
       S_SPRE, S_SSCAN, S_SOUT, S_HPRE, S_HCONV, S_GOUTP, S_HX2, S_FFN1, S_FFN2, S_FINAL };

__device__ void run_stage(const Params& p, int stage, int l, long tid, long nth) {
    const int nrows = (l == DEPTH - 1) ? BL : NT;
    switch (stage) {
        case S_INIT: st_init(p, tid, nth); break;
        case S_MOD: st_mod(p, tid, nth); break;
        case S_F1: st_filt1(p, tid, nth); break;
        case S_F2: st_filt2(p, tid, nth); break;
        case S_F3: st_filt3(p, tid, nth); break;
        case S_RSTD: st_rstd(p, tid, nth); break;
        case S_HX1: st_hx(p, l, 0, tid, nth); break;
        case S_GIN: st_gemm<0>(p, l, NT, tid, nth); break;
        case S_GLOG: st_gla_logs(p, l, tid, nth); break;
        case S_GSCAN: st_gla_scan(p, tid, nth); break;
        case S_GOUT: st_gla_out(p, l, tid, nth); break;
        case S_SPRE: st_ssd_pre(p, l, tid, nth); break;
        case S_SSCAN: st_ssd_scan(p, l, tid, nth); break;
        case S_SOUT: st_ssd_out(p, l, tid, nth); break;
        case S_HPRE: st_hy_pre(p, l, tid, nth); break;
        case S_HCONV: st_hy_conv(p, l, tid, nth); break;
        case S_GOUTP: st_gemm<1>(p, l, nrows, tid, nth); break;
        case S_HX2: st_hx(p, l, 1, tid, nth); break;
        case S_FFN1: st_gemm<2>(p, l, nrows, tid, nth); break;
        case S_FFN2: st_gemm<3>(p, l, nrows, tid, nth); break;
        case S_FINAL: st_final(p, tid, nth); break;
    }
}

static const int kLayerProg[] = { S_RSTD, S_HX1, S_GIN, S_GLOG, S_GSCAN, S_GOUT, S_SPRE, S_SSCAN, S_SOUT,
                                  S_HPRE, S_HCONV, S_GOUTP, S_RSTD, S_HX2, S_FFN1, S_FFN2 };
static const int kPreProg[] = { S_INIT, S_MOD, S_F1, S_F2, S_F3 };

static inline size_t al256(size_t v) { return (v + 255) & ~(size_t)255; }
static void carve(Params& p, char* ws, float* dout) {
    size_t off = 0;
    auto take = [&](size_t bytes) { char* q = ws + off; off += al256(bytes); return q; };
    p.XL = dout;
    p.XC = (float*)take((size_t)BC * DM * 4);
    p.MOD = (float*)take((size_t)DEPTH * (NB + 1) * 6 * DM * 4);
    p.HF = (float*)take((size_t)DEPTH * TF * 256 * 4);
    p.H1 = (float*)take((size_t)DEPTH * TF * 64 * 4);
    p.H2 = (float*)take((size_t)DEPTH * TF * 64 * 4);
    p.RSTD = (float*)take((size_t)NT * 4);
    p.DT = (float*)take((size_t)2 * NT * 6 * 4);
    p.P = (act_t*)take((size_t)NT * DIN * sizeof(act_t));
    p.Y = (act_t*)take((size_t)NT * DM * sizeof(act_t));
    char* r1 = take((size_t)NT * 896 * sizeof(act_t) + (size_t)NT * 384 * 4 + 256);
    p.LG = (float*)r1;
    p.O = (float*)(r1 + al256((size_t)2 * NT * 192 * 4));
    p.XBC = (act_t*)r1;
    p.YS = (float*)(r1 + al256((size_t)NT * 896 * sizeof(act_t)));
    p.VX = (float*)r1;
}
static void fill_inputs(Params& p, void* const* d_in) {
    const float** dst = (const float**)&p;
    for (int i = 0; i < 37; ++i) dst[i] = (const float*)d_in[i];
}

#ifndef CPU_EMU
__global__ void __launch_bounds__(256) k_stage(Params p, int stage, int l) {
    run_stage(p, stage, l, (long)blockIdx.x * blockDim.x + threadIdx.x, (long)gridDim.x * blockDim.x);
}

extern "C" void kernel_launch(void* const* d_in, const int* in_sizes, int n_in, void* d_out, int out_size,
                              void* d_ws, size_t ws_size, hipStream_t stream) {
    Params p{};
    fill_inputs(p, d_in);
    carve(p, (char*)d_ws, (float*)d_out);
    const int grid = 2048;
    for (int s : kPreProg) hipLaunchKernelGGL(k_stage, dim3(grid), dim3(256), 0, stream, p, s, 0);
    for (int l = 0; l < DEPTH; ++l)
        for (int s : kLayerProg) hipLaunchKernelGGL(k_stage, dim3(grid), dim3(256), 0, stream, p, s, l);
    hipLaunchKernelGGL(k_stage, dim3(grid), dim3(256), 0, stream, p, (int)S_RSTD, 0);
    hipLaunchKernelGGL(k_stage, dim3(grid), dim3(256), 0, stream, p, (int)S_FINAL, 0);
}
#endif
```

```cpp
#ifndef CPU_EMU
#include <hip/hip_runtime.h>
#include <hip/hip_cooperative_groups.h>
#include <cstdio>
#else
#include <cmath>
#include <cstring>
#include <cstdio>
#include <cstdlib>
#define __device__
#define __global__
#define __forceinline__ inline
#define __host__
#endif
#include <stdint.h>
#include <stddef.h>

#ifndef NB
#define NB 4
#endif
#ifndef SEQ
#define SEQ 8192
#endif
#ifndef CTX
#define CTX 256
#endif
#define DEPTH 2
#define DM 1024
#define GRID_W 64
#define ROWS_G (SEQ / GRID_W)
#define BL (NB * SEQ)
#define BC (NB * CTX)
#define NT (BL + BC)
#define NSEQ (2 * NB)
#define DIN 3244
#define LDP 3328
#define NFF2 (2 * DFF)
#define OFF_Q 0
#define OFF_K 192
#define OFF_V 384
#define OFF_G 768
#define OFF_GKF 1152
#define OFF_GKB 1168
#define OFF_HY 1184
#define OFF_Z 1952
#define OFF_XBC 2336
#define OFF_DTF 3232
#define OFF_DTB 3238
#define DFF 2816
#define TF (SEQ + CTX)
#define G1N 8720
#define EPSV 1e-6f

#ifdef ACT_FP32
typedef float act_t;
__device__ __forceinline__ float ldact(const act_t* p) { return *p; }
__device__ __forceinline__ void stact(act_t* p, float v) { *p = v; }
#else
typedef unsigned short act_t;
__device__ __forceinline__ float ldact(const act_t* p) {
    union { unsigned u; float f; } x; x.u = ((unsigned)*p) << 16; return x.f;
}
__device__ __forceinline__ void stact(act_t* p, float v) {
    union { float f; unsigned u; } x; x.f = v;
    unsigned r = x.u + 0x7FFFu + ((x.u >> 16) & 1u);
    *p = (unsigned short)(r >> 16);
}
#endif

struct Params {
    const float *x, *c, *ctx, *c_ctx, *mod_w, *mod_b, *norm1_g, *norm2_g, *w_in;
    const float *gk_w_f, *gk_b_f, *gk_w_b, *gk_b_b, *gla_norm_w;
    const float *hy_short_w, *hy_short_b, *hy_w1, *hy_b1, *hy_w2, *hy_b2, *hy_w3, *hy_freq, *hy_decay, *hy_bias;
    const float *ssd_conv_w, *ssd_conv_b, *ssd_dt_bias_f, *ssd_dt_bias_b, *ssd_a_log_f, *ssd_a_log_b, *ssd_d, *ssd_norm_w;
    const float *w_out, *ffn_w1, *ffn_w3, *ffn_w2, *final_g;
    float* XL;
    float* XC;
    float* MOD;
    float* HF;
    float* H1;
    float* H2;
    float* RSTD;
    act_t* P;
    act_t* Y;
    float* LG;
    float* O;
    act_t* XBC;
    float* YS;
    float* DT;
    float* VX;
    unsigned* BAR;
    unsigned short* G1;
    unsigned short* VXT;
    float* CONV;
    float* HFC;
    unsigned short *DSG, *SSG, *DSS;
    float *DECG, *DECS;
    unsigned short *WIN_T, *WOUT_T, *W13_T, *W2_T;
};

__device__ __forceinline__ float siluf(float x) { return x / (1.0f + expf(-x)); }
__device__ __forceinline__ float softplusf(float x) { return fmaxf(x, 0.0f) + log1pf(expf(-fabsf(x))); }
__device__ __forceinline__ float logsigmoidf(float x) { return -softplusf(-x); }

__device__ __forceinline__ float* xrow(const Params& p, int r) {
    return r < BL ? p.XL + (size_t)r * DM : p.XC + (size_t)(r - BL) * DM;
}
__device__ __forceinline__ int row_bb(int r) { return r < BL ? r / SEQ : NB; }
__device__ __forceinline__ int seq_len(int s) { return s < NB ? SEQ : CTX; }
__device__ __forceinline__ int seq_row0(int s) { return s < NB ? s * SEQ : BL + (s - NB) * CTX; }
__device__ __forceinline__ int colmajor_tok(int s, int pos) {
    return s < NB ? (pos % ROWS_G) * GRID_W + pos / ROWS_G : pos;
}

__device__ void st_init(const Params& p, long tid, long nth) {
    for (long i = tid; i < (long)BL * DM; i += nth) p.XL[i] = p.x[i];
    for (long i = tid; i < (long)BC * DM; i += nth) p.XC[i] = p.ctx[i];
}
__device__ void st_mod(const Params& p, long tid, long nth) {
    const long total = (long)DEPTH * (NB + 1) * 6 * DM;
    for (long i = tid; i < total; i += nth) {
        int n = (int)(i % (6 * DM));
        int bb = (int)((i / (6 * DM)) % (NB + 1));
        int l = (int)(i / ((long)6 * DM * (NB + 1)));
        const float* cv = bb < NB ? p.c + (size_t)bb * DM : p.c_ctx;
        const float* w = p.mod_w + (size_t)l * DM * 6 * DM + n;
        float acc = 0.f;
        for (int k = 0; k < DM; ++k) acc += siluf(cv[k]) * w[(size_t)k * 6 * DM];
        p.MOD[i] = acc + p.mod_b[(size_t)l * 6 * DM + n];
    }
}
__device__ __forceinline__ void filt_pos(int tt, float& rel) {
    int L = tt < SEQ ? SEQ : CTX; int t = tt < SEQ ? tt : tt - SEQ;
    rel = ((float)t - (float)(L / 2)) / (float)L;
}
__device__ void st_filt1(const Params& p, long tid, long nth) {
    const long total = (long)DEPTH * TF * 64;
    for (long i = tid; i < total; i += nth) {
        int o = (int)(i % 64); int tt = (int)((i / 64) % TF); int l = (int)(i / (64L * TF));
        float rel; filt_pos(tt, rel);
        const float* w1 = p.hy_w1 + (size_t)l * 33 * 64 + o;
        float acc = rel * w1[0];
        const float tw = 2.0f * 3.14159265358979323846f * rel;
        for (int j = 0; j < 16; ++j) {
            float band = 1e-4f + (float)j * ((15.0f - 1e-4f) / 15.0f);
            float ang = tw * band;
            acc += cosf(ang) * w1[(size_t)(1 + j) * 64];
            acc += -sinf(ang) * w1[(size_t)(17 + j) * 64];
        }
        p.H1[i] = sinf(p.hy_freq[l * 64 + o] * (acc + p.hy_b1[l * 64 + o]));
    }
}
__device__ void st_filt2(const Params& p, long tid, long nth) {
    const long total = (long)DEPTH * TF * 64;
    for (long i = tid; i < total; i += nth) {
        int o = (int)(i % 64); int l = (int)(i / (64L * TF));
        const float* h1 = p.H1 + (i - o);
        const float* w2 = p.hy_w2 + (size_t)l * 64 * 64 + o;
        float acc = 0.f;
        for (int j = 0; j < 64; ++j) acc += h1[j] * w2[(size_t)j * 64];
        p.H2[i] = sinf(p.hy_freq[l * 64 + o] * (acc + p.hy_b2[l * 64 + o]));
    }
}
__device__ void st_filt3(const Params& p, long tid, long nth) {
    const long total = (long)DEPTH * TF * 256;
    for (long i = tid; i < total; i += nth) {
        int c = (int)(i % 256); int tt = (int)((i / 256) % TF); int l = (int)(i / (256L * TF));
        float rel; filt_pos(tt, rel);
        const float* h2 = p.H2 + ((size_t)l * TF + tt) * 64;
        const float* w3 = p.hy_w3 + (size_t)l * 64 * 256 + c;
        float acc = 0.f;
        for (int j = 0; j < 64; ++j) acc += h2[j] * w3[(size_t)j * 256];
        const float hv = acc * expf(-2.0f * fabsf(rel) * p.hy_decay[l * 256 + c]);
        p.HF[i] = hv;
#ifndef CPU_EMU
        if (tt < SEQ) { unsigned short* q = p.G1 + ((size_t)l * 256 + c) * G1N + (8456 - tt); stact(q, hv); }
#endif
    }
#ifndef CPU_EMU
    constexpr int NPAD = 265 + (G1N - 8457);
    for (long i = tid; i < (long)DEPTH * 256 * NPAD; i += nth) {
        const int k = (int)(i % NPAD); const long lc = i / NPAD;
        p.G1[lc * G1N + (k < 265 ? k : 8457 + (k - 265))] = 0;
    }
#endif
}
__device__ void st_rstd(const Params& p, long tid, long nth) {
    for (long r = tid; r < NT; r += nth) {
        const float* xr = xrow(p, (int)r);
        float ss = 0.f;
        for (int k = 0; k < DM; ++k) ss += xr[k] * xr[k];
        p.RSTD[r] = 1.0f / sqrtf(ss / (float)DM + EPSV);
    }
}
__device__ void st_hx(const Params& p, int l, int which, long tid, long nth) {
    const float* g = (which ? p.norm2_g : p.norm1_g) + (size_t)l * DM;
    for (long i = tid; i < (long)NT * DM; i += nth) {
        int k = (int)(i % DM); int r = (int)(i / DM);
        const float* m = p.MOD + ((size_t)l * (NB + 1) + row_bb(r)) * 6 * DM;
        float sh = m[(which ? 3 : 0) * DM + k], sc = m[(which ? 4 : 1) * DM + k];
        float v = xrow(p, r)[k] * p.RSTD[r] * g[k];
        stact(p.Y + i, v * (1.0f + sc) + sh);
    }
}
template <int MODE>
__device__ void st_gemm(const Params& p, int l, int nrows, long tid, long nth) {
    const int N = MODE == 0 ? DIN : (MODE == 2 ? DFF : DM);
    const int K = MODE == 3 ? DFF : DM;
    const act_t* A = MODE == 3 ? p.P : p.Y;
    const int lda = MODE == 3 ? DFF : DM;
    const float* W = MODE == 0 ? p.w_in + (size_t)l * DM * DIN
                   : MODE == 1 ? p.w_out + (size_t)l * DM * DM
                   : MODE == 2 ? p.ffn_w1 + (size_t)l * DM * DFF
                               : p.ffn_w2 + (size_t)l * DFF * DM;
    const float* W3 = p.ffn_w3 + (size_t)l * DM * DFF;
    const int NQ = N / 4;
    const long total = (long)(nrows / 8) * NQ;
    for (long i = tid; i < total; i += nth) {
        const int cq = (int)(i % NQ); const int r0 = (int)(i / NQ) * 8; const int n0 = cq * 4;
        float acc[8][4]; float acc3[8][4];
#pragma unroll
        for (int a = 0; a < 8; ++a)
#pragma unroll
            for (int b = 0; b < 4; ++b) { acc[a][b] = 0.f; acc3[a][b] = 0.f; }
        for (int k = 0; k < K; ++k) {
            const float* wr = W + (size_t)k * N + n0;
            float w0 = wr[0], w1 = wr[1], w2 = wr[2], w3 = wr[3];
            float v0 = 0, v1 = 0, v2 = 0, v3 = 0;
            if (MODE == 2) { const float* w3r = W3 + (size_t)k * N + n0; v0 = w3r[0]; v1 = w3r[1]; v2 = w3r[2]; v3 = w3r[3]; }
#pragma unroll
            for (int a = 0; a < 8; ++a) {
                float av = ldact(A + (size_t)(r0 + a) * lda + k);
                acc[a][0] += av * w0; acc[a][1] += av * w1; acc[a][2] += av * w2; acc[a][3] += av * w3;
                if (MODE == 2) { acc3[a][0] += av * v0; acc3[a][1] += av * v1; acc3[a][2] += av * v2; acc3[a][3] += av * v3; }
            }
        }
        const int bb = row_bb(r0);
        const float* m = p.MOD + ((size_t)l * (NB + 1) + bb) * 6 * DM;
#pragma unroll
        for (int a = 0; a < 8; ++a) {
            const int r = r0 + a;
#pragma unroll
            for (int b = 0; b < 4; ++b) {
                const int n = n0 + b;
                if (MODE == 0) stact(p.P + (size_t)r * LDP + n, acc[a][b]);
                else if (MODE == 1) xrow(p, r)[n] += m[2 * DM + n] * acc[a][b];
                else if (MODE == 2) stact(p.P + (size_t)r * DFF + n, siluf(acc[a][b]) * acc3[a][b]);
                else xrow(p, r)[n] += m[5 * DM + n] * acc[a][b];
            }
        }
    }
}
__device__ void st_gla_logs(const Params& p, int l, long tid, long nth) {
    const long total = 2L * NT * 192;
    for (long i = tid; i < total; i += nth) {
        int col = (int)(i % 192); int r = (int)((i / 192) % NT); int dir = (int)(i / (192L * NT));
        const act_t* gk = p.P + (size_t)r * LDP + (dir ? OFF_GKB : OFF_GKF);
        const float* w = (dir ? p.gk_w_b : p.gk_w_f) + (size_t)l * 16 * 192 + col;
        float acc = (dir ? p.gk_b_b : p.gk_b_f)[l * 192 + col];
        for (int j = 0; j < 16; ++j) acc += ldact(gk + j) * w[j * 192];
        p.LG[i] = logsigmoidf(acc) * (1.0f / 16.0f);
    }
}
__device__ void st_gla_scan(const Params& p, long tid, long nth) {
    const long total = (long)NB * 6 * 64;
    for (long i = tid; i < total; i += nth) {
        const int e = (int)(i % 64); const int h = (int)((i / 64) % 6); const int b = (int)(i / 384);
        for (int dir = 0; dir < 2; ++dir) {
            float S[32];
#pragma unroll
            for (int d = 0; d < 32; ++d) S[d] = 0.f;
            const float* lg = p.LG + (size_t)dir * NT * 192;
            for (int part = 0; part < 2; ++part) {
                const int s = part == 0 ? NB + b : b;
                const int L = seq_len(s), r0 = seq_row0(s);
                for (int st = 0; st < L; ++st) {
                    const int t = dir == 0 ? st : L - 1 - st;
                    const int r = r0 + t;
                    const act_t* pr = p.P + (size_t)r * LDP;
                    const float* lr = lg + (size_t)r * 192 + h * 32;
                    const float v = ldact(pr + OFF_V + h * 64 + e);
                    float o = 0.f;
#pragma unroll
                    for (int d = 0; d < 32; ++d) {
                        S[d] = expf(lr[d]) * S[d] + ldact(pr + OFF_K + h * 32 + d) * v;
                        o += ldact(pr + OFF_Q + h * 32 + d) * S[d];
                    }
                    o *= 0.17677669529663687f;
                    float* op = p.O + (size_t)r * 384 + h * 64 + e;
                    if (dir == 0) *op = o; else *op += o;
                }
            }
        }
    }
}
__device__ void st_gla_out(const Params& p, int l, long tid, long nth) {
    const long total = (long)NT * 6;
    for (long i = tid; i < total; i += nth) {
        const int h = (int)(i % 6); const int r = (int)(i / 6);
        const float* o = p.O + (size_t)r * 384 + h * 64;
        float ss = 0.f;
        for (int e = 0; e < 64; ++e) ss += o[e] * o[e];
        const float rs = 1.0f / sqrtf(ss / 64.0f + EPSV);
        for (int e = 0; e < 64; ++e) {
            float g = ldact(p.P + (size_t)r * LDP + OFF_G + h * 64 + e);
            stact(p.Y + (size_t)r * DM + h * 64 + e, o[e] * rs * p.gla_norm_w[l * 64 + e] * siluf(g));
        }
    }
}
__device__ __forceinline__ float hy_u(const Params& p, int l, int s, int t, int j) {
    const int L = seq_len(s), r0 = seq_row0(s);
    const float* w = p.hy_short_w + (size_t)l * 3 * 768 + j;
    float acc = p.hy_short_b[l * 768 + j];
#pragma unroll
    for (int k = 0; k < 3; ++k) {
        int tt = t + k - 1;
        if (tt >= 0 && tt < L) acc += w[k * 768] * ldact(p.P + (size_t)(r0 + tt) * LDP + OFF_HY + j);
    }
    return acc;
}
__device__ void st_hy_pre(const Params& p, int l, long tid, long nth, int r_lo = 0, int r_hi = NT) {
    const long total = (long)(r_hi - r_lo) * 256;
    for (long i = tid; i < total; i += nth) {
        const int c = (int)(i % 256); const int r = r_lo + (int)(i / 256);
        const int s = r < BL ? r / SEQ : NB + (r - BL) / CTX;
        const int t = r - seq_row0(s);
        p.VX[(size_t)r * 256 + c] = hy_u(p, l, s, t, 512 + c) * hy_u(p, l, s, t, 256 + c);
    }
}
__device__ void st_hy_conv(const Params& p, int l, long tid, long nth, int r_lo = 0, int r_hi = NT) {
    const long total = (long)(r_hi - r_lo) * 256;
    for (long i = tid; i < total; i += nth) {
        const int c = (int)(i % 256); const int r = r_lo + (int)(i / 256);
        const int s = r < BL ? r / SEQ : NB + (r - BL) / CTX;
        const int L = seq_len(s), r0 = seq_row0(s);
        const int t = r - r0;
        const float* hf = p.HF + ((size_t)l * TF + (s < NB ? 0 : SEQ)) * 256 + c;
        int jlo = t + L / 2 - (L - 1); if (jlo < 0) jlo = 0;
        int jhi = t + L / 2; if (jhi > L - 1) jhi = L - 1;
        float acc = 0.f;
        for (int j = jlo; j <= jhi; ++j)
            acc += hf[(size_t)(t - j + L / 2) * 256] * p.VX[(size_t)(r0 + j) * 256 + c];
        const float x0 = hy_u(p, l, s, t, c);
        const float y = (acc + p.VX[(size_t)r * 256 + c] * p.hy_bias[l * 256 + c]) * x0;
        stact(p.Y + (size_t)r * DM + 384 + c, y);
    }
}
__device__ void st_ssd_pre(const Params& p, int l, long tid, long nth) {
    const long total = (long)NT * 896;
    for (long i = tid; i < total; i += nth) {
        const int j = (int)(i % 896); const int q = (int)(i / 896);
        const int s = q < BL ? q / SEQ : NB + (q - BL) / CTX;
        const int L = seq_len(s), r0 = seq_row0(s);
        const int pos = q - r0;
        const float* w = p.ssd_conv_w + (size_t)l * 3 * 896 + j;
        float acc = p.ssd_conv_b[l * 896 + j];
#pragma unroll
        for (int k = 0; k < 3; ++k) {
            int pp = pos + k - 1;
            if (pp >= 0 && pp < L) acc += w[k * 896] * ldact(p.P + (size_t)(r0 + colmajor_tok(s, pp)) * LDP + OFF_XBC + j);
        }
        stact(p.XBC + (size_t)(r0 + colmajor_tok(s, pos)) * 896 + j, siluf(acc));
    }
    const long total2 = 2L * NT * 6;
    for (long i = tid; i < total2; i += nth) {
        const int hd = (int)(i % 6); const int r = (int)((i / 6) % NT); const int dir = (int)(i / (6L * NT));
        float v = ldact(p.P + (size_t)r * LDP + (dir ? OFF_DTB : OFF_DTF) + hd) + (dir ? p.ssd_dt_bias_b : p.ssd_dt_bias_f)[l * 6 + hd];
        p.DT[i] = softplusf(v);
    }
}
__device__ void st_ssd_scan(const Params& p, int l, long tid, long nth) {
    const long total = (long)NB * 6 * 64;
    for (long i = tid; i < total; i += nth) {
        const int pp = (int)(i % 64); const int hd = (int)((i / 64) % 6); const int b = (int)(i / 384);
        const int g = hd / 3;
        const float dcoef = p.ssd_d[l * 6 + hd];
        for (int dir = 0; dir < 2; ++dir) {
            const float A = -expf((dir ? p.ssd_a_log_b : p.ssd_a_log_f)[l * 6 + hd]);
            float h[128];
#pragma unroll
            for (int n = 0; n < 128; ++n) h[n] = 0.f;
            for (int part = 0; part < 2; ++part) {
                const int s = part == 0 ? NB + b : b;
                const int L = seq_len(s), r0 = seq_row0(s);
                for (int st = 0; st < L; ++st) {
                    const int pos = dir == 0 ? st : L - 1 - st;
                    const int r = r0 + colmajor_tok(s, pos);
                    const act_t* xr = p.XBC + (size_t)r * 896;
                    const float dt = p.DT[((size_t)dir * NT + r) * 6 + hd];
                    const float xs = ldact(xr + hd * 64 + pp);
                    const float ea = expf(A * dt);
                    const float xd = xs * dt;
                    float y = 0.f;
#pragma unroll
                    for (int n = 0; n < 128; ++n) {
                        h[n] = ea * h[n] + xd * ldact(xr + 384 + g * 128 + n);
                        y += h[n] * ldact(xr + 640 + g * 128 + n);
                    }
                    float* yp = p.YS + (size_t)r * 384 + hd * 64 + pp;
                    if (dir == 0) *yp = y + dcoef * xs; else *yp += y;
                }
            }
        }
    }
}
__device__ void st_ssd_out(const Params& p, int l, long tid, long nth) {
    const long total = (long)NT * 2;
    for (long i = tid; i < total; i += nth) {
        const int g = (int)(i % 2); const int r = (int)(i / 2);
        const float* ys = p.YS + (size_t)r * 384 + g * 192;
        const act_t* z = p.P + (size_t)r * LDP + OFF_Z + g * 192;
        float ss = 0.f;
        for (int j = 0; j < 192; ++j) { float v = ys[j] * siluf(ldact(z + j)); ss += v * v; }
        const float rs = 1.0f / sqrtf(ss / 192.0f + EPSV);
        for (int j = 0; j < 192; ++j) {
            float v = ys[j] * siluf(ldact(z + j));
            stact(p.Y + (size_t)r * DM + 640 + g * 192 + j, v * rs * p.ssd_norm_w[l * 384 + g * 192 + j]);
        }
    }
}
__device__ void st_final(const Params& p, long tid, long nth) {
    for (long i = tid; i < (long)BL * DM; i += nth) {
        int k = (int)(i % DM); int r = (int)(i / DM);
        p.XL[i] = p.XL[i] * p.RSTD[r] * p.final_g[k];
    }
}

enum { S_INIT, S_MOD, S_F1, S_F2, S_F3, S_RSTD, S_HX1, S_GIN, S_GLOG, S_GSCAN, S_GOUT,
       S_SPRE, S_SSCAN, S_SOUT, S_HPRE, S_HCONV, S_GOUTP, S_HX2, S_FFN1, S_FFN2, S_FINAL };

__device__ void run_stage(const Params& p, int stage, int l, long tid, long nth) {
    const int nrows = (l == DEPTH - 1) ? BL : NT;
    switch (stage) {
        case S_INIT: st_init(p, tid, nth); break;
        case S_MOD: st_mod(p, tid, nth); break;
        case S_F1: st_filt1(p, tid, nth); break;
        case S_F2: st_filt2(p, tid, nth); break;
        case S_F3: st_filt3(p, tid, nth); break;
        case S_RSTD: st_rstd(p, tid, nth); break;
        case S_HX1: st_hx(p, l, 0, tid, nth); break;
        case S_GIN: st_gemm<0>(p, l, NT, tid, nth); break;
        case S_GLOG: st_gla_logs(p, l, tid, nth); break;
        case S_GSCAN: st_gla_scan(p, tid, nth); break;
        case S_GOUT: st_gla_out(p, l, tid, nth); break;
        case S_SPRE: st_ssd_pre(p, l, tid, nth); break;
        case S_SSCAN: st_ssd_scan(p, l, tid, nth); break;
        case S_SOUT: st_ssd_out(p, l, tid, nth); break;
        case S_HPRE: st_hy_pre(p, l, tid, nth); break;
        case S_HCONV: st_hy_conv(p, l, tid, nth); break;
        case S_GOUTP: st_gemm<1>(p, l, nrows, tid, nth); break;
        case S_HX2: st_hx(p, l, 1, tid, nth); break;
        case S_FFN1: st_gemm<2>(p, l, nrows, tid, nth); break;
        case S_FFN2: st_gemm<3>(p, l, nrows, tid, nth); break;
        case S_FINAL: st_final(p, tid, nth); break;
    }
}

static const int kLayerProg[] = { S_RSTD, S_HX1, S_GIN, S_GLOG, S_GSCAN, S_GOUT, S_SPRE, S_SSCAN, S_SOUT,
                                  S_HPRE, S_HCONV, S_GOUTP, S_RSTD, S_HX2, S_FFN1, S_FFN2 };
static const int kPreProg[] = { S_INIT, S_MOD, S_F1, S_F2, S_F3 };

static inline size_t al256(size_t v) { return (v + 255) & ~(size_t)255; }
static void carve(Params& p, char* ws, float* dout) {
    size_t off = 0;
    auto take = [&](size_t bytes) { char* q = ws + off; off += al256(bytes); return q; };
    p.XL = dout;
    p.XC = (float*)take((size_t)BC * DM * 4);
    p.MOD = (float*)take((size_t)DEPTH * (NB + 1) * 6 * DM * 4);
#ifdef CPU_EMU
    p.HF = (float*)take((size_t)DEPTH * TF * 256 * 4);
    p.RSTD = (float*)take((size_t)NT * 4);
    p.DT = (float*)take((size_t)2 * NT * 6 * 4);
#endif
    p.H1 = (float*)take((size_t)DEPTH * TF * 64 * 4);
    p.H2 = (float*)take((size_t)DEPTH * TF * 64 * 4);
    p.P = (act_t*)take((size_t)NT * LDP * sizeof(act_t));
    p.Y = (act_t*)take((size_t)NT * DM * sizeof(act_t));
#ifdef CPU_EMU
    char* r1 = take((size_t)NT * 896 * sizeof(act_t) + (size_t)NT * 384 * 4 + 256);
#else
    char* r1 = take((size_t)101 << 20);
#endif
    p.LG = (float*)r1;
    p.O = (float*)(r1 + al256((size_t)2 * NT * 192 * 4));
    p.XBC = (act_t*)r1;
    p.YS = (float*)(r1 + al256((size_t)NT * 896 * sizeof(act_t)));
#ifdef CPU_EMU
    p.VX = (float*)r1;
#else
    {
        char* q = r1;
        p.DSG = (unsigned short*)q; q += al256((size_t)2 * NB * 6 * ((CTX + SEQ) / 64) * 2048 * 2);
        p.SSG = (unsigned short*)q; q += al256((size_t)2 * NB * 6 * ((CTX + SEQ) / 64) * 2048 * 2);
        p.DECG = (float*)q; q += al256((size_t)2 * NB * 6 * ((CTX + SEQ) / 64) * 32 * 4);
        p.DSS = (unsigned short*)q; q += al256((size_t)2 * NB * 6 * ((CTX + SEQ) / 128) * 8192 * 2);
        p.DECS = (float*)q; q += al256((size_t)2 * NB * 6 * ((CTX + SEQ) / 128) * 4);
    }
    p.VXT = (unsigned short*)take((size_t)NB * 256 * SEQ * 2);
    p.CONV = (float*)take((size_t)NB * 256 * SEQ * 4);
    p.VX = (float*)take((size_t)BC * 256 * 4) - (size_t)BL * 256;
    p.HFC = (float*)take((size_t)DEPTH * CTX * 256 * 4);
#endif
    p.G1 = (unsigned short*)take((size_t)DEPTH * 256 * G1N * 2);
    p.BAR = (unsigned*)take(16384);
    p.WIN_T = (unsigned short*)take((size_t)DEPTH * LDP * DM * 2);
    p.WOUT_T = (unsigned short*)take((size_t)DEPTH * DM * DM * 2);
    p.W13_T = (unsigned short*)take((size_t)DEPTH * NFF2 * DM * 2);
    p.W2_T = (unsigned short*)take((size_t)DEPTH * DM * DFF * 2);
}
static void fill_inputs(Params& p, void* const* d_in) {
    const float** dst = (const float**)&p;
    for (int i = 0; i < 37; ++i) dst[i] = (const float*)d_in[i];
}

#ifndef CPU_EMU
namespace pg8 {
#define PG8_LAS __attribute__((address_space(3)))
typedef unsigned short bf16_t;
typedef short bf16x8 __attribute__((ext_vector_type(8)));
typedef float f32x4 __attribute__((ext_vector_type(4)));
typedef unsigned u32x4 __attribute__((ext_vector_type(4)));
constexpr int BM = 256, BK = 64, HALF = 128, HTB = HALF * BK * 2  , STAGE_BYTES = 8 * HTB, NXCD = 8, WGM = 8;

__host__ __device__ __forceinline__ int lds_byte(int r, int c) { const int st = (r >> 4) * 2 + (c >> 5), rr = r & 15, cc = c & 31, ob = rr * 64 + cc * 2; return st * 1024 + (ob ^ (((ob >> 9) & 1) << 5)); }
__host__ __device__ __forceinline__ void stage_rc(int b, int& R, int& C) { const int st = b / 1024, sb = b % 1024, swz = sb ^ (((sb >> 9) & 1) << 5); R = (st >> 1) * 16 + swz / 64; C = (st & 1) * 32 + (swz % 64) / 2; }
__host__ __device__ __forceinline__ int perm32(int rho) { const int n = rho >> 4, i = rho & 15; return 8 * (i >> 2) + 4 * n + (i & 3); }

struct Unit { int pm, pn, kb; };
struct Gemm { const bf16_t* A; const bf16_t* Bt; int M, N, K, ld; };

struct StaticOrder {
    int nM, nN, nwg, G, c;
    __host__ __device__ void init(int M, int N, int G_, int c_) { nM = M / BM; nN = N / BM; nwg = nM * nN; G = G_; c = c_; }
    __host__ __device__ bool next(int i, Unit& u) const {
        const long L = (long)i * G + c; if (L >= nwg) return false;
        int wgid = (int)L; { const int q = nwg / NXCD, r = nwg % NXCD, xcd = wgid % NXCD, off = wgid / NXCD; wgid = (xcd < r ? xcd * (q + 1) : r * (q + 1) + (xcd - r) * q) + off; }
        const int nig = WGM * nN, gid = wgid / nig, fm = gid * WGM, gsz = (nM - fm) < WGM ? (nM - fm) : WGM;
        u.pm = fm + ((wgid % nig) % gsz); u.pn = (wgid % nig) / gsz; u.kb = 0; return true;
    }
    __device__ __forceinline__ void a_ready(const Unit&) const {}
    __device__ __forceinline__ void done(const Unit&) const {}
};

__device__ __forceinline__ unsigned cvt_pk_bf16(float lo, float hi) { unsigned r; asm volatile("v_cvt_pk_bf16_f32 %0, %1, %2" : "=v"(r) : "v"(lo), "v"(hi)); return r; }
typedef float f32x2 __attribute__((ext_vector_type(2)));
__device__ __forceinline__ f32x2 gelu_pk(f32x2 v) {
    const f32x2 av = __builtin_elementwise_abs(v), d = av * 0.2316418882f + 1.0f;
    f32x2 t; t.x = __builtin_amdgcn_rcpf(d.x); t.y = __builtin_amdgcn_rcpf(d.y);
    f32x2 q = t * 0.5307027145f + (-0.7265760135f); q = q * t + 0.7107068705f; q = q * t + (-0.142248368f); q = q * t + 0.127414796f; q = q * t;
    const f32x2 s = (v * v) * (-0.72134752044f);
    f32x2 e; e.x = __builtin_amdgcn_exp2f(s.x); e.y = __builtin_amdgcn_exp2f(s.y);
    const f32x2 m = v * (q * e), r = v - m;
    f32x2 o; o.x = v.x < 0.f ? m.x : r.x; o.y = v.y < 0.f ? m.y : r.y; return o;
}

template <int ACT  > struct EpiBf16 {
    static constexpr bool PERM = true, AFTER_DRAIN = false; static_assert(ACT == 0 || ACT == 1, "EpiBf16: ACT is 0 (none) or 1 (gelu_pk)");
    bf16_t* O; int ldc; const float* bias; int split_cols; size_t split_stride; float scale0;
    __device__ __forceinline__ void operator()(const f32x4 (&acc)[2][2][4][2], const Unit& u, int wr, int wc, int fr, int fq) const {
        const int row0 = u.pm * BM + wr * 64 + fr; int colt = u.pn * BM; bf16_t* base = O;
        float sc = 1.f; if (split_cols) { const int t = colt / split_cols; base += (size_t)t * split_stride; colt -= t * split_cols; if (t == 0) sc = scale0; }
        const int col0 = colt + wc * 32 + 8 * fq, bcol0 = u.pn * BM + wc * 32 + 8 * fq;
        f32x4 bv[2][2];
#pragma unroll
        for (int bj = 0; bj < 2; ++bj)
#pragma unroll
            for (int n = 0; n < 2; ++n) bv[bj][n] = bias ? *(const f32x4*)(bias + bcol0 + bj * HALF + 4 * n) : (f32x4){0.f, 0.f, 0.f, 0.f};
#pragma unroll
        for (int ai = 0; ai < 2; ++ai)
#pragma unroll
            for (int m = 0; m < 4; ++m) { bf16_t* rowp = base + (size_t)(row0 + ai * HALF + m * 16) * ldc + col0;
#pragma unroll
                for (int bj = 0; bj < 2; ++bj) { f32x4 v0 = acc[ai][bj][m][0] + bv[bj][0], v1 = acc[ai][bj][m][1] + bv[bj][1];
                    if (ACT == 1) { f32x2 a = gelu_pk((f32x2){v0[0], v0[1]}), b = gelu_pk((f32x2){v0[2], v0[3]}), c = gelu_pk((f32x2){v1[0], v1[1]}), d = gelu_pk((f32x2){v1[2], v1[3]});
                        v0 = (f32x4){a.x, a.y, b.x, b.y}; v1 = (f32x4){c.x, c.y, d.x, d.y}; }
                    v0 = v0 * sc; v1 = v1 * sc; u32x4 w; w.x = cvt_pk_bf16(v0[0], v0[1]); w.y = cvt_pk_bf16(v0[2], v0[3]); w.z = cvt_pk_bf16(v1[0], v1[1]); w.w = cvt_pk_bf16(v1[2], v1[3]);
                    *(u32x4*)(rowp + bj * HALF) = w; } }
    }
};
template <class Epi, class Sched, bool ALIGN_EPI = false, bool SP2 = false>
__device__ __forceinline__ void gemm_phase(PG8_LAS unsigned char* lds, const Gemm g, const Sched& S, const Epi& E, int tid_o) {
    asm volatile("" : "+v"(tid_o));
    const int tid = tid_o, wid = __builtin_amdgcn_readfirstlane(tid >> 6), lane = tid & 63, wr = wid >> 2, wc = wid & 3, fr = lane & 15, fq = lane >> 4;
    const int K = g.ld, nt = g.K / BK;
    unsigned voffA[2], voffB[2];
#pragma unroll
    for (int i = 0; i < 2; ++i) { int R, C; stage_rc(tid * 16 + i * 8192, R, C); const int Rb = Epi::PERM ? ((R & ~31) + perm32(R & 31)) : R;
        voffA[i] = (unsigned)(R * K + C) * 2u; voffB[i] = (unsigned)(Rb * K + C) * 2u; }
    const size_t kstep = (size_t)(BK * 2);
    const size_t hstep = (size_t)HALF * K * 2;
    const size_t tstep = 2 * hstep;
    const unsigned ldsw = (unsigned)wid * 1024u;
    const int aoff = lds_byte(wr * 64 + fr, fq * 8), boff = lds_byte(wc * 32 + fr, fq * 8);
#define PG8_SA(b, h) (((b) * 2 + (h)) * HTB)
#define PG8_SB(b, h) ((4 + (b) * 2 + (h)) * HTB)
#define PG8_STAGE(bufoff, gbase, voff) do { _Pragma("unroll") for (int _i = 0; _i < 2; ++_i) \
        __builtin_amdgcn_global_load_lds((const unsigned*)((const char*)(gbase) + (voff)[_i]), (PG8_LAS unsigned*)(lds + (bufoff) + ldsw + _i * 8192), 16, 0, 0); } while (0)
#define PG8_LDA(dst, b, h) do { _Pragma("unroll") for (int m = 0; m < 4; ++m) _Pragma("unroll") for (int k = 0; k < 2; ++k) dst[m][k] = *(const PG8_LAS bf16x8*)(lds + PG8_SA(b, h) + aoff + m * 2048 + k * 1024); } while (0)
#define PG8_LDB(dst, b, h) do { _Pragma("unroll") for (int n = 0; n < 2; ++n) _Pragma("unroll") for (int k = 0; k < 2; ++k) dst[n][k] = *(const PG8_LAS bf16x8*)(lds + PG8_SB(b, h) + boff + n * 2048 + k * 1024); } while (0)
#define PG8_MMA(ai, bj, At, Bt) do { __builtin_amdgcn_s_setprio(1); _Pragma("unroll") for (int m = 0; m < 4; ++m) _Pragma("unroll") for (int n = 0; n < 2; ++n) _Pragma("unroll") for (int k = 0; k < 2; ++k) \
        acc[ai][bj][m][n] = __builtin_amdgcn_mfma_f32_16x16x32_bf16(Bt[n][k], At[m][k], acc[ai][bj][m][n], 0, 0, 0); __builtin_amdgcn_s_setprio(0); } while (0)
#define PG8_WAIT_V(n) asm volatile("s_waitcnt vmcnt(" #n ")" ::: "memory")
#define PG8_WAIT_L(n) asm volatile("s_waitcnt lgkmcnt(" #n ")" ::: "memory")
#define PG8_BAR __builtin_amdgcn_s_barrier()
#define PG8_SCHED __builtin_amdgcn_sched_barrier(0)
    Unit cur, nxt; int ui = 0;
    if (!S.next(0, cur)) return;
    f32x4 acc[2][2][4][2];
#pragma unroll
    for (int a = 0; a < 2; ++a)
#pragma unroll
        for (int b = 0; b < 2; ++b)
#pragma unroll
            for (int m = 0; m < 4; ++m)
#pragma unroll
                for (int n = 0; n < 2; ++n) acc[a][b][m][n] = (f32x4){0.f, 0.f, 0.f, 0.f};
    bf16x8 At[4][2], B0[2][2], B1[2][2];
    const char* cA = (const char*)g.A + (size_t)cur.pm * tstep + cur.kb; const char* cB = (const char*)g.Bt + (size_t)cur.pn * tstep + cur.kb;
    S.a_ready(cur);
    if constexpr (SP2) {
        PG8_STAGE(PG8_SB(0, 0), cB, voffB); PG8_STAGE(PG8_SB(0, 1), cB + hstep, voffB); PG8_STAGE(PG8_SA(0, 0), cA, voffA); PG8_STAGE(PG8_SA(0, 1), cA + hstep, voffA);
        if (wr == 1) PG8_BAR;
        PG8_WAIT_V(2); PG8_BAR;
        PG8_STAGE(PG8_SB(1, 0), cB + kstep, voffB); PG8_STAGE(PG8_SA(1, 0), cA + kstep, voffA); PG8_STAGE(PG8_SB(1, 1), cB + hstep + kstep, voffB);
        PG8_WAIT_V(6); PG8_BAR;
    } else {
        PG8_STAGE(PG8_SB(0, 0), cB, voffB); PG8_STAGE(PG8_SA(0, 0), cA, voffA); PG8_STAGE(PG8_SB(0, 1), cB + hstep, voffB); PG8_STAGE(PG8_SA(0, 1), cA + hstep, voffA);
        if (wr == 1) PG8_BAR;
        PG8_WAIT_V(4); PG8_BAR;
        PG8_STAGE(PG8_SB(1, 0), cB + kstep, voffB); PG8_STAGE(PG8_SA(1, 0), cA + kstep, voffA); PG8_STAGE(PG8_SB(1, 1), cB + hstep + kstep, voffB);
        PG8_WAIT_V(6); PG8_BAR;
    }
    for (;;) {
        const bool has_next = S.next(ui + 1, nxt);
        const char* nA = has_next ? (const char*)g.A + (size_t)nxt.pm * tstep + nxt.kb : cA; const char* nB = has_next ? (const char*)g.Bt + (size_t)nxt.pn * tstep + nxt.kb : cB;
        for (int t = 0; t < nt; t += 2) {
            const bool last = (t == nt - 2);
            const char* a1 = cA + (size_t)(t + 1) * kstep;
            const char* a2 = last ? nA : cA + (size_t)(t + 2) * kstep; const char* b2 = last ? nB : cB + (size_t)(t + 2) * kstep;
            const char* a3 = a2 + kstep; const char* b3 = b2 + kstep;
            if (last && has_next) S.a_ready(nxt);
            if constexpr (SP2) {
            PG8_LDB(B0, 0, 0); PG8_LDB(B1, 0, 1); PG8_SCHED; PG8_LDA(At, 0, 0); PG8_STAGE(PG8_SA(1, 1), a1 + hstep, voffA);
            PG8_WAIT_V(8); PG8_WAIT_L(0); PG8_BAR; PG8_MMA(0, 0, At, B0); PG8_MMA(0, 1, At, B1); PG8_BAR; PG8_SCHED;
            PG8_LDA(At, 0, 1); PG8_STAGE(PG8_SB(0, 0), b2, voffB); PG8_STAGE(PG8_SB(0, 1), b2 + hstep, voffB); PG8_STAGE(PG8_SA(0, 0), a2, voffA);
            PG8_WAIT_V(8); PG8_WAIT_L(0); PG8_BAR; PG8_MMA(1, 0, At, B0); PG8_MMA(1, 1, At, B1); PG8_BAR; PG8_SCHED;
            PG8_LDB(B0, 1, 0); PG8_LDB(B1, 1, 1); PG8_SCHED; PG8_LDA(At, 1, 0); PG8_STAGE(PG8_SA(0, 1), a2 + hstep, voffA);
            PG8_WAIT_V(8); PG8_WAIT_L(0); PG8_BAR; PG8_MMA(0, 0, At, B0); PG8_MMA(0, 1, At, B1); PG8_BAR; PG8_SCHED;
            PG8_LDA(At, 1, 1); PG8_STAGE(PG8_SB(1, 0), b3, voffB); PG8_STAGE(PG8_SB(1, 1), b3 + hstep, voffB); PG8_STAGE(PG8_SA(1, 0), a3, voffA);
            PG8_WAIT_V(8); PG8_WAIT_L(0); PG8_BAR; PG8_MMA(1, 0, At, B0); PG8_MMA(1, 1, At, B1); PG8_BAR; PG8_SCHED;
            } else {
            PG8_LDB(B0, 0, 0); PG8_SCHED; PG8_LDA(At, 0, 0); PG8_STAGE(PG8_SA(1, 1), a1 + hstep, voffA);
            PG8_WAIT_L(8); PG8_BAR; PG8_WAIT_L(0); PG8_MMA(0, 0, At, B0); PG8_BAR; PG8_SCHED;
            PG8_LDB(B1, 0, 1); PG8_STAGE(PG8_SB(0, 0), b2, voffB);
            PG8_BAR; PG8_WAIT_L(0); PG8_MMA(0, 1, At, B1); PG8_BAR;
            PG8_LDA(At, 0, 1); PG8_STAGE(PG8_SA(0, 0), a2, voffA);
            PG8_BAR; PG8_WAIT_L(0); PG8_MMA(1, 0, At, B0); PG8_BAR; PG8_SCHED;
            PG8_STAGE(PG8_SB(0, 1), b2 + hstep, voffB);
            PG8_WAIT_V(6); PG8_BAR; PG8_MMA(1, 1, At, B1); PG8_BAR;
            PG8_LDB(B0, 1, 0); PG8_SCHED; PG8_LDA(At, 1, 0); PG8_STAGE(PG8_SA(0, 1), a2 + hstep, voffA);
            PG8_WAIT_L(8); PG8_BAR; PG8_WAIT_L(0); PG8_MMA(0, 0, At, B0); PG8_BAR; PG8_SCHED;
            PG8_LDB(B1, 1, 1); PG8_STAGE(PG8_SB(1, 0), b3, voffB);
            PG8_BAR; PG8_WAIT_L(0); PG8_MMA(0, 1, At, B1); PG8_BAR;
            PG8_LDA(At, 1, 1); PG8_STAGE(PG8_SA(1, 0), a3, voffA);
            PG8_BAR; PG8_WAIT_L(0); PG8_MMA(1, 0, At, B0); PG8_BAR; PG8_SCHED;
            PG8_STAGE(PG8_SB(1, 1), b3 + hstep, voffB);
            PG8_WAIT_V(6); PG8_BAR; PG8_MMA(1, 1, At, B1); PG8_BAR;
            }
        }
        if constexpr (ALIGN_EPI) { if (wr == 0) PG8_BAR; }
        if constexpr (!Epi::AFTER_DRAIN) {
            unsigned z_ = 0u; asm volatile("" : "+v"(z_)); const int le_ = (int)__builtin_amdgcn_mbcnt_hi(~0u, __builtin_amdgcn_mbcnt_lo(~0u, z_));
            E(acc, cur, wr, wc, le_ & 15, le_ >> 4); S.done(cur); }
        if (!has_next) break;
#pragma unroll
        for (int a = 0; a < 2; ++a)
#pragma unroll
            for (int b = 0; b < 2; ++b)
#pragma unroll
                for (int m = 0; m < 4; ++m)
#pragma unroll
                    for (int n = 0; n < 2; ++n) acc[a][b][m][n] = (f32x4){0.f, 0.f, 0.f, 0.f};
        cur = nxt; cA = nA; cB = nB; ++ui;
        if constexpr (ALIGN_EPI) { if (wr == 1) PG8_BAR; }
    }
    PG8_WAIT_V(0);
    if constexpr (!ALIGN_EPI) { if (wr == 0) PG8_BAR; }
    PG8_BAR;
    if constexpr (Epi::AFTER_DRAIN) { E.fused(acc, cur, wr, wc, fr, fq, lds, wid, lane); S.done(cur); }
#undef PG8_SA
#undef PG8_SB
#undef PG8_STAGE
#undef PG8_LDA
#undef PG8_LDB
#undef PG8_MMA
#undef PG8_WAIT_V
#undef PG8_WAIT_L
#undef PG8_BAR
#undef PG8_SCHED
}
}

namespace pg8 {
struct EpiRes {
    static constexpr bool PERM = false, AFTER_DRAIN = false;
    float* XL; float* XC; const float* modl; int chunk; const float* SL; const float* SC;
    __device__ __forceinline__ void operator()(const f32x4 (&acc)[2][2][4][2], const Unit& u, int wr, int wc, int fr, int fq) const {
        asm volatile("" : "+v"(fr), "+v"(fq));
        const int rt0 = u.pm * BM;
        const int bb = rt0 < BL ? rt0 / SEQ : NB;
        const float* gate = modl + ((size_t)bb * 6 + chunk) * DM;
        float* xb = rt0 < BL ? XL + (size_t)rt0 * DM : XC + (size_t)(rt0 - BL) * DM;
        const float* sb = rt0 < BL ? SL + (size_t)rt0 * DM : SC + (size_t)(rt0 - BL) * DM;
        const int col0 = u.pn * BM + wc * 32 + fq * 4;
        f32x4 gv[2][2];
#pragma unroll
        for (int bj = 0; bj < 2; ++bj)
#pragma unroll
            for (int n = 0; n < 2; ++n) gv[bj][n] = *(const f32x4*)(gate + col0 + bj * HALF + n * 16);
#pragma unroll
        for (int ai = 0; ai < 2; ++ai)
#pragma unroll
            for (int m = 0; m < 4; ++m) {
                const size_t ro = (size_t)(wr * 64 + fr + ai * HALF + m * 16) * DM + col0;
#pragma unroll
                for (int bj = 0; bj < 2; ++bj)
#pragma unroll
                    for (int n = 0; n < 2; ++n) *(f32x4*)(xb + ro + bj * HALF + n * 16) = *(const f32x4*)(sb + ro + bj * HALF + n * 16) + gv[bj][n] * acc[ai][bj][m][n];
            }
    }
};
struct EpiSwiGLU {
    static constexpr bool PERM = true, AFTER_DRAIN = false;
    bf16_t* H;
    __device__ __forceinline__ void operator()(const f32x4 (&acc)[2][2][4][2], const Unit& u, int wr, int wc, int fr, int fq) const {
        asm volatile("" : "+v"(fr), "+v"(fq));
        const int row0 = u.pm * BM + wr * 64 + fr, hc0 = u.pn * HALF + wc * 32 + 8 * fq;
#pragma unroll
        for (int ai = 0; ai < 2; ++ai)
#pragma unroll
            for (int m = 0; m < 4; ++m) {
                bf16_t* rowp = H + (size_t)(row0 + ai * HALF + m * 16) * DFF + hc0;
                f32x4 v[2];
#pragma unroll
                for (int n = 0; n < 2; ++n)
#pragma unroll
                    for (int i = 0; i < 4; ++i) { const float a = acc[ai][0][m][n][i]; v[n][i] = a * __builtin_amdgcn_rcpf(1.0f + __expf(-a)) * acc[ai][1][m][n][i]; }
                u32x4 w; w.x = cvt_pk_bf16(v[0][0], v[0][1]); w.y = cvt_pk_bf16(v[0][2], v[0][3]); w.z = cvt_pk_bf16(v[1][0], v[1][1]); w.w = cvt_pk_bf16(v[1][2], v[1][3]);
                *(u32x4*)rowp = w;
            }
    }
};
}


namespace pg8 {
struct SplitKOrder {
    int nM, nN, S, ksl, nun, G, c;
    __device__ void init(int M, int N, int S_, int kslice_elems, int G_, int c_) { nM = M / BM; nN = N / BM; S = S_; ksl = kslice_elems; nun = nM * nN * S; G = G_; c = c_; }
    __device__ bool next(int i, Unit& u) const {
        const int L = i * G + c; if (L >= nun) return false;
        const int sl = L % S, t = L / S; u.pm = t % nM; u.pn = t / nM; u.kb = sl * ksl * 2; return true;
    }
    __device__ __forceinline__ void a_ready(const Unit&) const {}
    __device__ __forceinline__ void done(const Unit&) const {}
};
struct EpiSlab {
    static constexpr bool PERM = false, AFTER_DRAIN = false;
    float* SLAB; int rows, kslice_bytes;
    __device__ __forceinline__ void operator()(const f32x4 (&acc)[2][2][4][2], const Unit& u, int wr, int wc, int fr, int fq) const {
        asm volatile("" : "+v"(fr), "+v"(fq));
        float* xb = SLAB + ((size_t)(u.kb / kslice_bytes) * rows + (size_t)u.pm * BM) * DM;
        const int col0 = u.pn * BM + wc * 32 + fq * 4;
#pragma unroll
        for (int ai = 0; ai < 2; ++ai)
#pragma unroll
            for (int m = 0; m < 4; ++m) {
                const size_t ro = (size_t)(wr * 64 + fr + ai * HALF + m * 16) * DM + col0;
#pragma unroll
                for (int bj = 0; bj < 2; ++bj)
#pragma unroll
                    for (int n = 0; n < 2; ++n) *(f32x4*)(xb + ro + bj * HALF + n * 16) = acc[ai][bj][m][n];
            }
    }
};
}

#define LAS __attribute__((address_space(3)))
typedef float f32x4 __attribute__((ext_vector_type(4)));
typedef unsigned v4u __attribute__((ext_vector_type(4)));
#define REP_G1 1
#define REP_G3 1
#define REP_GLA 1
#define REP_SSD 1
#define REP_HY 1
#define REP_HX 1
#define REP_PRO 1
#define CTX_SPLITK 1
#define OLD_SHFL 0
#define REP_MIX 1
#define REP_PA 1
#define REP_PC 1
#define REP_H1 1
#define REP_H2 1
#define REP_H3 1
#define REP_HC 1
#define REP_S2 1
#define REP_S23 1
#define REP_S4 1
#define REP_M2 1
#define REP_M3 1
#define REP_M4 1
#define REP_INIT 1
#define REP_MOD 1
#define REP_F1 1
#define REP_WT 1
#define REP_F3 1
constexpr int LDS_BYTES = 163840;
namespace cg = cooperative_groups;

__device__ __forceinline__ unsigned f2bf_u(float f) { unsigned u = __builtin_bit_cast(unsigned, f); return (u + 0x7fffu + ((u >> 16) & 1u)) >> 16; }
__device__ __forceinline__ unsigned pk2(float lo, float hi) { return f2bf_u(lo) | (f2bf_u(hi) << 16); }
template <int M> __device__ __forceinline__ float swz_xor(float v) { return __builtin_bit_cast(float, __builtin_amdgcn_ds_swizzle(__builtin_bit_cast(int, v), (M << 10) | 0x1f)); }
#if OLD_SHFL
__device__ __forceinline__ float wave_sum(float v, int) {
#pragma unroll
    for (int o = 1; o < 64; o <<= 1) v += __shfl_xor(v, o);
    return v;
}
__device__ __forceinline__ float sum16(float v) { v += __shfl_xor(v, 1); v += __shfl_xor(v, 2); v += __shfl_xor(v, 4); v += __shfl_xor(v, 8); return v; }
__device__ __forceinline__ float wave_scan_incl(float v, int lane) {
#pragma unroll
    for (int off = 1; off < 64; off <<= 1) { const float up = __shfl_up(v, off); if (lane >= off) v += up; }
    return v;
}
#else
__device__ __forceinline__ float wave_sum(float v, int lane) {
    v += swz_xor<1>(v); v += swz_xor<2>(v); v += swz_xor<4>(v); v += swz_xor<8>(v); v += swz_xor<16>(v);
    return v + __builtin_bit_cast(float, __builtin_amdgcn_ds_bpermute((lane ^ 32) << 2, __builtin_bit_cast(int, v)));
}
__device__ __forceinline__ float sum16(float v) { v += swz_xor<1>(v); v += swz_xor<2>(v); v += swz_xor<4>(v); v += swz_xor<8>(v); return v; }
__device__ __forceinline__ float wave_scan_incl(float v, int lane) {
#pragma unroll
    for (int off = 1; off < 64; off <<= 1) {
        const float up = __builtin_bit_cast(float, __builtin_amdgcn_ds_bpermute((lane - off) << 2, __builtin_bit_cast(int, v)));
        if (lane >= off) v += up;
    }
    return v;
}
#endif
__device__ __forceinline__ float lane63(float v) { return __builtin_bit_cast(float, __builtin_amdgcn_readlane(__builtin_bit_cast(int, v), 63)); }
__device__ __forceinline__ void transpose_item(const float* W, int K, int N, unsigned short* WT, int dst_row0, LAS float* scr, int k0, int n0, int lane) {
    const int nn = n0 + (lane & 31);
#pragma unroll 8
    for (int i = 0; i < 32; ++i) { const int kk = 2 * i + (lane >> 5); scr[kk * 33 + (lane & 31)] = nn < N ? W[(size_t)(k0 + kk) * N + nn] : 0.f; }
    asm volatile("s_waitcnt lgkmcnt(0)" ::: "memory");
    const int c = lane & 7;
#pragma unroll
    for (int j = 0; j < 4; ++j) { const int n = (lane >> 3) + 8 * j; const LAS float* sp = scr + (8 * c) * 33 + n;
        v4u o; o.x = pk2(sp[0 * 33], sp[1 * 33]); o.y = pk2(sp[2 * 33], sp[3 * 33]); o.z = pk2(sp[4 * 33], sp[5 * 33]); o.w = pk2(sp[6 * 33], sp[7 * 33]);
        *(v4u*)(WT + (size_t)(dst_row0 + n) * K + k0 + 8 * c) = o; }
    asm volatile("s_waitcnt lgkmcnt(0)" ::: "memory");
}
__device__ __forceinline__ void prologue_weights(const Params& p, LAS float* scr, int gw, int NGW, int lane) {
    constexpr int I_IN = 16 * (LDP / 32), I_OUT = 16 * 32, I_W1 = 16 * (DFF / 32), I_W2 = (DFF / 64) * 32;
    constexpr int PER_L = I_IN + I_OUT + 2 * I_W1 + I_W2;
    for (int it = gw; it < DEPTH * PER_L; it += NGW) {
        const int l = it / PER_L; int r = it % PER_L;
        if (r < I_IN) { const int nb = r % (LDP / 32), kb = r / (LDP / 32);
            transpose_item(p.w_in + (size_t)l * DM * DIN, DM, DIN, p.WIN_T + (size_t)l * LDP * DM, nb * 32, scr, kb * 64, nb * 32, lane); continue; }
        r -= I_IN;
        if (r < I_OUT) { const int nb = r % 32, kb = r / 32;
            transpose_item(p.w_out + (size_t)l * DM * DM, DM, DM, p.WOUT_T + (size_t)l * DM * DM, nb * 32, scr, kb * 64, nb * 32, lane); continue; }
        r -= I_OUT;
        if (r < 2 * I_W1) { const int which = r / I_W1; r %= I_W1; const int nb = r % (DFF / 32), kb = r / (DFF / 32); const int n0 = nb * 32;
            const int drow = 256 * (n0 / 128) + 128 * which + (n0 % 128);
            transpose_item((which ? p.ffn_w3 : p.ffn_w1) + (size_t)l * DM * DFF, DM, DFF, p.W13_T + (size_t)l * NFF2 * DM, drow, scr, kb * 64, n0, lane); continue; }
        r -= 2 * I_W1;
        { const int nb = r % 32, kb = r / 32;
            transpose_item(p.ffn_w2 + (size_t)l * DFF * DM, DFF, DM, p.W2_T + (size_t)l * DM * DFF, nb * 32, scr, kb * 64, nb * 32, lane); }
    }
}

__device__ __forceinline__ void mod_partial(const Params& p, long tid, long nth, float* MODP) {
    for (long i = tid; i < 2L * 16 * 1536; i += nth) {
        const int n4 = (int)(i % 1536), kc = (int)((i / 1536) & 15), l = (int)(i / (1536 * 16));
        f32x4 acc[NB + 1];
        float z0 = 0.f; asm volatile("" : "+v"(z0));
#pragma unroll
        for (int bb = 0; bb <= NB; ++bb) acc[bb] = (f32x4){z0, z0, z0, z0};
        const float* w = p.mod_w + ((size_t)l * DM + kc * 64) * 6 * DM + 4 * n4;
#pragma unroll 4
        for (int k = 0; k < 64; ++k) {
            const f32x4 w4 = *(const f32x4*)(w + (size_t)k * 6 * DM);
#pragma unroll
            for (int bb = 0; bb <= NB; ++bb) {
                const float cv = (bb < NB ? p.c + (size_t)bb * DM : p.c_ctx)[kc * 64 + k];
                acc[bb] += w4 * (cv / (1.0f + __expf(-cv)));
            }
        }
#pragma unroll
        for (int bb = 0; bb <= NB; ++bb) *(f32x4*)(MODP + (((size_t)kc * DEPTH + l) * (NB + 1) + bb) * 6 * DM + 4 * n4) = acc[bb];
    }
}
__device__ __forceinline__ void mod_reduce(const Params& p, long tid, long nth, const float* MODP) {
    const long total = (long)DEPTH * (NB + 1) * 6 * DM;
    for (long i = tid; i < total; i += nth) {
        const int n = (int)(i % (6 * DM)), l = (int)(i / ((long)6 * DM * (NB + 1)));
        float acc = p.mod_b[(size_t)l * 6 * DM + n];
#pragma unroll
        for (int kc = 0; kc < 16; ++kc) acc += MODP[(size_t)kc * total + i];
        p.MOD[i] = acc;
    }
}
__device__ __forceinline__ void filt3_gpu(const Params& p, LAS unsigned char* lds, long tid, long nth, int tix, int bid, int G) {
    for (long i = tid; i < (long)DEPTH * CTX * 256; i += nth) {
        const int c = (int)(i & 255), tt = SEQ + (int)((i >> 8) % CTX), l = (int)(i / (256L * CTX));
        float rel; filt_pos(tt, rel);
        const float* h2 = p.H2 + ((size_t)l * TF + tt) * 64; const float* w3 = p.hy_w3 + (size_t)l * 64 * 256 + c;
        float acc = 0.f;
        for (int j = 0; j < 64; ++j) acc += h2[j] * w3[(size_t)j * 256];
        p.HFC[((size_t)l * CTX + (tt - SEQ)) * 256 + c] = acc * expf(-2.0f * fabsf(rel) * p.hy_decay[l * 256 + c]);
    }
    constexpr int NPAD = 265 + (G1N - 8457);
    for (long i = tid; i < (long)DEPTH * 256 * NPAD; i += nth) {
        const int k = (int)(i % NPAD); const long lc = i / NPAD;
        p.G1[lc * G1N + (k < 265 ? k : 8457 + (k - 265))] = 0;
    }
    LAS unsigned short* T = (LAS unsigned short*)lds;
    const int c = tix & 255, half = tix >> 8;
    for (int u = bid; u < DEPTH * (SEQ / 64); u += G) {
        const int l = u / (SEQ / 64), t0 = (u % (SEQ / 64)) * 64;
        float w[64];
#pragma unroll
        for (int j = 0; j < 64; ++j) w[j] = p.hy_w3[(size_t)l * 64 * 256 + j * 256 + c];
        const float dec = p.hy_decay[l * 256 + c];
#pragma unroll 2
        for (int k = 0; k < 32; ++k) {
            const int tt = t0 + 32 * half + k;
            const f32x4* h2 = (const f32x4*)(p.H2 + ((size_t)l * TF + tt) * 64);
            float acc = 0.f;
#pragma unroll
            for (int j = 0; j < 16; ++j) { const f32x4 h = h2[j]; acc += h.x * w[4 * j] + h.y * w[4 * j + 1] + h.z * w[4 * j + 2] + h.w * w[4 * j + 3]; }
            float rel; filt_pos(tt, rel);
            T[c * 72 + 63 - (32 * half + k)] = (unsigned short)f2bf_u(acc * __expf(-2.0f * fabsf(rel) * dec));
        }
        __syncthreads();
#pragma unroll 4
        for (int k = 0; k < 32; ++k) { const int e = k * 512 + tix, row = e >> 6, col = e & 63;
            p.G1[((size_t)l * 256 + row) * G1N + (8456 - t0 - 63) + col] = T[row * 72 + col]; }
        __syncthreads();
    }
}
__device__ __forceinline__ const float* xsrc_row(const Params& p, int r, bool from_input) {
    if (from_input) return r < BL ? p.x + (size_t)r * DM : p.ctx + (size_t)(r - BL) * DM;
    return r < BL ? p.XL + (size_t)r * DM : p.XC + (size_t)(r - BL) * DM;
}
template <bool SLAB>
__device__ __forceinline__ void hx_pass(const Params& p, int l, int which, int row_lo, int row_hi, int gw, int NGW, int lane, int nslab = 0, const float* slab = nullptr, const float* gate = nullptr, bool base_from_input = false) {
    const float* g = (which ? p.norm2_g : p.norm1_g) + (size_t)l * DM;
    for (int r = row_lo + gw; r < row_hi; r += NGW) {
        const float* m = p.MOD + ((size_t)l * (NB + 1) + row_bb(r)) * 6 * DM;
        const float* sh = m + (which ? 3 : 0) * DM; const float* sc = m + (which ? 4 : 1) * DM;
        f32x4 v[4]; float s = 0.f;
        if (SLAB) {
            const f32x4* x4 = (const f32x4*)(base_from_input ? p.ctx + (size_t)(r - BL) * DM : p.XC + (size_t)(r - BL) * DM) + lane;
            f32x4* xo = (f32x4*)(p.XC + (size_t)(r - BL) * DM) + lane;
            const f32x4* sl = (const f32x4*)(slab + (size_t)(r - BL) * DM) + lane;
#pragma unroll
            for (int j = 0; j < 4; ++j) v[j] = (f32x4){0.f, 0.f, 0.f, 0.f};
#pragma unroll 1
            for (int q = 0; q < nslab; ++q) {
#pragma unroll
                for (int j = 0; j < 4; ++j) v[j] += sl[(size_t)q * BC * (DM / 4) + 64 * j];
            }
#pragma unroll
            for (int j = 0; j < 4; ++j) { v[j] = x4[64 * j] + *(const f32x4*)(gate + 4 * lane + 256 * j) * v[j]; xo[64 * j] = v[j]; }
        } else {
            const f32x4* x4 = (const f32x4*)xsrc_row(p, r, l == 0 && which == 0) + lane;
#pragma unroll
            for (int j = 0; j < 4; ++j) v[j] = x4[64 * j];
        }
#pragma unroll
        for (int j = 0; j < 4; ++j) s += (v[j].x * v[j].x + v[j].y * v[j].y) + (v[j].z * v[j].z + v[j].w * v[j].w);
        const float rstd = 1.0f / sqrtf(wave_sum(s, lane) * (1.0f / DM) + EPSV);
        unsigned long long* o8 = (unsigned long long*)(p.Y + (size_t)r * DM) + lane;
#pragma unroll
        for (int j = 0; j < 4; ++j) {
            const int k = 4 * lane + 256 * j;
            const f32x4 gg = *(const f32x4*)(g + k), s1 = *(const f32x4*)(sc + k), s0 = *(const f32x4*)(sh + k);
            const f32x4 o = v[j] * rstd * gg * (s1 + 1.0f) + s0;
            o8[64 * j] = (unsigned long long)pk2(o.x, o.y) | ((unsigned long long)pk2(o.z, o.w) << 32);
        }
    }
}
__device__ __forceinline__ void final_pass(const Params& p, int gw, int NGW, int lane) {
    for (int r = gw; r < BL; r += NGW) {
        f32x4* x4 = (f32x4*)(p.XL + (size_t)r * DM) + lane;
        f32x4 v[4]; float s = 0.f;
#pragma unroll
        for (int j = 0; j < 4; ++j) { v[j] = x4[64 * j]; s += (v[j].x * v[j].x + v[j].y * v[j].y) + (v[j].z * v[j].z + v[j].w * v[j].w); }
        const float rstd = 1.0f / sqrtf(wave_sum(s, lane) * (1.0f / DM) + EPSV);
#pragma unroll
        for (int j = 0; j < 4; ++j) x4[64 * j] = v[j] * rstd * *(const f32x4*)(p.final_g + 4 * lane + 256 * j);
    }
}


#define GAS __attribute__((address_space(1)))
#define XB_TMO      128
#define XB_XCNT(j)  (256  + 64 * (j))
#define XB_XSUB(j)  (1280 + 64 * (j))
#define XB_XGEN(j)  (2304 + 64 * (j))
#define XB_TOP      3328
#define XB_TOPGEN   3392
#define XCD_BAR_WORDS 3456
#define XB_SPIN_CAP (1u << 18)

__device__ __forceinline__ unsigned xb_ld(unsigned* p)              { return __hip_atomic_load(p, __ATOMIC_RELAXED, __HIP_MEMORY_SCOPE_AGENT); }
__device__ __forceinline__ unsigned xb_add(unsigned* p, unsigned v) { return __hip_atomic_fetch_add(p, v, __ATOMIC_RELAXED, __HIP_MEMORY_SCOPE_AGENT); }
__device__ __forceinline__ unsigned xb_xcc_id() { return (unsigned)__builtin_amdgcn_s_getreg((3 << 11) | 20) & 0xFu; }
#define XB_SPIN(cond, bar) do { unsigned _sp = 0; while (cond) { __builtin_amdgcn_s_sleep(1); \
    if ((++_sp & 255u) == 0u) { if (xb_ld(&(bar)[XB_TMO])) break; if (_sp > XB_SPIN_CAP) { atomicAdd(&(bar)[XB_TMO], 1u); break; } } } } while (0)

struct XcdBarrier {
    unsigned* bar; unsigned x;
    volatile LAS unsigned* st;
};

__device__ __forceinline__ XcdBarrier xcd_barrier_post(unsigned* bar, volatile LAS unsigned* st) {
    XcdBarrier b; b.bar = bar; b.x = xb_xcc_id(); b.st = st;
    if (threadIdx.x == 0) (void)xb_add(&bar[XB_XCNT(b.x)], 1u);
    return b;
}
__device__ __forceinline__ void xcd_barrier_complete(unsigned* bar, unsigned x, unsigned& nloc, unsigned& nx) {
    const unsigned G = gridDim.x * gridDim.y * gridDim.z;
    unsigned sum, cnt, mine, sp = 0u;
    for (;;) {
        sum = 0u; cnt = 0u; mine = 0u;
#pragma unroll
        for (unsigned j = 0; j < 16; ++j) { const unsigned c = xb_ld(&bar[XB_XCNT(j)]); sum += c; cnt += (c > 0u) ? 1u : 0u; mine = (j == x) ? c : mine; }
        if (sum == G) break;
        __builtin_amdgcn_s_sleep(1);
        if ((++sp & 255u) == 0u) { if (xb_ld(&bar[XB_TMO])) break; if (sp > XB_SPIN_CAP) { atomicAdd(&bar[XB_TMO], 1u); break; } }
    }
    nloc = mine > 0u ? mine : 1u; nx = cnt > 0u ? cnt : 1u;
}

__device__ __forceinline__ void xcd_barrier(const XcdBarrier& b, bool leader) {
    asm volatile("s_waitcnt vmcnt(0)" ::: "memory");
    __syncthreads();
    if (leader) {
        unsigned* bar = b.bar;
        __builtin_amdgcn_s_waitcnt(0);
        unsigned nloc = b.st[0], nx = b.st[1];
        if (nloc == 0u) { xcd_barrier_complete(bar, b.x, nloc, nx); b.st[0] = nloc; b.st[1] = nx; }
        const unsigned old = xb_add(&bar[XB_XSUB(b.x)], 1u);
        const unsigned gen = old / nloc;
        if (old + 1u == (gen + 1u) * nloc) {
            __builtin_amdgcn_fence(__ATOMIC_RELEASE, "agent");
            asm volatile("s_waitcnt vmcnt(0)" ::: "memory");
            const unsigned og = xb_add(&bar[XB_TOP], 1u);
            const unsigned tg = og / nx;
            if (og + 1u == (tg + 1u) * nx) xb_add(&bar[XB_TOPGEN], 1u);
            else XB_SPIN(xb_ld(&bar[XB_TOPGEN]) == tg, bar);
            __builtin_amdgcn_fence(__ATOMIC_ACQUIRE, "agent");
            xb_add(&bar[XB_XGEN(b.x)], 1u);
            asm volatile("s_waitcnt vmcnt(0)" ::: "memory");
        } else {
            XB_SPIN(xb_ld(&bar[XB_XGEN(b.x)]) == gen, bar);
            __builtin_amdgcn_fence(__ATOMIC_ACQUIRE, "agent");
            asm volatile("s_waitcnt vmcnt(0)" ::: "memory");
        }
    }
    __syncthreads();
}
#define GNCC ((CTX + SEQ) / 64)
#define GCTXC (CTX / 64)
#define GLA_UNITS (NB * 6 * GNCC)
typedef short bf16x8 __attribute__((ext_vector_type(8)));
__device__ __forceinline__ int gla_row0(int b, int cc) { return cc < GCTXC ? BL + b * CTX + cc * 64 : b * SEQ + (cc - GCTXC) * 64; }
__device__ __forceinline__ size_t gla_uidx(int dir, int b, int h, int cc) { return (((size_t)dir * NB + b) * 6 + h) * GNCC + cc; }
__device__ __forceinline__ float bflo(unsigned u) { return __builtin_bit_cast(float, u << 16); }
__device__ __forceinline__ float bfhi(unsigned u) { return __builtin_bit_cast(float, u & 0xffff0000u); }
constexpr int GL_WL = 0, GL_BIAS = 24576, GL_VT = 26112, GL_KLT = 35328, GL_AC = 44544, GL_KD = 70144, GL_PART = 80384;
constexpr int GL_VTS = 72, GL_ACS = 200, GL_KDS = 40;

__device__ __forceinline__ void gla_stage_w(const Params& p, int l, LAS unsigned char* lds, int tix) {
    LAS float* WL = (LAS float*)(lds + GL_WL); LAS float* BI = (LAS float*)(lds + GL_BIAS);
    for (int i = tix; i < 6 * 1024; i += 512) { const int h = i >> 10, dir = (i >> 9) & 1, j = (i >> 5) & 15, d = i & 31;
        WL[i] = (dir ? p.gk_w_b : p.gk_w_f)[(size_t)l * 16 * 192 + j * 192 + h * 32 + d]; }
    if (tix < 384) { const int h = tix >> 6, dir = (tix >> 5) & 1, d = tix & 31; BI[tix] = (dir ? p.gk_b_b : p.gk_b_f)[l * 192 + h * 32 + d]; }
}
struct GlaPre { v4u v, gk0, gk1, q, k; };
template <bool NEEDQ>
__device__ __forceinline__ void gla_issue(const Params& p, int u, int tix, GlaPre& L) {
    const int b = u / (6 * GNCC), h = (u / GNCC) % 6, cc = u % GNCC, row0 = gla_row0(b, cc);
    const int lane = tix & 63, wave = tix >> 6, dir = wave >> 2, d0 = (wave & 3) * 8;
    L.v = *(const v4u*)(p.P + (size_t)(row0 + (tix >> 3)) * LDP + OFF_V + h * 64 + (tix & 7) * 8);
    const act_t* prow = p.P + (size_t)(row0 + lane) * LDP;
    L.gk0 = *(const v4u*)(prow + (dir ? OFF_GKB : OFF_GKF)); L.gk1 = *(const v4u*)(prow + (dir ? OFF_GKB : OFF_GKF) + 8);
    L.k = *(const v4u*)(prow + OFF_K + h * 32 + d0);
    if (NEEDQ) L.q = *(const v4u*)(prow + OFF_Q + h * 32 + d0);
}
__device__ __forceinline__ void gla_put_v(LAS unsigned char* lds, int tix, const v4u vv) {
    const int j = tix >> 3, eo = tix & 7;
    LAS unsigned short* VT = (LAS unsigned short*)(lds + GL_VT);
    VT[(eo * 8 + 0) * GL_VTS + j] = (unsigned short)(vv.x & 0xffff); VT[(eo * 8 + 1) * GL_VTS + j] = (unsigned short)(vv.x >> 16);
    VT[(eo * 8 + 2) * GL_VTS + j] = (unsigned short)(vv.y & 0xffff); VT[(eo * 8 + 3) * GL_VTS + j] = (unsigned short)(vv.y >> 16);
    VT[(eo * 8 + 4) * GL_VTS + j] = (unsigned short)(vv.z & 0xffff); VT[(eo * 8 + 5) * GL_VTS + j] = (unsigned short)(vv.z >> 16);
    VT[(eo * 8 + 6) * GL_VTS + j] = (unsigned short)(vv.w & 0xffff); VT[(eo * 8 + 7) * GL_VTS + j] = (unsigned short)(vv.w >> 16);
}
__device__ __forceinline__ void gla_phase_a(const v4u g0, const v4u g1, LAS unsigned char* lds, int h, int dir, int d0, int lane, float (&Bv)[8], float (&tot)[8]) {
    const LAS float* WL = (const LAS float*)(lds + GL_WL) + h * 1024 + dir * 512 + d0; const LAS float* BI = (const LAS float*)(lds + GL_BIAS) + h * 64 + dir * 32 + d0;
    float gk[16] = { bflo(g0.x), bfhi(g0.x), bflo(g0.y), bfhi(g0.y), bflo(g0.z), bfhi(g0.z), bflo(g0.w), bfhi(g0.w),
                     bflo(g1.x), bfhi(g1.x), bflo(g1.y), bfhi(g1.y), bflo(g1.z), bfhi(g1.z), bflo(g1.w), bfhi(g1.w) };
    float lg[8];
#pragma unroll
    for (int i = 0; i < 8; ++i) lg[i] = BI[i];
#pragma unroll
    for (int j = 0; j < 16; ++j) {
        const f32x4 w0 = *(const LAS f32x4*)(WL + j * 32), w1 = *(const LAS f32x4*)(WL + j * 32 + 4);
        lg[0] += gk[j] * w0.x; lg[1] += gk[j] * w0.y; lg[2] += gk[j] * w0.z; lg[3] += gk[j] * w0.w;
        lg[4] += gk[j] * w1.x; lg[5] += gk[j] * w1.y; lg[6] += gk[j] * w1.z; lg[7] += gk[j] * w1.w;
    }
#pragma unroll
    for (int i = 0; i < 8; ++i) {
        const float x = lg[i];
        lg[i] = -(fmaxf(-x, 0.f) + __logf(1.0f + __expf(-fabsf(x)))) * (1.0f / 16.0f);
        const float v = wave_scan_incl(lg[i], lane);
        tot[i] = lane63(v);
        Bv[i] = dir ? tot[i] - v + lg[i] : v;
    }
}
__device__ __forceinline__ void unpack8(const v4u k, float (&f)[8]) {
    f[0] = bflo(k.x); f[1] = bfhi(k.x); f[2] = bflo(k.y); f[3] = bfhi(k.y); f[4] = bflo(k.z); f[5] = bfhi(k.z); f[6] = bflo(k.w); f[7] = bfhi(k.w);
}
__device__ __forceinline__ int gla_count(int b) { if (gridDim.x != 256 || GLA_UNITS != 3168) return (GLA_UNITS - b + (int)gridDim.x - 1) / (int)gridDim.x; return b < 16 ? 7 : 12 + ((b - 16) < 176 ? 1 : 0); }
__device__ __forceinline__ int gla_unit_of(int b, int k) { if (gridDim.x != 256 || GLA_UNITS != 3168) return b + k * (int)gridDim.x; return b < 16 ? 7 * b + k : (k < 12 ? 112 + (b - 16) * 12 + k : 2992 + (b - 16)); }
__device__ __forceinline__ void gla_m2_phase(const Params& p, int l, LAS unsigned char* lds, int tix, int bid, unsigned short* DSG, float* DECG) {
    const int lane = tix & 63, wave = __builtin_amdgcn_readfirstlane(tix >> 6);
    gla_stage_w(p, l, lds, tix);
    GlaPre L;
    const int ncnt = gla_count(bid);
    if (ncnt > 0) gla_issue<false>(p, gla_unit_of(bid, 0), tix, L);
    __syncthreads();
#pragma unroll 1
    for (int kk = 0; kk < ncnt; ++kk) {
        const int u = gla_unit_of(bid, kk);
        const int b = u / (6 * GNCC), h = (u / GNCC) % 6, cc = u % GNCC;
        gla_put_v(lds, tix, L.v);
        {
            const int dir = wave >> 2, d0 = (wave & 3) * 8;
            float Bv[8], tot[8];
            gla_phase_a(L.gk0, L.gk1, lds, h, dir, d0, lane, Bv, tot);
            float kf[8]; unpack8(L.k, kf);
            LAS unsigned short* KLT = (LAS unsigned short*)(lds + GL_KLT) + (dir * 32 + d0) * GL_VTS + lane;
#pragma unroll
            for (int i = 0; i < 8; ++i) KLT[i * GL_VTS] = (unsigned short)f2bf_u(kf[i] * __expf(tot[i] - Bv[i]));
            if (lane == 0) {
                float* dg = DECG + gla_uidx(dir, b, h, cc) * 32 + d0;
#pragma unroll
                for (int i = 0; i < 8; ++i) dg[i] = __expf(tot[i]);
            }
        }
        if (kk + 1 < ncnt) gla_issue<false>(p, gla_unit_of(bid, kk + 1), tix, L);
        __syncthreads();
        {
            const int dir = wave >> 2, te = wave & 3, fr = lane & 15, fq = lane >> 4;
            unsigned short* out = DSG + gla_uidx(dir, b, h, cc) * 2048;
#pragma unroll
            for (int td = 0; td < 2; ++td) {
                f32x4 acc = {0.f, 0.f, 0.f, 0.f};
#pragma unroll
                for (int ks = 0; ks < 2; ++ks) {
                    const bf16x8 a = *(const LAS bf16x8*)(lds + GL_VT + ((16 * te + fr) * GL_VTS + 32 * ks + 8 * fq) * 2);
                    const bf16x8 bb = *(const LAS bf16x8*)(lds + GL_KLT + ((dir * 32 + 16 * td + fr) * GL_VTS + 32 * ks + 8 * fq) * 2);
                    acc = __builtin_amdgcn_mfma_f32_16x16x32_bf16(a, bb, acc, 0, 0, 0);
                }
#pragma unroll
                for (int r = 0; r < 4; ++r) out[(16 * te + 4 * fq + r) * 32 + 16 * td + fr] = (unsigned short)f2bf_u(acc[r]);
            }
        }
        __syncthreads();
    }
}
template <int NSTEP, int BATCH>
__device__ __forceinline__ void gla_m3_seg(f32x4& S, const unsigned short* DSG, const float* DECG, unsigned short* SSG, size_t base, int cc0, int step, int ed) {
    static_assert(NSTEP % BATCH == 0, "");
#pragma unroll 1
    for (int k0 = 0; k0 < NSTEP; k0 += BATCH) {
        f32x4 d[BATCH], dc[BATCH]; unsigned long long draw[BATCH];
#pragma unroll
        for (int j = 0; j < BATCH; ++j) { const size_t u = base + cc0 + (k0 + j) * step; draw[j] = *(const unsigned long long*)(DSG + u * 2048 + ed); dc[j] = *(const f32x4*)(DECG + u * 32 + (ed & 31)); }
#pragma unroll
        for (int j = 0; j < BATCH; ++j) { const unsigned lo = (unsigned)draw[j], hi = (unsigned)(draw[j] >> 32); d[j] = (f32x4){bflo(lo), bfhi(lo), bflo(hi), bfhi(hi)}; }
#pragma unroll
        for (int j = 0; j < BATCH; ++j) { const size_t u = base + cc0 + (k0 + j) * step;
            *(unsigned long long*)(SSG + u * 2048 + ed) = (unsigned long long)pk2(S.x, S.y) | ((unsigned long long)pk2(S.z, S.w) << 32);
            S = dc[j] * S + d[j]; }
    }
}
__device__ __forceinline__ void gla_m3(long tid, long nth, const unsigned short* DSG, const float* DECG, unsigned short* SSG) {
    for (long i = tid; i < 2L * NB * 6 * 512; i += nth) {
        const int ed = (int)(i & 511) * 4, chain = (int)(i >> 9), dir = chain / (NB * 6);
        const size_t base = (size_t)chain * GNCC;
        float z0 = 0.f; asm volatile("" : "+v"(z0));
        f32x4 S = {z0, z0, z0, z0};
        if (dir == 0) { gla_m3_seg<GCTXC, GCTXC>(S, DSG, DECG, SSG, base, 0, 1, ed); gla_m3_seg<GNCC - GCTXC, 16>(S, DSG, DECG, SSG, base, GCTXC, 1, ed); }
        else { gla_m3_seg<GCTXC, GCTXC>(S, DSG, DECG, SSG, base, GCTXC - 1, -1, ed); gla_m3_seg<GNCC - GCTXC, 16>(S, DSG, DECG, SSG, base, GNCC - 1, -1, ed); }
    }
}
struct GlaPre4 { bf16x8 s[2][2]; unsigned short g[4][2]; };
__device__ __forceinline__ void gla_issue4(const Params& p, int u, int tix, const unsigned short* SSG, GlaPre4& S) {
    const int b = u / (6 * GNCC), h = (u / GNCC) % 6, cc = u % GNCC, row0 = gla_row0(b, cc);
    const int lane = tix & 63, wave = tix >> 6, fr = lane & 15, fq = lane >> 4, ti = wave >> 1, ch = wave & 1;
#pragma unroll
    for (int dir = 0; dir < 2; ++dir)
#pragma unroll
        for (int n = 0; n < 2; ++n) S.s[dir][n] = *(const bf16x8*)(SSG + gla_uidx(dir, b, h, cc) * 2048 + (32 * ch + 16 * n + fr) * 32 + 8 * fq);
#pragma unroll
    for (int r = 0; r < 4; ++r)
#pragma unroll
        for (int n = 0; n < 2; ++n) S.g[r][n] = p.P[(size_t)(row0 + 16 * ti + 4 * fq + r) * LDP + OFF_G + h * 64 + 32 * ch + 16 * n + fr];
}
__device__ __forceinline__ void gla_m4_phase(const Params& p, int l, LAS unsigned char* lds, int tix, int bid, const unsigned short* SSG) {
    const int lane = tix & 63, wave = __builtin_amdgcn_readfirstlane(tix >> 6), fr = lane & 15, fq = lane >> 4;
    gla_stage_w(p, l, lds, tix);
    GlaPre L; GlaPre4 S;
    const int ncnt = gla_count(bid);
    if (ncnt > 0) { const int u0 = gla_unit_of(bid, 0); gla_issue<true>(p, u0, tix, L); gla_issue4(p, u0, tix, SSG, S); }
    __syncthreads();
#pragma unroll 1
    for (int kk = 0; kk < ncnt; ++kk) {
        const int u = gla_unit_of(bid, kk);
        const int b = u / (6 * GNCC), h = (u / GNCC) % 6, cc = u % GNCC, row0 = gla_row0(b, cc);
        gla_put_v(lds, tix, L.v);
        {
            const int dir = wave >> 2, d0 = (wave & 3) * 8;
            float Bv[8], tot[8];
            gla_phase_a(L.gk0, L.gk1, lds, h, dir, d0, lane, Bv, tot);
            float kf[8], qf[8]; unpack8(L.k, kf); unpack8(L.q, qf);
            float qd[8], kd[8];
#pragma unroll
            for (int i = 0; i < 8; ++i) { qd[i] = qf[i] * __expf(Bv[i]) * 0.17677669529663687f; kd[i] = kf[i] * __expf(-Bv[i]); }
            v4u w; w.x = pk2(qd[0], qd[1]); w.y = pk2(qd[2], qd[3]); w.z = pk2(qd[4], qd[5]); w.w = pk2(qd[6], qd[7]);
            *(LAS v4u*)(lds + GL_AC + (lane * GL_ACS + 128 + 32 * dir + d0) * 2) = w;
            w.x = pk2(kd[0], kd[1]); w.y = pk2(kd[2], kd[3]); w.z = pk2(kd[4], kd[5]); w.w = pk2(kd[6], kd[7]);
            *(LAS v4u*)(lds + GL_KD + ((dir * 64 + lane) * GL_KDS + d0) * 2) = w;
        }
        const bool more = kk + 1 < ncnt;
        if (more) gla_issue<true>(p, gla_unit_of(bid, kk + 1), tix, L);
        __syncthreads();
        {
            const int dir = wave >> 2, ti = wave & 3;
            const bf16x8 a = *(const LAS bf16x8*)(lds + GL_AC + ((16 * ti + fr) * GL_ACS + 128 + 32 * dir + 8 * fq) * 2);
            LAS unsigned short* AC = (LAS unsigned short*)(lds + GL_AC);
#pragma unroll
            for (int tj = 0; tj < 4; ++tj) {
                const bf16x8 bb = *(const LAS bf16x8*)(lds + GL_KD + ((dir * 64 + 16 * tj + fr) * GL_KDS + 8 * fq) * 2);
                f32x4 acc = {0.f, 0.f, 0.f, 0.f};
                acc = __builtin_amdgcn_mfma_f32_16x16x32_bf16(a, bb, acc, 0, 0, 0);
                const int j = 16 * tj + fr;
#pragma unroll
                for (int r = 0; r < 4; ++r) { const int i = 16 * ti + 4 * fq + r; const bool keep = dir ? (j >= i) : (j <= i);
                    AC[i * GL_ACS + 64 * dir + j] = (unsigned short)f2bf_u(keep ? acc[r] : 0.f); }
            }
        }
        __syncthreads();
        f32x4 acc[2] = { {0.f, 0.f, 0.f, 0.f}, {0.f, 0.f, 0.f, 0.f} };
        const int ti = wave >> 1, ch = wave & 1;
        {
            bf16x8 bv[2][2];
#pragma unroll
            for (int ks = 0; ks < 2; ++ks)
#pragma unroll
                for (int n = 0; n < 2; ++n) bv[ks][n] = *(const LAS bf16x8*)(lds + GL_VT + ((32 * ch + 16 * n + fr) * GL_VTS + 32 * ks + 8 * fq) * 2);
#pragma unroll
            for (int part = 0; part < 2; ++part)
#pragma unroll
                for (int ks = 0; ks < 2; ++ks) {
                    const bf16x8 a = *(const LAS bf16x8*)(lds + GL_AC + ((16 * ti + fr) * GL_ACS + 64 * part + 32 * ks + 8 * fq) * 2);
#pragma unroll
                    for (int n = 0; n < 2; ++n) acc[n] = __builtin_amdgcn_mfma_f32_16x16x32_bf16(a, bv[ks][n], acc[n], 0, 0, 0);
                }
#pragma unroll
            for (int dir = 0; dir < 2; ++dir) {
                const bf16x8 a = *(const LAS bf16x8*)(lds + GL_AC + ((16 * ti + fr) * GL_ACS + 128 + 32 * dir + 8 * fq) * 2);
#pragma unroll
                for (int n = 0; n < 2; ++n) acc[n] = __builtin_amdgcn_mfma_f32_16x16x32_bf16(a, S.s[dir][n], acc[n], 0, 0, 0);
            }
            LAS float* PART = (LAS float*)(lds + GL_PART);
#pragma unroll
            for (int r = 0; r < 4; ++r) {
                float ss = acc[0][r] * acc[0][r] + acc[1][r] * acc[1][r];
                ss = sum16(ss);
                if (fr == 0) PART[(16 * ti + 4 * fq + r) * 2 + ch] = ss;
            }
        }
        __syncthreads();
        {
            const LAS float* PART = (const LAS float*)(lds + GL_PART);
#pragma unroll
            for (int r = 0; r < 4; ++r) {
                const int i = 16 * ti + 4 * fq + r;
                const float rs = 1.0f / sqrtf((PART[i * 2] + PART[i * 2 + 1]) * (1.0f / 64.0f) + EPSV);
#pragma unroll
                for (int n = 0; n < 2; ++n) {
                    const int e = 32 * ch + 16 * n + fr;
                    const float g = bflo((unsigned)S.g[r][n]);
                    stact(p.Y + (size_t)(row0 + i) * DM + h * 64 + e, acc[n][r] * rs * p.gla_norm_w[l * 64 + e] * (g / (1.0f + __expf(-g))));
                }
            }
        }
        if (more) gla_issue4(p, gla_unit_of(bid, kk + 1), tix, SSG, S);
    }
    __syncthreads();
}

#define SNCC ((CTX + SEQ) / 128)
#define SCTXC (CTX / 128)
#define SSD_UNITS (NB * 2 * SNCC)
constexpr int SD_CM = 0, SD_BM = 34816, SD_XT = 69632, SD_HS = 121856, SD_DTL = 139264, SD_CSL = 142336, SD_TOT = 145408, SD_HS2OFF = 145440 - 121856;
constexpr int SD_S = 136;
static_assert(SD_HS + SD_HS2OFF + 64 * 136 * 2 <= LDS_BYTES - 64, "SSD LDS map");
__device__ __forceinline__ int ssd_row(int b, int cc, int i) {
    if (cc < SCTXC) return BL + b * CTX + cc * 128 + i;
    return b * SEQ + colmajor_tok(0, (cc - SCTXC) * 128 + i);
}
__device__ __forceinline__ size_t ssd_chain(int dir, int b, int head) { return ((size_t)dir * NB + b) * 6 + head; }
template <bool TR_B, bool WITH_C>
__device__ __forceinline__ void ssd_stage(const Params& p, int l, LAS unsigned char* lds, int b, int g, int cc, int tix) {
    const int sidx = cc < SCTXC ? NB + b : b, L = seq_len(sidx), r0 = seq_row0(sidx), pos0 = (cc < SCTXC ? cc : cc - SCTXC) * 128;
    constexpr int NQ = WITH_C ? 14 : 10;
    for (int item = tix; item < 128 * NQ; item += 512) {
        const int i = item & 127, q = item >> 7;
        const int col0 = q < 6 ? g * 192 + q * 32 : (q < 10 ? 384 + g * 128 + (q - 6) * 32 : 640 + g * 128 + (q - 10) * 32);
        const int pos = pos0 + i;
        const act_t* rc = p.P + (size_t)(r0 + colmajor_tok(sidx, pos)) * LDP + OFF_XBC + col0;
        const bool hp = pos > 0, hn = pos + 1 < L;
        const act_t* rp = hp ? p.P + (size_t)(r0 + colmajor_tok(sidx, pos - 1)) * LDP + OFF_XBC + col0 : rc;
        const act_t* rn = hn ? p.P + (size_t)(r0 + colmajor_tok(sidx, pos + 1)) * LDP + OFF_XBC + col0 : rc;
        const float* cw = p.ssd_conv_w + (size_t)l * 3 * 896 + col0; const float* cbias = p.ssd_conv_b + (size_t)l * 896 + col0;
#pragma unroll
        for (int o = 0; o < 4; ++o) {
            float xp[8], xc[8], xn[8], y[8];
            unpack8(*(const v4u*)(rp + 8 * o), xp); unpack8(*(const v4u*)(rc + 8 * o), xc); unpack8(*(const v4u*)(rn + 8 * o), xn);
#pragma unroll
            for (int e = 0; e < 8; ++e) {
                const int c = 8 * o + e;
                float a = cbias[c] + cw[896 + c] * xc[e];
                a += hp ? cw[c] * xp[e] : 0.f; a += hn ? cw[2 * 896 + c] * xn[e] : 0.f;
                y[e] = a / (1.0f + __expf(-a));
            }
            if (q < 6) {
                LAS unsigned short* d = (LAS unsigned short*)(lds + SD_XT) + (q * 32 + 8 * o) * SD_S + i;
#pragma unroll
                for (int e = 0; e < 8; ++e) d[e * SD_S] = (unsigned short)f2bf_u(y[e]);
            } else if (q < 10) {
                if (TR_B) { LAS unsigned short* d = (LAS unsigned short*)(lds + SD_BM) + ((q - 6) * 32 + 8 * o) * SD_S + i;
#pragma unroll
                    for (int e = 0; e < 8; ++e) d[e * SD_S] = (unsigned short)f2bf_u(y[e]);
                } else { v4u w; w.x = pk2(y[0], y[1]); w.y = pk2(y[2], y[3]); w.z = pk2(y[4], y[5]); w.w = pk2(y[6], y[7]);
                    *(LAS v4u*)(lds + SD_BM + (i * SD_S + (q - 6) * 32 + 8 * o) * 2) = w; }
            } else { v4u w; w.x = pk2(y[0], y[1]); w.y = pk2(y[2], y[3]); w.z = pk2(y[4], y[5]); w.w = pk2(y[6], y[7]);
                *(LAS v4u*)(lds + SD_CM + (i * SD_S + (q - 10) * 32 + 8 * o) * 2) = w; }
        }
    }
}
__device__ __forceinline__ void ssd_scans(const Params& p, int l, LAS unsigned char* lds, int b, int g, int cc, int wave, int lane) {
    if (wave < 6) {
        const int hg = wave % 3, dir = wave / 3, head = g * 3 + hg;
        const float bias = (dir ? p.ssd_dt_bias_b : p.ssd_dt_bias_f)[l * 6 + head];
        const float A = -__expf((dir ? p.ssd_a_log_b : p.ssd_a_log_f)[l * 6 + head]);
        float dt[2], a[2];
#pragma unroll
        for (int k = 0; k < 2; ++k) {
            const float x = ldact(p.P + (size_t)ssd_row(b, cc, 2 * lane + k) * LDP + (dir ? OFF_DTB : OFF_DTF) + head) + bias;
            dt[k] = fmaxf(x, 0.f) + log1pf(__expf(-fabsf(x))); a[k] = A * dt[k];
        }
        const float v = wave_scan_incl(a[0] + a[1], lane);
        const float tot = lane63(v);
        const float pf1 = v, pf0 = v - a[1];
        LAS float* DTL = (LAS float*)(lds + SD_DTL) + wave * 128 + 2 * lane; LAS float* CSL = (LAS float*)(lds + SD_CSL) + wave * 128 + 2 * lane;
        DTL[0] = dt[0]; DTL[1] = dt[1];
        CSL[0] = dir ? tot - pf0 + a[0] : pf0; CSL[1] = dir ? tot - pf1 + a[1] : pf1;
        if (lane == 0) ((LAS float*)(lds + SD_TOT))[wave] = tot;
    }
}
__device__ __forceinline__ void ssd_s2_unit(const Params& p, int l, LAS unsigned char* lds, int u, int tix, unsigned short* DSS, float* DECS) {
    const int b = u / (2 * SNCC), g = (u / SNCC) & 1, cc = u % SNCC;
    const int lane = tix & 63, wave = __builtin_amdgcn_readfirstlane(tix >> 6), fr = lane & 15, fq = lane >> 4;
    ssd_scans(p, l, lds, b, g, cc, wave, lane);
    ssd_stage<true, false>(p, l, lds, b, g, cc, tix);
    __syncthreads();
    if (tix < 6) DECS[ssd_chain(tix / 3, b, g * 3 + tix % 3) * SNCC + cc] = __expf(((const LAS float*)(lds + SD_TOT))[tix]);
#pragma unroll 1
    for (int k = 0; k < 3; ++k) {
        const int c3 = wave + 8 * k, tp = c3 & 3, combo = c3 >> 2, hg = combo % 3, dir = combo / 3;
        const LAS float* DTL = (const LAS float*)(lds + SD_DTL) + combo * 128; const LAS float* CSL = (const LAS float*)(lds + SD_CSL) + combo * 128;
        const float tot = ((const LAS float*)(lds + SD_TOT))[combo];
        bf16x8 a[4];
#pragma unroll
        for (int ks = 0; ks < 4; ++ks) {
            const int j0 = 32 * ks + 8 * fq;
            float xf[8]; unpack8(*(const LAS v4u*)(lds + SD_XT + ((hg * 64 + 16 * tp + fr) * SD_S + j0) * 2), xf);
            const f32x4 d0 = *(const LAS f32x4*)(DTL + j0), d1 = *(const LAS f32x4*)(DTL + j0 + 4), c0 = *(const LAS f32x4*)(CSL + j0), c1 = *(const LAS f32x4*)(CSL + j0 + 4);
            xf[0] *= d0.x * __expf(tot - c0.x); xf[1] *= d0.y * __expf(tot - c0.y); xf[2] *= d0.z * __expf(tot - c0.z); xf[3] *= d0.w * __expf(tot - c0.w);
            xf[4] *= d1.x * __expf(tot - c1.x); xf[5] *= d1.y * __expf(tot - c1.y); xf[6] *= d1.z * __expf(tot - c1.z); xf[7] *= d1.w * __expf(tot - c1.w);
            v4u w; w.x = pk2(xf[0], xf[1]); w.y = pk2(xf[2], xf[3]); w.z = pk2(xf[4], xf[5]); w.w = pk2(xf[6], xf[7]);
            a[ks] = __builtin_bit_cast(bf16x8, w);
        }
        unsigned short* out = DSS + (ssd_chain(dir, b, g * 3 + hg) * SNCC + cc) * 8192;
#pragma unroll
        for (int tn = 0; tn < 8; ++tn) {
            f32x4 acc = {0.f, 0.f, 0.f, 0.f};
#pragma unroll
            for (int ks = 0; ks < 4; ++ks) {
                const bf16x8 bb = *(const LAS bf16x8*)(lds + SD_BM + ((16 * tn + fr) * SD_S + 32 * ks + 8 * fq) * 2);
                acc = __builtin_amdgcn_mfma_f32_16x16x32_bf16(bb, a[ks], acc, 0, 0, 0);
            }
            *(unsigned long long*)(out + (16 * tp + fr) * 128 + 16 * tn + 4 * fq) = (unsigned long long)pk2(acc[0], acc[1]) | ((unsigned long long)pk2(acc[2], acc[3]) << 32);
        }
    }
    __syncthreads();
}
template <int NSTEP, int BATCH>
__device__ __forceinline__ void ssd_s3_seg(float (&S)[8], unsigned short* DSS, const float* DECS, size_t base, int cc0, int step, int el) {
    static_assert(NSTEP % BATCH == 0, "");
#pragma unroll 1
    for (int k0 = 0; k0 < NSTEP; k0 += BATCH) {
        v4u d[BATCH]; float dc[BATCH];
#pragma unroll
        for (int j = 0; j < BATCH; ++j) { const size_t u = base + cc0 + (k0 + j) * step; d[j] = *(const v4u*)(DSS + u * 8192 + el); dc[j] = DECS[u]; }
#pragma unroll
        for (int j = 0; j < BATCH; ++j) { const size_t u = base + cc0 + (k0 + j) * step;
            v4u w; w.x = pk2(S[0], S[1]); w.y = pk2(S[2], S[3]); w.z = pk2(S[4], S[5]); w.w = pk2(S[6], S[7]);
            *(v4u*)(DSS + u * 8192 + el) = w;
            float df[8]; unpack8(d[j], df);
#pragma unroll
            for (int e = 0; e < 8; ++e) S[e] = S[e] * dc[j] + df[e]; }
    }
}
__device__ __forceinline__ void ssd_s3(long tid, long nth, unsigned short* DSS, const float* DECS) {
    for (long i = tid; i < 2L * NB * 6 * 1024; i += nth) {
        const int el = (int)(i & 1023) * 8, chain = (int)(i >> 10), dir = chain / (NB * 6);
        const size_t base = (size_t)chain * SNCC;
        float z0 = 0.f; asm volatile("" : "+v"(z0));
        float S[8] = {z0, z0, z0, z0, z0, z0, z0, z0};
        if (dir == 0) { ssd_s3_seg<SCTXC, SCTXC>(S, DSS, DECS, base, 0, 1, el); ssd_s3_seg<SNCC - SCTXC, 8>(S, DSS, DECS, base, SCTXC, 1, el); }
        else { ssd_s3_seg<SCTXC, SCTXC>(S, DSS, DECS, base, SCTXC - 1, -1, el); ssd_s3_seg<SNCC - SCTXC, 8>(S, DSS, DECS, base, SNCC - 1, -1, el); }
    }
}
__device__ __forceinline__ void ssd_load_h(const unsigned short* HSS, int b, int head, int cc, int tix, v4u (&h)[2][2]) {
#pragma unroll
    for (int dir = 0; dir < 2; ++dir) {
        const unsigned short* hsrc = HSS + (ssd_chain(dir, b, head) * SNCC + cc) * 8192 + (tix >> 3) * 128 + (tix & 7) * 16;
        h[dir][0] = *(const v4u*)hsrc; h[dir][1] = *(const v4u*)(hsrc + 8);
    }
}
__device__ __forceinline__ void ssd_s4_unit(const Params& p, int l, LAS unsigned char* lds, int u, int tix, const unsigned short* HSS) {
    const int b = u / (2 * SNCC), g = (u / SNCC) & 1, cc = u % SNCC;
    const int lane = tix & 63, wave = __builtin_amdgcn_readfirstlane(tix >> 6), fr = lane & 15, fq = lane >> 4;
    ssd_scans(p, l, lds, b, g, cc, wave, lane);
    ssd_stage<false, true>(p, l, lds, b, g, cc, tix);
    __syncthreads();
    LAS unsigned char* cm_rd = lds + SD_CM + ((16 * wave + fr) * SD_S + 8 * fq) * 2;
    LAS unsigned char* bm_rd = lds + SD_BM + (fr * SD_S + 8 * fq) * 2;
    LAS unsigned char* m_rd = lds + SD_BM + ((16 * wave + fr) * SD_S + 8 * fq) * 2;
    LAS unsigned char* m_wr = lds + SD_BM + ((16 * wave + 4 * fq) * SD_S + fr) * 2;
    LAS unsigned char* xt_rd = lds + SD_XT + (fr * SD_S + 8 * fq) * 2;
    LAS unsigned char* hs_rd = lds + SD_HS + (fr * SD_S + 8 * fq) * 2;
    LAS unsigned char* hs_wr = lds + SD_HS + ((tix >> 3) * SD_S + (tix & 7) * 16) * 2;
    LAS unsigned char* sc_j = lds + SD_DTL + fr * 4;
    LAS unsigned char* sc_i = lds + SD_DTL + (16 * wave + 4 * fq) * 4;
    asm volatile("" : "+v"(cm_rd), "+v"(bm_rd), "+v"(m_rd), "+v"(m_wr), "+v"(xt_rd), "+v"(hs_rd), "+v"(hs_wr), "+v"(sc_j), "+v"(sc_i));
    f32x4 cb[8];
    bf16x8 ca[4];
#pragma unroll
    for (int ks = 0; ks < 4; ++ks) ca[ks] = *(const LAS bf16x8*)(cm_rd + 64 * ks);
#pragma unroll
    for (int tj = 0; tj < 8; ++tj) {
        cb[tj] = (f32x4){0.f, 0.f, 0.f, 0.f};
#pragma unroll
        for (int ks = 0; ks < 4; ++ks) {
            const bf16x8 bb = *(const LAS bf16x8*)(bm_rd + (16 * tj * SD_S + 32 * ks) * 2);
            cb[tj] = __builtin_amdgcn_mfma_f32_16x16x32_bf16(ca[ks], bb, cb[tj], 0, 0, 0);
        }
    }
    __syncthreads();
    f32x4 yacc[3][4];
#pragma unroll
    for (int hg = 0; hg < 3; ++hg)
#pragma unroll
        for (int tp = 0; tp < 4; ++tp) yacc[hg][tp] = (f32x4){0.f, 0.f, 0.f, 0.f};
#pragma unroll
    for (int hg = 0; hg < 3; ++hg) {
        v4u hreg[2][2];
        ssd_load_h(HSS, b, g * 3 + hg, cc, tix, hreg);
        __builtin_amdgcn_sched_barrier(0);
        float csfi[4], csbi[4];
#pragma unroll
        for (int r = 0; r < 4; ++r) { csfi[r] = *(const LAS float*)(sc_i + 3072 + hg * 512 + 4 * r); csbi[r] = *(const LAS float*)(sc_i + 3072 + (3 + hg) * 512 + 4 * r); }
#pragma unroll
        for (int tj = 0; tj < 8; ++tj) {
            const int j = 16 * tj + fr;
            const float csfj = *(const LAS float*)(sc_j + 3072 + hg * 512 + 64 * tj), csbj = *(const LAS float*)(sc_j + 3072 + (3 + hg) * 512 + 64 * tj);
            const float dtfj = *(const LAS float*)(sc_j + hg * 512 + 64 * tj), dtbj = *(const LAS float*)(sc_j + (3 + hg) * 512 + 64 * tj);
#pragma unroll
            for (int r = 0; r < 4; ++r) { const int i = 16 * wave + 4 * fq + r;
                const float arg = (j <= i) ? csfi[r] - csfj : csbi[r] - csbj;
                const float wgt = (j < i) ? dtfj : ((j > i) ? dtbj : dtfj + dtbj);
                *(LAS unsigned short*)(m_wr + (r * SD_S + 16 * tj) * 2) = (unsigned short)f2bf_u(cb[tj][r] * __expf(fminf(arg, 0.f)) * wgt); }
            __builtin_amdgcn_sched_barrier(0);
        }
        __builtin_amdgcn_sched_barrier(0);
#pragma unroll
        for (int dir = 0; dir < 2; ++dir) {
            *(LAS v4u*)(hs_wr + dir * SD_HS2OFF) = hreg[dir][0]; *(LAS v4u*)(hs_wr + dir * SD_HS2OFF + 16) = hreg[dir][1];
        }
        __syncthreads();
        f32x4 tmp[4];
#pragma unroll
        for (int tp = 0; tp < 4; ++tp) tmp[tp] = (f32x4){0.f, 0.f, 0.f, 0.f};
#pragma unroll
        for (int ks = 0; ks < 4; ++ks) {
            const bf16x8 am = *(const LAS bf16x8*)(m_rd + 64 * ks);
#pragma unroll
            for (int tp = 0; tp < 4; ++tp) {
                const bf16x8 bx = *(const LAS bf16x8*)(xt_rd + ((hg * 64 + 16 * tp) * SD_S + 32 * ks) * 2);
                yacc[hg][tp] = __builtin_amdgcn_mfma_f32_16x16x32_bf16(am, bx, yacc[hg][tp], 0, 0, 0);
                const bf16x8 bhf = *(const LAS bf16x8*)(hs_rd + (16 * tp * SD_S + 32 * ks) * 2);
                tmp[tp] = __builtin_amdgcn_mfma_f32_16x16x32_bf16(ca[ks], bhf, tmp[tp], 0, 0, 0);
            }
        }
#pragma unroll
        for (int r = 0; r < 4; ++r) { const float ef = __expf(csfi[r]);
#pragma unroll
            for (int tp = 0; tp < 4; ++tp) { yacc[hg][tp][r] += ef * tmp[tp][r]; tmp[tp][r] = 0.f; } }
#pragma unroll
        for (int ks = 0; ks < 4; ++ks)
#pragma unroll
            for (int tp = 0; tp < 4; ++tp) {
                const bf16x8 bhb = *(const LAS bf16x8*)(hs_rd + SD_HS2OFF + (16 * tp * SD_S + 32 * ks) * 2);
                tmp[tp] = __builtin_amdgcn_mfma_f32_16x16x32_bf16(ca[ks], bhb, tmp[tp], 0, 0, 0);
            }
#pragma unroll
        for (int r = 0; r < 4; ++r) { const float eb = __expf(csbi[r]);
#pragma unroll
            for (int tp = 0; tp < 4; ++tp) yacc[hg][tp][r] += eb * tmp[tp][r]; }
        __syncthreads();
    }
#pragma unroll
    for (int hg = 0; hg < 3; ++hg) {
        const float dcoef = p.ssd_d[l * 6 + g * 3 + hg];
#pragma unroll
        for (int tp = 0; tp < 4; ++tp) {
            const int pc = hg * 64 + 16 * tp + fr;
#pragma unroll
            for (int r = 0; r < 4; ++r)
                yacc[hg][tp][r] += dcoef * bflo((unsigned)((const LAS unsigned short*)(lds + SD_XT))[pc * SD_S + 16 * wave + 4 * fq + r]);
        }
    }
    __syncthreads();
    {
        LAS float* YL = (LAS float*)lds;
#pragma unroll
        for (int hg = 0; hg < 3; ++hg)
#pragma unroll
            for (int tp = 0; tp < 4; ++tp)
#pragma unroll
                for (int r = 0; r < 4; ++r) YL[(16 * wave + 4 * fq + r) * 196 + hg * 64 + 16 * tp + fr] = yacc[hg][tp][r];
        const float nw0 = p.ssd_norm_w[l * 384 + g * 192 + lane], nw1 = p.ssd_norm_w[l * 384 + g * 192 + 64 + lane], nw2 = p.ssd_norm_w[l * 384 + g * 192 + 128 + lane];
#pragma unroll 1
        for (int r8 = 0; r8 < 16; r8 += 8) {
            unsigned short zr[8][3];
#pragma unroll
            for (int k = 0; k < 8; ++k) {
                const act_t* zp = p.P + (size_t)ssd_row(b, cc, 16 * wave + r8 + k) * LDP + OFF_Z + g * 192 + lane;
                zr[k][0] = zp[0]; zr[k][1] = zp[64]; zr[k][2] = zp[128];
            }
#pragma unroll
            for (int k = 0; k < 8; ++k) {
                const int i = 16 * wave + r8 + k;
                const float z0 = bflo(zr[k][0]), z1 = bflo(zr[k][1]), z2 = bflo(zr[k][2]);
                const float v0 = YL[i * 196 + lane] * (z0 / (1.0f + __expf(-z0))), v1 = YL[i * 196 + 64 + lane] * (z1 / (1.0f + __expf(-z1))), v2 = YL[i * 196 + 128 + lane] * (z2 / (1.0f + __expf(-z2)));
                const float rs = 1.0f / sqrtf(wave_sum(v0 * v0 + v1 * v1 + v2 * v2, lane) * (1.0f / 192.0f) + EPSV);
                act_t* yp = p.Y + (size_t)ssd_row(b, cc, i) * DM + 640 + g * 192 + lane;
                stact(yp, v0 * rs * nw0); stact(yp + 64, v1 * rs * nw1); stact(yp + 128, v2 * rs * nw2);
            }
        }
    }
    __syncthreads();
}

typedef float f32x16 __attribute__((ext_vector_type(16)));
constexpr int HY_CP = 0, HY_MOFF = 4352, HY_U = 17920, HY_US = 264, HY_OUT = 85504;
__device__ __forceinline__ void hy_u8(const Params& p, int l, int b, int t, int col0, float (&y)[8]) {
    const act_t* rc = p.P + (size_t)(b * SEQ + t) * LDP + OFF_HY + col0;
    const float* w = p.hy_short_w + (size_t)l * 3 * 768 + col0; const float* bs = p.hy_short_b + (size_t)l * 768 + col0;
    float xc[8]; unpack8(*(const v4u*)rc, xc);
#pragma unroll
    for (int e = 0; e < 8; ++e) y[e] = bs[e] + w[768 + e] * xc[e];
    if (t > 0) { float xp[8]; unpack8(*(const v4u*)(rc - LDP), xp);
#pragma unroll
        for (int e = 0; e < 8; ++e) y[e] += w[e] * xp[e]; }
    if (t + 1 < SEQ) { float xn[8]; unpack8(*(const v4u*)(rc + LDP), xn);
#pragma unroll
        for (int e = 0; e < 8; ++e) y[e] += w[2 * 768 + e] * xn[e]; }
}

__device__ __forceinline__ void hy_ctx_conv(const Params& p, int l, long tid, long nth) {
    for (long i = tid; i < (long)BC * 256; i += nth) {
        const int c = (int)(i & 255), r = BL + (int)(i >> 8);
        const int s = NB + (r - BL) / CTX, r0 = seq_row0(s), t = r - r0;
        const float* hf = p.HFC + (size_t)l * CTX * 256 + c;
        int jlo = t + CTX / 2 - (CTX - 1); if (jlo < 0) jlo = 0;
        int jhi = t + CTX / 2; if (jhi > CTX - 1) jhi = CTX - 1;
        float acc = 0.f;
#pragma unroll 8
        for (int j = jlo; j <= jhi; ++j) acc += hf[(size_t)(t - j + CTX / 2) * 256] * p.VX[(size_t)(r0 + j) * 256 + c];
        const float x0 = hy_u(p, l, s, t, c);
        stact(p.Y + (size_t)r * DM + 384 + c, (acc + p.VX[(size_t)r * 256 + c] * p.hy_bias[l * 256 + c]) * x0);
    }
}
__device__ __forceinline__ void hy_h1_unit(const Params& p, int l, LAS unsigned char* lds, int u, int tix) {
    const int b = u / (SEQ / 64), t0 = (u % (SEQ / 64)) * 64;
    const int t = tix & 63, cg = tix >> 6;
    LAS unsigned short* T = (LAS unsigned short*)lds;
#pragma unroll 1
    for (int o = 0; o < 4; ++o) {
        const int c0 = 32 * cg + 8 * o;
        float x1[8], v[8]; hy_u8(p, l, b, t0 + t, 256 + c0, x1); hy_u8(p, l, b, t0 + t, 512 + c0, v);
#pragma unroll
        for (int e = 0; e < 8; ++e) T[(c0 + e) * 72 + t] = (unsigned short)f2bf_u(v[e] * x1[e]);
    }
    __syncthreads();
    {
        const int c = tix >> 1, half = tix & 1;
        unsigned short* dst = p.VXT + ((size_t)(b * 256 + c)) * SEQ + t0 + 32 * half;
#pragma unroll
        for (int k = 0; k < 4; ++k) *(v4u*)(dst + 8 * k) = *(const LAS v4u*)(lds + (c * 72 + 32 * half + 8 * k) * 2);
    }
    __syncthreads();
}
template <int ALPHA>
__device__ __forceinline__ bf16x8 hy_afrag(const LAS unsigned char* a) {
    constexpr int SFT = 8 - ALPHA, SIG = SFT >> 1, HALF = SFT & 1;
    const v4u Y = *(const LAS v4u*)(a + 16);
    if constexpr (ALPHA == 0) { return __builtin_bit_cast(bf16x8, Y); }
    else {
        const v4u X = *(const LAS v4u*)a;
        const unsigned W[9] = { X.x, X.y, X.z, X.w, Y.x, Y.y, Y.z, Y.w, 0u };
        v4u o;
        o.x = HALF ? __builtin_amdgcn_alignbit(W[SIG + 1], W[SIG + 0], 16) : W[SIG + 0];
        o.y = HALF ? __builtin_amdgcn_alignbit(W[SIG + 2], W[SIG + 1], 16) : W[SIG + 1];
        o.z = HALF ? __builtin_amdgcn_alignbit(W[SIG + 3], W[SIG + 2], 16) : W[SIG + 2];
        o.w = HALF ? __builtin_amdgcn_alignbit(W[SIG + 4], W[SIG + 3], 16) : W[SIG + 3];
        return __builtin_bit_cast(bf16x8, o);
    }
}
template <int ALPHA>
__device__ __forceinline__ void hy_stream(LAS unsigned char* lds, int lane, f32x16 (&acc)[4]) {
    const int r = lane & 31, hf = lane >> 5, Il = r >> 2, bt = r & 3;
    LAS unsigned char* a_base = lds + HY_CP + 2 * (HY_MOFF + 8 * (hf - r) + 4096) - 12288;
    LAS unsigned char* b_base = lds + HY_U + ((Il * 4 + bt) * HY_US + 8 * hf) * 2;
    asm volatile("" : "+v"(a_base), "+v"(b_base));
    const bf16x8 zero8 = {0, 0, 0, 0, 0, 0, 0, 0};
#pragma unroll 1
    for (int s = 0; s < 16; ++s) {
        LAS unsigned char* ap = a_base + 32 * s; LAS unsigned char* bp = b_base + 32 * s;
#pragma unroll 1
        for (int delta = 0; delta < 8; ++delta) {
            const bf16x8 a0 = hy_afrag<ALPHA>(ap + 3 * 4096), a1 = hy_afrag<ALPHA>(ap + 2 * 4096), a2 = hy_afrag<ALPHA>(ap + 4096), a3 = hy_afrag<ALPHA>(ap);
            bf16x8 b0 = *(const LAS bf16x8*)bp, b1 = *(const LAS bf16x8*)(bp + 16896), b2 = *(const LAS bf16x8*)(bp + 2 * 16896);
            LAS unsigned char* bp3 = bp + 3 * 16896;
            bf16x8 b3 = *(const LAS bf16x8*)bp3, b4 = *(const LAS bf16x8*)(bp3 + 16896);
            b0 = (Il >= delta) ? b0 : zero8; b4 = (Il < delta) ? b4 : zero8;
            acc[0] = __builtin_amdgcn_mfma_f32_32x32x16_bf16(a0, b2, acc[0], 0, 0, 0);
            acc[1] = __builtin_amdgcn_mfma_f32_32x32x16_bf16(a0, b3, acc[1], 0, 0, 0);
            acc[2] = __builtin_amdgcn_mfma_f32_32x32x16_bf16(a0, b4, acc[2], 0, 0, 0);
            acc[3] = __builtin_amdgcn_mfma_f32_32x32x16_bf16(a1, b4, acc[3], 0, 0, 0);
            acc[0] = __builtin_amdgcn_mfma_f32_32x32x16_bf16(a1, b1, acc[0], 0, 0, 0);
            acc[1] = __builtin_amdgcn_mfma_f32_32x32x16_bf16(a1, b2, acc[1], 0, 0, 0);
            acc[2] = __builtin_amdgcn_mfma_f32_32x32x16_bf16(a1, b3, acc[2], 0, 0, 0);
            acc[3] = __builtin_amdgcn_mfma_f32_32x32x16_bf16(a2, b3, acc[3], 0, 0, 0);
            acc[0] = __builtin_amdgcn_mfma_f32_32x32x16_bf16(a2, b0, acc[0], 0, 0, 0);
            acc[1] = __builtin_amdgcn_mfma_f32_32x32x16_bf16(a2, b1, acc[1], 0, 0, 0);
            acc[2] = __builtin_amdgcn_mfma_f32_32x32x16_bf16(a2, b2, acc[2], 0, 0, 0);
            acc[3] = __builtin_amdgcn_mfma_f32_32x32x16_bf16(a3, b2, acc[3], 0, 0, 0);
            acc[1] = __builtin_amdgcn_mfma_f32_32x32x16_bf16(a3, b0, acc[1], 0, 0, 0);
            acc[2] = __builtin_amdgcn_mfma_f32_32x32x16_bf16(a3, b1, acc[2], 0, 0, 0);
            if (delta == 0) {
                const bf16x8 a4 = hy_afrag<ALPHA>(ap - 4096);
                acc[2] = __builtin_amdgcn_mfma_f32_32x32x16_bf16(a4, b0, acc[2], 0, 0, 0);
                acc[3] = __builtin_amdgcn_mfma_f32_32x32x16_bf16(a4, b1, acc[3], 0, 0, 0);
            }
            ap -= 512; bp -= 2112;
        }
    }
}
__device__ __forceinline__ void hy_h2_channel(const Params& p, int l, LAS unsigned char* lds, int c, int tix) {
    const int lane = tix & 63, wave = __builtin_amdgcn_readfirstlane(tix >> 6);
    __syncthreads();
    for (int item = tix; item < 4096; item += 512) {
        const int bt = item >> 10, j = (item & 1023) * 8;
        *(LAS v4u*)(lds + HY_U + (((j >> 8) * 4 + bt) * HY_US + (j & 255)) * 2) = *(const v4u*)(p.VXT + ((size_t)(bt * 256 + c)) * SEQ + j);
    }
    {
        const unsigned short* g1 = p.G1 + ((size_t)l * 256 + c) * G1N;
        for (int item = tix; item < G1N / 8; item += 512) *(LAS v4u*)(lds + HY_CP + item * 16) = *(const v4u*)(g1 + item * 8);
    }
    __syncthreads();
    f32x16 acc[4];
#pragma unroll
    for (int i = 0; i < 4; ++i)
#pragma unroll
        for (int k = 0; k < 16; ++k) acc[i][k] = 0.f;
    switch (wave) {
        case 0: hy_stream<0>(lds, lane, acc); break;
        case 1: hy_stream<1>(lds, lane, acc); break;
        case 2: hy_stream<2>(lds, lane, acc); break;
        case 3: hy_stream<3>(lds, lane, acc); break;
        case 4: hy_stream<4>(lds, lane, acc); break;
        case 5: hy_stream<5>(lds, lane, acc); break;
        case 6: hy_stream<6>(lds, lane, acc); break;
        default: hy_stream<7>(lds, lane, acc); break;
    }
    const int r = lane & 31, hf = lane >> 5;
    LAS float* ST = (LAS float*)(lds + HY_U);
#pragma unroll
    for (int half = 0; half < 2; ++half) {
        __syncthreads();
#pragma unroll
        for (int ii = 0; ii < 2; ++ii)
#pragma unroll
            for (int k = 0; k < 16; ++k)
                ST[(32 * ii + r) * 257 + 8 * ((k & 3) + 8 * (k >> 2) + 4 * hf) + wave] = acc[2 * half + ii][k];
        __syncthreads();
        for (int item = tix; item < 64 * 64; item += 512) {
            const int R = item >> 6, c4 = (item & 63) * 4;
            f32x4 v; v.x = ST[R * 257 + c4]; v.y = ST[R * 257 + c4 + 1]; v.z = ST[R * 257 + c4 + 2]; v.w = ST[R * 257 + c4 + 3];
            *(f32x4*)(p.CONV + ((size_t)((R & 3) * 256 + c)) * SEQ + 256 * (16 * half + (R >> 2)) + c4) = v;
        }
    }
}
__device__ __forceinline__ void hy_h3_unit(const Params& p, int l, LAS unsigned char* lds, int u, int tix) {
    const int b = u / (SEQ / 64), t0 = (u % (SEQ / 64)) * 64;
    LAS float* T = (LAS float*)lds;
    for (int item = tix; item < 4096; item += 512) {
        const int c = item >> 4, t4 = (item & 15) * 4;
        *(LAS f32x4*)(T + c * 68 + t4) = *(const f32x4*)(p.CONV + ((size_t)(b * 256 + c)) * SEQ + t0 + t4);
    }
    __syncthreads();
    const int t = tix & 63, cg = tix >> 6;
#pragma unroll 1
    for (int o = 0; o < 4; ++o) {
        const int c0 = 32 * cg + 8 * o;
        float x0[8], x1[8], v[8]; hy_u8(p, l, b, t0 + t, c0, x0); hy_u8(p, l, b, t0 + t, 256 + c0, x1); hy_u8(p, l, b, t0 + t, 512 + c0, v);
        float y[8];
#pragma unroll
        for (int e = 0; e < 8; ++e) y[e] = (T[(c0 + e) * 68 + t] + v[e] * x1[e] * p.hy_bias[l * 256 + c0 + e]) * x0[e];
        v4u w; w.x = pk2(y[0], y[1]); w.y = pk2(y[2], y[3]); w.z = pk2(y[4], y[5]); w.w = pk2(y[6], y[7]);
        *(v4u*)(p.Y + (size_t)(b * SEQ + t0 + t) * DM + 384 + c0) = w;
    }
    __syncthreads();
}

__global__ void __launch_bounds__(512, 2) mega_fwd(Params p_arg) {
    extern __shared__ __attribute__((aligned(16))) unsigned char lds_raw[];
    LAS unsigned char* lds = (LAS unsigned char*)lds_raw;
    cg::grid_group grid = cg::this_grid();
    const long nth = (long)gridDim.x * 512;
    const int NGW = gridDim.x * 8, G = gridDim.x;
    const int wave_s = __builtin_amdgcn_readfirstlane((int)threadIdx.x >> 6);
#define MY_TIX() ([&]() { unsigned z_ = 0u; asm volatile("" : "+v"(z_)); return (wave_s << 6) | (int)__builtin_amdgcn_mbcnt_hi(~0u, __builtin_amdgcn_mbcnt_lo(~0u, z_)); }())
    constexpr int LDS_BARW = LDS_BYTES - 64;
    if (threadIdx.x < 2) ((LAS unsigned*)(lds + LDS_BARW))[threadIdx.x] = 0u;
    __syncthreads();
    { const __attribute__((address_space(4))) Params* kp0 = (const __attribute__((address_space(4))) Params*)__builtin_amdgcn_kernarg_segment_ptr();
      (void)xcd_barrier_post(kp0->BAR, (volatile LAS unsigned*)(lds + LDS_BARW)); }
#define GSYNC() do { const __attribute__((address_space(4))) Params* kpb_ = (const __attribute__((address_space(4))) Params*)__builtin_amdgcn_kernarg_segment_ptr(); \
    asm volatile("" : "+s"(kpb_)); XcdBarrier xb_; xb_.bar = kpb_->BAR; xb_.x = xb_xcc_id(); xb_.st = (volatile LAS unsigned*)(lds + LDS_BARW); xcd_barrier(xb_, MY_TIX() == 0); } while (0)
#define PH_IDS() int tix_ = MY_TIX(); asm volatile("" : "+v"(tix_)); const long tid = (long)blockIdx.x * 512 + tix_; const int lane = tix_ & 63; \
    const int wave = __builtin_amdgcn_readfirstlane(tix_ >> 6); const int gw = blockIdx.x * 8 + wave; (void)tid; (void)lane; (void)gw; \
    const __attribute__((address_space(4))) Params* kp_ = (const __attribute__((address_space(4))) Params*)__builtin_amdgcn_kernarg_segment_ptr(); \
    asm volatile("" : "+s"(kp_)); const Params& p = *(const Params*)kp_;

    for (int rep = 0; rep < REP_PRO; ++rep) {
    { PH_IDS(); for (int q = 0; q < REP_MOD; ++q) mod_partial(p, tid, nth, (float*)p.DSS); for (int q = 0; q < REP_F1; ++q) st_filt1(p, tid, nth);
      for (int q = 0; q < REP_WT; ++q) prologue_weights(p, (LAS float*)(lds + wave * 16384), gw, NGW, lane); }
    grid.sync();
    { PH_IDS(); mod_reduce(p, tid, nth, (const float*)p.DSS); st_filt2(p, tid, nth); }
    GSYNC();
    { PH_IDS(); for (int q = 0; q < REP_F3; ++q) filt3_gpu(p, lds, tid, nth, tix_, blockIdx.x, G); }
    GSYNC();
    }
#pragma unroll 1
    for (int l = 0; l < DEPTH; ++l) {
        const int nrows = (l == DEPTH - 1) ? BL : NT;
        for (int rep = 0; rep < REP_HX; ++rep) {
        { PH_IDS(); hx_pass<false>(p, l, 0, 0, (CTX_SPLITK && l > 0) ? BL : NT, gw, NGW, lane); }
        if (CTX_SPLITK && l > 0) { PH_IDS(); hx_pass<true>(p, l, 0, BL, NT, gw, NGW, lane, DFF / 256, (const float*)p.DSG, p.MOD + ((size_t)(l - 1) * (NB + 1) + NB) * 6 * DM + 5 * DM, false); }
        GSYNC();
        }
        for (int rep = 0; rep < REP_G1; ++rep)
        {   PH_IDS();
            pg8::Gemm g{p.Y, p.WIN_T + (size_t)l * LDP * DM, NT, LDP, DM, DM}; pg8::StaticOrder S; S.init(NT, LDP, G, (int)blockIdx.x);
            pg8::EpiBf16<0> E{p.P, LDP, nullptr, 0, 0, 1.f};
            pg8::gemm_phase<pg8::EpiBf16<0>, pg8::StaticOrder, true, true>(lds, g, S, E, tix_);
            GSYNC();
        }
        for (int rep = 0; rep < REP_MIX; ++rep) {
        for (int qa = 0; qa < REP_PA; ++qa)
        {   PH_IDS();
            for (int u = blockIdx.x; u < SSD_UNITS; u += G) ssd_s2_unit(p, l, lds, u, tix_, p.DSS, p.DECS);
            gla_m2_phase(p, l, lds, tix_, blockIdx.x, p.DSG, p.DECG);
            for (int u = blockIdx.x; u < NB * (SEQ / 64); u += G) hy_h1_unit(p, l, lds, u, tix_);
            if (l < DEPTH - 1) st_hy_pre(p, l, tid, nth, BL, NT);
        }
        GSYNC();
        {   PH_IDS();
            for (int q = 0; q < REP_H2; ++q) for (int c = blockIdx.x; c < 256; c += G) hy_h2_channel(p, l, lds, c, tix_);
            {
                const long vt = ((long)wave * G + blockIdx.x) * 64 + lane;
                if (nth >= 131072) {
                    if (vt < 49152) ssd_s3(vt, 49152, p.DSS, p.DECS);
                    else if (vt < 49152 + 24576) { for (int q = 0; q < REP_M3; ++q) gla_m3(vt - 49152, 24576, p.DSG, p.DECG, p.SSG); }
                    else if (l < DEPTH - 1) hy_ctx_conv(p, l, vt - (49152 + 24576), nth - (49152 + 24576));
                } else { ssd_s3(vt, nth, p.DSS, p.DECS); gla_m3(vt, nth, p.DSG, p.DECG, p.SSG); if (l < DEPTH - 1) hy_ctx_conv(p, l, vt, nth); }
            }
        }
        GSYNC();
        for (int qc = 0; qc < REP_PC; ++qc)
        {   PH_IDS();
            for (int u = blockIdx.x; u < SSD_UNITS; u += G) ssd_s4_unit(p, l, lds, u, tix_, p.DSS);
            gla_m4_phase(p, l, lds, tix_, blockIdx.x, p.SSG);
            for (int u = blockIdx.x; u < NB * (SEQ / 64); u += G) hy_h3_unit(p, l, lds, u, tix_);
        }
        GSYNC();
        }
        {   PH_IDS();
            const int mrows = (CTX_SPLITK || l == DEPTH - 1) ? BL : NT; pg8::Gemm g{p.Y, p.WOUT_T + (size_t)l * DM * DM, mrows, DM, DM, DM}; pg8::StaticOrder S; S.init(mrows, DM, G, (int)blockIdx.x);
            pg8::EpiRes E{p.XL, p.XC, p.MOD + (size_t)l * (NB + 1) * 6 * DM, 2, l == 0 ? p.x : p.XL, l == 0 ? p.ctx : p.XC};
            pg8::gemm_phase<pg8::EpiRes, pg8::StaticOrder, true, true>(lds, g, S, E, tix_);
        }
        if (CTX_SPLITK && l < DEPTH - 1) {   PH_IDS();
            {
                pg8::Gemm gc{p.Y + (size_t)BL * DM, p.WOUT_T + (size_t)l * DM * DM, BC, DM, 256, DM}; pg8::SplitKOrder SC; SC.init(BC, DM, DM / 256, 256, G, (int)blockIdx.x);
                pg8::EpiSlab EC{(float*)p.DSG, BC, 512};
                pg8::gemm_phase<pg8::EpiSlab, pg8::SplitKOrder, true, true>(lds, gc, SC, EC, tix_);
            }
        }
        GSYNC();
        for (int rep = 0; rep < REP_HX; ++rep) {
        { PH_IDS(); hx_pass<false>(p, l, 1, 0, CTX_SPLITK ? BL : nrows, gw, NGW, lane); }
        if (CTX_SPLITK && l < DEPTH - 1) { PH_IDS(); hx_pass<true>(p, l, 1, BL, NT, gw, NGW, lane, DM / 256, (const float*)p.DSG, p.MOD + ((size_t)l * (NB + 1) + NB) * 6 * DM + 2 * DM, l == 0); }
        GSYNC();
        }
        for (int rep = 0; rep < REP_G3; ++rep)
        {   PH_IDS();
            pg8::Gemm g{p.Y, p.W13_T + (size_t)l * NFF2 * DM, nrows, NFF2, DM, DM}; pg8::StaticOrder S; S.init(nrows, NFF2, G, (int)blockIdx.x);
            pg8::EpiSwiGLU E{p.P};
            pg8::gemm_phase<pg8::EpiSwiGLU, pg8::StaticOrder, true, true>(lds, g, S, E, tix_);
            GSYNC();
        }
        {   PH_IDS();
            const int mrows = (CTX_SPLITK || l == DEPTH - 1) ? BL : NT; pg8::Gemm g{p.P, p.W2_T + (size_t)l * DM * DFF, mrows, DM, DFF, DFF}; pg8::StaticOrder S; S.init(mrows, DM, G, (int)blockIdx.x);
            pg8::EpiRes E{p.XL, p.XC, p.MOD + (size_t)l * (NB + 1) * 6 * DM, 5, p.XL, p.XC};
            pg8::gemm_phase<pg8::EpiRes, pg8::StaticOrder, true, true>(lds, g, S, E, tix_);
        }
        if (CTX_SPLITK && l < DEPTH - 1) {   PH_IDS();
            {
                pg8::Gemm gc{p.P + (size_t)BL * DFF, p.W2_T + (size_t)l * DM * DFF, BC, DM, 256, DFF}; pg8::SplitKOrder SC; SC.init(BC, DM, DFF / 256, 256, G, (int)blockIdx.x);
                pg8::EpiSlab EC{(float*)p.DSG, BC, 512};
                pg8::gemm_phase<pg8::EpiSlab, pg8::SplitKOrder, true, true>(lds, gc, SC, EC, tix_);
            }
        }
        GSYNC();
    }
    { PH_IDS(); final_pass(p, gw, NGW, lane); }
}

extern "C" void kernel_launch(void* const* d_in, const int* in_sizes, int n_in, void* d_out, int out_size,
                              void* d_ws, size_t ws_size, hipStream_t stream) {
    static int grid_blocks = 0;
    if (!grid_blocks) {
        int dev = 0, cus = 0, per_cu = 0;
        (void)hipGetDevice(&dev);
        (void)hipDeviceGetAttribute(&cus, hipDeviceAttributeMultiprocessorCount, dev);
        (void)hipFuncSetAttribute((const void*)mega_fwd, hipFuncAttributeMaxDynamicSharedMemorySize, LDS_BYTES);
        (void)hipOccupancyMaxActiveBlocksPerMultiprocessor(&per_cu, mega_fwd, 512, LDS_BYTES);
        if (per_cu < 1) per_cu = 1;
        grid_blocks = cus;
    }
    Params p{};
    fill_inputs(p, d_in);
    carve(p, (char*)d_ws, (float*)d_out);
    (void)hipMemsetAsync(p.BAR, 0, 16384, stream);
    void* args[] = { &p };
    hipError_t e = hipLaunchCooperativeKernel((void*)mega_fwd, dim3(grid_blocks), dim3(512), args, LDS_BYTES, stream);
    if (e != hipSuccess) fprintf(stderr, "cooperative launch failed: %s (grid %d)\n", hipGetErrorString(e), grid_blocks);
}
#endif
```

```cpp
#ifndef CPU_EMU
#include <hip/hip_runtime.h>
#include <hip/hip_cooperative_groups.h>
#include <cstdio>
#else
#include <cmath>
#include <cstring>
#include <cstdio>
#include <cstdlib>
#define __device__
#define __global__
#define __forceinline__ inline
#define __host__
#endif
#include <stdint.h>
#include <stddef.h>

#ifndef NB
#define NB 4
#endif
#ifndef SEQ
#define SEQ 8192
#endif
#ifndef CTX
#define CTX 256
#endif
#define DEPTH 2
#define DM 1024
#define GRID_W 64
#define ROWS_G (SEQ / GRID_W)
#define BL (NB * SEQ)
#define BC (NB * CTX)
#define NT (BL + BC)
#define NSEQ (2 * NB)
#define DIN 3244
#define LDP 3328
#define NFF2 (2 * DFF)
#define OFF_Q 0
#define OFF_K 192
#define OFF_V 384
#define OFF_G 768
#define OFF_GKF 1152
#define OFF_GKB 1168
#define OFF_HY 1184
#define OFF_Z 1952
#define OFF_XBC 2336
#define OFF_DTF 3232
#define OFF_DTB 3238
#define DFF 2816
#define TF (SEQ + CTX)
#define G1N 8720
#define EPSV 1e-6f

#ifdef ACT_FP32
typedef float act_t;
__device__ __forceinline__ float ldact(const act_t* p) { return *p; }
__device__ __forceinline__ void stact(act_t* p, float v) { *p = v; }
#else
typedef unsigned short act_t;
__device__ __forceinline__ float ldact(const act_t* p) {
    union { unsigned u; float f; } x; x.u = ((unsigned)*p) << 16; return x.f;
}
__device__ __forceinline__ void stact(act_t* p, float v) {
    union { float f; unsigned u; } x; x.f = v;
    unsigned r = x.u + 0x7FFFu + ((x.u >> 16) & 1u);
    *p = (unsigned short)(r >> 16);
}
#endif

struct Params {
    const float *x, *c, *ctx, *c_ctx, *mod_w, *mod_b, *norm1_g, *norm2_g, *w_in;
    const float *gk_w_f, *gk_b_f, *gk_w_b, *gk_b_b, *gla_norm_w;
    const float *hy_short_w, *hy_short_b, *hy_w1, *hy_b1, *hy_w2, *hy_b2, *hy_w3, *hy_freq, *hy_decay, *hy_bias;
    const float *ssd_conv_w, *ssd_conv_b, *ssd_dt_bias_f, *ssd_dt_bias_b, *ssd_a_log_f, *ssd_a_log_b, *ssd_d, *ssd_norm_w;
    const float *w_out, *ffn_w1, *ffn_w3, *ffn_w2, *final_g;
    float* XL;
    float* XC;
    float* MOD;
    float* HF;
    float* H1;
    float* H2;
    float* RSTD;
    act_t* P;
    act_t* Y;
    float* LG;
    float* O;
    act_t* XBC;
    float* YS;
    float* DT;
    float* VX;
    unsigned* BAR;
    unsigned short* G1;
    unsigned short* VXT;
    float* CONV;
    float* HFC;
    unsigned short *DSG, *SSG, *DSS;
    float *DECG, *DECS;
    unsigned short *WIN_T, *WOUT_T, *W13_T, *W2_T;
};

__device__ __forceinline__ float siluf(float x) { return x / (1.0f + expf(-x)); }
__device__ __forceinline__ float softplusf(float x) { return fmaxf(x, 0.0f) + log1pf(expf(-fabsf(x))); }
__device__ __forceinline__ float logsigmoidf(float x) { return -softplusf(-x); }

__device__ __forceinline__ float* xrow(const Params& p, int r) {
    return r < BL ? p.XL + (size_t)r * DM : p.XC + (size_t)(r - BL) * DM;
}
__device__ __forceinline__ int row_bb(int r) { return r < BL ? r / SEQ : NB; }
__device__ __forceinline__ int seq_len(int s) { return s < NB ? SEQ : CTX; }
__device__ __forceinline__ int seq_row0(int s) { return s < NB ? s * SEQ : BL + (s - NB) * CTX; }
__device__ __forceinline__ int colmajor_tok(int s, int pos) {
    return s < NB ? (pos % ROWS_G) * GRID_W + pos / ROWS_G : pos;
}

__device__ void st_init(const Params& p, long tid, long nth) {
    for (long i = tid; i < (long)BL * DM; i += nth) p.XL[i] = p.x[i];
    for (long i = tid; i < (long)BC * DM; i += nth) p.XC[i] = p.ctx[i];
}
__device__ void st_mod(const Params& p, long tid, long nth) {
    const long total = (long)DEPTH * (NB + 1) * 6 * DM;
    for (long i = tid; i < total; i += nth) {
        int n = (int)(i % (6 * DM));
        int bb = (int)((i / (6 * DM)) % (NB + 1));
        int l = (int)(i / ((long)6 * DM * (NB + 1)));
        const float* cv = bb < NB ? p.c + (size_t)bb * DM : p.c_ctx;
        const float* w = p.mod_w + (size_t)l * DM * 6 * DM + n;
        float acc = 0.f;
        for (int k = 0; k < DM; ++k) acc += siluf(cv[k]) * w[(size_t)k * 6 * DM];
        p.MOD[i] = acc + p.mod_b[(size_t)l * 6 * DM + n];
    }
}
__device__ __forceinline__ void filt_pos(int tt, float& rel) {
    int L = tt < SEQ ? SEQ : CTX; int t = tt < SEQ ? tt : tt - SEQ;
    rel = ((float)t - (float)(L / 2)) / (float)L;
}
__device__ void st_filt1(const Params& p, long tid, long nth) {
    const long total = (long)DEPTH * TF * 64;
    for (long i = tid; i < total; i += nth) {
        int o = (int)(i % 64); int tt = (int)((i / 64) % TF); int l = (int)(i / (64L * TF));
        float rel; filt_pos(tt, rel);
        const float* w1 = p.hy_w1 + (size_t)l * 33 * 64 + o;
        float acc = rel * w1[0];
        const float tw = 2.0f * 3.14159265358979323846f * rel;
        for (int j = 0; j < 16; ++j) {
            float band = 1e-4f + (float)j * ((15.0f - 1e-4f) / 15.0f);
            float ang = tw * band;
            acc += cosf(ang) * w1[(size_t)(1 + j) * 64];
            acc += -sinf(ang) * w1[(size_t)(17 + j) * 64];
        }
        p.H1[i] = sinf(p.hy_freq[l * 64 + o] * (acc + p.hy_b1[l * 64 + o]));
    }
}
__device__ void st_filt2(const Params& p, long tid, long nth) {
    const long total = (long)DEPTH * TF * 64;
    for (long i = tid; i < total; i += nth) {
        int o = (int)(i % 64); int l = (int)(i / (64L * TF));
        const float* h1 = p.H1 + (i - o);
        const float* w2 = p.hy_w2 + (size_t)l * 64 * 64 + o;
        float acc = 0.f;
        for (int j = 0; j < 64; ++j) acc += h1[j] * w2[(size_t)j * 64];
        p.H2[i] = sinf(p.hy_freq[l * 64 + o] * (acc + p.hy_b2[l * 64 + o]));
    }
}
__device__ void st_filt3(const Params& p, long tid, long nth) {
    const long total = (long)DEPTH * TF * 256;
    for (long i = tid; i < total; i += nth) {
        int c = (int)(i % 256); int tt = (int)((i / 256) % TF); int l = (int)(i / (256L * TF));
        float rel; filt_pos(tt, rel);
        const float* h2 = p.H2 + ((size_t)l * TF + tt) * 64;
        const float* w3 = p.hy_w3 + (size_t)l * 64 * 256 + c;
        float acc = 0.f;
        for (int j = 0; j < 64; ++j) acc += h2[j] * w3[(size_t)j * 256];
        const float hv = acc * expf(-2.0f * fabsf(rel) * p.hy_decay[l * 256 + c]);
        p.HF[i] = hv;
#ifndef CPU_EMU
        if (tt < SEQ) { unsigned short* q = p.G1 + ((size_t)l * 256 + c) * G1N + (8456 - tt); stact(q, hv); }
#endif
    }
#ifndef CPU_EMU
    constexpr int NPAD = 265 + (G1N - 8457);
    for (long i = tid; i < (long)DEPTH * 256 * NPAD; i += nth) {
        const int k = (int)(i % NPAD); const long lc = i / NPAD;
        p.G1[lc * G1N + (k < 265 ? k : 8457 + (k - 265))] = 0;
    }
#endif
}
__device__ void st_rstd(const Params& p, long tid, long nth) {
    for (long r = tid; r < NT; r += nth) {
        const float* xr = xrow(p, (int)r);
        float ss = 0.f;
        for (int k = 0; k < DM; ++k) ss += xr[k] * xr[k];
        p.RSTD[r] = 1.0f / sqrtf(ss / (float)DM + EPSV);
    }
}
__device__ void st_hx(const Params& p, int l, int which, long tid, long nth) {
    const float* g = (which ? p.norm2_g : p.norm1_g) + (size_t)l * DM;
    for (long i = tid; i < (long)NT * DM; i += nth) {
        int k = (int)(i % DM); int r = (int)(i / DM);
        const float* m = p.MOD + ((size_t)l * (NB + 1) + row_bb(r)) * 6 * DM;
        float sh = m[(which ? 3 : 0) * DM + k], sc = m[(which ? 4 : 1) * DM + k];
        float v = xrow(p, r)[k] * p.RSTD[r] * g[k];
        stact(p.Y + i, v * (1.0f + sc) + sh);
    }
}
template <int MODE>
__device__ void st_gemm(const Params& p, int l, int nrows, long tid, long nth) {
    const int N = MODE == 0 ? DIN : (MODE == 2 ? DFF : DM);
    const int K = MODE == 3 ? DFF : DM;
    const act_t* A = MODE == 3 ? p.P : p.Y;
    const int lda = MODE == 3 ? DFF : DM;
    const float* W = MODE == 0 ? p.w_in + (size_t)l * DM * DIN
                   : MODE == 1 ? p.w_out + (size_t)l * DM * DM
                   : MODE == 2 ? p.ffn_w1 + (size_t)l * DM * DFF
                               : p.ffn_w2 + (size_t)l * DFF * DM;
    const float* W3 = p.ffn_w3 + (size_t)l * DM * DFF;
    const int NQ = N / 4;
    const long total = (long)(nrows / 8) * NQ;
    for (long i = tid; i < total; i += nth) {
        const int cq = (int)(i % NQ); const int r0 = (int)(i / NQ) * 8; const int n0 = cq * 4;
        float acc[8][4]; float acc3[8][4];
#pragma unroll
        for (int a = 0; a < 8; ++a)
#pragma unroll
            for (int b = 0; b < 4; ++b) { acc[a][b] = 0.f; acc3[a][b] = 0.f; }
        for (int k = 0; k < K; ++k) {
            const float* wr = W + (size_t)k * N + n0;
            float w0 = wr[0], w1 = wr[1], w2 = wr[2], w3 = wr[3];
            float v0 = 0, v1 = 0, v2 = 0, v3 = 0;
            if (MODE == 2) { const float* w3r = W3 + (size_t)k * N + n0; v0 = w3r[0]; v1 = w3r[1]; v2 = w3r[2]; v3 = w3r[3]; }
#pragma unroll
            for (int a = 0; a < 8; ++a) {
                float av = ldact(A + (size_t)(r0 + a) * lda + k);
                acc[a][0] += av * w0; acc[a][1] += av * w1; acc[a][2] += av * w2; acc[a][3] += av * w3;
                if (MODE == 2) { acc3[a][0] += av * v0; acc3[a][1] += av * v1; acc3[a][2] += av * v2; acc3[a][3] += av * v3; }
            }
        }
        const int bb = row_bb(r0);
        const float* m = p.MOD + ((size_t)l * (NB + 1) + bb) * 6 * DM;
#pragma unroll
        for (int a = 0; a < 8; ++a) {
            const int r = r0 + a;
#pragma unroll
            for (int b = 0; b < 4; ++b) {
                const int n = n0 + b;
                if (MODE == 0) stact(p.P + (size_t)r * LDP + n, acc[a][b]);
                else if (MODE == 1) xrow(p, r)[n] += m[2 * DM + n] * acc[a][b];
                else if (MODE == 2) stact(p.P + (size_t)r * DFF + n, siluf(acc[a][b]) * acc3[a][b]);
                else xrow(p, r)[n] += m[5 * DM + n] * acc[a][b];
            }
        }
    }
}
__device__ void st_gla_logs(const Params& p, int l, long tid, long nth) {
    const long total = 2L * NT * 192;
    for (long i = tid; i < total; i += nth) {
        int col = (int)(i % 192); int r = (int)((i / 192) % NT); int dir = (int)(i / (192L * NT));
        const act_t* gk = p.P + (size_t)r * LDP + (dir ? OFF_GKB : OFF_GKF);
        const float* w = (dir ? p.gk_w_b : p.gk_w_f) + (size_t)l * 16 * 192 + col;
        float acc = (dir ? p.gk_b_b : p.gk_b_f)[l * 192 + col];
        for (int j = 0; j < 16; ++j) acc += ldact(gk + j) * w[j * 192];
        p.LG[i] = logsigmoidf(acc) * (1.0f / 16.0f);
    }
}
__device__ void st_gla_scan(const Params& p, long tid, long nth) {
    const long total = (long)NB * 6 * 64;
    for (long i = tid; i < total; i += nth) {
        const int e = (int)(i % 64); const int h = (int)((i / 64) % 6); const int b = (int)(i / 384);
        for (int dir = 0; dir < 2; ++dir) {
            float S[32];
#pragma unroll
            for (int d = 0; d < 32; ++d) S[d] = 0.f;
            const float* lg = p.LG + (size_t)dir * NT * 192;
            for (int part = 0; part < 2; ++part) {
                const int s = part == 0 ? NB + b : b;
                const int L = seq_len(s), r0 = seq_row0(s);
                for (int st = 0; st < L; ++st) {
                    const int t = dir == 0 ? st : L - 1 - st;
                    const int r = r0 + t;
                    const act_t* pr = p.P + (size_t)r * LDP;
                    const float* lr = lg + (size_t)r * 192 + h * 32;
                    const float v = ldact(pr + OFF_V + h * 64 + e);
                    float o = 0.f;
#pragma unroll
                    for (int d = 0; d < 32; ++d) {
                        S[d] = expf(lr[d]) * S[d] + ldact(pr + OFF_K + h * 32 + d) * v;
                        o += ldact(pr + OFF_Q + h * 32 + d) * S[d];
                    }
                    o *= 0.17677669529663687f;
                    float* op = p.O + (size_t)r * 384 + h * 64 + e;
                    if (dir == 0) *op = o; else *op += o;
                }
            }
        }
    }
}
__device__ void st_gla_out(const Params& p, int l, long tid, long nth) {
    const long total = (long)NT * 6;
    for (long i = tid; i < total; i += nth) {
        const int h = (int)(i % 6); const int r = (int)(i / 6);
        const float* o = p.O + (size_t)r * 384 + h * 64;
        float ss = 0.f;
        for (int e = 0; e < 64; ++e) ss += o[e] * o[e];
        const float rs = 1.0f / sqrtf(ss / 64.0f + EPSV);
        for (int e = 0; e < 64; ++e) {
            float g = ldact(p.P + (size_t)r * LDP + OFF_G + h * 64 + e);
            stact(p.Y + (size_t)r * DM + h * 64 + e, o[e] * rs * p.gla_norm_w[l * 64 + e] * siluf(g));
        }
    }
}
__device__ __forceinline__ float hy_u(const Params& p, int l, int s, int t, int j) {
    const int L = seq_len(s), r0 = seq_row0(s);
    const float* w = p.hy_short_w + (size_t)l * 3 * 768 + j;
    float acc = p.hy_short_b[l * 768 + j];
#pragma unroll
    for (int k = 0; k < 3; ++k) {
        int tt = t + k - 1;
        if (tt >= 0 && tt < L) acc += w[k * 768] * ldact(p.P + (size_t)(r0 + tt) * LDP + OFF_HY + j);
    }
    return acc;
}
__device__ void st_hy_pre(const Params& p, int l, long tid, long nth, int r_lo = 0, int r_hi = NT) {
    const long total = (long)(r_hi - r_lo) * 256;
    for (long i = tid; i < total; i += nth) {
        const int c = (int)(i % 256); const int r = r_lo + (int)(i / 256);
        const int s = r < BL ? r / SEQ : NB + (r - BL) / CTX;
        const int t = r - seq_row0(s);
        p.VX[(size_t)r * 256 + c] = hy_u(p, l, s, t, 512 + c) * hy_u(p, l, s, t, 256 + c);
    }
}
__device__ void st_hy_conv(const Params& p, int l, long tid, long nth, int r_lo = 0, int r_hi = NT) {
    const long total = (long)(r_hi - r_lo) * 256;
    for (long i = tid; i < total; i += nth) {
        const int c = (int)(i % 256); const int r = r_lo + (int)(i / 256);
        const int s = r < BL ? r / SEQ : NB + (r - BL) / CTX;
        const int L = seq_len(s), r0 = seq_row0(s);
        const int t = r - r0;
        const float* hf = p.HF + ((size_t)l * TF + (s < NB ? 0 : SEQ)) * 256 + c;
        int jlo = t + L / 2 - (L - 1); if (jlo < 0) jlo = 0;
        int jhi = t + L / 2; if (jhi > L - 1) jhi = L - 1;
        float acc = 0.f;
        for (int j = jlo; j <= jhi; ++j)
            acc += hf[(size_t)(t - j + L / 2) * 256] * p.VX[(size_t)(r0 + j) * 256 + c];
        const float x0 = hy_u(p, l, s, t, c);
        const float y = (acc + p.VX[(size_t)r * 256 + c] * p.hy_bias[l * 256 + c]) * x0;
        stact(p.Y + (size_t)r * DM + 384 + c, y);
    }
}
__device__ void st_ssd_pre(const Params& p, int l, long tid, long nth) {
    const long total = (long)NT * 896;
    for (long i = tid; i < total; i += nth) {
        const int j = (int)(i % 896); const int q = (int)(i / 896);
        const int s = q < BL ? q / SEQ : NB + (q - BL) / CTX;
        const int L = seq_len(s), r0 = seq_row0(s);
        const int pos = q - r0;
        const float* w = p.ssd_conv_w + (size_t)l * 3 * 896 + j;
        float acc = p.ssd_conv_b[l * 896 + j];
#pragma unroll
        for (int k = 0; k < 3; ++k) {
            int pp = pos + k - 1;
            if (pp >= 0 && pp < L) acc += w[k * 896] * ldact(p.P + (size_t)(r0 + colmajor_tok(s, pp)) * LDP + OFF_XBC + j);
        }
        stact(p.XBC + (size_t)(r0 + colmajor_tok(s, pos)) * 896 + j, siluf(acc));
    }
    const long total2 = 2L * NT * 6;
    for (long i = tid; i < total2; i += nth) {
        const int hd = (int)(i % 6); const int r = (int)((i / 6) % NT); const int dir = (int)(i / (6L * NT));
        float v = ldact(p.P + (size_t)r * LDP + (dir ? OFF_DTB : OFF_DTF) + hd) + (dir ? p.ssd_dt_bias_b : p.ssd_dt_bias_f)[l * 6 + hd];
        p.DT[i] = softplusf(v);
    }
}
__device__ void st_ssd_scan(const Params& p, int l, long tid, long nth) {
    const long total = (long)NB * 6 * 64;
    for (long i = tid; i < total; i += nth) {
        const int pp = (int)(i % 64); const int hd = (int)((i / 64) % 6); const int b = (int)(i / 384);
        const int g = hd / 3;
        const float dcoef = p.ssd_d[l * 6 + hd];
        for (int dir = 0; dir < 2; ++dir) {
            const float A = -expf((dir ? p.ssd_a_log_b : p.ssd_a_log_f)[l * 6 + hd]);
            float h[128];
#pragma unroll
            for (int n = 0; n < 128; ++n) h[n] = 0.f;
            for (int part = 0; part < 2; ++part) {
                const int s = part == 0 ? NB + b : b;
                const int L = seq_len(s), r0 = seq_row0(s);
                for (int st = 0; st < L; ++st) {
                    const int pos = dir == 0 ? st : L - 1 - st;
                    const int r = r0 + colmajor_tok(s, pos);
                    const act_t* xr = p.XBC + (size_t)r * 896;
                    const float dt = p.DT[((size_t)dir * NT + r) * 6 + hd];
                    const float xs = ldact(xr + hd * 64 + pp);
                    const float ea = expf(A * dt);
                    const float xd = xs * dt;
                    float y = 0.f;
#pragma unroll
                    for (int n = 0; n < 128; ++n) {
                        h[n] = ea * h[n] + xd * ldact(xr + 384 + g * 128 + n);
                        y += h[n] * ldact(xr + 640 + g * 128 + n);
                    }
                    float* yp = p.YS + (size_t)r * 384 + hd * 64 + pp;
                    if (dir == 0) *yp = y + dcoef * xs; else *yp += y;
                }
            }
        }
    }
}
__device__ void st_ssd_out(const Params& p, int l, long tid, long nth) {
    const long total = (long)NT * 2;
    for (long i = tid; i < total; i += nth) {
        const int g = (int)(i % 2); const int r = (int)(i / 2);
        const float* ys = p.YS + (size_t)r * 384 + g * 192;
        const act_t* z = p.P + (size_t)r * LDP + OFF_Z + g * 192;
        float ss = 0.f;
        for (int j = 0; j < 192; ++j) { float v = ys[j] * siluf(ldact(z + j)); ss += v * v; }
        const float rs = 1.0f / sqrtf(ss / 192.0f + EPSV);
        for (int j = 0; j < 192; ++j) {
            float v = ys[j] * siluf(ldact(z + j));
            stact(p.Y + (size_t)r * DM + 640 + g * 192 + j, v * rs * p.ssd_norm_w[l * 384 + g * 192 + j]);
        }
    }
}
__device__ void st_final(const Params& p, long tid, long nth) {
    for (long i = tid; i < (long)BL * DM; i += nth) {
        int k = (int)(i % DM); int r = (int)(i / DM);
        p.XL[i] = p.XL[i] * p.RSTD[r] * p.final_g[k];
    }
}

enum { S_INIT, S_MOD, S_F1, S_F2, S_F3, S_RSTD, S_HX1, S_GIN, S_GLOG, S_GSCAN, S_GOUT,
       S_SPRE, S_SSCAN, S_SOUT, S_HPRE, S_HCONV, S_GOUTP, S_HX2, S_FFN1, S_FFN2, S_FINAL };

__device__ void run_stage(const Params& p, int stage, int l, long tid, long nth) {
    const int nrows = (l == DEPTH - 1) ? BL : NT;
    switch (stage) {
        case S_INIT: st_init(p, tid, nth); break;
        case S_MOD: st_mod(p, tid, nth); break;
        case S_F1: st_filt1(p, tid, nth); break;
        case S_F2: st_filt2(p, tid, nth); break;
        case S_F3: st_filt3(p, tid, nth); break;
        case S_RSTD: st_rstd(p, tid, nth); break;
        case S_HX1: st_hx(p, l, 0, tid, nth); break;
        case S_GIN: st_gemm<0>(p, l, NT, tid, nth); break;
        case S_GLOG: st_gla_logs(p, l, tid, nth); break;
        case S_GSCAN: st_gla_scan(p, tid, nth); break;
        case S_GOUT: st_gla_out(p, l, tid, nth); break;
        case S_SPRE: st_ssd_pre(p, l, tid, nth); break;
        case S_SSCAN: st_ssd_scan(p, l, tid, nth); break;
        case S_SOUT: st_ssd_out(p, l, tid, nth); break;
        case S_HPRE: st_hy_pre(p, l, tid, nth); break;
        case S_HCONV: st_hy_conv(p, l, tid, nth); break;
        case S_GOUTP: st_gemm<1>(p, l, nrows, tid, nth); break;
        case S_HX2: st_hx(p, l, 1, tid, nth); break;
        case S_FFN1: st_gemm<2>(p, l, nrows, tid, nth); break;
        case S_FFN2: st_gemm<3>(p, l, nrows, tid, nth); break;
        case S_FINAL: st_final(p, tid, nth); break;
    }
}

static const int kLayerProg[] = { S_RSTD, S_HX1, S_GIN, S_GLOG, S_GSCAN, S_GOUT, S_SPRE, S_SSCAN, S_SOUT,
                                  S_HPRE, S_HCONV, S_GOUTP, S_RSTD, S_HX2, S_FFN1, S_FFN2 };
static const int kPreProg[] = { S_INIT, S_MOD, S_F1, S_F2, S_F3 };

static inline size_t al256(size_t v) { return (v + 255) & ~(size_t)255; }
static void carve(Params& p, char* ws, float* dout) {
    size_t off = 0;
    auto take = [&](size_t bytes) { char* q = ws + off; off += al256(bytes); return q; };
    p.XL = dout;
    p.XC = (float*)take((size_t)BC * DM * 4);
    p.MOD = (float*)take((size_t)DEPTH * (NB + 1) * 6 * DM * 4);
#ifdef CPU_EMU
    p.HF = (float*)take((size_t)DEPTH * TF * 256 * 4);
    p.RSTD = (float*)take((size_t)NT * 4);
    p.DT = (float*)take((size_t)2 * NT * 6 * 4);
#endif
    p.H1 = (float*)take((size_t)DEPTH * TF * 64 * 4);
    p.H2 = (float*)take((size_t)DEPTH * TF * 64 * 4);
    p.P = (act_t*)take((size_t)NT * LDP * sizeof(act_t));
    p.Y = (act_t*)take((size_t)NT * DM * sizeof(act_t));
#ifdef CPU_EMU
    char* r1 = take((size_t)NT * 896 * sizeof(act_t) + (size_t)NT * 384 * 4 + 256);
#else
    char* r1 = take((size_t)101 << 20);
#endif
    p.LG = (float*)r1;
    p.O = (float*)(r1 + al256((size_t)2 * NT * 192 * 4));
    p.XBC = (act_t*)r1;
    p.YS = (float*)(r1 + al256((size_t)NT * 896 * sizeof(act_t)));
#ifdef CPU_EMU
    p.VX = (float*)r1;
#else
    {
        char* q = r1;
        p.DSG = (unsigned short*)q; q += al256((size_t)2 * NB * 6 * ((CTX + SEQ) / 64) * 2048 * 2);
        p.SSG = (unsigned short*)q; q += al256((size_t)2 * NB * 6 * ((CTX + SEQ) / 64) * 2048 * 2);
        p.DECG = (float*)q; q += al256((size_t)2 * NB * 6 * ((CTX + SEQ) / 64) * 32 * 4);
        p.DSS = (unsigned short*)q; q += al256((size_t)2 * NB * 6 * ((CTX + SEQ) / 128) * 8192 * 2);
        p.DECS = (float*)q; q += al256((size_t)2 * NB * 6 * ((CTX + SEQ) / 128) * 4);
    }
    p.VXT = (unsigned short*)take((size_t)NB * 256 * SEQ * 2);
    p.CONV = (float*)take((size_t)NB * 256 * SEQ * 4);
    p.VX = (float*)take((size_t)BC * 256 * 4) - (size_t)BL * 256;
    p.HFC = (float*)take((size_t)DEPTH * CTX * 256 * 4);
#endif
    p.G1 = (unsigned short*)take((size_t)DEPTH * 256 * G1N * 2);
    p.BAR = (unsigned*)take(16384);
    p.WIN_T = (unsigned short*)take((size_t)DEPTH * LDP * DM * 2);
    p.WOUT_T = (unsigned short*)take((size_t)DEPTH * DM * DM * 2);
    p.W13_T = (unsigned short*)take((size_t)DEPTH * NFF2 * DM * 2);
    p.W2_T = (unsigned short*)take((size_t)DEPTH * DM * DFF * 2);
}
static void fill_inputs(Params& p, void* const* d_in) {
    const float** dst = (const float**)&p;
    for (int i = 0; i < 37; ++i) dst[i] = (const float*)d_in[i];
}

#ifndef CPU_EMU
namespace pg8 {
#define PG8_LAS __attribute__((address_space(3)))
typedef unsigned short bf16_t;
typedef short bf16x8 __attribute__((ext_vector_type(8)));
typedef float f32x4 __attribute__((ext_vector_type(4)));
typedef unsigned u32x4 __attribute__((ext_vector_type(4)));
constexpr int BM = 256, BK = 64, HALF = 128, HTB = HALF * BK * 2  , STAGE_BYTES = 8 * HTB, NXCD = 8, WGM = 8;

__host__ __device__ __forceinline__ int lds_byte(int r, int c) { const int st = (r >> 4) * 2 + (c >> 5), rr = r & 15, cc = c & 31, ob = rr * 64 + cc * 2; return st * 1024 + (ob ^ (((ob >> 9) & 1) << 5)); }
__host__ __device__ __forceinline__ void stage_rc(int b, int& R, int& C) { const int st = b / 1024, sb = b % 1024, swz = sb ^ (((sb >> 9) & 1) << 5); R = (st >> 1) * 16 + swz / 64; C = (st & 1) * 32 + (swz % 64) / 2; }
__host__ __device__ __forceinline__ int perm32(int rho) { const int n = rho >> 4, i = rho & 15; return 8 * (i >> 2) + 4 * n + (i & 3); }

struct Unit { int pm, pn, kb; };
struct Gemm { const bf16_t* A; const bf16_t* Bt; int M, N, K, ld; };

struct StaticOrder {
    int nM, nN, nwg, G, c;
    __host__ __device__ void init(int M, int N, int G_, int c_) { nM = M / BM; nN = N / BM; nwg = nM * nN; G = G_; c = c_; }
    __host__ __device__ bool next(int i, Unit& u) const {
        const long L = (long)i * G + c; if (L >= nwg) return false;
        int wgid = (int)L; { const int q = nwg / NXCD, r = nwg % NXCD, xcd = wgid % NXCD, off = wgid / NXCD; wgid = (xcd < r ? xcd * (q + 1) : r * (q + 1) + (xcd - r) * q) + off; }
        const int nig = WGM * nN, gid = wgid / nig, fm = gid * WGM, gsz = (nM - fm) < WGM ? (nM - fm) : WGM;
        u.pm = fm + ((wgid % nig) % gsz); u.pn = (wgid % nig) / gsz; u.kb = 0; return true;
    }
    __device__ __forceinline__ void a_ready(const Unit&) const {}
    __device__ __forceinline__ void done(const Unit&) const {}
};

__device__ __forceinline__ unsigned cvt_pk_bf16(float lo, float hi) { unsigned r; asm volatile("v_cvt_pk_bf16_f32 %0, %1, %2" : "=v"(r) : "v"(lo), "v"(hi)); return r; }
typedef float f32x2 __attribute__((ext_vector_type(2)));
__device__ __forceinline__ f32x2 gelu_pk(f32x2 v) {
    const f32x2 av = __builtin_elementwise_abs(v), d = av * 0.2316418882f + 1.0f;
    f32x2 t; t.x = __builtin_amdgcn_rcpf(d.x); t.y = __builtin_amdgcn_rcpf(d.y);
    f32x2 q = t * 0.5307027145f + (-0.7265760135f); q = q * t + 0.7107068705f; q = q * t + (-0.142248368f); q = q * t + 0.127414796f; q = q * t;
    const f32x2 s = (v * v) * (-0.72134752044f);
    f32x2 e; e.x = __builtin_amdgcn_exp2f(s.x); e.y = __builtin_amdgcn_exp2f(s.y);
    const f32x2 m = v * (q * e), r = v - m;
    f32x2 o; o.x = v.x < 0.f ? m.x : r.x; o.y = v.y < 0.f ? m.y : r.y; return o;
}

template <int ACT  > struct EpiBf16 {
    static constexpr bool PERM = true, AFTER_DRAIN = false; static_assert(ACT == 0 || ACT == 1, "EpiBf16: ACT is 0 (none) or 1 (gelu_pk)");
    bf16_t* O; int ldc; const float* bias; int split_cols; size_t split_stride; float scale0;
    __device__ __forceinline__ void operator()(const f32x4 (&acc)[2][2][4][2], const Unit& u, int wr, int wc, int fr, int fq) const {
        const int row0 = u.pm * BM + wr * 64 + fr; int colt = u.pn * BM; bf16_t* base = O;
        float sc = 1.f; if (split_cols) { const int t = colt / split_cols; base += (size_t)t * split_stride; colt -= t * split_cols; if (t == 0) sc = scale0; }
        const int col0 = colt + wc * 32 + 8 * fq, bcol0 = u.pn * BM + wc * 32 + 8 * fq;
        f32x4 bv[2][2];
#pragma unroll
        for (int bj = 0; bj < 2; ++bj)
#pragma unroll
            for (int n = 0; n < 2; ++n) bv[bj][n] = bias ? *(const f32x4*)(bias + bcol0 + bj * HALF + 4 * n) : (f32x4){0.f, 0.f, 0.f, 0.f};
#pragma unroll
        for (int ai = 0; ai < 2; ++ai)
#pragma unroll
            for (int m = 0; m < 4; ++m) { bf16_t* rowp = base + (size_t)(row0 + ai * HALF + m * 16) * ldc + col0;
#pragma unroll
                for (int bj = 0; bj < 2; ++bj) { f32x4 v0 = acc[ai][bj][m][0] + bv[bj][0], v1 = acc[ai][bj][m][1] + bv[bj][1];
                    if (ACT == 1) { f32x2 a = gelu_pk((f32x2){v0[0], v0[1]}), b = gelu_pk((f32x2){v0[2], v0[3]}), c = gelu_pk((f32x2){v1[0], v1[1]}), d = gelu_pk((f32x2){v1[2], v1[3]});
                        v0 = (f32x4){a.x, a.y, b.x, b.y}; v1 = (f32x4){c.x, c.y, d.x, d.y}; }
                    v0 = v0 * sc; v1 = v1 * sc; u32x4 w; w.x = cvt_pk_bf16(v0[0], v0[1]); w.y = cvt_pk_bf16(v0[2], v0[3]); w.z = cvt_pk_bf16(v1[0], v1[1]); w.w = cvt_pk_bf16(v1[2], v1[3]);
                    *(u32x4*)(rowp + bj * HALF) = w; } }
    }
};
template <class Epi, class Sched, bool ALIGN_EPI = false, bool SP2 = false>
__device__ __forceinline__ void gemm_phase(PG8_LAS unsigned char* lds, const Gemm g, const Sched& S, const Epi& E, int tid_o) {
    asm volatile("" : "+v"(tid_o));
    const int tid = tid_o, wid = __builtin_amdgcn_readfirstlane(tid >> 6), lane = tid & 63, wr = wid >> 2, wc = wid & 3, fr = lane & 15, fq = lane >> 4;
    const int K = g.ld, nt = g.K / BK;
    unsigned voffA[2], voffB[2];
#pragma unroll
    for (int i = 0; i < 2; ++i) { int R, C; stage_rc(tid * 16 + i * 8192, R, C); const int Rb = Epi::PERM ? ((R & ~31) + perm32(R & 31)) : R;
        voffA[i] = (unsigned)(R * K + C) * 2u; voffB[i] = (unsigned)(Rb * K + C) * 2u; }
    const size_t kstep = (size_t)(BK * 2);
    const size_t hstep = (size_t)HALF * K * 2;
    const size_t tstep = 2 * hstep;
    const unsigned ldsw = (unsigned)wid * 1024u;
    const int aoff = lds_byte(wr * 64 + fr, fq * 8), boff = lds_byte(wc * 32 + fr, fq * 8);
#define PG8_SA(b, h) (((b) * 2 + (h)) * HTB)
#define PG8_SB(b, h) ((4 + (b) * 2 + (h)) * HTB)
#define PG8_STAGE(bufoff, gbase, voff) do { _Pragma("unroll") for (int _i = 0; _i < 2; ++_i) \
        __builtin_amdgcn_global_load_lds((const unsigned*)((const char*)(gbase) + (voff)[_i]), (PG8_LAS unsigned*)(lds + (bufoff) + ldsw + _i * 8192), 16, 0, 0); } while (0)
#define PG8_LDA(dst, b, h) do { _Pragma("unroll") for (int m = 0; m < 4; ++m) _Pragma("unroll") for (int k = 0; k < 2; ++k) dst[m][k] = *(const PG8_LAS bf16x8*)(lds + PG8_SA(b, h) + aoff + m * 2048 + k * 1024); } while (0)
#define PG8_LDB(dst, b, h) do { _Pragma("unroll") for (int n = 0; n < 2; ++n) _Pragma("unroll") for (int k = 0; k < 2; ++k) dst[n][k] = *(const PG8_LAS bf16x8*)(lds + PG8_SB(b, h) + boff + n * 2048 + k * 1024); } while (0)
#define PG8_MMA(ai, bj, At, Bt) do { __builtin_amdgcn_s_setprio(1); _Pragma("unroll") for (int m = 0; m < 4; ++m) _Pragma("unroll") for (int n = 0; n < 2; ++n) _Pragma("unroll") for (int k = 0; k < 2; ++k) \
        acc[ai][bj][m][n] = __builtin_amdgcn_mfma_f32_16x16x32_bf16(Bt[n][k], At[m][k], acc[ai][bj][m][n], 0, 0, 0); __builtin_amdgcn_s_setprio(0); } while (0)
#define PG8_WAIT_V(n) asm volatile("s_waitcnt vmcnt(" #n ")" ::: "memory")
#define PG8_WAIT_L(n) asm volatile("s_waitcnt lgkmcnt(" #n ")" ::: "memory")
#define PG8_BAR __builtin_amdgcn_s_barrier()
#define PG8_SCHED __builtin_amdgcn_sched_barrier(0)
    Unit cur, nxt; int ui = 0;
    if (!S.next(0, cur)) return;
    f32x4 acc[2][2][4][2];
#pragma unroll
    for (int a = 0; a < 2; ++a)
#pragma unroll
        for (int b = 0; b < 2; ++b)
#pragma unroll
            for (int m = 0; m < 4; ++m)
#pragma unroll
                for (int n = 0; n < 2; ++n) acc[a][b][m][n] = (f32x4){0.f, 0.f, 0.f, 0.f};
    bf16x8 At[4][2], B0[2][2], B1[2][2];
    const char* cA = (const char*)g.A + (size_t)cur.pm * tstep + cur.kb; const char* cB = (const char*)g.Bt + (size_t)cur.pn * tstep + cur.kb;
    S.a_ready(cur);
    if constexpr (SP2) {
        PG8_STAGE(PG8_SB(0, 0), cB, voffB); PG8_STAGE(PG8_SB(0, 1), cB + hstep, voffB); PG8_STAGE(PG8_SA(0, 0), cA, voffA); PG8_STAGE(PG8_SA(0, 1), cA + hstep, voffA);
        if (wr == 1) PG8_BAR;
        PG8_WAIT_V(2); PG8_BAR;
        PG8_STAGE(PG8_SB(1, 0), cB + kstep, voffB); PG8_STAGE(PG8_SA(1, 0), cA + kstep, voffA); PG8_STAGE(PG8_SB(1, 1), cB + hstep + kstep, voffB);
        PG8_WAIT_V(6); PG8_BAR;
    } else {
        PG8_STAGE(PG8_SB(0, 0), cB, voffB); PG8_STAGE(PG8_SA(0, 0), cA, voffA); PG8_STAGE(PG8_SB(0, 1), cB + hstep, voffB); PG8_STAGE(PG8_SA(0, 1), cA + hstep, voffA);
        if (wr == 1) PG8_BAR;
        PG8_WAIT_V(4); PG8_BAR;
        PG8_STAGE(PG8_SB(1, 0), cB + kstep, voffB); PG8_STAGE(PG8_SA(1, 0), cA + kstep, voffA); PG8_STAGE(PG8_SB(1, 1), cB + hstep + kstep, voffB);
        PG8_WAIT_V(6); PG8_BAR;
    }
    for (;;) {
        const bool has_next = S.next(ui + 1, nxt);
        const char* nA = has_next ? (const char*)g.A + (size_t)nxt.pm * tstep + nxt.kb : cA; const char* nB = has_next ? (const char*)g.Bt + (size_t)nxt.pn * tstep + nxt.kb : cB;
        for (int t = 0; t < nt; t += 2) {
            const bool last = (t == nt - 2);
            const char* a1 = cA + (size_t)(t + 1) * kstep;
            const char* a2 = last ? nA : cA + (size_t)(t + 2) * kstep; const char* b2 = last ? nB : cB + (size_t)(t + 2) * kstep;
            const char* a3 = a2 + kstep; const char* b3 = b2 + kstep;
            if (last && has_next) S.a_ready(nxt);
            if constexpr (SP2) {
            PG8_LDB(B0, 0, 0); PG8_LDB(B1, 0, 1); PG8_SCHED; PG8_LDA(At, 0, 0); PG8_STAGE(PG8_SA(1, 1), a1 + hstep, voffA);
            PG8_WAIT_V(8); PG8_WAIT_L(0); PG8_BAR; PG8_MMA(0, 0, At, B0); PG8_MMA(0, 1, At, B1); PG8_BAR; PG8_SCHED;
            PG8_LDA(At, 0, 1); PG8_STAGE(PG8_SB(0, 0), b2, voffB); PG8_STAGE(PG8_SB(0, 1), b2 + hstep, voffB); PG8_STAGE(PG8_SA(0, 0), a2, voffA);
            PG8_WAIT_V(8); PG8_WAIT_L(0); PG8_BAR; PG8_MMA(1, 0, At, B0); PG8_MMA(1, 1, At, B1); PG8_BAR; PG8_SCHED;
            PG8_LDB(B0, 1, 0); PG8_LDB(B1, 1, 1); PG8_SCHED; PG8_LDA(At, 1, 0); PG8_STAGE(PG8_SA(0, 1), a2 + hstep, voffA);
            PG8_WAIT_V(8); PG8_WAIT_L(0); PG8_BAR; PG8_MMA(0, 0, At, B0); PG8_MMA(0, 1, At, B1); PG8_BAR; PG8_SCHED;
            PG8_LDA(At, 1, 1); PG8_STAGE(PG8_SB(1, 0), b3, voffB); PG8_STAGE(PG8_SB(1, 1), b3 + hstep, voffB); PG8_STAGE(PG8_SA(1, 0), a3, voffA);
            PG8_WAIT_V(8); PG8_WAIT_L(0); PG8_BAR; PG8_MMA(1, 0, At, B0); PG8_MMA(1, 1, At, B1); PG8_BAR; PG8_SCHED;
            } else {
            PG8_LDB(B0, 0, 0); PG8_SCHED; PG8_LDA(At, 0, 0); PG8_STAGE(PG8_SA(1, 1), a1 + hstep, voffA);
            PG8_WAIT_L(8); PG8_BAR; PG8_WAIT_L(0); PG8_MMA(0, 0, At, B0); PG8_BAR; PG8_SCHED;
            PG8_LDB(B1, 0, 1); PG8_STAGE(PG8_SB(0, 0), b2, voffB);
            PG8_BAR; PG8_WAIT_L(0); PG8_MMA(0, 1, At, B1); PG8_BAR;
            PG8_LDA(At, 0, 1); PG8_STAGE(PG8_SA(0, 0), a2, voffA);
            PG8_BAR; PG8_WAIT_L(0); PG8_MMA(1, 0, At, B0); PG8_BAR; PG8_SCHED;
            PG8_STAGE(PG8_SB(0, 1), b2 + hstep, voffB);
            PG8_WAIT_V(6); PG8_BAR; PG8_MMA(1, 1, At, B1); PG8_BAR;
            PG8_LDB(B0, 1, 0); PG8_SCHED; PG8_LDA(At, 1, 0); PG8_STAGE(PG8_SA(0, 1), a2 + hstep, voffA);
            PG8_WAIT_L(8); PG8_BAR; PG8_WAIT_L(0); PG8_MMA(0, 0, At, B0); PG8_BAR; PG8_SCHED;
            PG8_LDB(B1, 1, 1); PG8_STAGE(PG8_SB(1, 0), b3, voffB);
            PG8_BAR; PG8_WAIT_L(0); PG8_MMA(0, 1, At, B1); PG8_BAR;
            PG8_LDA(At, 1, 1); PG8_STAGE(PG8_SA(1, 0), a3, voffA);
            PG8_BAR; PG8_WAIT_L(0); PG8_MMA(1, 0, At, B0); PG8_BAR; PG8_SCHED;
            PG8_STAGE(PG8_SB(1, 1), b3 + hstep, voffB);
            PG8_WAIT_V(6); PG8_BAR; PG8_MMA(1, 1, At, B1); PG8_BAR;
            }
        }
        if constexpr (ALIGN_EPI) { if (wr == 0) PG8_BAR; }
        if constexpr (!Epi::AFTER_DRAIN) {
            unsigned z_ = 0u; asm volatile("" : "+v"(z_)); const int le_ = (int)__builtin_amdgcn_mbcnt_hi(~0u, __builtin_amdgcn_mbcnt_lo(~0u, z_));
            E(acc, cur, wr, wc, le_ & 15, le_ >> 4); S.done(cur); }
        if (!has_next) break;
#pragma unroll
        for (int a = 0; a < 2; ++a)
#pragma unroll
            for (int b = 0; b < 2; ++b)
#pragma unroll
                for (int m = 0; m < 4; ++m)
#pragma unroll
                    for (int n = 0; n < 2; ++n) acc[a][b][m][n] = (f32x4){0.f, 0.f, 0.f, 0.f};
        cur = nxt; cA = nA; cB = nB; ++ui;
        if constexpr (ALIGN_EPI) { if (wr == 1) PG8_BAR; }
    }
    PG8_WAIT_V(0);
    if constexpr (!ALIGN_EPI) { if (wr == 0) PG8_BAR; }
    PG8_BAR;
    if constexpr (Epi::AFTER_DRAIN) { E.fused(acc, cur, wr, wc, fr, fq, lds, wid, lane); S.done(cur); }
#undef PG8_SA
#undef PG8_SB
#undef PG8_STAGE
#undef PG8_LDA
#undef PG8_LDB
#undef PG8_MMA
#undef PG8_WAIT_V
#undef PG8_WAIT_L
#undef PG8_BAR
#undef PG8_SCHED
}
}

namespace pg8 {
struct EpiRes {
    static constexpr bool PERM = false, AFTER_DRAIN = false;
    float* XL; float* XC; const float* modl; int chunk; const float* SL; const float* SC;
    __device__ __forceinline__ void operator()(const f32x4 (&acc)[2][2][4][2], const Unit& u, int wr, int wc, int fr, int fq) const {
        asm volatile("" : "+v"(fr), "+v"(fq));
        const int rt0 = u.pm * BM;
        const int bb = rt0 < BL ? rt0 / SEQ : NB;
        const float* gate = modl + ((size_t)bb * 6 + chunk) * DM;
        float* xb = rt0 < BL ? XL + (size_t)rt0 * DM : XC + (size_t)(rt0 - BL) * DM;
        const float* sb = rt0 < BL ? SL + (size_t)rt0 * DM : SC + (size_t)(rt0 - BL) * DM;
        const int col0 = u.pn * BM + wc * 32 + fq * 4;
        f32x4 gv[2][2];
#pragma unroll
        for (int bj = 0; bj < 2; ++bj)
#pragma unroll
            for (int n = 0; n < 2; ++n) gv[bj][n] = *(const f32x4*)(gate + col0 + bj * HALF + n * 16);
#pragma unroll
        for (int ai = 0; ai < 2; ++ai)
#pragma unroll
            for (int m = 0; m < 4; ++m) {
                const size_t ro = (size_t)(wr * 64 + fr + ai * HALF + m * 16) * DM + col0;
#pragma unroll
                for (int bj = 0; bj < 2; ++bj)
#pragma unroll
                    for (int n = 0; n < 2; ++n) *(f32x4*)(xb + ro + bj * HALF + n * 16) = *(const f32x4*)(sb + ro + bj * HALF + n * 16) + gv[bj][n] * acc[ai][bj][m][n];
            }
    }
};
struct EpiSwiGLU {
    static constexpr bool PERM = true, AFTER_DRAIN = false;
    bf16_t* H;
    __device__ __forceinline__ void operator()(const f32x4 (&acc)[2][2][4][2], const Unit& u, int wr, int wc, int fr, int fq) const {
        asm volatile("" : "+v"(fr), "+v"(fq));
        const int row0 = u.pm * BM + wr * 64 + fr, hc0 = u.pn * HALF + wc * 32 + 8 * fq;
#pragma unroll
        for (int ai = 0; ai < 2; ++ai)
#pragma unroll
            for (int m = 0; m < 4; ++m) {
                bf16_t* rowp = H + (size_t)(row0 + ai * HALF + m * 16) * DFF + hc0;
                f32x4 v[2];
#pragma unroll
                for (int n = 0; n < 2; ++n)
#pragma unroll
                    for (int i = 0; i < 4; ++i) { const float a = acc[ai][0][m][n][i]; v[n][i] = a * __builtin_amdgcn_rcpf(1.0f + __expf(-a)) * acc[ai][1][m][n][i]; }
                u32x4 w; w.x = cvt_pk_bf16(v[0][0], v[0][1]); w.y = cvt_pk_bf16(v[0][2], v[0][3]); w.z = cvt_pk_bf16(v[1][0], v[1][1]); w.w = cvt_pk_bf16(v[1][2], v[1][3]);
                *(u32x4*)rowp = w;
            }
    }
};
}


namespace pg8 {
struct SplitKOrder {
    int nM, nN, S, ksl, nun, G, c;
    __device__ void init(int M, int N, int S_, int kslice_elems, int G_, int c_) { nM = M / BM; nN = N / BM; S = S_; ksl = kslice_elems; nun = nM * nN * S; G = G_; c = c_; }
    __device__ bool next(int i, Unit& u) const {
        const int L = i * G + c; if (L >= nun) return false;
        const int sl = L % S, t = L / S; u.pm = t % nM; u.pn = t / nM; u.kb = sl * ksl * 2; return true;
    }
    __device__ __forceinline__ void a_ready(const Unit&) const {}
    __device__ __forceinline__ void done(const Unit&) const {}
};
struct EpiSlab {
    static constexpr bool PERM = false, AFTER_DRAIN = false;
    float* SLAB; int rows, kslice_bytes;
    __device__ __forceinline__ void operator()(const f32x4 (&acc)[2][2][4][2], const Unit& u, int wr, int wc, int fr, int fq) const {
        asm volatile("" : "+v"(fr), "+v"(fq));
        float* xb = SLAB + ((size_t)(u.kb / kslice_bytes) * rows + (size_t)u.pm * BM) * DM;
        const int col0 = u.pn * BM + wc * 32 + fq * 4;
#pragma unroll
        for (int ai = 0; ai < 2; ++ai)
#pragma unroll
            for (int m = 0; m < 4; ++m) {
                const size_t ro = (size_t)(wr * 64 + fr + ai * HALF + m * 16) * DM + col0;
#pragma unroll
                for (int bj = 0; bj < 2; ++bj)
#pragma unroll
                    for (int n = 0; n < 2; ++n) *(f32x4*)(xb + ro + bj * HALF + n * 16) = acc[ai][bj][m][n];
            }
    }
};
}

#define LAS __attribute__((address_space(3)))
typedef float f32x4 __attribute__((ext_vector_type(4)));
typedef unsigned v4u __attribute__((ext_vector_type(4)));
#define REP_G1 1
#define REP_G3 1
#define REP_GLA 1
#define REP_SSD 1
#define REP_HY 1
#define REP_HX 1
#define REP_PRO 1
#define CTX_SPLITK 1
#define OLD_SHFL 0
#define REP_MIX 1
#define REP_PA 1
#define REP_PC 1
#define REP_H1 1
#define REP_H2 1
#define REP_H3 1
#define REP_HC 1
#define REP_S2 1
#define REP_S23 1
#define REP_S4 1
#define REP_M2 1
#define REP_M3 1
#define REP_M4 1
#define REP_INIT 1
#define REP_MOD 1
#define REP_F1 1
#define REP_WT 1
#define REP_F3 1
constexpr int LDS_BYTES = 163840;
namespace cg = cooperative_groups;

__device__ __forceinline__ unsigned f2bf_u(float f) { unsigned u = __builtin_bit_cast(unsigned, f); return (u + 0x7fffu + ((u >> 16) & 1u)) >> 16; }
__device__ __forceinline__ unsigned pk2(float lo, float hi) { return f2bf_u(lo) | (f2bf_u(hi) << 16); }
template <int M> __device__ __forceinline__ float swz_xor(float v) { return __builtin_bit_cast(float, __builtin_amdgcn_ds_swizzle(__builtin_bit_cast(int, v), (M << 10) | 0x1f)); }
#if OLD_SHFL
__device__ __forceinline__ float wave_sum(float v, int) {
#pragma unroll
    for (int o = 1; o < 64; o <<= 1) v += __shfl_xor(v, o);
    return v;
}
__device__ __forceinline__ float sum16(float v) { v += __shfl_xor(v, 1); v += __shfl_xor(v, 2); v += __shfl_xor(v, 4); v += __shfl_xor(v, 8); return v; }
__device__ __forceinline__ float wave_scan_incl(float v, int lane) {
#pragma unroll
    for (int off = 1; off < 64; off <<= 1) { const float up = __shfl_up(v, off); if (lane >= off) v += up; }
    return v;
}
#else
__device__ __forceinline__ float wave_sum(float v, int lane) {
    v += swz_xor<1>(v); v += swz_xor<2>(v); v += swz_xor<4>(v); v += swz_xor<8>(v); v += swz_xor<16>(v);
    return v + __builtin_bit_cast(float, __builtin_amdgcn_ds_bpermute((lane ^ 32) << 2, __builtin_bit_cast(int, v)));
}
__device__ __forceinline__ float sum16(float v) { v += swz_xor<1>(v); v += swz_xor<2>(v); v += swz_xor<4>(v); v += swz_xor<8>(v); return v; }
__device__ __forceinline__ float wave_scan_incl(float v, int lane) {
#pragma unroll
    for (int off = 1; off < 64; off <<= 1) {
        const float up = __builtin_bit_cast(float, __builtin_amdgcn_ds_bpermute((lane - off) << 2, __builtin_bit_cast(int, v)));
        if (lane >= off) v += up;
    }
    return v;
}
#endif
__device__ __forceinline__ float lane63(float v) { return __builtin_bit_cast(float, __builtin_amdgcn_readlane(__builtin_bit_cast(int, v), 63)); }
__device__ __forceinline__ void transpose_item(const float* W, int K, int N, unsigned short* WT, int dst_row0, LAS float* scr, int k0, int n0, int lane) {
    const int nn = n0 + (lane & 31);
#pragma unroll 8
    for (int i = 0; i < 32; ++i) { const int kk = 2 * i + (lane >> 5); scr[kk * 33 + (lane & 31)] = nn < N ? W[(size_t)(k0 + kk) * N + nn] : 0.f; }
    asm volatile("s_waitcnt lgkmcnt(0)" ::: "memory");
    const int c = lane & 7;
#pragma unroll
    for (int j = 0; j < 4; ++j) { const int n = (lane >> 3) + 8 * j; const LAS float* sp = scr + (8 * c) * 33 + n;
        v4u o; o.x = pk2(sp[0 * 33], sp[1 * 33]); o.y = pk2(sp[2 * 33], sp[3 * 33]); o.z = pk2(sp[4 * 33], sp[5 * 33]); o.w = pk2(sp[6 * 33], sp[7 * 33]);
        *(v4u*)(WT + (size_t)(dst_row0 + n) * K + k0 + 8 * c) = o; }
    asm volatile("s_waitcnt lgkmcnt(0)" ::: "memory");
}
__device__ __forceinline__ void prologue_weights(const Params& p, LAS float* scr, int gw, int NGW, int lane) {
    constexpr int I_IN = 16 * (LDP / 32), I_OUT = 16 * 32, I_W1 = 16 * (DFF / 32), I_W2 = (DFF / 64) * 32;
    constexpr int PER_L = I_IN + I_OUT + 2 * I_W1 + I_W2;
    for (int it = gw; it < DEPTH * PER_L; it += NGW) {
        const int l = it / PER_L; int r = it % PER_L;
        if (r < I_IN) { const int nb = r % (LDP / 32), kb = r / (LDP / 32);
            transpose_item(p.w_in + (size_t)l * DM * DIN, DM, DIN, p.WIN_T + (size_t)l * LDP * DM, nb * 32, scr, kb * 64, nb * 32, lane); continue; }
        r -= I_IN;
        if (r < I_OUT) { const int nb = r % 32, kb = r / 32;
            transpose_item(p.w_out + (size_t)l * DM * DM, DM, DM, p.WOUT_T + (size_t)l * DM * DM, nb * 32, scr, kb * 64, nb * 32, lane); continue; }
        r -= I_OUT;
        if (r < 2 * I_W1) { const int which = r / I_W1; r %= I_W1; const int nb = r % (DFF / 32), kb = r / (DFF / 32); const int n0 = nb * 32;
            const int drow = 256 * (n0 / 128) + 128 * which + (n0 % 128);
            transpose_item((which ? p.ffn_w3 : p.ffn_w1) + (size_t)l * DM * DFF, DM, DFF, p.W13_T + (size_t)l * NFF2 * DM, drow, scr, kb * 64, n0, lane); continue; }
        r -= 2 * I_W1;
        { const int nb = r % 32, kb = r / 32;
            transpose_item(p.ffn_w2 + (size_t)l * DFF * DM, DFF, DM, p.W2_T + (size_t)l * DM * DFF, nb * 32, scr, kb * 64, nb * 32, lane); }
    }
}

__device__ __forceinline__ void mod_partial(const Params& p, long tid, long nth, float* MODP) {
    for (long i = tid; i < 2L * 16 * 1536; i += nth) {
        const int n4 = (int)(i % 1536), kc = (int)((i / 1536) & 15), l = (int)(i / (1536 * 16));
        f32x4 acc[NB + 1];
        float z0 = 0.f; asm volatile("" : "+v"(z0));
#pragma unroll
        for (int bb = 0; bb <= NB; ++bb) acc[bb] = (f32x4){z0, z0, z0, z0};
        const float* w = p.mod_w + ((size_t)l * DM + kc * 64) * 6 * DM + 4 * n4;
#pragma unroll 4
        for (int k = 0; k < 64; ++k) {
            const f32x4 w4 = *(const f32x4*)(w + (size_t)k * 6 * DM);
#pragma unroll
            for (int bb = 0; bb <= NB; ++bb) {
                const float cv = (bb < NB ? p.c + (size_t)bb * DM : p.c_ctx)[kc * 64 + k];
                acc[bb] += w4 * (cv / (1.0f + __expf(-cv)));
            }
        }
#pragma unroll
        for (int bb = 0; bb <= NB; ++bb) *(f32x4*)(MODP + (((size_t)kc * DEPTH + l) * (NB + 1) + bb) * 6 * DM + 4 * n4) = acc[bb];
    }
}
__device__ __forceinline__ void mod_reduce(const Params& p, long tid, long nth, const float* MODP) {
    const long total = (long)DEPTH * (NB + 1) * 6 * DM;
    for (long i = tid; i < total; i += nth) {
        const int n = (int)(i % (6 * DM)), l = (int)(i / ((long)6 * DM * (NB + 1)));
        float acc = p.mod_b[(size_t)l * 6 * DM + n];
#pragma unroll
        for (int kc = 0; kc < 16; ++kc) acc += MODP[(size_t)kc * total + i];
        p.MOD[i] = acc;
    }
}
constexpr int FL_Z = 0, FL_H1 = 8704, FL_H2 = 8704 + 16640, FL_T = 8704 + 2 * 16640;
constexpr int FILT_UNITS = DEPTH * (SEQ / 64) + DEPTH * (CTX / 64);
__device__ __forceinline__ void filt_unit(const Params& p, LAS unsigned char* lds, int u, int tix) {
    const bool isctx = u >= DEPTH * (SEQ / 64);
    const int uu = isctx ? u - DEPTH * (SEQ / 64) : u, per = isctx ? CTX / 64 : SEQ / 64;
    const int l = uu / per, t0 = (uu % per) * 64, ttb = (isctx ? SEQ : 0) + t0;
    LAS float* Z = (LAS float*)(lds + FL_Z); LAS float* H1 = (LAS float*)(lds + FL_H1); LAS float* H2 = (LAS float*)(lds + FL_H2);
    __syncthreads();
    {
        const int tap = tix & 63, bq = tix >> 6;
        float rel; filt_pos(ttb + tap, rel);
        const float tw = 2.0f * 3.14159265358979323846f * rel;
        if (bq == 0) Z[tap * 34] = rel;
#pragma unroll
        for (int k = 0; k < 2; ++k) { const int j = 2 * bq + k; const float ang = tw * (1e-4f + (float)j * ((15.0f - 1e-4f) / 15.0f));
            Z[tap * 34 + 1 + j] = cosf(ang); Z[tap * 34 + 17 + j] = -sinf(ang); }
    }
    __syncthreads();
    {
        const int tap = tix & 63, o0 = (tix >> 6) * 8;
        float acc[8];
#pragma unroll
        for (int e = 0; e < 8; ++e) acc[e] = 0.f;
        const float* w1 = p.hy_w1 + (size_t)l * 33 * 64 + o0;
#pragma unroll 3
        for (int i = 0; i < 33; ++i) { const float zv = Z[tap * 34 + i];
#pragma unroll
            for (int e = 0; e < 8; ++e) acc[e] += zv * w1[i * 64 + e]; }
#pragma unroll
        for (int e = 0; e < 8; ++e) H1[tap * 65 + o0 + e] = sinf(p.hy_freq[l * 64 + o0 + e] * (acc[e] + p.hy_b1[l * 64 + o0 + e]));
    }
    __syncthreads();
    {
        const int tap = tix & 63, o0 = (tix >> 6) * 8;
        float acc[8];
#pragma unroll
        for (int e = 0; e < 8; ++e) acc[e] = 0.f;
        const float* w2 = p.hy_w2 + (size_t)l * 64 * 64 + o0;
#pragma unroll 4
        for (int j = 0; j < 64; ++j) { const float hv = H1[tap * 65 + j];
#pragma unroll
            for (int e = 0; e < 8; ++e) acc[e] += hv * w2[j * 64 + e]; }
#pragma unroll
        for (int e = 0; e < 8; ++e) H2[tap * 65 + o0 + e] = sinf(p.hy_freq[l * 64 + o0 + e] * (acc[e] + p.hy_b2[l * 64 + o0 + e]));
    }
    __syncthreads();
    {
        const int c = tix & 255, half = tix >> 8;
        float w[64];
#pragma unroll
        for (int j = 0; j < 64; ++j) w[j] = p.hy_w3[(size_t)l * 64 * 256 + j * 256 + c];
        const float dec = p.hy_decay[l * 256 + c];
#pragma unroll 2
        for (int k = 0; k < 32; ++k) {
            const int tap = 32 * half + k;
            float acc = 0.f;
#pragma unroll
            for (int j = 0; j < 64; ++j) acc += H2[tap * 65 + j] * w[j];
            float rel; filt_pos(ttb + tap, rel);
            const float hv = acc * expf(-2.0f * fabsf(rel) * dec);
            if (isctx) ((LAS float*)(lds + FL_T))[tap * 260 + c] = hv;
            else ((LAS unsigned short*)(lds + FL_T))[c * 72 + 63 - tap] = (unsigned short)f2bf_u(hv);
        }
    }
    __syncthreads();
    if (isctx) {
        for (int e = tix; e < 64 * 256; e += 512) p.HFC[((size_t)l * CTX + t0 + (e >> 8)) * 256 + (e & 255)] = ((const LAS float*)(lds + FL_T))[(e >> 8) * 260 + (e & 255)];
    } else {
#pragma unroll 4
        for (int k = 0; k < 32; ++k) { const int e = k * 512 + tix, row = e >> 6, col = e & 63;
            p.G1[((size_t)l * 256 + row) * G1N + (8456 - t0 - 63) + col] = ((const LAS unsigned short*)(lds + FL_T))[row * 72 + col]; }
    }
}
__device__ __forceinline__ void filt_all(const Params& p, LAS unsigned char* lds, long tid, long nth, int tix, int bid, int G) {
    constexpr int NPAD = 265 + (G1N - 8457);
    for (long i = tid; i < (long)DEPTH * 256 * NPAD; i += nth) {
        const int k = (int)(i % NPAD); const long lc = i / NPAD;
        p.G1[lc * G1N + (k < 265 ? k : 8457 + (k - 265))] = 0;
    }
    for (int u = bid; u < FILT_UNITS; u += G) filt_unit(p, lds, u, tix);
    __syncthreads();
}
__device__ __forceinline__ const float* xsrc_row(const Params& p, int r, bool from_input) {
    if (from_input) return r < BL ? p.x + (size_t)r * DM : p.ctx + (size_t)(r - BL) * DM;
    return r < BL ? p.XL + (size_t)r * DM : p.XC + (size_t)(r - BL) * DM;
}
template <bool SLAB>
__device__ __forceinline__ void hx_pass(const Params& p, int l, int which, int row_lo, int row_hi, int gw, int NGW, int lane, int nslab = 0, const float* slab = nullptr, const float* gate = nullptr, bool base_from_input = false) {
    const float* g = (which ? p.norm2_g : p.norm1_g) + (size_t)l * DM;
    for (int r = row_lo + gw; r < row_hi; r += NGW) {
        const float* m = p.MOD + ((size_t)l * (NB + 1) + row_bb(r)) * 6 * DM;
        const float* sh = m + (which ? 3 : 0) * DM; const float* sc = m + (which ? 4 : 1) * DM;
        f32x4 v[4]; float s = 0.f;
        if (SLAB) {
            const f32x4* x4 = (const f32x4*)(base_from_input ? p.ctx + (size_t)(r - BL) * DM : p.XC + (size_t)(r - BL) * DM) + lane;
            f32x4* xo = (f32x4*)(p.XC + (size_t)(r - BL) * DM) + lane;
            const f32x4* sl = (const f32x4*)(slab + (size_t)(r - BL) * DM) + lane;
#pragma unroll
            for (int j = 0; j < 4; ++j) v[j] = (f32x4){0.f, 0.f, 0.f, 0.f};
#pragma unroll 1
            for (int q = 0; q < nslab; ++q) {
#pragma unroll
                for (int j = 0; j < 4; ++j) v[j] += sl[(size_t)q * BC * (DM / 4) + 64 * j];
            }
#pragma unroll
            for (int j = 0; j < 4; ++j) { v[j] = x4[64 * j] + *(const f32x4*)(gate + 4 * lane + 256 * j) * v[j]; xo[64 * j] = v[j]; }
        } else {
            const f32x4* x4 = (const f32x4*)xsrc_row(p, r, l == 0 && which == 0) + lane;
#pragma unroll
            for (int j = 0; j < 4; ++j) v[j] = x4[64 * j];
        }
#pragma unroll
        for (int j = 0; j < 4; ++j) s += (v[j].x * v[j].x + v[j].y * v[j].y) + (v[j].z * v[j].z + v[j].w * v[j].w);
        const float rstd = 1.0f / sqrtf(wave_sum(s, lane) * (1.0f / DM) + EPSV);
        unsigned long long* o8 = (unsigned long long*)(p.Y + (size_t)r * DM) + lane;
#pragma unroll
        for (int j = 0; j < 4; ++j) {
            const int k = 4 * lane + 256 * j;
            const f32x4 gg = *(const f32x4*)(g + k), s1 = *(const f32x4*)(sc + k), s0 = *(const f32x4*)(sh + k);
            const f32x4 o = v[j] * rstd * gg * (s1 + 1.0f) + s0;
            o8[64 * j] = (unsigned long long)pk2(o.x, o.y) | ((unsigned long long)pk2(o.z, o.w) << 32);
        }
    }
}
__device__ __forceinline__ void final_pass(const Params& p, int gw, int NGW, int lane) {
    for (int r = gw; r < BL; r += NGW) {
        f32x4* x4 = (f32x4*)(p.XL + (size_t)r * DM) + lane;
        f32x4 v[4]; float s = 0.f;
#pragma unroll
        for (int j = 0; j < 4; ++j) { v[j] = x4[64 * j]; s += (v[j].x * v[j].x + v[j].y * v[j].y) + (v[j].z * v[j].z + v[j].w * v[j].w); }
        const float rstd = 1.0f / sqrtf(wave_sum(s, lane) * (1.0f / DM) + EPSV);
#pragma unroll
        for (int j = 0; j < 4; ++j) x4[64 * j] = v[j] * rstd * *(const f32x4*)(p.final_g + 4 * lane + 256 * j);
    }
}


#define GAS __attribute__((address_space(1)))
#define XB_TMO      128
#define XB_XCNT(j)  (256  + 64 * (j))
#define XB_XSUB(j)  (1280 + 64 * (j))
#define XB_XGEN(j)  (2304 + 64 * (j))
#define XB_TOP      3328
#define XB_TOPGEN   3392
#define XCD_BAR_WORDS 3456
#define XB_SPIN_CAP (1u << 18)

__device__ __forceinline__ unsigned xb_ld(unsigned* p)              { return __hip_atomic_load(p, __ATOMIC_RELAXED, __HIP_MEMORY_SCOPE_AGENT); }
__device__ __forceinline__ unsigned xb_add(unsigned* p, unsigned v) { return __hip_atomic_fetch_add(p, v, __ATOMIC_RELAXED, __HIP_MEMORY_SCOPE_AGENT); }
__device__ __forceinline__ unsigned xb_xcc_id() { return (unsigned)__builtin_amdgcn_s_getreg((3 << 11) | 20) & 0xFu; }
#define XB_SPIN(cond, bar) do { unsigned _sp = 0; while (cond) { __builtin_amdgcn_s_sleep(1); \
    if ((++_sp & 255u) == 0u) { if (xb_ld(&(bar)[XB_TMO])) break; if (_sp > XB_SPIN_CAP) { atomicAdd(&(bar)[XB_TMO], 1u); break; } } } } while (0)

struct XcdBarrier {
    unsigned* bar; unsigned x;
    volatile LAS unsigned* st;
};

__device__ __forceinline__ XcdBarrier xcd_barrier_post(unsigned* bar, volatile LAS unsigned* st) {
    XcdBarrier b; b.bar = bar; b.x = xb_xcc_id(); b.st = st;
    if (threadIdx.x == 0) (void)xb_add(&bar[XB_XCNT(b.x)], 1u);
    return b;
}
__device__ __forceinline__ void xcd_barrier_complete(unsigned* bar, unsigned x, unsigned& nloc, unsigned& nx) {
    const unsigned G = gridDim.x * gridDim.y * gridDim.z;
    unsigned sum, cnt, mine, sp = 0u;
    for (;;) {
        sum = 0u; cnt = 0u; mine = 0u;
#pragma unroll
        for (unsigned j = 0; j < 16; ++j) { const unsigned c = xb_ld(&bar[XB_XCNT(j)]); sum += c; cnt += (c > 0u) ? 1u : 0u; mine = (j == x) ? c : mine; }
        if (sum == G) break;
        __builtin_amdgcn_s_sleep(1);
        if ((++sp & 255u) == 0u) { if (xb_ld(&bar[XB_TMO])) break; if (sp > XB_SPIN_CAP) { atomicAdd(&bar[XB_TMO], 1u); break; } }
    }
    nloc = mine > 0u ? mine : 1u; nx = cnt > 0u ? cnt : 1u;
}

__device__ __forceinline__ void xcd_barrier(const XcdBarrier& b, bool leader) {
    asm volatile("s_waitcnt vmcnt(0)" ::: "memory");
    __syncthreads();
    if (leader) {
        unsigned* bar = b.bar;
        __builtin_amdgcn_s_waitcnt(0);
        unsigned nloc = b.st[0], nx = b.st[1];
        if (nloc == 0u) { xcd_barrier_complete(bar, b.x, nloc, nx); b.st[0] = nloc; b.st[1] = nx; }
        const unsigned old = xb_add(&bar[XB_XSUB(b.x)], 1u);
        const unsigned gen = old / nloc;
        if (old + 1u == (gen + 1u) * nloc) {
            __builtin_amdgcn_fence(__ATOMIC_RELEASE, "agent");
            asm volatile("s_waitcnt vmcnt(0)" ::: "memory");
            const unsigned og = xb_add(&bar[XB_TOP], 1u);
            const unsigned tg = og / nx;
            if (og + 1u == (tg + 1u) * nx) xb_add(&bar[XB_TOPGEN], 1u);
            else XB_SPIN(xb_ld(&bar[XB_TOPGEN]) == tg, bar);
            __builtin_amdgcn_fence(__ATOMIC_ACQUIRE, "agent");
            xb_add(&bar[XB_XGEN(b.x)], 1u);
            asm volatile("s_waitcnt vmcnt(0)" ::: "memory");
        } else {
            XB_SPIN(xb_ld(&bar[XB_XGEN(b.x)]) == gen, bar);
            __builtin_amdgcn_fence(__ATOMIC_ACQUIRE, "agent");
            asm volatile("s_waitcnt vmcnt(0)" ::: "memory");
        }
    }
    __syncthreads();
}
#define GNCC ((CTX + SEQ) / 64)
#define GCTXC (CTX / 64)
#define GLA_UNITS (NB * 6 * GNCC)
typedef short bf16x8 __attribute__((ext_vector_type(8)));
__device__ __forceinline__ int gla_row0(int b, int cc) { return cc < GCTXC ? BL + b * CTX + cc * 64 : b * SEQ + (cc - GCTXC) * 64; }
__device__ __forceinline__ size_t gla_uidx(int dir, int b, int h, int cc) { return (((size_t)dir * NB + b) * 6 + h) * GNCC + cc; }
__device__ __forceinline__ float bflo(unsigned u) { return __builtin_bit_cast(float, u << 16); }
__device__ __forceinline__ float bfhi(unsigned u) { return __builtin_bit_cast(float, u & 0xffff0000u); }
constexpr int GL_WL = 0, GL_BIAS = 24576, GL_VT = 26112, GL_KLT = 35328, GL_AC = 44544, GL_KD = 70144, GL_PART = 80384;
constexpr int GL_VTS = 72, GL_ACS = 200, GL_KDS = 40;

__device__ __forceinline__ void gla_stage_w(const Params& p, int l, LAS unsigned char* lds, int tix) {
    LAS float* WL = (LAS float*)(lds + GL_WL); LAS float* BI = (LAS float*)(lds + GL_BIAS);
    for (int i = tix; i < 6 * 1024; i += 512) { const int h = i >> 10, dir = (i >> 9) & 1, j = (i >> 5) & 15, d = i & 31;
        WL[i] = (dir ? p.gk_w_b : p.gk_w_f)[(size_t)l * 16 * 192 + j * 192 + h * 32 + d]; }
    if (tix < 384) { const int h = tix >> 6, dir = (tix >> 5) & 1, d = tix & 31; BI[tix] = (dir ? p.gk_b_b : p.gk_b_f)[l * 192 + h * 32 + d]; }
}
struct GlaPre { v4u v, gk0, gk1, q, k; };
template <bool NEEDQ>
__device__ __forceinline__ void gla_issue(const Params& p, int u, int tix, GlaPre& L) {
    const int b = u / (6 * GNCC), h = (u / GNCC) % 6, cc = u % GNCC, row0 = gla_row0(b, cc);
    const int lane = tix & 63, wave = tix >> 6, dir = wave >> 2, d0 = (wave & 3) * 8;
    L.v = *(const v4u*)(p.P + (size_t)(row0 + (tix >> 3)) * LDP + OFF_V + h * 64 + (tix & 7) * 8);
    const act_t* prow = p.P + (size_t)(row0 + lane) * LDP;
    L.gk0 = *(const v4u*)(prow + (dir ? OFF_GKB : OFF_GKF)); L.gk1 = *(const v4u*)(prow + (dir ? OFF_GKB : OFF_GKF) + 8);
    L.k = *(const v4u*)(prow + OFF_K + h * 32 + d0);
    if (NEEDQ) L.q = *(const v4u*)(prow + OFF_Q + h * 32 + d0);
}
__device__ __forceinline__ void gla_put_v(LAS unsigned char* lds, int tix, const v4u vv) {
    const int j = tix >> 3, eo = tix & 7;
    LAS unsigned short* VT = (LAS unsigned short*)(lds + GL_VT);
    VT[(eo * 8 + 0) * GL_VTS + j] = (unsigned short)(vv.x & 0xffff); VT[(eo * 8 + 1) * GL_VTS + j] = (unsigned short)(vv.x >> 16);
    VT[(eo * 8 + 2) * GL_VTS + j] = (unsigned short)(vv.y & 0xffff); VT[(eo * 8 + 3) * GL_VTS + j] = (unsigned short)(vv.y >> 16);
    VT[(eo * 8 + 4) * GL_VTS + j] = (unsigned short)(vv.z & 0xffff); VT[(eo * 8 + 5) * GL_VTS + j] = (unsigned short)(vv.z >> 16);
    VT[(eo * 8 + 6) * GL_VTS + j] = (unsigned short)(vv.w & 0xffff); VT[(eo * 8 + 7) * GL_VTS + j] = (unsigned short)(vv.w >> 16);
}
__device__ __forceinline__ void gla_phase_a(const v4u g0, const v4u g1, LAS unsigned char* lds, int h, int dir, int d0, int lane, float (&Bv)[8], float (&tot)[8]) {
    const LAS float* WL = (const LAS float*)(lds + GL_WL) + h * 1024 + dir * 512 + d0; const LAS float* BI = (const LAS float*)(lds + GL_BIAS) + h * 64 + dir * 32 + d0;
    float gk[16] = { bflo(g0.x), bfhi(g0.x), bflo(g0.y), bfhi(g0.y), bflo(g0.z), bfhi(g0.z), bflo(g0.w), bfhi(g0.w),
                     bflo(g1.x), bfhi(g1.x), bflo(g1.y), bfhi(g1.y), bflo(g1.z), bfhi(g1.z), bflo(g1.w), bfhi(g1.w) };
    float lg[8];
#pragma unroll
    for (int i = 0; i < 8; ++i) lg[i] = BI[i];
#pragma unroll
    for (int j = 0; j < 16; ++j) {
        const f32x4 w0 = *(const LAS f32x4*)(WL + j * 32), w1 = *(const LAS f32x4*)(WL + j * 32 + 4);
        lg[0] += gk[j] * w0.x; lg[1] += gk[j] * w0.y; lg[2] += gk[j] * w0.z; lg[3] += gk[j] * w0.w;
        lg[4] += gk[j] * w1.x; lg[5] += gk[j] * w1.y; lg[6] += gk[j] * w1.z; lg[7] += gk[j] * w1.w;
    }
#pragma unroll
    for (int i = 0; i < 8; ++i) {
        const float x = lg[i];
        lg[i] = -(fmaxf(-x, 0.f) + __logf(1.0f + __expf(-fabsf(x)))) * (1.0f / 16.0f);
        const float v = wave_scan_incl(lg[i], lane);
        tot[i] = lane63(v);
        Bv[i] = dir ? tot[i] - v + lg[i] : v;
    }
}
__device__ __forceinline__ void unpack8(const v4u k, float (&f)[8]) {
    f[0] = bflo(k.x); f[1] = bfhi(k.x); f[2] = bflo(k.y); f[3] = bfhi(k.y); f[4] = bflo(k.z); f[5] = bfhi(k.z); f[6] = bflo(k.w); f[7] = bfhi(k.w);
}
__device__ __forceinline__ int gla_count(int b) { if (gridDim.x != 256 || GLA_UNITS != 3168) return (GLA_UNITS - b + (int)gridDim.x - 1) / (int)gridDim.x; return b < 16 ? 7 : 12 + ((b - 16) < 176 ? 1 : 0); }
__device__ __forceinline__ int gla_unit_of(int b, int k) { if (gridDim.x != 256 || GLA_UNITS != 3168) return b + k * (int)gridDim.x; return b < 16 ? 7 * b + k : (k < 12 ? 112 + (b - 16) * 12 + k : 2992 + (b - 16)); }
__device__ __forceinline__ void gla_m2_phase(const Params& p, int l, LAS unsigned char* lds, int tix, int bid, unsigned short* DSG, float* DECG) {
    const int lane = tix & 63, wave = __builtin_amdgcn_readfirstlane(tix >> 6);
    gla_stage_w(p, l, lds, tix);
    GlaPre L;
    const int ncnt = gla_count(bid);
    if (ncnt > 0) gla_issue<false>(p, gla_unit_of(bid, 0), tix, L);
    __syncthreads();
#pragma unroll 1
    for (int kk = 0; kk < ncnt; ++kk) {
        const int u = gla_unit_of(bid, kk);
        const int b = u / (6 * GNCC), h = (u / GNCC) % 6, cc = u % GNCC;
        gla_put_v(lds, tix, L.v);
        {
            const int dir = wave >> 2, d0 = (wave & 3) * 8;
            float Bv[8], tot[8];
            gla_phase_a(L.gk0, L.gk1, lds, h, dir, d0, lane, Bv, tot);
            float kf[8]; unpack8(L.k, kf);
            LAS unsigned short* KLT = (LAS unsigned short*)(lds + GL_KLT) + (dir * 32 + d0) * GL_VTS + lane;
#pragma unroll
            for (int i = 0; i < 8; ++i) KLT[i * GL_VTS] = (unsigned short)f2bf_u(kf[i] * __expf(tot[i] - Bv[i]));
            if (lane == 0) {
                float* dg = DECG + gla_uidx(dir, b, h, cc) * 32 + d0;
#pragma unroll
                for (int i = 0; i < 8; ++i) dg[i] = __expf(tot[i]);
            }
        }
        if (kk + 1 < ncnt) gla_issue<false>(p, gla_unit_of(bid, kk + 1), tix, L);
        __syncthreads();
        {
            const int dir = wave >> 2, te = wave & 3, fr = lane & 15, fq = lane >> 4;
            unsigned short* out = DSG + gla_uidx(dir, b, h, cc) * 2048;
#pragma unroll
            for (int td = 0; td < 2; ++td) {
                f32x4 acc = {0.f, 0.f, 0.f, 0.f};
#pragma unroll
                for (int ks = 0; ks < 2; ++ks) {
                    const bf16x8 a = *(const LAS bf16x8*)(lds + GL_VT + ((16 * te + fr) * GL_VTS + 32 * ks + 8 * fq) * 2);
                    const bf16x8 bb = *(const LAS bf16x8*)(lds + GL_KLT + ((dir * 32 + 16 * td + fr) * GL_VTS + 32 * ks + 8 * fq) * 2);
                    acc = __builtin_amdgcn_mfma_f32_16x16x32_bf16(a, bb, acc, 0, 0, 0);
                }
#pragma unroll
                for (int r = 0; r < 4; ++r) out[(16 * te + 4 * fq + r) * 32 + 16 * td + fr] = (unsigned short)f2bf_u(acc[r]);
            }
        }
        __syncthreads();
    }
}
template <int NSTEP, int BATCH>
__device__ __forceinline__ void gla_m3_seg(f32x4& S, const unsigned short* DSG, const float* DECG, unsigned short* SSG, size_t base, int cc0, int step, int ed) {
    static_assert(NSTEP % BATCH == 0, "");
#pragma unroll 1
    for (int k0 = 0; k0 < NSTEP; k0 += BATCH) {
        f32x4 d[BATCH], dc[BATCH]; unsigned long long draw[BATCH];
#pragma unroll
        for (int j = 0; j < BATCH; ++j) { const size_t u = base + cc0 + (k0 + j) * step; draw[j] = *(const unsigned long long*)(DSG + u * 2048 + ed); dc[j] = *(const f32x4*)(DECG + u * 32 + (ed & 31)); }
#pragma unroll
        for (int j = 0; j < BATCH; ++j) { const unsigned lo = (unsigned)draw[j], hi = (unsigned)(draw[j] >> 32); d[j] = (f32x4){bflo(lo), bfhi(lo), bflo(hi), bfhi(hi)}; }
#pragma unroll
        for (int j = 0; j < BATCH; ++j) { const size_t u = base + cc0 + (k0 + j) * step;
            *(unsigned long long*)(SSG + u * 2048 + ed) = (unsigned long long)pk2(S.x, S.y) | ((unsigned long long)pk2(S.z, S.w) << 32);
            S = dc[j] * S + d[j]; }
    }
}
__device__ __forceinline__ void gla_m3(long tid, long nth, const unsigned short* DSG, const float* DECG, unsigned short* SSG) {
    for (long i = tid; i < 2L * NB * 6 * 512; i += nth) {
        const int ed = (int)(i & 511) * 4, chain = (int)(i >> 9), dir = chain / (NB * 6);
        const size_t base = (size_t)chain * GNCC;
        float z0 = 0.f; asm volatile("" : "+v"(z0));
        f32x4 S = {z0, z0, z0, z0};
        if (dir == 0) { gla_m3_seg<GCTXC, GCTXC>(S, DSG, DECG, SSG, base, 0, 1, ed); gla_m3_seg<GNCC - GCTXC, 16>(S, DSG, DECG, SSG, base, GCTXC, 1, ed); }
        else { gla_m3_seg<GCTXC, GCTXC>(S, DSG, DECG, SSG, base, GCTXC - 1, -1, ed); gla_m3_seg<GNCC - GCTXC, 16>(S, DSG, DECG, SSG, base, GNCC - 1, -1, ed); }
    }
}
struct GlaPre4 { bf16x8 s[2][2]; unsigned short g[4][2]; };
__device__ __forceinline__ void gla_issue4(const Params& p, int u, int tix, const unsigned short* SSG, GlaPre4& S) {
    const int b = u / (6 * GNCC), h = (u / GNCC) % 6, cc = u % GNCC, row0 = gla_row0(b, cc);
    const int lane = tix & 63, wave = tix >> 6, fr = lane & 15, fq = lane >> 4, ti = wave >> 1, ch = wave & 1;
#pragma unroll
    for (int dir = 0; dir < 2; ++dir)
#pragma unroll
        for (int n = 0; n < 2; ++n) S.s[dir][n] = *(const bf16x8*)(SSG + gla_uidx(dir, b, h, cc) * 2048 + (32 * ch + 16 * n + fr) * 32 + 8 * fq);
#pragma unroll
    for (int r = 0; r < 4; ++r)
#pragma unroll
        for (int n = 0; n < 2; ++n) S.g[r][n] = p.P[(size_t)(row0 + 16 * ti + 4 * fq + r) * LDP + OFF_G + h * 64 + 32 * ch + 16 * n + fr];
}
__device__ __forceinline__ void gla_m4_phase(const Params& p, int l, LAS unsigned char* lds, int tix, int bid, const unsigned short* SSG) {
    const int lane = tix & 63, wave = __builtin_amdgcn_readfirstlane(tix >> 6), fr = lane & 15, fq = lane >> 4;
    gla_stage_w(p, l, lds, tix);
    GlaPre L; GlaPre4 S;
    const int ncnt = gla_count(bid);
    if (ncnt > 0) { const int u0 = gla_unit_of(bid, 0); gla_issue<true>(p, u0, tix, L); gla_issue4(p, u0, tix, SSG, S); }
    __syncthreads();
#pragma unroll 1
    for (int kk = 0; kk < ncnt; ++kk) {
        const int u = gla_unit_of(bid, kk);
        const int b = u / (6 * GNCC), h = (u / GNCC) % 6, cc = u % GNCC, row0 = gla_row0(b, cc);
        gla_put_v(lds, tix, L.v);
        {
            const int dir = wave >> 2, d0 = (wave & 3) * 8;
            float Bv[8], tot[8];
            gla_phase_a(L.gk0, L.gk1, lds, h, dir, d0, lane, Bv, tot);
            float kf[8], qf[8]; unpack8(L.k, kf); unpack8(L.q, qf);
            float qd[8], kd[8];
#pragma unroll
            for (int i = 0; i < 8; ++i) { qd[i] = qf[i] * __expf(Bv[i]) * 0.17677669529663687f; kd[i] = kf[i] * __expf(-Bv[i]); }
            v4u w; w.x = pk2(qd[0], qd[1]); w.y = pk2(qd[2], qd[3]); w.z = pk2(qd[4], qd[5]); w.w = pk2(qd[6], qd[7]);
            *(LAS v4u*)(lds + GL_AC + (lane * GL_ACS + 128 + 32 * dir + d0) * 2) = w;
            w.x = pk2(kd[0], kd[1]); w.y = pk2(kd[2], kd[3]); w.z = pk2(kd[4], kd[5]); w.w = pk2(kd[6], kd[7]);
            *(LAS v4u*)(lds + GL_KD + ((dir * 64 + lane) * GL_KDS + d0) * 2) = w;
        }
        const bool more = kk + 1 < ncnt;
        if (more) gla_issue<true>(p, gla_unit_of(bid, kk + 1), tix, L);
        __syncthreads();
        {
            const int dir = wave >> 2, ti = wave & 3;
            const bf16x8 a = *(const LAS bf16x8*)(lds + GL_AC + ((16 * ti + fr) * GL_ACS + 128 + 32 * dir + 8 * fq) * 2);
            LAS unsigned short* AC = (LAS unsigned short*)(lds + GL_AC);
#pragma unroll
            for (int tj = 0; tj < 4; ++tj) {
                const bf16x8 bb = *(const LAS bf16x8*)(lds + GL_KD + ((dir * 64 + 16 * tj + fr) * GL_KDS + 8 * fq) * 2);
                f32x4 acc = {0.f, 0.f, 0.f, 0.f};
                acc = __builtin_amdgcn_mfma_f32_16x16x32_bf16(a, bb, acc, 0, 0, 0);
                const int j = 16 * tj + fr;
#pragma unroll
                for (int r = 0; r < 4; ++r) { const int i = 16 * ti + 4 * fq + r; const bool keep = dir ? (j >= i) : (j <= i);
                    AC[i * GL_ACS + 64 * dir + j] = (unsigned short)f2bf_u(keep ? acc[r] : 0.f); }
            }
        }
        __syncthreads();
        f32x4 acc[2] = { {0.f, 0.f, 0.f, 0.f}, {0.f, 0.f, 0.f, 0.f} };
        const int ti = wave >> 1, ch = wave & 1;
        {
            bf16x8 bv[2][2];
#pragma unroll
            for (int ks = 0; ks < 2; ++ks)
#pragma unroll
                for (int n = 0; n < 2; ++n) bv[ks][n] = *(const LAS bf16x8*)(lds + GL_VT + ((32 * ch + 16 * n + fr) * GL_VTS + 32 * ks + 8 * fq) * 2);
#pragma unroll
            for (int part = 0; part < 2; ++part)
#pragma unroll
                for (int ks = 0; ks < 2; ++ks) {
                    const bf16x8 a = *(const LAS bf16x8*)(lds + GL_AC + ((16 * ti + fr) * GL_ACS + 64 * part + 32 * ks + 8 * fq) * 2);
#pragma unroll
                    for (int n = 0; n < 2; ++n) acc[n] = __builtin_amdgcn_mfma_f32_16x16x32_bf16(a, bv[ks][n], acc[n], 0, 0, 0);
                }
#pragma unroll
            for (int dir = 0; dir < 2; ++dir) {
                const bf16x8 a = *(const LAS bf16x8*)(lds + GL_AC + ((16 * ti + fr) * GL_ACS + 128 + 32 * dir + 8 * fq) * 2);
#pragma unroll
                for (int n = 0; n < 2; ++n) acc[n] = __builtin_amdgcn_mfma_f32_16x16x32_bf16(a, S.s[dir][n], acc[n], 0, 0, 0);
            }
            LAS float* PART = (LAS float*)(lds + GL_PART);
#pragma unroll
            for (int r = 0; r < 4; ++r) {
                float ss = acc[0][r] * acc[0][r] + acc[1][r] * acc[1][r];
                ss = sum16(ss);
                if (fr == 0) PART[(16 * ti + 4 * fq + r) * 2 + ch] = ss;
            }
        }
        __syncthreads();
        {
            const LAS float* PART = (const LAS float*)(lds + GL_PART);
#pragma unroll
            for (int r = 0; r < 4; ++r) {
                const int i = 16 * ti + 4 * fq + r;
                const float rs = 1.0f / sqrtf((PART[i * 2] + PART[i * 2 + 1]) * (1.0f / 64.0f) + EPSV);
#pragma unroll
                for (int n = 0; n < 2; ++n) {
                    const int e = 32 * ch + 16 * n + fr;
                    const float g = bflo((unsigned)S.g[r][n]);
                    stact(p.Y + (size_t)(row0 + i) * DM + h * 64 + e, acc[n][r] * rs * p.gla_norm_w[l * 64 + e] * (g / (1.0f + __expf(-g))));
                }
            }
        }
        if (more) gla_issue4(p, gla_unit_of(bid, kk + 1), tix, SSG, S);
    }
    __syncthreads();
}

#define SNCC ((CTX + SEQ) / 128)
#define SCTXC (CTX / 128)
#define SSD_UNITS (NB * 2 * SNCC)
constexpr int SD_CM = 0, SD_BM = 34816, SD_XT = 69632, SD_HS = 121856, SD_DTL = 139264, SD_CSL = 142336, SD_TOT = 145408, SD_HS2OFF = 145440 - 121856;
constexpr int SD_S = 136;
static_assert(SD_HS + SD_HS2OFF + 64 * 136 * 2 <= LDS_BYTES - 64, "SSD LDS map");
__device__ __forceinline__ int ssd_row(int b, int cc, int i) {
    if (cc < SCTXC) return BL + b * CTX + cc * 128 + i;
    return b * SEQ + colmajor_tok(0, (cc - SCTXC) * 128 + i);
}
__device__ __forceinline__ size_t ssd_chain(int dir, int b, int head) { return ((size_t)dir * NB + b) * 6 + head; }
template <bool TR_B, bool WITH_C>
__device__ __forceinline__ void ssd_stage(const Params& p, int l, LAS unsigned char* lds, int b, int g, int cc, int tix) {
    const int sidx = cc < SCTXC ? NB + b : b, L = seq_len(sidx), r0 = seq_row0(sidx), pos0 = (cc < SCTXC ? cc : cc - SCTXC) * 128;
    constexpr int NQ = WITH_C ? 14 : 10;
    for (int item = tix; item < 128 * NQ; item += 512) {
        const int i = item & 127, q = item >> 7;
        const int col0 = q < 6 ? g * 192 + q * 32 : (q < 10 ? 384 + g * 128 + (q - 6) * 32 : 640 + g * 128 + (q - 10) * 32);
        const int pos = pos0 + i;
        const act_t* rc = p.P + (size_t)(r0 + colmajor_tok(sidx, pos)) * LDP + OFF_XBC + col0;
        const bool hp = pos > 0, hn = pos + 1 < L;
        const act_t* rp = hp ? p.P + (size_t)(r0 + colmajor_tok(sidx, pos - 1)) * LDP + OFF_XBC + col0 : rc;
        const act_t* rn = hn ? p.P + (size_t)(r0 + colmajor_tok(sidx, pos + 1)) * LDP + OFF_XBC + col0 : rc;
        const float* cw = p.ssd_conv_w + (size_t)l * 3 * 896 + col0; const float* cbias = p.ssd_conv_b + (size_t)l * 896 + col0;
#pragma unroll
        for (int o = 0; o < 4; ++o) {
            float xp[8], xc[8], xn[8], y[8];
            unpack8(*(const v4u*)(rp + 8 * o), xp); unpack8(*(const v4u*)(rc + 8 * o), xc); unpack8(*(const v4u*)(rn + 8 * o), xn);
#pragma unroll
            for (int e = 0; e < 8; ++e) {
                const int c = 8 * o + e;
                float a = cbias[c] + cw[896 + c] * xc[e];
                a += hp ? cw[c] * xp[e] : 0.f; a += hn ? cw[2 * 896 + c] * xn[e] : 0.f;
                y[e] = a / (1.0f + __expf(-a));
            }
            if (q < 6) {
                LAS unsigned short* d = (LAS unsigned short*)(lds + SD_XT) + (q * 32 + 8 * o) * SD_S + i;
#pragma unroll
                for (int e = 0; e < 8; ++e) d[e * SD_S] = (unsigned short)f2bf_u(y[e]);
            } else if (q < 10) {
                if (TR_B) { LAS unsigned short* d = (LAS unsigned short*)(lds + SD_BM) + ((q - 6) * 32 + 8 * o) * SD_S + i;
#pragma unroll
                    for (int e = 0; e < 8; ++e) d[e * SD_S] = (unsigned short)f2bf_u(y[e]);
                } else { v4u w; w.x = pk2(y[0], y[1]); w.y = pk2(y[2], y[3]); w.z = pk2(y[4], y[5]); w.w = pk2(y[6], y[7]);
                    *(LAS v4u*)(lds + SD_BM + (i * SD_S + (q - 6) * 32 + 8 * o) * 2) = w; }
            } else { v4u w; w.x = pk2(y[0], y[1]); w.y = pk2(y[2], y[3]); w.z = pk2(y[4], y[5]); w.w = pk2(y[6], y[7]);
                *(LAS v4u*)(lds + SD_CM + (i * SD_S + (q - 10) * 32 + 8 * o) * 2) = w; }
        }
    }
}
__device__ __forceinline__ void ssd_scans(const Params& p, int l, LAS unsigned char* lds, int b, int g, int cc, int wave, int lane) {
    if (wave < 6) {
        const int hg = wave % 3, dir = wave / 3, head = g * 3 + hg;
        const float bias = (dir ? p.ssd_dt_bias_b : p.ssd_dt_bias_f)[l * 6 + head];
        const float A = -__expf((dir ? p.ssd_a_log_b : p.ssd_a_log_f)[l * 6 + head]);
        float dt[2], a[2];
#pragma unroll
        for (int k = 0; k < 2; ++k) {
            const float x = ldact(p.P + (size_t)ssd_row(b, cc, 2 * lane + k) * LDP + (dir ? OFF_DTB : OFF_DTF) + head) + bias;
            dt[k] = fmaxf(x, 0.f) + log1pf(__expf(-fabsf(x))); a[k] = A * dt[k];
        }
        const float v = wave_scan_incl(a[0] + a[1], lane);
        const float tot = lane63(v);
        const float pf1 = v, pf0 = v - a[1];
        LAS float* DTL = (LAS float*)(lds + SD_DTL) + wave * 128 + 2 * lane; LAS float* CSL = (LAS float*)(lds + SD_CSL) + wave * 128 + 2 * lane;
        DTL[0] = dt[0]; DTL[1] = dt[1];
        CSL[0] = dir ? tot - pf0 + a[0] : pf0; CSL[1] = dir ? tot - pf1 + a[1] : pf1;
        if (lane == 0) ((LAS float*)(lds + SD_TOT))[wave] = tot;
    }
}
__device__ __forceinline__ void ssd_s2_unit(const Params& p, int l, LAS unsigned char* lds, int u, int tix, unsigned short* DSS, float* DECS) {
    const int b = u / (2 * SNCC), g = (u / SNCC) & 1, cc = u % SNCC;
    const int lane = tix & 63, wave = __builtin_amdgcn_readfirstlane(tix >> 6), fr = lane & 15, fq = lane >> 4;
    ssd_scans(p, l, lds, b, g, cc, wave, lane);
    ssd_stage<true, false>(p, l, lds, b, g, cc, tix);
    __syncthreads();
    if (tix < 6) DECS[ssd_chain(tix / 3, b, g * 3 + tix % 3) * SNCC + cc] = __expf(((const LAS float*)(lds + SD_TOT))[tix]);
#pragma unroll 1
    for (int k = 0; k < 3; ++k) {
        const int c3 = wave + 8 * k, tp = c3 & 3, combo = c3 >> 2, hg = combo % 3, dir = combo / 3;
        const LAS float* DTL = (const LAS float*)(lds + SD_DTL) + combo * 128; const LAS float* CSL = (const LAS float*)(lds + SD_CSL) + combo * 128;
        const float tot = ((const LAS float*)(lds + SD_TOT))[combo];
        bf16x8 a[4];
#pragma unroll
        for (int ks = 0; ks < 4; ++ks) {
            const int j0 = 32 * ks + 8 * fq;
            float xf[8]; unpack8(*(const LAS v4u*)(lds + SD_XT + ((hg * 64 + 16 * tp + fr) * SD_S + j0) * 2), xf);
            const f32x4 d0 = *(const LAS f32x4*)(DTL + j0), d1 = *(const LAS f32x4*)(DTL + j0 + 4), c0 = *(const LAS f32x4*)(CSL + j0), c1 = *(const LAS f32x4*)(CSL + j0 + 4);
            xf[0] *= d0.x * __expf(tot - c0.x); xf[1] *= d0.y * __expf(tot - c0.y); xf[2] *= d0.z * __expf(tot - c0.z); xf[3] *= d0.w * __expf(tot - c0.w);
            xf[4] *= d1.x * __expf(tot - c1.x); xf[5] *= d1.y * __expf(tot - c1.y); xf[6] *= d1.z * __expf(tot - c1.z); xf[7] *= d1.w * __expf(tot - c1.w);
            v4u w; w.x = pk2(xf[0], xf[1]); w.y = pk2(xf[2], xf[3]); w.z = pk2(xf[4], xf[5]); w.w = pk2(xf[6], xf[7]);
            a[ks] = __builtin_bit_cast(bf16x8, w);
        }
        unsigned short* out = DSS + (ssd_chain(dir, b, g * 3 + hg) * SNCC + cc) * 8192;
#pragma unroll
        for (int tn = 0; tn < 8; ++tn) {
            f32x4 acc = {0.f, 0.f, 0.f, 0.f};
#pragma unroll
            for (int ks = 0; ks < 4; ++ks) {
                const bf16x8 bb = *(const LAS bf16x8*)(lds + SD_BM + ((16 * tn + fr) * SD_S + 32 * ks + 8 * fq) * 2);
                acc = __builtin_amdgcn_mfma_f32_16x16x32_bf16(bb, a[ks], acc, 0, 0, 0);
            }
            *(unsigned long long*)(out + (16 * tp + fr) * 128 + 16 * tn + 4 * fq) = (unsigned long long)pk2(acc[0], acc[1]) | ((unsigned long long)pk2(acc[2], acc[3]) << 32);
        }
    }
    __syncthreads();
}
template <int NSTEP, int BATCH>
__device__ __forceinline__ void ssd_s3_seg(float (&S)[8], unsigned short* DSS, const float* DECS, size_t base, int cc0, int step, int el) {
    static_assert(NSTEP % BATCH == 0, "");
#pragma unroll 1
    for (int k0 = 0; k0 < NSTEP; k0 += BATCH) {
        v4u d[BATCH]; float dc[BATCH];
#pragma unroll
        for (int j = 0; j < BATCH; ++j) { const size_t u = base + cc0 + (k0 + j) * step; d[j] = *(const v4u*)(DSS + u * 8192 + el); dc[j] = DECS[u]; }
#pragma unroll
        for (int j = 0; j < BATCH; ++j) { const size_t u = base + cc0 + (k0 + j) * step;
            v4u w; w.x = pk2(S[0], S[1]); w.y = pk2(S[2], S[3]); w.z = pk2(S[4], S[5]); w.w = pk2(S[6], S[7]);
            *(v4u*)(DSS + u * 8192 + el) = w;
            float df[8]; unpack8(d[j], df);
#pragma unroll
            for (int e = 0; e < 8; ++e) S[e] = S[e] * dc[j] + df[e]; }
    }
}
__device__ __forceinline__ void ssd_s3(long tid, long nth, unsigned short* DSS, const float* DECS) {
    for (long i = tid; i < 2L * NB * 6 * 1024; i += nth) {
        const int el = (int)(i & 1023) * 8, chain = (int)(i >> 10), dir = chain / (NB * 6);
        const size_t base = (size_t)chain * SNCC;
        float z0 = 0.f; asm volatile("" : "+v"(z0));
        float S[8] = {z0, z0, z0, z0, z0, z0, z0, z0};
        if (dir == 0) { ssd_s3_seg<SCTXC, SCTXC>(S, DSS, DECS, base, 0, 1, el); ssd_s3_seg<SNCC - SCTXC, 8>(S, DSS, DECS, base, SCTXC, 1, el); }
        else { ssd_s3_seg<SCTXC, SCTXC>(S, DSS, DECS, base, SCTXC - 1, -1, el); ssd_s3_seg<SNCC - SCTXC, 8>(S, DSS, DECS, base, SNCC - 1, -1, el); }
    }
}
__device__ __forceinline__ void ssd_load_h(const unsigned short* HSS, int b, int head, int cc, int tix, v4u (&h)[2][2]) {
#pragma unroll
    for (int dir = 0; dir < 2; ++dir) {
        const unsigned short* hsrc = HSS + (ssd_chain(dir, b, head) * SNCC + cc) * 8192 + (tix >> 3) * 128 + (tix & 7) * 16;
        h[dir][0] = *(const v4u*)hsrc; h[dir][1] = *(const v4u*)(hsrc + 8);
    }
}
__device__ __forceinline__ void ssd_s4_unit(const Params& p, int l, LAS unsigned char* lds, int u, int tix, const unsigned short* HSS) {
    const int b = u / (2 * SNCC), g = (u / SNCC) & 1, cc = u % SNCC;
    const int lane = tix & 63, wave = __builtin_amdgcn_readfirstlane(tix >> 6), fr = lane & 15, fq = lane >> 4;
    ssd_scans(p, l, lds, b, g, cc, wave, lane);
    ssd_stage<false, true>(p, l, lds, b, g, cc, tix);
    __syncthreads();
    LAS unsigned char* cm_rd = lds + SD_CM + ((16 * wave + fr) * SD_S + 8 * fq) * 2;
    LAS unsigned char* bm_rd = lds + SD_BM + (fr * SD_S + 8 * fq) * 2;
    LAS unsigned char* m_rd = lds + SD_BM + ((16 * wave + fr) * SD_S + 8 * fq) * 2;
    LAS unsigned char* m_wr = lds + SD_BM + ((16 * wave + 4 * fq) * SD_S + fr) * 2;
    LAS unsigned char* xt_rd = lds + SD_XT + (fr * SD_S + 8 * fq) * 2;
    LAS unsigned char* hs_rd = lds + SD_HS + (fr * SD_S + 8 * fq) * 2;
    LAS unsigned char* hs_wr = lds + SD_HS + ((tix >> 3) * SD_S + (tix & 7) * 16) * 2;
    LAS unsigned char* sc_j = lds + SD_DTL + fr * 4;
    LAS unsigned char* sc_i = lds + SD_DTL + (16 * wave + 4 * fq) * 4;
    asm volatile("" : "+v"(cm_rd), "+v"(bm_rd), "+v"(m_rd), "+v"(m_wr), "+v"(xt_rd), "+v"(hs_rd), "+v"(hs_wr), "+v"(sc_j), "+v"(sc_i));
    f32x4 cb[8];
    bf16x8 ca[4];
#pragma unroll
    for (int ks = 0; ks < 4; ++ks) ca[ks] = *(const LAS bf16x8*)(cm_rd + 64 * ks);
#pragma unroll
    for (int tj = 0; tj < 8; ++tj) {
        cb[tj] = (f32x4){0.f, 0.f, 0.f, 0.f};
#pragma unroll
        for (int ks = 0; ks < 4; ++ks) {
            const bf16x8 bb = *(const LAS bf16x8*)(bm_rd + (16 * tj * SD_S + 32 * ks) * 2);
            cb[tj] = __builtin_amdgcn_mfma_f32_16x16x32_bf16(ca[ks], bb, cb[tj], 0, 0, 0);
        }
    }
    __syncthreads();
    f32x4 yacc[3][4];
#pragma unroll
    for (int hg = 0; hg < 3; ++hg)
#pragma unroll
        for (int tp = 0; tp < 4; ++tp) yacc[hg][tp] = (f32x4){0.f, 0.f, 0.f, 0.f};
#pragma unroll
    for (int hg = 0; hg < 3; ++hg) {
        v4u hreg[2][2];
        ssd_load_h(HSS, b, g * 3 + hg, cc, tix, hreg);
        __builtin_amdgcn_sched_barrier(0);
        float csfi[4], csbi[4];
#pragma unroll
        for (int r = 0; r < 4; ++r) { csfi[r] = *(const LAS float*)(sc_i + 3072 + hg * 512 + 4 * r); csbi[r] = *(const LAS float*)(sc_i + 3072 + (3 + hg) * 512 + 4 * r); }
#pragma unroll
        for (int tj = 0; tj < 8; ++tj) {
            const int j = 16 * tj + fr;
            const float csfj = *(const LAS float*)(sc_j + 3072 + hg * 512 + 64 * tj), csbj = *(const LAS float*)(sc_j + 3072 + (3 + hg) * 512 + 64 * tj);
            const float dtfj = *(const LAS float*)(sc_j + hg * 512 + 64 * tj), dtbj = *(const LAS float*)(sc_j + (3 + hg) * 512 + 64 * tj);
#pragma unroll
            for (int r = 0; r < 4; ++r) { const int i = 16 * wave + 4 * fq + r;
                const float arg = (j <= i) ? csfi[r] - csfj : csbi[r] - csbj;
                const float wgt = (j < i) ? dtfj : ((j > i) ? dtbj : dtfj + dtbj);
                *(LAS unsigned short*)(m_wr + (r * SD_S + 16 * tj) * 2) = (unsigned short)f2bf_u(cb[tj][r] * __expf(fminf(arg, 0.f)) * wgt); }
            __builtin_amdgcn_sched_barrier(0);
        }
        __builtin_amdgcn_sched_barrier(0);
#pragma unroll
        for (int dir = 0; dir < 2; ++dir) {
            *(LAS v4u*)(hs_wr + dir * SD_HS2OFF) = hreg[dir][0]; *(LAS v4u*)(hs_wr + dir * SD_HS2OFF + 16) = hreg[dir][1];
        }
        __syncthreads();
        f32x4 tmp[4];
#pragma unroll
        for (int tp = 0; tp < 4; ++tp) tmp[tp] = (f32x4){0.f, 0.f, 0.f, 0.f};
#pragma unroll
        for (int ks = 0; ks < 4; ++ks) {
            const bf16x8 am = *(const LAS bf16x8*)(m_rd + 64 * ks);
#pragma unroll
            for (int tp = 0; tp < 4; ++tp) {
                const bf16x8 bx = *(const LAS bf16x8*)(xt_rd + ((hg * 64 + 16 * tp) * SD_S + 32 * ks) * 2);
                yacc[hg][tp] = __builtin_amdgcn_mfma_f32_16x16x32_bf16(am, bx, yacc[hg][tp], 0, 0, 0);
                const bf16x8 bhf = *(const LAS bf16x8*)(hs_rd + (16 * tp * SD_S + 32 * ks) * 2);
                tmp[tp] = __builtin_amdgcn_mfma_f32_16x16x32_bf16(ca[ks], bhf, tmp[tp], 0, 0, 0);
            }
        }
#pragma unroll
        for (int r = 0; r < 4; ++r) { const float ef = __expf(csfi[r]);
#pragma unroll
            for (int tp = 0; tp < 4; ++tp) { yacc[hg][tp][r] += ef * tmp[tp][r]; tmp[tp][r] = 0.f; } }
#pragma unroll
        for (int ks = 0; ks < 4; ++ks)
#pragma unroll
            for (int tp = 0; tp < 4; ++tp) {
                const bf16x8 bhb = *(const LAS bf16x8*)(hs_rd + SD_HS2OFF + (16 * tp * SD_S + 32 * ks) * 2);
                tmp[tp] = __builtin_amdgcn_mfma_f32_16x16x32_bf16(ca[ks], bhb, tmp[tp], 0, 0, 0);
            }
#pragma unroll
        for (int r = 0; r < 4; ++r) { const float eb = __expf(csbi[r]);
#pragma unroll
            for (int tp = 0; tp < 4; ++tp) yacc[hg][tp][r] += eb * tmp[tp][r]; }
        __syncthreads();
    }
#pragma unroll
    for (int hg = 0; hg < 3; ++hg) {
        const float dcoef = p.ssd_d[l * 6 + g * 3 + hg];
#pragma unroll
        for (int tp = 0; tp < 4; ++tp) {
            const int pc = hg * 64 + 16 * tp + fr;
#pragma unroll
            for (int r = 0; r < 4; ++r)
                yacc[hg][tp][r] += dcoef * bflo((unsigned)((const LAS unsigned short*)(lds + SD_XT))[pc * SD_S + 16 * wave + 4 * fq + r]);
        }
    }
    __syncthreads();
    {
        LAS float* YL = (LAS float*)lds;
#pragma unroll
        for (int hg = 0; hg < 3; ++hg)
#pragma unroll
            for (int tp = 0; tp < 4; ++tp)
#pragma unroll
                for (int r = 0; r < 4; ++r) YL[(16 * wave + 4 * fq + r) * 196 + hg * 64 + 16 * tp + fr] = yacc[hg][tp][r];
        const float nw0 = p.ssd_norm_w[l * 384 + g * 192 + lane], nw1 = p.ssd_norm_w[l * 384 + g * 192 + 64 + lane], nw2 = p.ssd_norm_w[l * 384 + g * 192 + 128 + lane];
#pragma unroll 1
        for (int r8 = 0; r8 < 16; r8 += 8) {
            unsigned short zr[8][3];
#pragma unroll
            for (int k = 0; k < 8; ++k) {
                const act_t* zp = p.P + (size_t)ssd_row(b, cc, 16 * wave + r8 + k) * LDP + OFF_Z + g * 192 + lane;
                zr[k][0] = zp[0]; zr[k][1] = zp[64]; zr[k][2] = zp[128];
            }
#pragma unroll
            for (int k = 0; k < 8; ++k) {
                const int i = 16 * wave + r8 + k;
                const float z0 = bflo(zr[k][0]), z1 = bflo(zr[k][1]), z2 = bflo(zr[k][2]);
                const float v0 = YL[i * 196 + lane] * (z0 / (1.0f + __expf(-z0))), v1 = YL[i * 196 + 64 + lane] * (z1 / (1.0f + __expf(-z1))), v2 = YL[i * 196 + 128 + lane] * (z2 / (1.0f + __expf(-z2)));
                const float rs = 1.0f / sqrtf(wave_sum(v0 * v0 + v1 * v1 + v2 * v2, lane) * (1.0f / 192.0f) + EPSV);
                act_t* yp = p.Y + (size_t)ssd_row(b, cc, i) * DM + 640 + g * 192 + lane;
                stact(yp, v0 * rs * nw0); stact(yp + 64, v1 * rs * nw1); stact(yp + 128, v2 * rs * nw2);
            }
        }
    }
    __syncthreads();
}

typedef float f32x16 __attribute__((ext_vector_type(16)));
constexpr int HY_CP = 0, HY_MOFF = 4352, HY_U = 17920, HY_US = 264, HY_OUT = 85504;
__device__ __forceinline__ void hy_u8(const Params& p, int l, int b, int t, int col0, float (&y)[8]) {
    const act_t* rc = p.P + (size_t)(b * SEQ + t) * LDP + OFF_HY + col0;
    const float* w = p.hy_short_w + (size_t)l * 3 * 768 + col0; const float* bs = p.hy_short_b + (size_t)l * 768 + col0;
    float xc[8]; unpack8(*(const v4u*)rc, xc);
#pragma unroll
    for (int e = 0; e < 8; ++e) y[e] = bs[e] + w[768 + e] * xc[e];
    if (t > 0) { float xp[8]; unpack8(*(const v4u*)(rc - LDP), xp);
#pragma unroll
        for (int e = 0; e < 8; ++e) y[e] += w[e] * xp[e]; }
    if (t + 1 < SEQ) { float xn[8]; unpack8(*(const v4u*)(rc + LDP), xn);
#pragma unroll
        for (int e = 0; e < 8; ++e) y[e] += w[2 * 768 + e] * xn[e]; }
}

__device__ __forceinline__ void hy_ctx_conv(const Params& p, int l, long tid, long nth) {
    for (long i = tid; i < (long)BC * 256; i += nth) {
        const int c = (int)(i & 255), r = BL + (int)(i >> 8);
        const int s = NB + (r - BL) / CTX, r0 = seq_row0(s), t = r - r0;
        const float* hf = p.HFC + (size_t)l * CTX * 256 + c;
        int jlo = t + CTX / 2 - (CTX - 1); if (jlo < 0) jlo = 0;
        int jhi = t + CTX / 2; if (jhi > CTX - 1) jhi = CTX - 1;
        float acc = 0.f;
#pragma unroll 8
        for (int j = jlo; j <= jhi; ++j) acc += hf[(size_t)(t - j + CTX / 2) * 256] * p.VX[(size_t)(r0 + j) * 256 + c];
        const float x0 = hy_u(p, l, s, t, c);
        stact(p.Y + (size_t)r * DM + 384 + c, (acc + p.VX[(size_t)r * 256 + c] * p.hy_bias[l * 256 + c]) * x0);
    }
}
__device__ __forceinline__ void hy_h1_unit(const Params& p, int l, LAS unsigned char* lds, int u, int tix) {
    const int b = u / (SEQ / 64), t0 = (u % (SEQ / 64)) * 64;
    const int t = tix & 63, cg = tix >> 6;
    LAS unsigned short* T = (LAS unsigned short*)lds;
#pragma unroll 1
    for (int o = 0; o < 4; ++o) {
        const int c0 = 32 * cg + 8 * o;
        float x1[8], v[8]; hy_u8(p, l, b, t0 + t, 256 + c0, x1); hy_u8(p, l, b, t0 + t, 512 + c0, v);
#pragma unroll
        for (int e = 0; e < 8; ++e) T[(c0 + e) * 72 + t] = (unsigned short)f2bf_u(v[e] * x1[e]);
    }
    __syncthreads();
    {
        const int c = tix >> 1, half = tix & 1;
        unsigned short* dst = p.VXT + ((size_t)(b * 256 + c)) * SEQ + t0 + 32 * half;
#pragma unroll
        for (int k = 0; k < 4; ++k) *(v4u*)(dst + 8 * k) = *(const LAS v4u*)(lds + (c * 72 + 32 * half + 8 * k) * 2);
    }
    __syncthreads();
}
template <int ALPHA>
__device__ __forceinline__ bf16x8 hy_afrag(const LAS unsigned char* a) {
    constexpr int SFT = 8 - ALPHA, SIG = SFT >> 1, HALF = SFT & 1;
    const v4u Y = *(const LAS v4u*)(a + 16);
    if constexpr (ALPHA == 0) { return __builtin_bit_cast(bf16x8, Y); }
    else {
        const v4u X = *(const LAS v4u*)a;
        const unsigned W[9] = { X.x, X.y, X.z, X.w, Y.x, Y.y, Y.z, Y.w, 0u };
        v4u o;
        o.x = HALF ? __builtin_amdgcn_alignbit(W[SIG + 1], W[SIG + 0], 16) : W[SIG + 0];
        o.y = HALF ? __builtin_amdgcn_alignbit(W[SIG + 2], W[SIG + 1], 16) : W[SIG + 1];
        o.z = HALF ? __builtin_amdgcn_alignbit(W[SIG + 3], W[SIG + 2], 16) : W[SIG + 2];
        o.w = HALF ? __builtin_amdgcn_alignbit(W[SIG + 4], W[SIG + 3], 16) : W[SIG + 3];
        return __builtin_bit_cast(bf16x8, o);
    }
}
template <int ALPHA>
__device__ __forceinline__ void hy_stream(LAS unsigned char* lds, int lane, f32x16 (&acc)[4]) {
    const int r = lane & 31, hf = lane >> 5, Il = r >> 2, bt = r & 3;
    LAS unsigned char* a_base = lds + HY_CP + 2 * (HY_MOFF + 8 * (hf - r) + 4096) - 12288;
    LAS unsigned char* b_base = lds + HY_U + ((Il * 4 + bt) * HY_US + 8 * hf) * 2;
    asm volatile("" : "+v"(a_base), "+v"(b_base));
    const bf16x8 zero8 = {0, 0, 0, 0, 0, 0, 0, 0};
#pragma unroll 1
    for (int s = 0; s < 16; ++s) {
        LAS unsigned char* ap = a_base + 32 * s; LAS unsigned char* bp = b_base + 32 * s;
#pragma unroll 1
        for (int delta = 0; delta < 8; ++delta) {
            const bf16x8 a0 = hy_afrag<ALPHA>(ap + 3 * 4096), a1 = hy_afrag<ALPHA>(ap + 2 * 4096), a2 = hy_afrag<ALPHA>(ap + 4096), a3 = hy_afrag<ALPHA>(ap);
            bf16x8 b0 = *(const LAS bf16x8*)bp, b1 = *(const LAS bf16x8*)(bp + 16896), b2 = *(const LAS bf16x8*)(bp + 2 * 16896);
            LAS unsigned char* bp3 = bp + 3 * 16896;
            bf16x8 b3 = *(const LAS bf16x8*)bp3, b4 = *(const LAS bf16x8*)(bp3 + 16896);
            b0 = (Il >= delta) ? b0 : zero8; b4 = (Il < delta) ? b4 : zero8;
            acc[0] = __builtin_amdgcn_mfma_f32_32x32x16_bf16(a0, b2, acc[0], 0, 0, 0);
            acc[1] = __builtin_amdgcn_mfma_f32_32x32x16_bf16(a0, b3, acc[1], 0, 0, 0);
            acc[2] = __builtin_amdgcn_mfma_f32_32x32x16_bf16(a0, b4, acc[2], 0, 0, 0);
            acc[3] = __builtin_amdgcn_mfma_f32_32x32x16_bf16(a1, b4, acc[3], 0, 0, 0);
            acc[0] = __builtin_amdgcn_mfma_f32_32x32x16_bf16(a1, b1, acc[0], 0, 0, 0);
            acc[1] = __builtin_amdgcn_mfma_f32_32x32x16_bf16(a1, b2, acc[1], 0, 0, 0);
            acc[2] = __builtin_amdgcn_mfma_f32_32x32x16_bf16(a1, b3, acc[2], 0, 0, 0);
            acc[3] = __builtin_amdgcn_mfma_f32_32x32x16_bf16(a2, b3, acc[3], 0, 0, 0);
            acc[0] = __builtin_amdgcn_mfma_f32_32x32x16_bf16(a2, b0, acc[0], 0, 0, 0);
            acc[1] = __builtin_amdgcn_mfma_f32_32x32x16_bf16(a2, b1, acc[1], 0, 0, 0);
            acc[2] = __builtin_amdgcn_mfma_f32_32x32x16_bf16(a2, b2, acc[2], 0, 0, 0);
            acc[3] = __builtin_amdgcn_mfma_f32_32x32x16_bf16(a3, b2, acc[3], 0, 0, 0);
            acc[1] = __builtin_amdgcn_mfma_f32_32x32x16_bf16(a3, b0, acc[1], 0, 0, 0);
            acc[2] = __builtin_amdgcn_mfma_f32_32x32x16_bf16(a3, b1, acc[2], 0, 0, 0);
            if (delta == 0) {
                const bf16x8 a4 = hy_afrag<ALPHA>(ap - 4096);
                acc[2] = __builtin_amdgcn_mfma_f32_32x32x16_bf16(a4, b0, acc[2], 0, 0, 0);
                acc[3] = __builtin_amdgcn_mfma_f32_32x32x16_bf16(a4, b1, acc[3], 0, 0, 0);
            }
            ap -= 512; bp -= 2112;
        }
    }
}
__device__ __forceinline__ void hy_h2_channel(const Params& p, int l, LAS unsigned char* lds, int c, int tix) {
    const int lane = tix & 63, wave = __builtin_amdgcn_readfirstlane(tix >> 6);
    __syncthreads();
    for (int item = tix; item < 4096; item += 512) {
        const int bt = item >> 10, j = (item & 1023) * 8;
        *(LAS v4u*)(lds + HY_U + (((j >> 8) * 4 + bt) * HY_US + (j & 255)) * 2) = *(const v4u*)(p.VXT + ((size_t)(bt * 256 + c)) * SEQ + j);
    }
    {
        const unsigned short* g1 = p.G1 + ((size_t)l * 256 + c) * G1N;
        for (int item = tix; item < G1N / 8; item += 512) *(LAS v4u*)(lds + HY_CP + item * 16) = *(const v4u*)(g1 + item * 8);
    }
    __syncthreads();
    f32x16 acc[4];
#pragma unroll
    for (int i = 0; i < 4; ++i)
#pragma unroll
        for (int k = 0; k < 16; ++k) acc[i][k] = 0.f;
    switch (wave) {
        case 0: hy_stream<0>(lds, lane, acc); break;
        case 1: hy_stream<1>(lds, lane, acc); break;
        case 2: hy_stream<2>(lds, lane, acc); break;
        case 3: hy_stream<3>(lds, lane, acc); break;
        case 4: hy_stream<4>(lds, lane, acc); break;
        case 5: hy_stream<5>(lds, lane, acc); break;
        case 6: hy_stream<6>(lds, lane, acc); break;
        default: hy_stream<7>(lds, lane, acc); break;
    }
    const int r = lane & 31, hf = lane >> 5;
    LAS float* ST = (LAS float*)(lds + HY_U);
#pragma unroll
    for (int half = 0; half < 2; ++half) {
        __syncthreads();
#pragma unroll
        for (int ii = 0; ii < 2; ++ii)
#pragma unroll
            for (int k = 0; k < 16; ++k)
                ST[(32 * ii + r) * 257 + 8 * ((k & 3) + 8 * (k >> 2) + 4 * hf) + wave] = acc[2 * half + ii][k];
        __syncthreads();
        for (int item = tix; item < 64 * 64; item += 512) {
            const int R = item >> 6, c4 = (item & 63) * 4;
            f32x4 v; v.x = ST[R * 257 + c4]; v.y = ST[R * 257 + c4 + 1]; v.z = ST[R * 257 + c4 + 2]; v.w = ST[R * 257 + c4 + 3];
            *(f32x4*)(p.CONV + ((size_t)((R & 3) * 256 + c)) * SEQ + 256 * (16 * half + (R >> 2)) + c4) = v;
        }
    }
}
__device__ __forceinline__ void hy_h3_unit(const Params& p, int l, LAS unsigned char* lds, int u, int tix) {
    const int b = u / (SEQ / 64), t0 = (u % (SEQ / 64)) * 64;
    LAS float* T = (LAS float*)lds;
    for (int item = tix; item < 4096; item += 512) {
        const int c = item >> 4, t4 = (item & 15) * 4;
        *(LAS f32x4*)(T + c * 68 + t4) = *(const f32x4*)(p.CONV + ((size_t)(b * 256 + c)) * SEQ + t0 + t4);
    }
    __syncthreads();
    const int t = tix & 63, cg = tix >> 6;
#pragma unroll 1
    for (int o = 0; o < 4; ++o) {
        const int c0 = 32 * cg + 8 * o;
        float x0[8], x1[8], v[8]; hy_u8(p, l, b, t0 + t, c0, x0); hy_u8(p, l, b, t0 + t, 256 + c0, x1); hy_u8(p, l, b, t0 + t, 512 + c0, v);
        float y[8];
#pragma unroll
        for (int e = 0; e < 8; ++e) y[e] = (T[(c0 + e) * 68 + t] + v[e] * x1[e] * p.hy_bias[l * 256 + c0 + e]) * x0[e];
        v4u w; w.x = pk2(y[0], y[1]); w.y = pk2(y[2], y[3]); w.z = pk2(y[4], y[5]); w.w = pk2(y[6], y[7]);
        *(v4u*)(p.Y + (size_t)(b * SEQ + t0 + t) * DM + 384 + c0) = w;
    }
    __syncthreads();
}

__global__ void __launch_bounds__(512, 2) mega_fwd(Params p_arg) {
    extern __shared__ __attribute__((aligned(16))) unsigned char lds_raw[];
    LAS unsigned char* lds = (LAS unsigned char*)lds_raw;
    cg::grid_group grid = cg::this_grid();
    const long nth = (long)gridDim.x * 512;
    const int NGW = gridDim.x * 8, G = gridDim.x;
    const int wave_s = __builtin_amdgcn_readfirstlane((int)threadIdx.x >> 6);
#define MY_TIX() ([&]() { unsigned z_ = 0u; asm volatile("" : "+v"(z_)); return (wave_s << 6) | (int)__builtin_amdgcn_mbcnt_hi(~0u, __builtin_amdgcn_mbcnt_lo(~0u, z_)); }())
    constexpr int LDS_BARW = LDS_BYTES - 64;
    if (threadIdx.x < 2) ((LAS unsigned*)(lds + LDS_BARW))[threadIdx.x] = 0u;
    __syncthreads();
    { const __attribute__((address_space(4))) Params* kp0 = (const __attribute__((address_space(4))) Params*)__builtin_amdgcn_kernarg_segment_ptr();
      (void)xcd_barrier_post(kp0->BAR, (volatile LAS unsigned*)(lds + LDS_BARW)); }
#define GSYNC() do { const __attribute__((address_space(4))) Params* kpb_ = (const __attribute__((address_space(4))) Params*)__builtin_amdgcn_kernarg_segment_ptr(); \
    asm volatile("" : "+s"(kpb_)); XcdBarrier xb_; xb_.bar = kpb_->BAR; xb_.x = xb_xcc_id(); xb_.st = (volatile LAS unsigned*)(lds + LDS_BARW); xcd_barrier(xb_, MY_TIX() == 0); } while (0)
#define PH_IDS() int tix_ = MY_TIX(); asm volatile("" : "+v"(tix_)); const long tid = (long)blockIdx.x * 512 + tix_; const int lane = tix_ & 63; \
    const int wave = __builtin_amdgcn_readfirstlane(tix_ >> 6); const int gw = blockIdx.x * 8 + wave; (void)tid; (void)lane; (void)gw; \
    const __attribute__((address_space(4))) Params* kp_ = (const __attribute__((address_space(4))) Params*)__builtin_amdgcn_kernarg_segment_ptr(); \
    asm volatile("" : "+s"(kp_)); const Params& p = *(const Params*)kp_;

    for (int rep = 0; rep < REP_PRO; ++rep) {
    { PH_IDS(); mod_partial(p, tid, nth, (float*)p.DSS);
      prologue_weights(p, (LAS float*)(lds + wave * 16384), gw, NGW, lane);
      filt_all(p, lds, tid, nth, tix_, blockIdx.x, G); }
    grid.sync();
    { PH_IDS(); mod_reduce(p, tid, nth, (const float*)p.DSS); }
    GSYNC();
    }
#pragma unroll 1
    for (int l = 0; l < DEPTH; ++l) {
        const int nrows = (l == DEPTH - 1) ? BL : NT;
        for (int rep = 0; rep < REP_HX; ++rep) {
        { PH_IDS(); hx_pass<false>(p, l, 0, 0, (CTX_SPLITK && l > 0) ? BL : NT, gw, NGW, lane); }
        if (CTX_SPLITK && l > 0) { PH_IDS(); hx_pass<true>(p, l, 0, BL, NT, gw, NGW, lane, DFF / 256, (const float*)p.DSG, p.MOD + ((size_t)(l - 1) * (NB + 1) + NB) * 6 * DM + 5 * DM, false); }
        GSYNC();
        }
        for (int rep = 0; rep < REP_G1; ++rep)
        {   PH_IDS();
            pg8::Gemm g{p.Y, p.WIN_T + (size_t)l * LDP * DM, NT, LDP, DM, DM}; pg8::StaticOrder S; S.init(NT, LDP, G, (int)blockIdx.x);
            pg8::EpiBf16<0> E{p.P, LDP, nullptr, 0, 0, 1.f};
            pg8::gemm_phase<pg8::EpiBf16<0>, pg8::StaticOrder, true, true>(lds, g, S, E, tix_);
            GSYNC();
        }
        for (int rep = 0; rep < REP_MIX; ++rep) {
        for (int qa = 0; qa < REP_PA; ++qa)
        {   PH_IDS();
            for (int u = blockIdx.x; u < SSD_UNITS; u += G) ssd_s2_unit(p, l, lds, u, tix_, p.DSS, p.DECS);
            gla_m2_phase(p, l, lds, tix_, blockIdx.x, p.DSG, p.DECG);
            for (int u = blockIdx.x; u < NB * (SEQ / 64); u += G) hy_h1_unit(p, l, lds, u, tix_);
            if (l < DEPTH - 1) st_hy_pre(p, l, tid, nth, BL, NT);
        }
        GSYNC();
        {   PH_IDS();
            for (int q = 0; q < REP_H2; ++q) for (int c = blockIdx.x; c < 256; c += G) hy_h2_channel(p, l, lds, c, tix_);
            {
                const long vt = ((long)wave * G + blockIdx.x) * 64 + lane;
                if (nth >= 131072) {
                    if (vt < 49152) ssd_s3(vt, 49152, p.DSS, p.DECS);
                    else if (vt < 49152 + 24576) { for (int q = 0; q < REP_M3; ++q) gla_m3(vt - 49152, 24576, p.DSG, p.DECG, p.SSG); }
                    else if (l < DEPTH - 1) hy_ctx_conv(p, l, vt - (49152 + 24576), nth - (49152 + 24576));
                } else { ssd_s3(vt, nth, p.DSS, p.DECS); gla_m3(vt, nth, p.DSG, p.DECG, p.SSG); if (l < DEPTH - 1) hy_ctx_conv(p, l, vt, nth); }
            }
        }
        GSYNC();
        for (int qc = 0; qc < REP_PC; ++qc)
        {   PH_IDS();
            for (int u = blockIdx.x; u < SSD_UNITS; u += G) ssd_s4_unit(p, l, lds, u, tix_, p.DSS);
            gla_m4_phase(p, l, lds, tix_, blockIdx.x, p.SSG);
            for (int u = blockIdx.x; u < NB * (SEQ / 64); u += G) hy_h3_unit(p, l, lds, u, tix_);
        }
        GSYNC();
        }
        {   PH_IDS();
            const int mrows = (CTX_SPLITK || l == DEPTH - 1) ? BL : NT; pg8::Gemm g{p.Y, p.WOUT_T + (size_t)l * DM * DM, mrows, DM, DM, DM}; pg8::StaticOrder S; S.init(mrows, DM, G, (int)blockIdx.x);
            pg8::EpiRes E{p.XL, p.XC, p.MOD + (size_t)l * (NB + 1) * 6 * DM, 2, l == 0 ? p.x : p.XL, l == 0 ? p.ctx : p.XC};
            pg8::gemm_phase<pg8::EpiRes, pg8::StaticOrder, true, true>(lds, g, S, E, tix_);
        }
        if (CTX_SPLITK && l < DEPTH - 1) {   PH_IDS();
            {
                pg8::Gemm gc{p.Y + (size_t)BL * DM, p.WOUT_T + (size_t)l * DM * DM, BC, DM, 256, DM}; pg8::SplitKOrder SC; SC.init(BC, DM, DM / 256, 256, G, (int)blockIdx.x);
                pg8::EpiSlab EC{(float*)p.DSG, BC, 512};
                pg8::gemm_phase<pg8::EpiSlab, pg8::SplitKOrder, true, true>(lds, gc, SC, EC, tix_);
            }
        }
        GSYNC();
        for (int rep = 0; rep < REP_HX; ++rep) {
        { PH_IDS(); hx_pass<false>(p, l, 1, 0, CTX_SPLITK ? BL : nrows, gw, NGW, lane); }
        if (CTX_SPLITK && l < DEPTH - 1) { PH_IDS(); hx_pass<true>(p, l, 1, BL, NT, gw, NGW, lane, DM / 256, (const float*)p.DSG, p.MOD + ((size_t)l * (NB + 1) + NB) * 6 * DM + 2 * DM, l == 0); }
        GSYNC();
        }
        for (int rep = 0; rep < REP_G3; ++rep)
        {   PH_IDS();
            pg8::Gemm g{p.Y, p.W13_T + (size_t)l * NFF2 * DM, nrows, NFF2, DM, DM}; pg8::StaticOrder S; S.init(nrows, NFF2, G, (int)blockIdx.x);
            pg8::EpiSwiGLU E{p.P};
            pg8::gemm_phase<pg8::EpiSwiGLU, pg8::StaticOrder, true, true>(lds, g, S, E, tix_);
            GSYNC();
        }
        {   PH_IDS();
            const int mrows = (CTX_SPLITK || l == DEPTH - 1) ? BL : NT; pg8::Gemm g{p.P, p.W2_T + (size_t)l * DM * DFF, mrows, DM, DFF, DFF}; pg8::StaticOrder S; S.init(mrows, DM, G, (int)blockIdx.x);
            pg8::EpiRes E{p.XL, p.XC, p.MOD + (size_t)l * (NB + 1) * 6 * DM, 5, p.XL, p.XC};
            pg8::gemm_phase<pg8::EpiRes, pg8::StaticOrder, true, true>(lds, g, S, E, tix_);
        }
        if (CTX_SPLITK && l < DEPTH - 1) {   PH_IDS();
            {
                pg8::Gemm gc{p.P + (size_t)BL * DFF, p.W2_T + (size_t)l * DM * DFF, BC, DM, 256, DFF}; pg8::SplitKOrder SC; SC.init(BC, DM, DFF / 256, 256, G, (int)blockIdx.x);
                pg8::EpiSlab EC{(float*)p.DSG, BC, 512};
                pg8::gemm_phase<pg8::EpiSlab, pg8::SplitKOrder, true, true>(lds, gc, SC, EC, tix_);
            }
        }
        GSYNC();
    }
    { PH_IDS(); final_pass(p, gw, NGW, lane); }
}

extern "C" void kernel_launch(void* const* d_in, const int* in_sizes, int n_in, void* d_out, int out_size,
                              void* d_ws, size_t ws_size, hipStream_t stream) {
    static int grid_blocks = 0;
    if (!grid_blocks) {
        int dev = 0, cus = 0, per_cu = 0;
        (void)hipGetDevice(&dev);
        (void)hipDeviceGetAttribute(&cus, hipDeviceAttributeMultiprocessorCount, dev);
        (void)hipFuncSetAttribute((const void*)mega_fwd, hipFuncAttributeMaxDynamicSharedMemorySize, LDS_BYTES);
        (void)hipOccupancyMaxActiveBlocksPerMultiprocessor(&per_cu, mega_fwd, 512, LDS_BYTES);
        if (per_cu < 1) per_cu = 1;
        grid_blocks = cus;
    }
    Params p{};
    fill_inputs(p, d_in);
    carve(p, (char*)d_ws, (float*)d_out);
    (void)hipMemsetAsync(p.BAR, 0, 16384, stream);
    void* args[] = { &p };
    hipError_t e = hipLaunchCooperativeKernel((void*)mega_fwd, dim3(grid_blocks), dim3(512), args, LDS_BYTES, stream);
    if (e != hipSuccess) fprintf(stderr, "cooperative launch failed: %s (grid %d)\n", hipGetErrorString(e), grid_blocks);
}
#endif
```

```cpp
#ifndef CPU_EMU
#include <hip/hip_runtime.h>
#include <hip/hip_cooperative_groups.h>
#include <cstdio>
#else
#include <cmath>
#include <cstring>
#include <cstdio>
#include <cstdlib>
#define __device__
#define __global__
#define __forceinline__ inline
#define __host__
#endif
#include <stdint.h>
#include <stddef.h>

#ifndef NB
#define NB 4
#endif
#ifndef SEQ
#define SEQ 8192
#endif
#ifndef CTX
#define CTX 256
#endif
#define DEPTH 2
#define DM 1024
#define GRID_W 64
#define ROWS_G (SEQ / GRID_W)
#define BL (NB * SEQ)
#define BC (NB * CTX)
#define NT (BL + BC)
#define NSEQ (2 * NB)
#define DIN 3244
#define LDP 3328
#define NFF2 (2 * DFF)
#define OFF_Q 0
#define OFF_K 192
#define OFF_V 384
#define OFF_G 768
#define OFF_GKF 1152
#define OFF_GKB 1168
#define OFF_HY 1184
#define OFF_Z 1952
#define OFF_XBC 2336
#define OFF_DTF 3232
#define OFF_DTB 3238
#define DFF 2816
#define TF (SEQ + CTX)
#define G1N 8720
#define EPSV 1e-6f

#ifdef ACT_FP32
typedef float act_t;
__device__ __forceinline__ float ldact(const act_t* p) { return *p; }
__device__ __forceinline__ void stact(act_t* p, float v) { *p = v; }
#else
typedef unsigned short act_t;
__device__ __forceinline__ float ldact(const act_t* p) {
    union { unsigned u; float f; } x; x.u = ((unsigned)*p) << 16; return x.f;
}
__device__ __forceinline__ void stact(act_t* p, float v) {
    union { float f; unsigned u; } x; x.f = v;
    unsigned r = x.u + 0x7FFFu + ((x.u >> 16) & 1u);
    *p = (unsigned short)(r >> 16);
}
#endif

struct Params {
    const float *x, *c, *ctx, *c_ctx, *mod_w, *mod_b, *norm1_g, *norm2_g, *w_in;
    const float *gk_w_f, *gk_b_f, *gk_w_b, *gk_b_b, *gla_norm_w;
    const float *hy_short_w, *hy_short_b, *hy_w1, *hy_b1, *hy_w2, *hy_b2, *hy_w3, *hy_freq, *hy_decay, *hy_bias;
    const float *ssd_conv_w, *ssd_conv_b, *ssd_dt_bias_f, *ssd_dt_bias_b, *ssd_a_log_f, *ssd_a_log_b, *ssd_d, *ssd_norm_w;
    const float *w_out, *ffn_w1, *ffn_w3, *ffn_w2, *final_g;
    float* XL;
    float* XC;
    float* MOD;
    float* HF;
    float* H1;
    float* H2;
    float* RSTD;
    act_t* P;
    act_t* Y;
    float* LG;
    float* O;
    act_t* XBC;
    float* YS;
    float* DT;
    float* VX;
    unsigned* BAR;
    unsigned short* G1;
    unsigned short* VXT;
    float* CONV;
    float* HFC;
    unsigned short *DSG, *SSG, *DSS;
    float *DECG, *DECS;
    unsigned short *WIN_T, *WOUT_T, *W13_T, *W2_T;
};

__device__ __forceinline__ float siluf(float x) { return x / (1.0f + expf(-x)); }
__device__ __forceinline__ float softplusf(float x) { return fmaxf(x, 0.0f) + log1pf(expf(-fabsf(x))); }
__device__ __forceinline__ float logsigmoidf(float x) { return -softplusf(-x); }

__device__ __forceinline__ float* xrow(const Params& p, int r) {
    return r < BL ? p.XL + (size_t)r * DM : p.XC + (size_t)(r - BL) * DM;
}
__device__ __forceinline__ int row_bb(int r) { return r < BL ? r / SEQ : NB; }
__device__ __forceinline__ int seq_len(int s) { return s < NB ? SEQ : CTX; }
__device__ __forceinline__ int seq_row0(int s) { return s < NB ? s * SEQ : BL + (s - NB) * CTX; }
__device__ __forceinline__ int colmajor_tok(int s, int pos) {
    return s < NB ? (pos % ROWS_G) * GRID_W + pos / ROWS_G : pos;
}

__device__ void st_init(const Params& p, long tid, long nth) {
    for (long i = tid; i < (long)BL * DM; i += nth) p.XL[i] = p.x[i];
    for (long i = tid; i < (long)BC * DM; i += nth) p.XC[i] = p.ctx[i];
}
__device__ void st_mod(const Params& p, long tid, long nth) {
    const long total = (long)DEPTH * (NB + 1) * 6 * DM;
    for (long i = tid; i < total; i += nth) {
        int n = (int)(i % (6 * DM));
        int bb = (int)((i / (6 * DM)) % (NB + 1));
        int l = (int)(i / ((long)6 * DM * (NB + 1)));
        const float* cv = bb < NB ? p.c + (size_t)bb * DM : p.c_ctx;
        const float* w = p.mod_w + (size_t)l * DM * 6 * DM + n;
        float acc = 0.f;
        for (int k = 0; k < DM; ++k) acc += siluf(cv[k]) * w[(size_t)k * 6 * DM];
        p.MOD[i] = acc + p.mod_b[(size_t)l * 6 * DM + n];
    }
}
__device__ __forceinline__ void filt_pos(int tt, float& rel) {
    int L = tt < SEQ ? SEQ : CTX; int t = tt < SEQ ? tt : tt - SEQ;
    rel = ((float)t - (float)(L / 2)) / (float)L;
}
__device__ void st_filt1(const Params& p, long tid, long nth) {
    const long total = (long)DEPTH * TF * 64;
    for (long i = tid; i < total; i += nth) {
        int o = (int)(i % 64); int tt = (int)((i / 64) % TF); int l = (int)(i / (64L * TF));
        float rel; filt_pos(tt, rel);
        const float* w1 = p.hy_w1 + (size_t)l * 33 * 64 + o;
        float acc = rel * w1[0];
        const float tw = 2.0f * 3.14159265358979323846f * rel;
        for (int j = 0; j < 16; ++j) {
            float band = 1e-4f + (float)j * ((15.0f - 1e-4f) / 15.0f);
            float ang = tw * band;
            acc += cosf(ang) * w1[(size_t)(1 + j) * 64];
            acc += -sinf(ang) * w1[(size_t)(17 + j) * 64];
        }
        p.H1[i] = sinf(p.hy_freq[l * 64 + o] * (acc + p.hy_b1[l * 64 + o]));
    }
}
__device__ void st_filt2(const Params& p, long tid, long nth) {
    const long total = (long)DEPTH * TF * 64;
    for (long i = tid; i < total; i += nth) {
        int o = (int)(i % 64); int l = (int)(i / (64L * TF));
        const float* h1 = p.H1 + (i - o);
        const float* w2 = p.hy_w2 + (size_t)l * 64 * 64 + o;
        float acc = 0.f;
        for (int j = 0; j < 64; ++j) acc += h1[j] * w2[(size_t)j * 64];
        p.H2[i] = sinf(p.hy_freq[l * 64 + o] * (acc + p.hy_b2[l * 64 + o]));
    }
}
__device__ void st_filt3(const Params& p, long tid, long nth) {
    const long total = (long)DEPTH * TF * 256;
    for (long i = tid; i < total; i += nth) {
        int c = (int)(i % 256); int tt = (int)((i / 256) % TF); int l = (int)(i / (256L * TF));
        float rel; filt_pos(tt, rel);
        const float* h2 = p.H2 + ((size_t)l * TF + tt) * 64;
        const float* w3 = p.hy_w3 + (size_t)l * 64 * 256 + c;
        float acc = 0.f;
        for (int j = 0; j < 64; ++j) acc += h2[j] * w3[(size_t)j * 256];
        const float hv = acc * expf(-2.0f * fabsf(rel) * p.hy_decay[l * 256 + c]);
        p.HF[i] = hv;
#ifndef CPU_EMU
        if (tt < SEQ) { unsigned short* q = p.G1 + ((size_t)l * 256 + c) * G1N + (8456 - tt); stact(q, hv); }
#endif
    }
#ifndef CPU_EMU
    constexpr int NPAD = 265 + (G1N - 8457);
    for (long i = tid; i < (long)DEPTH * 256 * NPAD; i += nth) {
        const int k = (int)(i % NPAD); const long lc = i / NPAD;
        p.G1[lc * G1N + (k < 265 ? k : 8457 + (k - 265))] = 0;
    }
#endif
}
__device__ void st_rstd(const Params& p, long tid, long nth) {
    for (long r = tid; r < NT; r += nth) {
        const float* xr = xrow(p, (int)r);
        float ss = 0.f;
        for (int k = 0; k < DM; ++k) ss += xr[k] * xr[k];
        p.RSTD[r] = 1.0f / sqrtf(ss / (float)DM + EPSV);
    }
}
__device__ void st_hx(const Params& p, int l, int which, long tid, long nth) {
    const float* g = (which ? p.norm2_g : p.norm1_g) + (size_t)l * DM;
    for (long i = tid; i < (long)NT * DM; i += nth) {
        int k = (int)(i % DM); int r = (int)(i / DM);
        const float* m = p.MOD + ((size_t)l * (NB + 1) + row_bb(r)) * 6 * DM;
        float sh = m[(which ? 3 : 0) * DM + k], sc = m[(which ? 4 : 1) * DM + k];
        float v = xrow(p, r)[k] * p.RSTD[r] * g[k];
        stact(p.Y + i, v * (1.0f + sc) + sh);
    }
}
template <int MODE>
__device__ void st_gemm(const Params& p, int l, int nrows, long tid, long nth) {
    const int N = MODE == 0 ? DIN : (MODE == 2 ? DFF : DM);
    const int K = MODE == 3 ? DFF : DM;
    const act_t* A = MODE == 3 ? p.P : p.Y;
    const int lda = MODE == 3 ? DFF : DM;
    const float* W = MODE == 0 ? p.w_in + (size_t)l * DM * DIN
                   : MODE == 1 ? p.w_out + (size_t)l * DM * DM
                   : MODE == 2 ? p.ffn_w1 + (size_t)l * DM * DFF
                               : p.ffn_w2 + (size_t)l * DFF * DM;
    const float* W3 = p.ffn_w3 + (size_t)l * DM * DFF;
    const int NQ = N / 4;
    const long total = (long)(nrows / 8) * NQ;
    for (long i = tid; i < total; i += nth) {
        const int cq = (int)(i % NQ); const int r0 = (int)(i / NQ) * 8; const int n0 = cq * 4;
        float acc[8][4]; float acc3[8][4];
#pragma unroll
        for (int a = 0; a < 8; ++a)
#pragma unroll
            for (int b = 0; b < 4; ++b) { acc[a][b] = 0.f; acc3[a][b] = 0.f; }
        for (int k = 0; k < K; ++k) {
            const float* wr = W + (size_t)k * N + n0;
            float w0 = wr[0], w1 = wr[1], w2 = wr[2], w3 = wr[3];
            float v0 = 0, v1 = 0, v2 = 0, v3 = 0;
            if (MODE == 2) { const float* w3r = W3 + (size_t)k * N + n0; v0 = w3r[0]; v1 = w3r[1]; v2 = w3r[2]; v3 = w3r[3]; }
#pragma unroll
            for (int a = 0; a < 8; ++a) {
                float av = ldact(A + (size_t)(r0 + a) * lda + k);
                acc[a][0] += av * w0; acc[a][1] += av * w1; acc[a][2] += av * w2; acc[a][3] += av * w3;
                if (MODE == 2) { acc3[a][0] += av * v0; acc3[a][1] += av * v1; acc3[a][2] += av * v2; acc3[a][3] += av * v3; }
            }
        }
        const int bb = row_bb(r0);
        const float* m = p.MOD + ((size_t)l * (NB + 1) + bb) * 6 * DM;
#pragma unroll
        for (int a = 0; a < 8; ++a) {
            const int r = r0 + a;
#pragma unroll
            for (int b = 0; b < 4; ++b) {
                const int n = n0 + b;
                if (MODE == 0) stact(p.P + (size_t)r * LDP + n, acc[a][b]);
                else if (MODE == 1) xrow(p, r)[n] += m[2 * DM + n] * acc[a][b];
                else if (MODE == 2) stact(p.P + (size_t)r * DFF + n, siluf(acc[a][b]) * acc3[a][b]);
                else xrow(p, r)[n] += m[5 * DM + n] * acc[a][b];
            }
        }
    }
}
__device__ void st_gla_logs(const Params& p, int l, long tid, long nth) {
    const long total = 2L * NT * 192;
    for (long i = tid; i < total; i += nth) {
        int col = (int)(i % 192); int r = (int)((i / 192) % NT); int dir = (int)(i / (192L * NT));
        const act_t* gk = p.P + (size_t)r * LDP + (dir ? OFF_GKB : OFF_GKF);
        const float* w = (dir ? p.gk_w_b : p.gk_w_f) + (size_t)l * 16 * 192 + col;
        float acc = (dir ? p.gk_b_b : p.gk_b_f)[l * 192 + col];
        for (int j = 0; j < 16; ++j) acc += ldact(gk + j) * w[j * 192];
        p.LG[i] = logsigmoidf(acc) * (1.0f / 16.0f);
    }
}
__device__ void st_gla_scan(const Params& p, long tid, long nth) {
    const long total = (long)NB * 6 * 64;
    for (long i = tid; i < total; i += nth) {
        const int e = (int)(i % 64); const int h = (int)((i / 64) % 6); const int b = (int)(i / 384);
        for (int dir = 0; dir < 2; ++dir) {
            float S[32];
#pragma unroll
            for (int d = 0; d < 32; ++d) S[d] = 0.f;
            const float* lg = p.LG + (size_t)dir * NT * 192;
            for (int part = 0; part < 2; ++part) {
                const int s = part == 0 ? NB + b : b;
                const int L = seq_len(s), r0 = seq_row0(s);
                for (int st = 0; st < L; ++st) {
                    const int t = dir == 0 ? st : L - 1 - st;
                    const int r = r0 + t;
                    const act_t* pr = p.P + (size_t)r * LDP;
                    const float* lr = lg + (size_t)r * 192 + h * 32;
                    const float v = ldact(pr + OFF_V + h * 64 + e);
                    float o = 0.f;
#pragma unroll
                    for (int d = 0; d < 32; ++d) {
                        S[d] = expf(lr[d]) * S[d] + ldact(pr + OFF_K + h * 32 + d) * v;
                        o += ldact(pr + OFF_Q + h * 32 + d) * S[d];
                    }
                    o *= 0.17677669529663687f;
                    float* op = p.O + (size_t)r * 384 + h * 64 + e;
                    if (dir == 0) *op = o; else *op += o;
                }
            }
        }
    }
}
__device__ void st_gla_out(const Params& p, int l, long tid, long nth) {
    const long total = (long)NT * 6;
    for (long i = tid; i < total; i += nth) {
        const int h = (int)(i % 6); const int r = (int)(i / 6);
        const float* o = p.O + (size_t)r * 384 + h * 64;
        float ss = 0.f;
        for (int e = 0; e < 64; ++e) ss += o[e] * o[e];
        const float rs = 1.0f / sqrtf(ss / 64.0f + EPSV);
        for (int e = 0; e < 64; ++e) {
            float g = ldact(p.P + (size_t)r * LDP + OFF_G + h * 64 + e);
            stact(p.Y + (size_t)r * DM + h * 64 + e, o[e] * rs * p.gla_norm_w[l * 64 + e] * siluf(g));
        }
    }
}
__device__ __forceinline__ float hy_u(const Params& p, int l, int s, int t, int j) {
    const int L = seq_len(s), r0 = seq_row0(s);
    const float* w = p.hy_short_w + (size_t)l * 3 * 768 + j;
    float acc = p.hy_short_b[l * 768 + j];
#pragma unroll
    for (int k = 0; k < 3; ++k) {
        int tt = t + k - 1;
        if (tt >= 0 && tt < L) acc += w[k * 768] * ldact(p.P + (size_t)(r0 + tt) * LDP + OFF_HY + j);
    }
    return acc;
}
__device__ void st_hy_pre(const Params& p, int l, long tid, long nth, int r_lo = 0, int r_hi = NT) {
    const long total = (long)(r_hi - r_lo) * 256;
    for (long i = tid; i < total; i += nth) {
        const int c = (int)(i % 256); const int r = r_lo + (int)(i / 256);
        const int s = r < BL ? r / SEQ : NB + (r - BL) / CTX;
        const int t = r - seq_row0(s);
        p.VX[(size_t)r * 256 + c] = hy_u(p, l, s, t, 512 + c) * hy_u(p, l, s, t, 256 + c);
    }
}
__device__ void st_hy_conv(const Params& p, int l, long tid, long nth, int r_lo = 0, int r_hi = NT) {
    const long total = (long)(r_hi - r_lo) * 256;
    for (long i = tid; i < total; i += nth) {
        const int c = (int)(i % 256); const int r = r_lo + (int)(i / 256);
        const int s = r < BL ? r / SEQ : NB + (r - BL) / CTX;
        const int L = seq_len(s), r0 = seq_row0(s);
        const int t = r - r0;
        const float* hf = p.HF + ((size_t)l * TF + (s < NB ? 0 : SEQ)) * 256 + c;
        int jlo = t + L / 2 - (L - 1); if (jlo < 0) jlo = 0;
        int jhi = t + L / 2; if (jhi > L - 1) jhi = L - 1;
        float acc = 0.f;
        for (int j = jlo; j <= jhi; ++j)
            acc += hf[(size_t)(t - j + L / 2) * 256] * p.VX[(size_t)(r0 + j) * 256 + c];
        const float x0 = hy_u(p, l, s, t, c);
        const float y = (acc + p.VX[(size_t)r * 256 + c] * p.hy_bias[l * 256 + c]) * x0;
        stact(p.Y + (size_t)r * DM + 384 + c, y);
    }
}
__device__ void st_ssd_pre(const Params& p, int l, long tid, long nth) {
    const long total = (long)NT * 896;
    for (long i = tid; i < total; i += nth) {
        const int j = (int)(i % 896); const int q = (int)(i / 896);
        const int s = q < BL ? q / SEQ : NB + (q - BL) / CTX;
        const int L = seq_len(s), r0 = seq_row0(s);
        const int pos = q - r0;
        const float* w = p.ssd_conv_w + (size_t)l * 3 * 896 + j;
        float acc = p.ssd_conv_b[l * 896 + j];
#pragma unroll
        for (int k = 0; k < 3; ++k) {
            int pp = pos + k - 1;
            if (pp >= 0 && pp < L) acc += w[k * 896] * ldact(p.P + (size_t)(r0 + colmajor_tok(s, pp)) * LDP + OFF_XBC + j);
        }
        stact(p.XBC + (size_t)(r0 + colmajor_tok(s, pos)) * 896 + j, siluf(acc));
    }
    const long total2 = 2L * NT * 6;
    for (long i = tid; i < total2; i += nth) {
        const int hd = (int)(i % 6); const int r = (int)((i / 6) % NT); const int dir = (int)(i / (6L * NT));
        float v = ldact(p.P + (size_t)r * LDP + (dir ? OFF_DTB : OFF_DTF) + hd) + (dir ? p.ssd_dt_bias_b : p.ssd_dt_bias_f)[l * 6 + hd];
        p.DT[i] = softplusf(v);
    }
}
__device__ void st_ssd_scan(const Params& p, int l, long tid, long nth) {
    const long total = (long)NB * 6 * 64;
    for (long i = tid; i < total; i += nth) {
        const int pp = (int)(i % 64); const int hd = (int)((i / 64) % 6); const int b = (int)(i / 384);
        const int g = hd / 3;
        const float dcoef = p.ssd_d[l * 6 + hd];
        for (int dir = 0; dir < 2; ++dir) {
            const float A = -expf((dir ? p.ssd_a_log_b : p.ssd_a_log_f)[l * 6 + hd]);
            float h[128];
#pragma unroll
            for (int n = 0; n < 128; ++n) h[n] = 0.f;
            for (int part = 0; part < 2; ++part) {
                const int s = part == 0 ? NB + b : b;
                const int L = seq_len(s), r0 = seq_row0(s);
                for (int st = 0; st < L; ++st) {
                    const int pos = dir == 0 ? st : L - 1 - st;
                    const int r = r0 + colmajor_tok(s, pos);
                    const act_t* xr = p.XBC + (size_t)r * 896;
                    const float dt = p.DT[((size_t)dir * NT + r) * 6 + hd];
                    const float xs = ldact(xr + hd * 64 + pp);
                    const float ea = expf(A * dt);
                    const float xd = xs * dt;
                    float y = 0.f;
#pragma unroll
                    for (int n = 0; n < 128; ++n) {
                        h[n] = ea * h[n] + xd * ldact(xr + 384 + g * 128 + n);
                        y += h[n] * ldact(xr + 640 + g * 128 + n);
                    }
                    float* yp = p.YS + (size_t)r * 384 + hd * 64 + pp;
                    if (dir == 0) *yp = y + dcoef * xs; else *yp += y;
                }
            }
        }
    }
}
__device__ void st_ssd_out(const Params& p, int l, long tid, long nth) {
    const long total = (long)NT * 2;
    for (long i = tid; i < total; i += nth) {
        const int g = (int)(i % 2); const int r = (int)(i / 2);
        const float* ys = p.YS + (size_t)r * 384 + g * 192;
        const act_t* z = p.P + (size_t)r * LDP + OFF_Z + g * 192;
        float ss = 0.f;
        for (int j = 0; j < 192; ++j) { float v = ys[j] * siluf(ldact(z + j)); ss += v * v; }
        const float rs = 1.0f / sqrtf(ss / 192.0f + EPSV);
        for (int j = 0; j < 192; ++j) {
            float v = ys[j] * siluf(ldact(z + j));
            stact(p.Y + (size_t)r * DM + 640 + g * 192 + j, v * rs * p.ssd_norm_w[l * 384 + g * 192 + j]);
        }
    }
}
__device__ void st_final(const Params& p, long tid, long nth) {
    for (long i = tid; i < (long)BL * DM; i += nth) {
        int k = (int)(i % DM); int r = (int)(i / DM);
        p.XL[i] = p.XL[i] * p.RSTD[r] * p.final_g[k];
    }
}

enum { S_INIT, S_MOD, S_F1, S_F2, S_F3, S_RSTD, S_HX1, S_GIN, S_GLOG, S_GSCAN, S_GOUT,
       S_SPRE, S_SSCAN, S_SOUT, S_HPRE, S_HCONV, S_GOUTP, S_HX2, S_FFN1, S_FFN2, S_FINAL };

__device__ void run_stage(const Params& p, int stage, int l, long tid, long nth) {
    const int nrows = (l == DEPTH - 1) ? BL : NT;
    switch (stage) {
        case S_INIT: st_init(p, tid, nth); break;
        case S_MOD: st_mod(p, tid, nth); break;
        case S_F1: st_filt1(p, tid, nth); break;
        case S_F2: st_filt2(p, tid, nth); break;
        case S_F3: st_filt3(p, tid, nth); break;
        case S_RSTD: st_rstd(p, tid, nth); break;
        case S_HX1: st_hx(p, l, 0, tid, nth); break;
        case S_GIN: st_gemm<0>(p, l, NT, tid, nth); break;
        case S_GLOG: st_gla_logs(p, l, tid, nth); break;
        case S_GSCAN: st_gla_scan(p, tid, nth); break;
        case S_GOUT: st_gla_out(p, l, tid, nth); break;
        case S_SPRE: st_ssd_pre(p, l, tid, nth); break;
        case S_SSCAN: st_ssd_scan(p, l, tid, nth); break;
        case S_SOUT: st_ssd_out(p, l, tid, nth); break;
        case S_HPRE: st_hy_pre(p, l, tid, nth); break;
        case S_HCONV: st_hy_conv(p, l, tid, nth); break;
        case S_GOUTP: st_gemm<1>(p, l, nrows, tid, nth); break;
        case S_HX2: st_hx(p, l, 1, tid, nth); break;
        case S_FFN1: st_gemm<2>(p, l, nrows, tid, nth); break;
        case S_FFN2: st_gemm<3>(p, l, nrows, tid, nth); break;
        case S_FINAL: st_final(p, tid, nth); break;
    }
}

static const int kLayerProg[] = { S_RSTD, S_HX1, S_GIN, S_GLOG, S_GSCAN, S_GOUT, S_SPRE, S_SSCAN, S_SOUT,
                                  S_HPRE, S_HCONV, S_GOUTP, S_RSTD, S_HX2, S_FFN1, S_FFN2 };
static const int kPreProg[] = { S_INIT, S_MOD, S_F1, S_F2, S_F3 };

static inline size_t al256(size_t v) { return (v + 255) & ~(size_t)255; }
static void carve(Params& p, char* ws, float* dout) {
    size_t off = 0;
    auto take = [&](size_t bytes) { char* q = ws + off; off += al256(bytes); return q; };
    p.XL = dout;
    p.XC = (float*)take((size_t)BC * DM * 4);
    p.MOD = (float*)take((size_t)DEPTH * (NB + 1) * 6 * DM * 4);
#ifdef CPU_EMU
    p.HF = (float*)take((size_t)DEPTH * TF * 256 * 4);
    p.RSTD = (float*)take((size_t)NT * 4);
    p.DT = (float*)take((size_t)2 * NT * 6 * 4);
#endif
    p.H1 = (float*)take((size_t)DEPTH * TF * 64 * 4);
    p.H2 = (float*)take((size_t)DEPTH * TF * 64 * 4);
    p.P = (act_t*)take((size_t)NT * LDP * sizeof(act_t));
    p.Y = (act_t*)take((size_t)NT * DM * sizeof(act_t));
#ifdef CPU_EMU
    char* r1 = take((size_t)NT * 896 * sizeof(act_t) + (size_t)NT * 384 * 4 + 256);
#else
    char* r1 = take((size_t)101 << 20);
#endif
    p.LG = (float*)r1;
    p.O = (float*)(r1 + al256((size_t)2 * NT * 192 * 4));
    p.XBC = (act_t*)r1;
    p.YS = (float*)(r1 + al256((size_t)NT * 896 * sizeof(act_t)));
#ifdef CPU_EMU
    p.VX = (float*)r1;
#else
    {
        char* q = r1;
        p.DSG = (unsigned short*)q; q += al256((size_t)2 * NB * 6 * ((CTX + SEQ) / 64) * 2048 * 2);
        p.SSG = (unsigned short*)q; q += al256((size_t)2 * NB * 6 * ((CTX + SEQ) / 64) * 2048 * 2);
        p.DECG = (float*)q; q += al256((size_t)2 * NB * 6 * ((CTX + SEQ) / 64) * 32 * 4);
        p.DSS = (unsigned short*)q; q += al256((size_t)2 * NB * 6 * ((CTX + SEQ) / 128) * 8192 * 2);
        p.DECS = (float*)q; q += al256((size_t)2 * NB * 6 * ((CTX + SEQ) / 128) * 4);
    }
    p.VXT = (unsigned short*)take((size_t)NB * 256 * SEQ * 2);
    p.CONV = (float*)take((size_t)NB * 256 * SEQ * 4);
    p.VX = (float*)take((size_t)BC * 256 * 4) - (size_t)BL * 256;
    p.HFC = (float*)take((size_t)DEPTH * CTX * 256 * 4);
#endif
    p.G1 = (unsigned short*)take((size_t)DEPTH * 256 * G1N * 2);
    p.BAR = (unsigned*)take(16384);
    p.WIN_T = (unsigned short*)take((size_t)DEPTH * LDP * DM * 2);
    p.WOUT_T = (unsigned short*)take((size_t)DEPTH * DM * DM * 2);
    p.W13_T = (unsigned short*)take((size_t)DEPTH * NFF2 * DM * 2);
    p.W2_T = (unsigned short*)take((size_t)DEPTH * DM * DFF * 2);
}
static void fill_inputs(Params& p, void* const* d_in) {
    const float** dst = (const float**)&p;
    for (int i = 0; i < 37; ++i) dst[i] = (const float*)d_in[i];
}

#ifndef CPU_EMU
namespace pg8 {
#define PG8_LAS __attribute__((address_space(3)))
typedef unsigned short bf16_t;
typedef short bf16x8 __attribute__((ext_vector_type(8)));
typedef float f32x4 __attribute__((ext_vector_type(4)));
typedef unsigned u32x4 __attribute__((ext_vector_type(4)));
constexpr int BM = 256, BK = 64, HALF = 128, HTB = HALF * BK * 2  , STAGE_BYTES = 8 * HTB, NXCD = 8, WGM = 8;

__host__ __device__ __forceinline__ int lds_byte(int r, int c) { const int st = (r >> 4) * 2 + (c >> 5), rr = r & 15, cc = c & 31, ob = rr * 64 + cc * 2; return st * 1024 + (ob ^ (((ob >> 9) & 1) << 5)); }
__host__ __device__ __forceinline__ void stage_rc(int b, int& R, int& C) { const int st = b / 1024, sb = b % 1024, swz = sb ^ (((sb >> 9) & 1) << 5); R = (st >> 1) * 16 + swz / 64; C = (st & 1) * 32 + (swz % 64) / 2; }
__host__ __device__ __forceinline__ int perm32(int rho) { const int n = rho >> 4, i = rho & 15; return 8 * (i >> 2) + 4 * n + (i & 3); }

struct Unit { int pm, pn, kb; };
struct Gemm { const bf16_t* A; const bf16_t* Bt; int M, N, K, ld; };

struct StaticOrder {
    int nM, nN, nwg, G, c;
    __host__ __device__ void init(int M, int N, int G_, int c_) { nM = M / BM; nN = N / BM; nwg = nM * nN; G = G_; c = c_; }
    __host__ __device__ bool next(int i, Unit& u) const {
        const long L = (long)i * G + c; if (L >= nwg) return false;
        int wgid = (int)L; { const int q = nwg / NXCD, r = nwg % NXCD, xcd = wgid % NXCD, off = wgid / NXCD; wgid = (xcd < r ? xcd * (q + 1) : r * (q + 1) + (xcd - r) * q) + off; }
        const int nig = WGM * nN, gid = wgid / nig, fm = gid * WGM, gsz = (nM - fm) < WGM ? (nM - fm) : WGM;
        u.pm = fm + ((wgid % nig) % gsz); u.pn = (wgid % nig) / gsz; u.kb = 0; return true;
    }
    __device__ __forceinline__ void a_ready(const Unit&) const {}
    __device__ __forceinline__ void done(const Unit&) const {}
};

__device__ __forceinline__ unsigned cvt_pk_bf16(float lo, float hi) { unsigned r; asm volatile("v_cvt_pk_bf16_f32 %0, %1, %2" : "=v"(r) : "v"(lo), "v"(hi)); return r; }
typedef float f32x2 __attribute__((ext_vector_type(2)));
__device__ __forceinline__ f32x2 gelu_pk(f32x2 v) {
    const f32x2 av = __builtin_elementwise_abs(v), d = av * 0.2316418882f + 1.0f;
    f32x2 t; t.x = __builtin_amdgcn_rcpf(d.x); t.y = __builtin_amdgcn_rcpf(d.y);
    f32x2 q = t * 0.5307027145f + (-0.7265760135f); q = q * t + 0.7107068705f; q = q * t + (-0.142248368f); q = q * t + 0.127414796f; q = q * t;
    const f32x2 s = (v * v) * (-0.72134752044f);
    f32x2 e; e.x = __builtin_amdgcn_exp2f(s.x); e.y = __builtin_amdgcn_exp2f(s.y);
    const f32x2 m = v * (q * e), r = v - m;
    f32x2 o; o.x = v.x < 0.f ? m.x : r.x; o.y = v.y < 0.f ? m.y : r.y; return o;
}

template <int ACT  > struct EpiBf16 {
    static constexpr bool PERM = true, AFTER_DRAIN = false; static_assert(ACT == 0 || ACT == 1, "EpiBf16: ACT is 0 (none) or 1 (gelu_pk)");
    bf16_t* O; int ldc; const float* bias; int split_cols; size_t split_stride; float scale0;
    __device__ __forceinline__ void operator()(const f32x4 (&acc)[2][2][4][2], const Unit& u, int wr, int wc, int fr, int fq) const {
        const int row0 = u.pm * BM + wr * 64 + fr; int colt = u.pn * BM; bf16_t* base = O;
        float sc = 1.f; if (split_cols) { const int t = colt / split_cols; base += (size_t)t * split_stride; colt -= t * split_cols; if (t == 0) sc = scale0; }
        const int col0 = colt + wc * 32 + 8 * fq, bcol0 = u.pn * BM + wc * 32 + 8 * fq;
        f32x4 bv[2][2];
#pragma unroll
        for (int bj = 0; bj < 2; ++bj)
#pragma unroll
            for (int n = 0; n < 2; ++n) bv[bj][n] = bias ? *(const f32x4*)(bias + bcol0 + bj * HALF + 4 * n) : (f32x4){0.f, 0.f, 0.f, 0.f};
#pragma unroll
        for (int ai = 0; ai < 2; ++ai)
#pragma unroll
            for (int m = 0; m < 4; ++m) { bf16_t* rowp = base + (size_t)(row0 + ai * HALF + m * 16) * ldc + col0;
#pragma unroll
                for (int bj = 0; bj < 2; ++bj) { f32x4 v0 = acc[ai][bj][m][0] + bv[bj][0], v1 = acc[ai][bj][m][1] + bv[bj][1];
                    if (ACT == 1) { f32x2 a = gelu_pk((f32x2){v0[0], v0[1]}), b = gelu_pk((f32x2){v0[2], v0[3]}), c = gelu_pk((f32x2){v1[0], v1[1]}), d = gelu_pk((f32x2){v1[2], v1[3]});
                        v0 = (f32x4){a.x, a.y, b.x, b.y}; v1 = (f32x4){c.x, c.y, d.x, d.y}; }
                    v0 = v0 * sc; v1 = v1 * sc; u32x4 w; w.x = cvt_pk_bf16(v0[0], v0[1]); w.y = cvt_pk_bf16(v0[2], v0[3]); w.z = cvt_pk_bf16(v1[0], v1[1]); w.w = cvt_pk_bf16(v1[2], v1[3]);
                    *(u32x4*)(rowp + bj * HALF) = w; } }
    }
};
template <class Epi, class Sched, bool ALIGN_EPI = false, bool SP2 = false>
__device__ __forceinline__ void gemm_phase(PG8_LAS unsigned char* lds, const Gemm g, const Sched& S, const Epi& E, int tid_o) {
    asm volatile("" : "+v"(tid_o));
    const int tid = tid_o, wid = __builtin_amdgcn_readfirstlane(tid >> 6), lane = tid & 63, wr = wid >> 2, wc = wid & 3, fr = lane & 15, fq = lane >> 4;
    const int K = g.ld, nt = g.K / BK;
    unsigned voffA[2], voffB[2];
#pragma unroll
    for (int i = 0; i < 2; ++i) { int R, C; stage_rc(tid * 16 + i * 8192, R, C); const int Rb = Epi::PERM ? ((R & ~31) + perm32(R & 31)) : R;
        voffA[i] = (unsigned)(R * K + C) * 2u; voffB[i] = (unsigned)(Rb * K + C) * 2u; }
    const size_t kstep = (size_t)(BK * 2);
    const size_t hstep = (size_t)HALF * K * 2;
    const size_t tstep = 2 * hstep;
    const unsigned ldsw = (unsigned)wid * 1024u;
    const int aoff = lds_byte(wr * 64 + fr, fq * 8), boff = lds_byte(wc * 32 + fr, fq * 8);
#define PG8_SA(b, h) (((b) * 2 + (h)) * HTB)
#define PG8_SB(b, h) ((4 + (b) * 2 + (h)) * HTB)
#define PG8_STAGE(bufoff, gbase, voff) do { _Pragma("unroll") for (int _i = 0; _i < 2; ++_i) \
        __builtin_amdgcn_global_load_lds((const unsigned*)((const char*)(gbase) + (voff)[_i]), (PG8_LAS unsigned*)(lds + (bufoff) + ldsw + _i * 8192), 16, 0, 0); } while (0)
#define PG8_LDA(dst, b, h) do { _Pragma("unroll") for (int m = 0; m < 4; ++m) _Pragma("unroll") for (int k = 0; k < 2; ++k) dst[m][k] = *(const PG8_LAS bf16x8*)(lds + PG8_SA(b, h) + aoff + m * 2048 + k * 1024); } while (0)
#define PG8_LDB(dst, b, h) do { _Pragma("unroll") for (int n = 0; n < 2; ++n) _Pragma("unroll") for (int k = 0; k < 2; ++k) dst[n][k] = *(const PG8_LAS bf16x8*)(lds + PG8_SB(b, h) + boff + n * 2048 + k * 1024); } while (0)
#define PG8_MMA(ai, bj, At, Bt) do { __builtin_amdgcn_s_setprio(1); _Pragma("unroll") for (int m = 0; m < 4; ++m) _Pragma("unroll") for (int n = 0; n < 2; ++n) _Pragma("unroll") for (int k = 0; k < 2; ++k) \
        acc[ai][bj][m][n] = __builtin_amdgcn_mfma_f32_16x16x32_bf16(Bt[n][k], At[m][k], acc[ai][bj][m][n], 0, 0, 0); __builtin_amdgcn_s_setprio(0); } while (0)
#define PG8_WAIT_V(n) asm volatile("s_waitcnt vmcnt(" #n ")" ::: "memory")
#define PG8_WAIT_L(n) asm volatile("s_waitcnt lgkmcnt(" #n ")" ::: "memory")
#define PG8_BAR __builtin_amdgcn_s_barrier()
#define PG8_SCHED __builtin_amdgcn_sched_barrier(0)
    Unit cur, nxt; int ui = 0;
    if (!S.next(0, cur)) return;
    f32x4 acc[2][2][4][2];
#pragma unroll
    for (int a = 0; a < 2; ++a)
#pragma unroll
        for (int b = 0; b < 2; ++b)
#pragma unroll
            for (int m = 0; m < 4; ++m)
#pragma unroll
                for (int n = 0; n < 2; ++n) acc[a][b][m][n] = (f32x4){0.f, 0.f, 0.f, 0.f};
    bf16x8 At[4][2], B0[2][2], B1[2][2];
    const char* cA = (const char*)g.A + (size_t)cur.pm * tstep + cur.kb; const char* cB = (const char*)g.Bt + (size_t)cur.pn * tstep + cur.kb;
    S.a_ready(cur);
    if constexpr (SP2) {
        PG8_STAGE(PG8_SB(0, 0), cB, voffB); PG8_STAGE(PG8_SB(0, 1), cB + hstep, voffB); PG8_STAGE(PG8_SA(0, 0), cA, voffA); PG8_STAGE(PG8_SA(0, 1), cA + hstep, voffA);
        if (wr == 1) PG8_BAR;
        PG8_WAIT_V(2); PG8_BAR;
        PG8_STAGE(PG8_SB(1, 0), cB + kstep, voffB); PG8_STAGE(PG8_SA(1, 0), cA + kstep, voffA); PG8_STAGE(PG8_SB(1, 1), cB + hstep + kstep, voffB);
        PG8_WAIT_V(6); PG8_BAR;
    } else {
        PG8_STAGE(PG8_SB(0, 0), cB, voffB); PG8_STAGE(PG8_SA(0, 0), cA, voffA); PG8_STAGE(PG8_SB(0, 1), cB + hstep, voffB); PG8_STAGE(PG8_SA(0, 1), cA + hstep, voffA);
        if (wr == 1) PG8_BAR;
        PG8_WAIT_V(4); PG8_BAR;
        PG8_STAGE(PG8_SB(1, 0), cB + kstep, voffB); PG8_STAGE(PG8_SA(1, 0), cA + kstep, voffA); PG8_STAGE(PG8_SB(1, 1), cB + hstep + kstep, voffB);
        PG8_WAIT_V(6); PG8_BAR;
    }
    for (;;) {
        const bool has_next = S.next(ui + 1, nxt);
        const char* nA = has_next ? (const char*)g.A + (size_t)nxt.pm * tstep + nxt.kb : cA; const char* nB = has_next ? (const char*)g.Bt + (size_t)nxt.pn * tstep + nxt.kb : cB;
        for (int t = 0; t < nt; t += 2) {
            const bool last = (t == nt - 2);
            const char* a1 = cA + (size_t)(t + 1) * kstep;
            const char* a2 = last ? nA : cA + (size_t)(t + 2) * kstep; const char* b2 = last ? nB : cB + (size_t)(t + 2) * kstep;
            const char* a3 = a2 + kstep; const char* b3 = b2 + kstep;
            if (last && has_next) S.a_ready(nxt);
            if constexpr (SP2) {
            PG8_LDB(B0, 0, 0); PG8_LDB(B1, 0, 1); PG8_SCHED; PG8_LDA(At, 0, 0); PG8_STAGE(PG8_SA(1, 1), a1 + hstep, voffA);
            PG8_WAIT_V(8); PG8_WAIT_L(0); PG8_BAR; PG8_MMA(0, 0, At, B0); PG8_MMA(0, 1, At, B1); PG8_BAR; PG8_SCHED;
            PG8_LDA(At, 0, 1); PG8_STAGE(PG8_SB(0, 0), b2, voffB); PG8_STAGE(PG8_SB(0, 1), b2 + hstep, voffB); PG8_STAGE(PG8_SA(0, 0), a2, voffA);
            PG8_WAIT_V(8); PG8_WAIT_L(0); PG8_BAR; PG8_MMA(1, 0, At, B0); PG8_MMA(1, 1, At, B1); PG8_BAR; PG8_SCHED;
            PG8_LDB(B0, 1, 0); PG8_LDB(B1, 1, 1); PG8_SCHED; PG8_LDA(At, 1, 0); PG8_STAGE(PG8_SA(0, 1), a2 + hstep, voffA);
            PG8_WAIT_V(8); PG8_WAIT_L(0); PG8_BAR; PG8_MMA(0, 0, At, B0); PG8_MMA(0, 1, At, B1); PG8_BAR; PG8_SCHED;
            PG8_LDA(At, 1, 1); PG8_STAGE(PG8_SB(1, 0), b3, voffB); PG8_STAGE(PG8_SB(1, 1), b3 + hstep, voffB); PG8_STAGE(PG8_SA(1, 0), a3, voffA);
            PG8_WAIT_V(8); PG8_WAIT_L(0); PG8_BAR; PG8_MMA(1, 0, At, B0); PG8_MMA(1, 1, At, B1); PG8_BAR; PG8_SCHED;
            } else {
            PG8_LDB(B0, 0, 0); PG8_SCHED; PG8_LDA(At, 0, 0); PG8_STAGE(PG8_SA(1, 1), a1 + hstep, voffA);
            PG8_WAIT_L(8); PG8_BAR; PG8_WAIT_L(0); PG8_MMA(0, 0, At, B0); PG8_BAR; PG8_SCHED;
            PG8_LDB(B1, 0, 1); PG8_STAGE(PG8_SB(0, 0), b2, voffB);
            PG8_BAR; PG8_WAIT_L(0); PG8_MMA(0, 1, At, B1); PG8_BAR;
            PG8_LDA(At, 0, 1); PG8_STAGE(PG8_SA(0, 0), a2, voffA);
            PG8_BAR; PG8_WAIT_L(0); PG8_MMA(1, 0, At, B0); PG8_BAR; PG8_SCHED;
            PG8_STAGE(PG8_SB(0, 1), b2 + hstep, voffB);
            PG8_WAIT_V(6); PG8_BAR; PG8_MMA(1, 1, At, B1); PG8_BAR;
            PG8_LDB(B0, 1, 0); PG8_SCHED; PG8_LDA(At, 1, 0); PG8_STAGE(PG8_SA(0, 1), a2 + hstep, voffA);
            PG8_WAIT_L(8); PG8_BAR; PG8_WAIT_L(0); PG8_MMA(0, 0, At, B0); PG8_BAR; PG8_SCHED;
            PG8_LDB(B1, 1, 1); PG8_STAGE(PG8_SB(1, 0), b3, voffB);
            PG8_BAR; PG8_WAIT_L(0); PG8_MMA(0, 1, At, B1); PG8_BAR;
            PG8_LDA(At, 1, 1); PG8_STAGE(PG8_SA(1, 0), a3, voffA);
            PG8_BAR; PG8_WAIT_L(0); PG8_MMA(1, 0, At, B0); PG8_BAR; PG8_SCHED;
            PG8_STAGE(PG8_SB(1, 1), b3 + hstep, voffB);
            PG8_WAIT_V(6); PG8_BAR; PG8_MMA(1, 1, At, B1); PG8_BAR;
            }
        }
        if constexpr (ALIGN_EPI) { if (wr == 0) PG8_BAR; }
        if constexpr (!Epi::AFTER_DRAIN) {
            unsigned z_ = 0u; asm volatile("" : "+v"(z_)); const int le_ = (int)__builtin_amdgcn_mbcnt_hi(~0u, __builtin_amdgcn_mbcnt_lo(~0u, z_));
            E(acc, cur, wr, wc, le_ & 15, le_ >> 4); S.done(cur); }
        if (!has_next) break;
#pragma unroll
        for (int a = 0; a < 2; ++a)
#pragma unroll
            for (int b = 0; b < 2; ++b)
#pragma unroll
                for (int m = 0; m < 4; ++m)
#pragma unroll
                    for (int n = 0; n < 2; ++n) acc[a][b][m][n] = (f32x4){0.f, 0.f, 0.f, 0.f};
        cur = nxt; cA = nA; cB = nB; ++ui;
        if constexpr (ALIGN_EPI) { if (wr == 1) PG8_BAR; }
    }
    PG8_WAIT_V(0);
    if constexpr (!ALIGN_EPI) { if (wr == 0) PG8_BAR; }
    PG8_BAR;
    if constexpr (Epi::AFTER_DRAIN) { E.fused(acc, cur, wr, wc, fr, fq, lds, wid, lane); S.done(cur); }
#undef PG8_SA
#undef PG8_SB
#undef PG8_STAGE
#undef PG8_LDA
#undef PG8_LDB
#undef PG8_MMA
#undef PG8_WAIT_V
#undef PG8_WAIT_L
#undef PG8_BAR
#undef PG8_SCHED
}
}

namespace pg8 {
struct EpiRes {
    static constexpr bool PERM = false, AFTER_DRAIN = false;
    float* XL; float* XC; const float* modl; int chunk; const float* SL; const float* SC;
    __device__ __forceinline__ void operator()(const f32x4 (&acc)[2][2][4][2], const Unit& u, int wr, int wc, int fr, int fq) const {
        asm volatile("" : "+v"(fr), "+v"(fq));
        const int rt0 = u.pm * BM;
        const int bb = rt0 < BL ? rt0 / SEQ : NB;
        const float* gate = modl + ((size_t)bb * 6 + chunk) * DM;
        float* xb = rt0 < BL ? XL + (size_t)rt0 * DM : XC + (size_t)(rt0 - BL) * DM;
        const float* sb = rt0 < BL ? SL + (size_t)rt0 * DM : SC + (size_t)(rt0 - BL) * DM;
        const int col0 = u.pn * BM + wc * 32 + fq * 4;
        f32x4 gv[2][2];
#pragma unroll
        for (int bj = 0; bj < 2; ++bj)
#pragma unroll
            for (int n = 0; n < 2; ++n) gv[bj][n] = *(const f32x4*)(gate + col0 + bj * HALF + n * 16);
#pragma unroll
        for (int ai = 0; ai < 2; ++ai)
#pragma unroll
            for (int m = 0; m < 4; ++m) {
                const size_t ro = (size_t)(wr * 64 + fr + ai * HALF + m * 16) * DM + col0;
#pragma unroll
                for (int bj = 0; bj < 2; ++bj)
#pragma unroll
                    for (int n = 0; n < 2; ++n) *(f32x4*)(xb + ro + bj * HALF + n * 16) = *(const f32x4*)(sb + ro + bj * HALF + n * 16) + gv[bj][n] * acc[ai][bj][m][n];
            }
    }
};
struct EpiSwiGLU {
    static constexpr bool PERM = true, AFTER_DRAIN = false;
    bf16_t* H;
    __device__ __forceinline__ void operator()(const f32x4 (&acc)[2][2][4][2], const Unit& u, int wr, int wc, int fr, int fq) const {
        asm volatile("" : "+v"(fr), "+v"(fq));
        const int row0 = u.pm * BM + wr * 64 + fr, hc0 = u.pn * HALF + wc * 32 + 8 * fq;
#pragma unroll
        for (int ai = 0; ai < 2; ++ai)
#pragma unroll
            for (int m = 0; m < 4; ++m) {
                bf16_t* rowp = H + (size_t)(row0 + ai * HALF + m * 16) * DFF + hc0;
                f32x4 v[2];
#pragma unroll
                for (int n = 0; n < 2; ++n)
#pragma unroll
                    for (int i = 0; i < 4; ++i) { const float a = acc[ai][0][m][n][i]; v[n][i] = a * __builtin_amdgcn_rcpf(1.0f + __expf(-a)) * acc[ai][1][m][n][i]; }
                u32x4 w; w.x = cvt_pk_bf16(v[0][0], v[0][1]); w.y = cvt_pk_bf16(v[0][2], v[0][3]); w.z = cvt_pk_bf16(v[1][0], v[1][1]); w.w = cvt_pk_bf16(v[1][2], v[1][3]);
                *(u32x4*)rowp = w;
            }
    }
};
}


namespace pg8 {
struct SplitKOrder {
    int nM, nN, S, ksl, nun, G, c;
    __device__ void init(int M, int N, int S_, int kslice_elems, int G_, int c_) { nM = M / BM; nN = N / BM; S = S_; ksl = kslice_elems; nun = nM * nN * S; G = G_; c = c_; }
    __device__ bool next(int i, Unit& u) const {
        const int L = i * G + c; if (L >= nun) return false;
        const int sl = L % S, t = L / S; u.pm = t % nM; u.pn = t / nM; u.kb = sl * ksl * 2; return true;
    }
    __device__ __forceinline__ void a_ready(const Unit&) const {}
    __device__ __forceinline__ void done(const Unit&) const {}
};
struct EpiSlab {
    static constexpr bool PERM = false, AFTER_DRAIN = false;
    float* SLAB; int rows, kslice_bytes;
    __device__ __forceinline__ void operator()(const f32x4 (&acc)[2][2][4][2], const Unit& u, int wr, int wc, int fr, int fq) const {
        asm volatile("" : "+v"(fr), "+v"(fq));
        float* xb = SLAB + ((size_t)(u.kb / kslice_bytes) * rows + (size_t)u.pm * BM) * DM;
        const int col0 = u.pn * BM + wc * 32 + fq * 4;
#pragma unroll
        for (int ai = 0; ai < 2; ++ai)
#pragma unroll
            for (int m = 0; m < 4; ++m) {
                const size_t ro = (size_t)(wr * 64 + fr + ai * HALF + m * 16) * DM + col0;
#pragma unroll
                for (int bj = 0; bj < 2; ++bj)
#pragma unroll
                    for (int n = 0; n < 2; ++n) *(f32x4*)(xb + ro + bj * HALF + n * 16) = acc[ai][bj][m][n];
            }
    }
};
}

#define LAS __attribute__((address_space(3)))
typedef float f32x4 __attribute__((ext_vector_type(4)));
typedef unsigned v4u __attribute__((ext_vector_type(4)));
#define REP_G1 1
#define REP_G3 1
#define REP_GLA 1
#define REP_SSD 1
#define REP_HY 1
#define REP_HX 1
#define REP_PRO 1
#define CTX_SPLITK 1
#define OLD_SHFL 0
#define REP_MIX 1
#define REP_PA 1
#define REP_PC 1
#define REP_H1 1
#define REP_H2 1
#define REP_H3 1
#define REP_HC 1
#define REP_S2 1
#define REP_S23 1
#define REP_S4 1
#define REP_M2 1
#define REP_M3 1
#define REP_M4 1
#define REP_INIT 1
#define REP_MOD 1
#define REP_F1 1
#define REP_WT 1
#define REP_F3 1
constexpr int LDS_BYTES = 163840;
namespace cg = cooperative_groups;

__device__ __forceinline__ unsigned f2bf_u(float f) { unsigned u = __builtin_bit_cast(unsigned, f); return (u + 0x7fffu + ((u >> 16) & 1u)) >> 16; }
__device__ __forceinline__ unsigned pk2(float lo, float hi) { return f2bf_u(lo) | (f2bf_u(hi) << 16); }
template <int M> __device__ __forceinline__ float swz_xor(float v) { return __builtin_bit_cast(float, __builtin_amdgcn_ds_swizzle(__builtin_bit_cast(int, v), (M << 10) | 0x1f)); }
#if OLD_SHFL
__device__ __forceinline__ float wave_sum(float v, int) {
#pragma unroll
    for (int o = 1; o < 64; o <<= 1) v += __shfl_xor(v, o);
    return v;
}
__device__ __forceinline__ float sum16(float v) { v += __shfl_xor(v, 1); v += __shfl_xor(v, 2); v += __shfl_xor(v, 4); v += __shfl_xor(v, 8); return v; }
__device__ __forceinline__ float wave_scan_incl(float v, int lane) {
#pragma unroll
    for (int off = 1; off < 64; off <<= 1) { const float up = __shfl_up(v, off); if (lane >= off) v += up; }
    return v;
}
#else
__device__ __forceinline__ float wave_sum(float v, int lane) {
    v += swz_xor<1>(v); v += swz_xor<2>(v); v += swz_xor<4>(v); v += swz_xor<8>(v); v += swz_xor<16>(v);
    return v + __builtin_bit_cast(float, __builtin_amdgcn_ds_bpermute((lane ^ 32) << 2, __builtin_bit_cast(int, v)));
}
__device__ __forceinline__ float sum16(float v) { v += swz_xor<1>(v); v += swz_xor<2>(v); v += swz_xor<4>(v); v += swz_xor<8>(v); return v; }
__device__ __forceinline__ float wave_scan_incl(float v, int lane) {
#pragma unroll
    for (int off = 1; off < 64; off <<= 1) {
        const float up = __builtin_bit_cast(float, __builtin_amdgcn_ds_bpermute((lane - off) << 2, __builtin_bit_cast(int, v)));
        if (lane >= off) v += up;
    }
    return v;
}
#endif
__device__ __forceinline__ float lane63(float v) { return __builtin_bit_cast(float, __builtin_amdgcn_readlane(__builtin_bit_cast(int, v), 63)); }
__device__ __forceinline__ void transpose_item(const float* W, int K, int N, unsigned short* WT, int dst_row0, LAS float* scr, int k0, int n0, int lane) {
    const int nn = n0 + (lane & 31);
#pragma unroll 8
    for (int i = 0; i < 32; ++i) { const int kk = 2 * i + (lane >> 5); scr[kk * 33 + (lane & 31)] = nn < N ? W[(size_t)(k0 + kk) * N + nn] : 0.f; }
    asm volatile("s_waitcnt lgkmcnt(0)" ::: "memory");
    const int c = lane & 7;
#pragma unroll
    for (int j = 0; j < 4; ++j) { const int n = (lane >> 3) + 8 * j; const LAS float* sp = scr + (8 * c) * 33 + n;
        v4u o; o.x = pk2(sp[0 * 33], sp[1 * 33]); o.y = pk2(sp[2 * 33], sp[3 * 33]); o.z = pk2(sp[4 * 33], sp[5 * 33]); o.w = pk2(sp[6 * 33], sp[7 * 33]);
        *(v4u*)(WT + (size_t)(dst_row0 + n) * K + k0 + 8 * c) = o; }
    asm volatile("s_waitcnt lgkmcnt(0)" ::: "memory");
}
__device__ __forceinline__ void prologue_weights(const Params& p, LAS float* scr, int gw, int NGW, int lane) {
    constexpr int I_IN = 16 * (LDP / 32), I_OUT = 16 * 32, I_W1 = 16 * (DFF / 32), I_W2 = (DFF / 64) * 32;
    constexpr int PER_L = I_IN + I_OUT + 2 * I_W1 + I_W2;
    for (int it = gw; it < DEPTH * PER_L; it += NGW) {
        const int l = it / PER_L; int r = it % PER_L;
        if (r < I_IN) { const int nb = r % (LDP / 32), kb = r / (LDP / 32);
            transpose_item(p.w_in + (size_t)l * DM * DIN, DM, DIN, p.WIN_T + (size_t)l * LDP * DM, nb * 32, scr, kb * 64, nb * 32, lane); continue; }
        r -= I_IN;
        if (r < I_OUT) { const int nb = r % 32, kb = r / 32;
            transpose_item(p.w_out + (size_t)l * DM * DM, DM, DM, p.WOUT_T + (size_t)l * DM * DM, nb * 32, scr, kb * 64, nb * 32, lane); continue; }
        r -= I_OUT;
        if (r < 2 * I_W1) { const int which = r / I_W1; r %= I_W1; const int nb = r % (DFF / 32), kb = r / (DFF / 32); const int n0 = nb * 32;
            const int drow = 256 * (n0 / 128) + 128 * which + (n0 % 128);
            transpose_item((which ? p.ffn_w3 : p.ffn_w1) + (size_t)l * DM * DFF, DM, DFF, p.W13_T + (size_t)l * NFF2 * DM, drow, scr, kb * 64, n0, lane); continue; }
        r -= 2 * I_W1;
        { const int nb = r % 32, kb = r / 32;
            transpose_item(p.ffn_w2 + (size_t)l * DFF * DM, DFF, DM, p.W2_T + (size_t)l * DM * DFF, nb * 32, scr, kb * 64, nb * 32, lane); }
    }
}

__device__ __forceinline__ void mod_partial(const Params& p, long tid, long nth, float* MODP) {
    for (long i = tid; i < 2L * 16 * 1536; i += nth) {
        const int n4 = (int)(i % 1536), kc = (int)((i / 1536) & 15), l = (int)(i / (1536 * 16));
        f32x4 acc[NB + 1];
        float z0 = 0.f; asm volatile("" : "+v"(z0));
#pragma unroll
        for (int bb = 0; bb <= NB; ++bb) acc[bb] = (f32x4){z0, z0, z0, z0};
        const float* w = p.mod_w + ((size_t)l * DM + kc * 64) * 6 * DM + 4 * n4;
#pragma unroll 4
        for (int k = 0; k < 64; ++k) {
            const f32x4 w4 = *(const f32x4*)(w + (size_t)k * 6 * DM);
#pragma unroll
            for (int bb = 0; bb <= NB; ++bb) {
                const float cv = (bb < NB ? p.c + (size_t)bb * DM : p.c_ctx)[kc * 64 + k];
                acc[bb] += w4 * (cv / (1.0f + __expf(-cv)));
            }
        }
#pragma unroll
        for (int bb = 0; bb <= NB; ++bb) *(f32x4*)(MODP + (((size_t)kc * DEPTH + l) * (NB + 1) + bb) * 6 * DM + 4 * n4) = acc[bb];
    }
}
__device__ __forceinline__ void mod_reduce(const Params& p, long tid, long nth, const float* MODP) {
    const long total = (long)DEPTH * (NB + 1) * 6 * DM;
    for (long i = tid; i < total; i += nth) {
        const int n = (int)(i % (6 * DM)), l = (int)(i / ((long)6 * DM * (NB + 1)));
        float acc = p.mod_b[(size_t)l * 6 * DM + n];
#pragma unroll
        for (int kc = 0; kc < 16; ++kc) acc += MODP[(size_t)kc * total + i];
        p.MOD[i] = acc;
    }
}
constexpr int FL_Z = 0, FL_H1 = 8704, FL_H2 = 8704 + 16640, FL_T = 8704 + 2 * 16640;
constexpr int FILT_UNITS = DEPTH * (SEQ / 64) + DEPTH * (CTX / 64);
__device__ __forceinline__ void filt_unit(const Params& p, LAS unsigned char* lds, int u, int tix) {
    const bool isctx = u >= DEPTH * (SEQ / 64);
    const int uu = isctx ? u - DEPTH * (SEQ / 64) : u, per = isctx ? CTX / 64 : SEQ / 64;
    const int l = uu / per, t0 = (uu % per) * 64, ttb = (isctx ? SEQ : 0) + t0;
    LAS float* Z = (LAS float*)(lds + FL_Z); LAS float* H1 = (LAS float*)(lds + FL_H1); LAS float* H2 = (LAS float*)(lds + FL_H2);
    __syncthreads();
    {
        const int tap = tix & 63, bq = tix >> 6;
        float rel; filt_pos(ttb + tap, rel);
        const float tw = 2.0f * 3.14159265358979323846f * rel;
        if (bq == 0) Z[tap * 34] = rel;
#pragma unroll
        for (int k = 0; k < 2; ++k) { const int j = 2 * bq + k; const float ang = tw * (1e-4f + (float)j * ((15.0f - 1e-4f) / 15.0f));
            Z[tap * 34 + 1 + j] = cosf(ang); Z[tap * 34 + 17 + j] = -sinf(ang); }
    }
    __syncthreads();
    {
        const int tap = tix & 63, o0 = (tix >> 6) * 8;
        float acc[8];
#pragma unroll
        for (int e = 0; e < 8; ++e) acc[e] = 0.f;
        const float* w1 = p.hy_w1 + (size_t)l * 33 * 64 + o0;
#pragma unroll 3
        for (int i = 0; i < 33; ++i) { const float zv = Z[tap * 34 + i];
#pragma unroll
            for (int e = 0; e < 8; ++e) acc[e] += zv * w1[i * 64 + e]; }
#pragma unroll
        for (int e = 0; e < 8; ++e) H1[tap * 65 + o0 + e] = sinf(p.hy_freq[l * 64 + o0 + e] * (acc[e] + p.hy_b1[l * 64 + o0 + e]));
    }
    __syncthreads();
    {
        const int tap = tix & 63, o0 = (tix >> 6) * 8;
        float acc[8];
#pragma unroll
        for (int e = 0; e < 8; ++e) acc[e] = 0.f;
        const float* w2 = p.hy_w2 + (size_t)l * 64 * 64 + o0;
#pragma unroll 4
        for (int j = 0; j < 64; ++j) { const float hv = H1[tap * 65 + j];
#pragma unroll
            for (int e = 0; e < 8; ++e) acc[e] += hv * w2[j * 64 + e]; }
#pragma unroll
        for (int e = 0; e < 8; ++e) H2[tap * 65 + o0 + e] = sinf(p.hy_freq[l * 64 + o0 + e] * (acc[e] + p.hy_b2[l * 64 + o0 + e]));
    }
    __syncthreads();
    {
        const int c = tix & 255, half = tix >> 8;
        float w[64];
#pragma unroll
        for (int j = 0; j < 64; ++j) w[j] = p.hy_w3[(size_t)l * 64 * 256 + j * 256 + c];
        const float dec = p.hy_decay[l * 256 + c];
#pragma unroll 2
        for (int k = 0; k < 32; ++k) {
            const int tap = 32 * half + k;
            float acc = 0.f;
#pragma unroll
            for (int j = 0; j < 64; ++j) acc += H2[tap * 65 + j] * w[j];
            float rel; filt_pos(ttb + tap, rel);
            const float hv = acc * expf(-2.0f * fabsf(rel) * dec);
            if (isctx) ((LAS float*)(lds + FL_T))[tap * 260 + c] = hv;
            else ((LAS unsigned short*)(lds + FL_T))[c * 72 + 63 - tap] = (unsigned short)f2bf_u(hv);
        }
    }
    __syncthreads();
    if (isctx) {
        for (int e = tix; e < 64 * 256; e += 512) p.HFC[((size_t)l * CTX + t0 + (e >> 8)) * 256 + (e & 255)] = ((const LAS float*)(lds + FL_T))[(e >> 8) * 260 + (e & 255)];
    } else {
#pragma unroll 4
        for (int k = 0; k < 32; ++k) { const int e = k * 512 + tix, row = e >> 6, col = e & 63;
            p.G1[((size_t)l * 256 + row) * G1N + (8456 - t0 - 63) + col] = ((const LAS unsigned short*)(lds + FL_T))[row * 72 + col]; }
    }
}
__device__ __forceinline__ void filt_all(const Params& p, LAS unsigned char* lds, long tid, long nth, int tix, int bid, int G) {
    constexpr int NPAD = 265 + (G1N - 8457);
    for (long i = tid; i < (long)DEPTH * 256 * NPAD; i += nth) {
        const int k = (int)(i % NPAD); const long lc = i / NPAD;
        p.G1[lc * G1N + (k < 265 ? k : 8457 + (k - 265))] = 0;
    }
    for (int u = bid; u < FILT_UNITS; u += G) filt_unit(p, lds, u, tix);
    __syncthreads();
}
__device__ __forceinline__ const float* xsrc_row(const Params& p, int r, bool from_input) {
    if (from_input) return r < BL ? p.x + (size_t)r * DM : p.ctx + (size_t)(r - BL) * DM;
    return r < BL ? p.XL + (size_t)r * DM : p.XC + (size_t)(r - BL) * DM;
}
template <bool SLAB>
__device__ __forceinline__ void hx_pass(const Params& p, int l, int which, int row_lo, int row_hi, int gw, int NGW, int lane, int nslab = 0, const float* slab = nullptr, const float* gate = nullptr, bool base_from_input = false) {
    const float* g = (which ? p.norm2_g : p.norm1_g) + (size_t)l * DM;
    for (int r = row_lo + gw; r < row_hi; r += NGW) {
        const float* m = p.MOD + ((size_t)l * (NB + 1) + row_bb(r)) * 6 * DM;
        const float* sh = m + (which ? 3 : 0) * DM; const float* sc = m + (which ? 4 : 1) * DM;
        f32x4 v[4]; float s = 0.f;
        if (SLAB) {
            const f32x4* x4 = (const f32x4*)(base_from_input ? p.ctx + (size_t)(r - BL) * DM : p.XC + (size_t)(r - BL) * DM) + lane;
            f32x4* xo = (f32x4*)(p.XC + (size_t)(r - BL) * DM) + lane;
            const f32x4* sl = (const f32x4*)(slab + (size_t)(r - BL) * DM) + lane;
#pragma unroll
            for (int j = 0; j < 4; ++j) v[j] = (f32x4){0.f, 0.f, 0.f, 0.f};
#pragma unroll 1
            for (int q = 0; q < nslab; ++q) {
#pragma unroll
                for (int j = 0; j < 4; ++j) v[j] += sl[(size_t)q * BC * (DM / 4) + 64 * j];
            }
#pragma unroll
            for (int j = 0; j < 4; ++j) { v[j] = x4[64 * j] + *(const f32x4*)(gate + 4 * lane + 256 * j) * v[j]; xo[64 * j] = v[j]; }
        } else {
            const f32x4* x4 = (const f32x4*)xsrc_row(p, r, l == 0 && which == 0) + lane;
#pragma unroll
            for (int j = 0; j < 4; ++j) v[j] = x4[64 * j];
        }
#pragma unroll
        for (int j = 0; j < 4; ++j) s += (v[j].x * v[j].x + v[j].y * v[j].y) + (v[j].z * v[j].z + v[j].w * v[j].w);
        const float rstd = 1.0f / sqrtf(wave_sum(s, lane) * (1.0f / DM) + EPSV);
        unsigned long long* o8 = (unsigned long long*)(p.Y + (size_t)r * DM) + lane;
#pragma unroll
        for (int j = 0; j < 4; ++j) {
            const int k = 4 * lane + 256 * j;
            const f32x4 gg = *(const f32x4*)(g + k), s1 = *(const f32x4*)(sc + k), s0 = *(const f32x4*)(sh + k);
            const f32x4 o = v[j] * rstd * gg * (s1 + 1.0f) + s0;
            o8[64 * j] = (unsigned long long)pk2(o.x, o.y) | ((unsigned long long)pk2(o.z, o.w) << 32);
        }
    }
}
__device__ __forceinline__ void final_pass(const Params& p, int gw, int NGW, int lane) {
    for (int r = gw; r < BL; r += NGW) {
        f32x4* x4 = (f32x4*)(p.XL + (size_t)r * DM) + lane;
        f32x4 v[4]; float s = 0.f;
#pragma unroll
        for (int j = 0; j < 4; ++j) { v[j] = x4[64 * j]; s += (v[j].x * v[j].x + v[j].y * v[j].y) + (v[j].z * v[j].z + v[j].w * v[j].w); }
        const float rstd = 1.0f / sqrtf(wave_sum(s, lane) * (1.0f / DM) + EPSV);
#pragma unroll
        for (int j = 0; j < 4; ++j) x4[64 * j] = v[j] * rstd * *(const f32x4*)(p.final_g + 4 * lane + 256 * j);
    }
}


#define GAS __attribute__((address_space(1)))
#define XB_TMO      128
#define XB_XCNT(j)  (256  + 64 * (j))
#define XB_XSUB(j)  (1280 + 64 * (j))
#define XB_XGEN(j)  (2304 + 64 * (j))
#define XB_TOP      3328
#define XB_TOPGEN   3392
#define XCD_BAR_WORDS 3456
#define XB_SPIN_CAP (1u << 18)

__device__ __forceinline__ unsigned xb_ld(unsigned* p)              { return __hip_atomic_load(p, __ATOMIC_RELAXED, __HIP_MEMORY_SCOPE_AGENT); }
__device__ __forceinline__ unsigned xb_add(unsigned* p, unsigned v) { return __hip_atomic_fetch_add(p, v, __ATOMIC_RELAXED, __HIP_MEMORY_SCOPE_AGENT); }
__device__ __forceinline__ unsigned xb_xcc_id() { return (unsigned)__builtin_amdgcn_s_getreg((3 << 11) | 20) & 0xFu; }
#define XB_SPIN(cond, bar) do { unsigned _sp = 0; while (cond) { __builtin_amdgcn_s_sleep(1); \
    if ((++_sp & 255u) == 0u) { if (xb_ld(&(bar)[XB_TMO])) break; if (_sp > XB_SPIN_CAP) { atomicAdd(&(bar)[XB_TMO], 1u); break; } } } } while (0)

struct XcdBarrier {
    unsigned* bar; unsigned x;
    volatile LAS unsigned* st;
};

__device__ __forceinline__ XcdBarrier xcd_barrier_post(unsigned* bar, volatile LAS unsigned* st) {
    XcdBarrier b; b.bar = bar; b.x = xb_xcc_id(); b.st = st;
    if (threadIdx.x == 0) (void)xb_add(&bar[XB_XCNT(b.x)], 1u);
    return b;
}
__device__ __forceinline__ void xcd_barrier_complete(unsigned* bar, unsigned x, unsigned& nloc, unsigned& nx) {
    const unsigned G = gridDim.x * gridDim.y * gridDim.z;
    unsigned sum, cnt, mine, sp = 0u;
    for (;;) {
        sum = 0u; cnt = 0u; mine = 0u;
#pragma unroll
        for (unsigned j = 0; j < 16; ++j) { const unsigned c = xb_ld(&bar[XB_XCNT(j)]); sum += c; cnt += (c > 0u) ? 1u : 0u; mine = (j == x) ? c : mine; }
        if (sum == G) break;
        __builtin_amdgcn_s_sleep(1);
        if ((++sp & 255u) == 0u) { if (xb_ld(&bar[XB_TMO])) break; if (sp > XB_SPIN_CAP) { atomicAdd(&bar[XB_TMO], 1u); break; } }
    }
    nloc = mine > 0u ? mine : 1u; nx = cnt > 0u ? cnt : 1u;
}

__device__ __forceinline__ void xcd_barrier(const XcdBarrier& b, bool leader) {
    asm volatile("s_waitcnt vmcnt(0)" ::: "memory");
    __syncthreads();
    if (leader) {
        unsigned* bar = b.bar;
        __builtin_amdgcn_s_waitcnt(0);
        unsigned nloc = b.st[0], nx = b.st[1];
        if (nloc == 0u) { xcd_barrier_complete(bar, b.x, nloc, nx); b.st[0] = nloc; b.st[1] = nx; }
        const unsigned old = xb_add(&bar[XB_XSUB(b.x)], 1u);
        const unsigned gen = old / nloc;
        if (old + 1u == (gen + 1u) * nloc) {
            __builtin_amdgcn_fence(__ATOMIC_RELEASE, "agent");
            asm volatile("s_waitcnt vmcnt(0)" ::: "memory");
            const unsigned og = xb_add(&bar[XB_TOP], 1u);
            const unsigned tg = og / nx;
            if (og + 1u == (tg + 1u) * nx) xb_add(&bar[XB_TOPGEN], 1u);
            else XB_SPIN(xb_ld(&bar[XB_TOPGEN]) == tg, bar);
            __builtin_amdgcn_fence(__ATOMIC_ACQUIRE, "agent");
            xb_add(&bar[XB_XGEN(b.x)], 1u);
            asm volatile("s_waitcnt vmcnt(0)" ::: "memory");
        } else {
            XB_SPIN(xb_ld(&bar[XB_XGEN(b.x)]) == gen, bar);
            __builtin_amdgcn_fence(__ATOMIC_ACQUIRE, "agent");
            asm volatile("s_waitcnt vmcnt(0)" ::: "memory");
        }
    }
    __syncthreads();
}
#define GNCC ((CTX + SEQ) / 64)
#define GCTXC (CTX / 64)
#define GLA_UNITS (NB * 6 * GNCC)
typedef short bf16x8 __attribute__((ext_vector_type(8)));
__device__ __forceinline__ int gla_row0(int b, int cc) { return cc < GCTXC ? BL + b * CTX + cc * 64 : b * SEQ + (cc - GCTXC) * 64; }
__device__ __forceinline__ size_t gla_uidx(int dir, int b, int h, int cc) { return (((size_t)dir * NB + b) * 6 + h) * GNCC + cc; }
__device__ __forceinline__ float bflo(unsigned u) { return __builtin_bit_cast(float, u << 16); }
__device__ __forceinline__ float bfhi(unsigned u) { return __builtin_bit_cast(float, u & 0xffff0000u); }
constexpr int GL_WL = 0, GL_BIAS = 24576, GL_VT = 26112, GL_KLT = 35328, GL_AC = 44544, GL_KD = 70144, GL_PART = 80384;
constexpr int GL_VTS = 72, GL_ACS = 200, GL_KDS = 40;

__device__ __forceinline__ void gla_stage_w(const Params& p, int l, LAS unsigned char* lds, int tix) {
    LAS float* WL = (LAS float*)(lds + GL_WL); LAS float* BI = (LAS float*)(lds + GL_BIAS);
    for (int i = tix; i < 6 * 1024; i += 512) { const int h = i >> 10, dir = (i >> 9) & 1, j = (i >> 5) & 15, d = i & 31;
        WL[i] = (dir ? p.gk_w_b : p.gk_w_f)[(size_t)l * 16 * 192 + j * 192 + h * 32 + d]; }
    if (tix < 384) { const int h = tix >> 6, dir = (tix >> 5) & 1, d = tix & 31; BI[tix] = (dir ? p.gk_b_b : p.gk_b_f)[l * 192 + h * 32 + d]; }
}
struct GlaPre { v4u v, gk0, gk1, q, k; };
template <bool NEEDQ>
__device__ __forceinline__ void gla_issue(const Params& p, int u, int tix, GlaPre& L) {
    const int b = u / (6 * GNCC), h = (u / GNCC) % 6, cc = u % GNCC, row0 = gla_row0(b, cc);
    const int lane = tix & 63, wave = tix >> 6, dir = wave >> 2, d0 = (wave & 3) * 8;
    L.v = *(const v4u*)(p.P + (size_t)(row0 + (tix >> 3)) * LDP + OFF_V + h * 64 + (tix & 7) * 8);
    const act_t* prow = p.P + (size_t)(row0 + lane) * LDP;
    L.gk0 = *(const v4u*)(prow + (dir ? OFF_GKB : OFF_GKF)); L.gk1 = *(const v4u*)(prow + (dir ? OFF_GKB : OFF_GKF) + 8);
    L.k = *(const v4u*)(prow + OFF_K + h * 32 + d0);
    if (NEEDQ) L.q = *(const v4u*)(prow + OFF_Q + h * 32 + d0);
}
__device__ __forceinline__ void gla_put_v(LAS unsigned char* lds, int tix, const v4u vv) {
    const int j = tix >> 3, eo = tix & 7;
    LAS unsigned short* VT = (LAS unsigned short*)(lds + GL_VT);
    VT[(eo * 8 + 0) * GL_VTS + j] = (unsigned short)(vv.x & 0xffff); VT[(eo * 8 + 1) * GL_VTS + j] = (unsigned short)(vv.x >> 16);
    VT[(eo * 8 + 2) * GL_VTS + j] = (unsigned short)(vv.y & 0xffff); VT[(eo * 8 + 3) * GL_VTS + j] = (unsigned short)(vv.y >> 16);
    VT[(eo * 8 + 4) * GL_VTS + j] = (unsigned short)(vv.z & 0xffff); VT[(eo * 8 + 5) * GL_VTS + j] = (unsigned short)(vv.z >> 16);
    VT[(eo * 8 + 6) * GL_VTS + j] = (unsigned short)(vv.w & 0xffff); VT[(eo * 8 + 7) * GL_VTS + j] = (unsigned short)(vv.w >> 16);
}
__device__ __forceinline__ void gla_phase_a(const v4u g0, const v4u g1, LAS unsigned char* lds, int h, int dir, int d0, int lane, float (&Bv)[8], float (&tot)[8]) {
    const LAS float* WL = (const LAS float*)(lds + GL_WL) + h * 1024 + dir * 512 + d0; const LAS float* BI = (const LAS float*)(lds + GL_BIAS) + h * 64 + dir * 32 + d0;
    float gk[16] = { bflo(g0.x), bfhi(g0.x), bflo(g0.y), bfhi(g0.y), bflo(g0.z), bfhi(g0.z), bflo(g0.w), bfhi(g0.w),
                     bflo(g1.x), bfhi(g1.x), bflo(g1.y), bfhi(g1.y), bflo(g1.z), bfhi(g1.z), bflo(g1.w), bfhi(g1.w) };
    float lg[8];
#pragma unroll
    for (int i = 0; i < 8; ++i) lg[i] = BI[i];
#pragma unroll
    for (int j = 0; j < 16; ++j) {
        const f32x4 w0 = *(const LAS f32x4*)(WL + j * 32), w1 = *(const LAS f32x4*)(WL + j * 32 + 4);
        lg[0] += gk[j] * w0.x; lg[1] += gk[j] * w0.y; lg[2] += gk[j] * w0.z; lg[3] += gk[j] * w0.w;
        lg[4] += gk[j] * w1.x; lg[5] += gk[j] * w1.y; lg[6] += gk[j] * w1.z; lg[7] += gk[j] * w1.w;
    }
#pragma unroll
    for (int i = 0; i < 8; ++i) {
        const float x = lg[i];
        lg[i] = -(fmaxf(-x, 0.f) + __logf(1.0f + __expf(-fabsf(x)))) * (1.0f / 16.0f);
        const float v = wave_scan_incl(lg[i], lane);
        tot[i] = lane63(v);
        Bv[i] = dir ? tot[i] - v + lg[i] : v;
    }
}
__device__ __forceinline__ void unpack8(const v4u k, float (&f)[8]) {
    f[0] = bflo(k.x); f[1] = bfhi(k.x); f[2] = bflo(k.y); f[3] = bfhi(k.y); f[4] = bflo(k.z); f[5] = bfhi(k.z); f[6] = bflo(k.w); f[7] = bfhi(k.w);
}
__device__ __forceinline__ int gla_count(int b, int ph) {
    if (gridDim.x != 256 || GLA_UNITS != 3168) return (GLA_UNITS - b + (int)gridDim.x - 1) / (int)gridDim.x;
    const int n0 = ph ? 5 : 7, extra = 3168 - 16 * n0 - 240 * 12;
    return b < 16 ? n0 : 12 + ((b - 16) < extra ? 1 : 0);
}
__device__ __forceinline__ int gla_unit_of(int b, int k, int ph) {
    if (gridDim.x != 256 || GLA_UNITS != 3168) return b + k * (int)gridDim.x;
    const int n0 = ph ? 5 : 7;
    return b < 16 ? n0 * b + k : (k < 12 ? 16 * n0 + (b - 16) * 12 + k : 16 * n0 + 2880 + (b - 16));
}
__device__ __forceinline__ void gla_m2_phase(const Params& p, int l, LAS unsigned char* lds, int tix, int bid, unsigned short* DSG, float* DECG) {
    const int lane = tix & 63, wave = __builtin_amdgcn_readfirstlane(tix >> 6);
    gla_stage_w(p, l, lds, tix);
    GlaPre L;
    const int ncnt = gla_count(bid, 0);
    if (ncnt > 0) gla_issue<false>(p, gla_unit_of(bid, 0, 0), tix, L);
    __syncthreads();
#pragma unroll 1
    for (int kk = 0; kk < ncnt; ++kk) {
        const int u = gla_unit_of(bid, kk, 0);
        const int b = u / (6 * GNCC), h = (u / GNCC) % 6, cc = u % GNCC;
        gla_put_v(lds, tix, L.v);
        {
            const int dir = wave >> 2, d0 = (wave & 3) * 8;
            float Bv[8], tot[8];
            gla_phase_a(L.gk0, L.gk1, lds, h, dir, d0, lane, Bv, tot);
            float kf[8]; unpack8(L.k, kf);
            LAS unsigned short* KLT = (LAS unsigned short*)(lds + GL_KLT) + (dir * 32 + d0) * GL_VTS + lane;
#pragma unroll
            for (int i = 0; i < 8; ++i) KLT[i * GL_VTS] = (unsigned short)f2bf_u(kf[i] * __expf(tot[i] - Bv[i]));
            if (lane == 0) {
                float* dg = DECG + gla_uidx(dir, b, h, cc) * 32 + d0;
#pragma unroll
                for (int i = 0; i < 8; ++i) dg[i] = __expf(tot[i]);
            }
        }
        if (kk + 1 < ncnt) gla_issue<false>(p, gla_unit_of(bid, kk + 1, 0), tix, L);
        __syncthreads();
        {
            const int dir = wave >> 2, te = wave & 3, fr = lane & 15, fq = lane >> 4;
            unsigned short* out = DSG + gla_uidx(dir, b, h, cc) * 2048;
#pragma unroll
            for (int td = 0; td < 2; ++td) {
                f32x4 acc = {0.f, 0.f, 0.f, 0.f};
#pragma unroll
                for (int ks = 0; ks < 2; ++ks) {
                    const bf16x8 a = *(const LAS bf16x8*)(lds + GL_VT + ((16 * te + fr) * GL_VTS + 32 * ks + 8 * fq) * 2);
                    const bf16x8 bb = *(const LAS bf16x8*)(lds + GL_KLT + ((dir * 32 + 16 * td + fr) * GL_VTS + 32 * ks + 8 * fq) * 2);
                    acc = __builtin_amdgcn_mfma_f32_16x16x32_bf16(a, bb, acc, 0, 0, 0);
                }
#pragma unroll
                for (int r = 0; r < 4; ++r) out[(16 * te + 4 * fq + r) * 32 + 16 * td + fr] = (unsigned short)f2bf_u(acc[r]);
            }
        }
        __syncthreads();
    }
}
template <int NSTEP, int BATCH>
__device__ __forceinline__ void gla_m3_seg(f32x4& S, const unsigned short* DSG, const float* DECG, unsigned short* SSG, size_t base, int cc0, int step, int ed) {
    static_assert(NSTEP % BATCH == 0, "");
#pragma unroll 1
    for (int k0 = 0; k0 < NSTEP; k0 += BATCH) {
        f32x4 d[BATCH], dc[BATCH]; unsigned long long draw[BATCH];
#pragma unroll
        for (int j = 0; j < BATCH; ++j) { const size_t u = base + cc0 + (k0 + j) * step; draw[j] = *(const unsigned long long*)(DSG + u * 2048 + ed); dc[j] = *(const f32x4*)(DECG + u * 32 + (ed & 31)); }
#pragma unroll
        for (int j = 0; j < BATCH; ++j) { const unsigned lo = (unsigned)draw[j], hi = (unsigned)(draw[j] >> 32); d[j] = (f32x4){bflo(lo), bfhi(lo), bflo(hi), bfhi(hi)}; }
#pragma unroll
        for (int j = 0; j < BATCH; ++j) { const size_t u = base + cc0 + (k0 + j) * step;
            *(unsigned long long*)(SSG + u * 2048 + ed) = (unsigned long long)pk2(S.x, S.y) | ((unsigned long long)pk2(S.z, S.w) << 32);
            S = dc[j] * S + d[j]; }
    }
}
__device__ __forceinline__ void gla_m3(long tid, long nth, const unsigned short* DSG, const float* DECG, unsigned short* SSG) {
    for (long i = tid; i < 2L * NB * 6 * 512; i += nth) {
        const int ed = (int)(i & 511) * 4, chain = (int)(i >> 9), dir = chain / (NB * 6);
        const size_t base = (size_t)chain * GNCC;
        float z0 = 0.f; asm volatile("" : "+v"(z0));
        f32x4 S = {z0, z0, z0, z0};
        if (dir == 0) { gla_m3_seg<GCTXC, GCTXC>(S, DSG, DECG, SSG, base, 0, 1, ed); gla_m3_seg<GNCC - GCTXC, 16>(S, DSG, DECG, SSG, base, GCTXC, 1, ed); }
        else { gla_m3_seg<GCTXC, GCTXC>(S, DSG, DECG, SSG, base, GCTXC - 1, -1, ed); gla_m3_seg<GNCC - GCTXC, 16>(S, DSG, DECG, SSG, base, GNCC - 1, -1, ed); }
    }
}
struct GlaPre4 { bf16x8 s[2][2]; unsigned short g[4][2]; };
__device__ __forceinline__ void gla_issue4(const Params& p, int u, int tix, const unsigned short* SSG, GlaPre4& S) {
    const int b = u / (6 * GNCC), h = (u / GNCC) % 6, cc = u % GNCC, row0 = gla_row0(b, cc);
    const int lane = tix & 63, wave = tix >> 6, fr = lane & 15, fq = lane >> 4, ti = wave >> 1, ch = wave & 1;
#pragma unroll
    for (int dir = 0; dir < 2; ++dir)
#pragma unroll
        for (int n = 0; n < 2; ++n) S.s[dir][n] = *(const bf16x8*)(SSG + gla_uidx(dir, b, h, cc) * 2048 + (32 * ch + 16 * n + fr) * 32 + 8 * fq);
#pragma unroll
    for (int r = 0; r < 4; ++r)
#pragma unroll
        for (int n = 0; n < 2; ++n) S.g[r][n] = p.P[(size_t)(row0 + 16 * ti + 4 * fq + r) * LDP + OFF_G + h * 64 + 32 * ch + 16 * n + fr];
}
__device__ __forceinline__ void gla_m4_phase(const Params& p, int l, LAS unsigned char* lds, int tix, int bid, const unsigned short* SSG) {
    const int lane = tix & 63, wave = __builtin_amdgcn_readfirstlane(tix >> 6), fr = lane & 15, fq = lane >> 4;
    gla_stage_w(p, l, lds, tix);
    GlaPre L; GlaPre4 S;
    const int ncnt = gla_count(bid, 1);
    if (ncnt > 0) { const int u0 = gla_unit_of(bid, 0, 1); gla_issue<true>(p, u0, tix, L); gla_issue4(p, u0, tix, SSG, S); }
    __syncthreads();
#pragma unroll 1
    for (int kk = 0; kk < ncnt; ++kk) {
        const int u = gla_unit_of(bid, kk, 1);
        const int b = u / (6 * GNCC), h = (u / GNCC) % 6, cc = u % GNCC, row0 = gla_row0(b, cc);
        gla_put_v(lds, tix, L.v);
        {
            const int dir = wave >> 2, d0 = (wave & 3) * 8;
            float Bv[8], tot[8];
            gla_phase_a(L.gk0, L.gk1, lds, h, dir, d0, lane, Bv, tot);
            float kf[8], qf[8]; unpack8(L.k, kf); unpack8(L.q, qf);
            float qd[8], kd[8];
#pragma unroll
            for (int i = 0; i < 8; ++i) { qd[i] = qf[i] * __expf(Bv[i]) * 0.17677669529663687f; kd[i] = kf[i] * __expf(-Bv[i]); }
            v4u w; w.x = pk2(qd[0], qd[1]); w.y = pk2(qd[2], qd[3]); w.z = pk2(qd[4], qd[5]); w.w = pk2(qd[6], qd[7]);
            *(LAS v4u*)(lds + GL_AC + (lane * GL_ACS + 128 + 32 * dir + d0) * 2) = w;
            w.x = pk2(kd[0], kd[1]); w.y = pk2(kd[2], kd[3]); w.z = pk2(kd[4], kd[5]); w.w = pk2(kd[6], kd[7]);
            *(LAS v4u*)(lds + GL_KD + ((dir * 64 + lane) * GL_KDS + d0) * 2) = w;
        }
        const bool more = kk + 1 < ncnt;
        if (more) gla_issue<true>(p, gla_unit_of(bid, kk + 1, 1), tix, L);
        __syncthreads();
        {
            const int dir = wave >> 2, ti = wave & 3;
            const bf16x8 a = *(const LAS bf16x8*)(lds + GL_AC + ((16 * ti + fr) * GL_ACS + 128 + 32 * dir + 8 * fq) * 2);
            LAS unsigned short* AC = (LAS unsigned short*)(lds + GL_AC);
#pragma unroll
            for (int tj = 0; tj < 4; ++tj) {
                const bf16x8 bb = *(const LAS bf16x8*)(lds + GL_KD + ((dir * 64 + 16 * tj + fr) * GL_KDS + 8 * fq) * 2);
                f32x4 acc = {0.f, 0.f, 0.f, 0.f};
                acc = __builtin_amdgcn_mfma_f32_16x16x32_bf16(a, bb, acc, 0, 0, 0);
                const int j = 16 * tj + fr;
#pragma unroll
                for (int r = 0; r < 4; ++r) { const int i = 16 * ti + 4 * fq + r; const bool keep = dir ? (j >= i) : (j <= i);
                    AC[i * GL_ACS + 64 * dir + j] = (unsigned short)f2bf_u(keep ? acc[r] : 0.f); }
            }
        }
        __syncthreads();
        f32x4 acc[2] = { {0.f, 0.f, 0.f, 0.f}, {0.f, 0.f, 0.f, 0.f} };
        const int ti = wave >> 1, ch = wave & 1;
        {
            bf16x8 bv[2][2];
#pragma unroll
            for (int ks = 0; ks < 2; ++ks)
#pragma unroll
                for (int n = 0; n < 2; ++n) bv[ks][n] = *(const LAS bf16x8*)(lds + GL_VT + ((32 * ch + 16 * n + fr) * GL_VTS + 32 * ks + 8 * fq) * 2);
#pragma unroll
            for (int part = 0; part < 2; ++part)
#pragma unroll
                for (int ks = 0; ks < 2; ++ks) {
                    const bf16x8 a = *(const LAS bf16x8*)(lds + GL_AC + ((16 * ti + fr) * GL_ACS + 64 * part + 32 * ks + 8 * fq) * 2);
#pragma unroll
                    for (int n = 0; n < 2; ++n) acc[n] = __builtin_amdgcn_mfma_f32_16x16x32_bf16(a, bv[ks][n], acc[n], 0, 0, 0);
                }
#pragma unroll
            for (int dir = 0; dir < 2; ++dir) {
                const bf16x8 a = *(const LAS bf16x8*)(lds + GL_AC + ((16 * ti + fr) * GL_ACS + 128 + 32 * dir + 8 * fq) * 2);
#pragma unroll
                for (int n = 0; n < 2; ++n) acc[n] = __builtin_amdgcn_mfma_f32_16x16x32_bf16(a, S.s[dir][n], acc[n], 0, 0, 0);
            }
            LAS float* PART = (LAS float*)(lds + GL_PART);
#pragma unroll
            for (int r = 0; r < 4; ++r) {
                float ss = acc[0][r] * acc[0][r] + acc[1][r] * acc[1][r];
                ss = sum16(ss);
                if (fr == 0) PART[(16 * ti + 4 * fq + r) * 2 + ch] = ss;
            }
        }
        __syncthreads();
        {
            const LAS float* PART = (const LAS float*)(lds + GL_PART);
#pragma unroll
            for (int r = 0; r < 4; ++r) {
                const int i = 16 * ti + 4 * fq + r;
                const float rs = 1.0f / sqrtf((PART[i * 2] + PART[i * 2 + 1]) * (1.0f / 64.0f) + EPSV);
#pragma unroll
                for (int n = 0; n < 2; ++n) {
                    const int e = 32 * ch + 16 * n + fr;
                    const float g = bflo((unsigned)S.g[r][n]);
                    stact(p.Y + (size_t)(row0 + i) * DM + h * 64 + e, acc[n][r] * rs * p.gla_norm_w[l * 64 + e] * (g / (1.0f + __expf(-g))));
                }
            }
        }
        if (more) gla_issue4(p, gla_unit_of(bid, kk + 1, 1), tix, SSG, S);
    }
    __syncthreads();
}

#define SNCC ((CTX + SEQ) / 128)
#define SCTXC (CTX / 128)
#define SSD_UNITS (NB * 2 * SNCC)
constexpr int SD_CM = 0, SD_BM = 34816, SD_XT = 69632, SD_HS = 121856, SD_DTL = 139264, SD_CSL = 142336, SD_TOT = 145408, SD_HS2OFF = 145440 - 121856;
constexpr int SD_S = 136;
static_assert(SD_HS + SD_HS2OFF + 64 * 136 * 2 <= LDS_BYTES - 64, "SSD LDS map");
__device__ __forceinline__ int ssd_row(int b, int cc, int i) {
    if (cc < SCTXC) return BL + b * CTX + cc * 128 + i;
    return b * SEQ + colmajor_tok(0, (cc - SCTXC) * 128 + i);
}
__device__ __forceinline__ size_t ssd_chain(int dir, int b, int head) { return ((size_t)dir * NB + b) * 6 + head; }
template <bool TR_B, bool WITH_C>
__device__ __forceinline__ void ssd_stage(const Params& p, int l, LAS unsigned char* lds, int b, int g, int cc, int tix) {
    const int sidx = cc < SCTXC ? NB + b : b, L = seq_len(sidx), r0 = seq_row0(sidx), pos0 = (cc < SCTXC ? cc : cc - SCTXC) * 128;
    constexpr int NQ = WITH_C ? 14 : 10;
    for (int item = tix; item < 128 * NQ; item += 512) {
        const int i = item & 127, q = item >> 7;
        const int col0 = q < 6 ? g * 192 + q * 32 : (q < 10 ? 384 + g * 128 + (q - 6) * 32 : 640 + g * 128 + (q - 10) * 32);
        const int pos = pos0 + i;
        const act_t* rc = p.P + (size_t)(r0 + colmajor_tok(sidx, pos)) * LDP + OFF_XBC + col0;
        const bool hp = pos > 0, hn = pos + 1 < L;
        const act_t* rp = hp ? p.P + (size_t)(r0 + colmajor_tok(sidx, pos - 1)) * LDP + OFF_XBC + col0 : rc;
        const act_t* rn = hn ? p.P + (size_t)(r0 + colmajor_tok(sidx, pos + 1)) * LDP + OFF_XBC + col0 : rc;
        const float* cw = p.ssd_conv_w + (size_t)l * 3 * 896 + col0; const float* cbias = p.ssd_conv_b + (size_t)l * 896 + col0;
#pragma unroll
        for (int o = 0; o < 4; ++o) {
            float xp[8], xc[8], xn[8], y[8];
            unpack8(*(const v4u*)(rp + 8 * o), xp); unpack8(*(const v4u*)(rc + 8 * o), xc); unpack8(*(const v4u*)(rn + 8 * o), xn);
#pragma unroll
            for (int e = 0; e < 8; ++e) {
                const int c = 8 * o + e;
                float a = cbias[c] + cw[896 + c] * xc[e];
                a += hp ? cw[c] * xp[e] : 0.f; a += hn ? cw[2 * 896 + c] * xn[e] : 0.f;
                y[e] = a / (1.0f + __expf(-a));
            }
            if (q < 6) {
                LAS unsigned short* d = (LAS unsigned short*)(lds + SD_XT) + (q * 32 + 8 * o) * SD_S + i;
#pragma unroll
                for (int e = 0; e < 8; ++e) d[e * SD_S] = (unsigned short)f2bf_u(y[e]);
            } else if (q < 10) {
                if (TR_B) { LAS unsigned short* d = (LAS unsigned short*)(lds + SD_BM) + ((q - 6) * 32 + 8 * o) * SD_S + i;
#pragma unroll
                    for (int e = 0; e < 8; ++e) d[e * SD_S] = (unsigned short)f2bf_u(y[e]);
                } else { v4u w; w.x = pk2(y[0], y[1]); w.y = pk2(y[2], y[3]); w.z = pk2(y[4], y[5]); w.w = pk2(y[6], y[7]);
                    *(LAS v4u*)(lds + SD_BM + (i * SD_S + (q - 6) * 32 + 8 * o) * 2) = w; }
            } else { v4u w; w.x = pk2(y[0], y[1]); w.y = pk2(y[2], y[3]); w.z = pk2(y[4], y[5]); w.w = pk2(y[6], y[7]);
                *(LAS v4u*)(lds + SD_CM + (i * SD_S + (q - 10) * 32 + 8 * o) * 2) = w; }
        }
    }
}
__device__ __forceinline__ void ssd_scans(const Params& p, int l, LAS unsigned char* lds, int b, int g, int cc, int wave, int lane) {
    if (wave < 6) {
        const int hg = wave % 3, dir = wave / 3, head = g * 3 + hg;
        const float bias = (dir ? p.ssd_dt_bias_b : p.ssd_dt_bias_f)[l * 6 + head];
        const float A = -__expf((dir ? p.ssd_a_log_b : p.ssd_a_log_f)[l * 6 + head]);
        float dt[2], a[2];
#pragma unroll
        for (int k = 0; k < 2; ++k) {
            const float x = ldact(p.P + (size_t)ssd_row(b, cc, 2 * lane + k) * LDP + (dir ? OFF_DTB : OFF_DTF) + head) + bias;
            dt[k] = fmaxf(x, 0.f) + log1pf(__expf(-fabsf(x))); a[k] = A * dt[k];
        }
        const float v = wave_scan_incl(a[0] + a[1], lane);
        const float tot = lane63(v);
        const float pf1 = v, pf0 = v - a[1];
        LAS float* DTL = (LAS float*)(lds + SD_DTL) + wave * 128 + 2 * lane; LAS float* CSL = (LAS float*)(lds + SD_CSL) + wave * 128 + 2 * lane;
        DTL[0] = dt[0]; DTL[1] = dt[1];
        CSL[0] = dir ? tot - pf0 + a[0] : pf0; CSL[1] = dir ? tot - pf1 + a[1] : pf1;
        if (lane == 0) ((LAS float*)(lds + SD_TOT))[wave] = tot;
    }
}
__device__ __forceinline__ void ssd_s2_unit(const Params& p, int l, LAS unsigned char* lds, int u, int tix, unsigned short* DSS, float* DECS) {
    const int b = u / (2 * SNCC), g = (u / SNCC) & 1, cc = u % SNCC;
    const int lane = tix & 63, wave = __builtin_amdgcn_readfirstlane(tix >> 6), fr = lane & 15, fq = lane >> 4;
    ssd_scans(p, l, lds, b, g, cc, wave, lane);
    ssd_stage<true, false>(p, l, lds, b, g, cc, tix);
    __syncthreads();
    if (tix < 6) DECS[ssd_chain(tix / 3, b, g * 3 + tix % 3) * SNCC + cc] = __expf(((const LAS float*)(lds + SD_TOT))[tix]);
#pragma unroll 1
    for (int k = 0; k < 3; ++k) {
        const int c3 = wave + 8 * k, tp = c3 & 3, combo = c3 >> 2, hg = combo % 3, dir = combo / 3;
        const LAS float* DTL = (const LAS float*)(lds + SD_DTL) + combo * 128; const LAS float* CSL = (const LAS float*)(lds + SD_CSL) + combo * 128;
        const float tot = ((const LAS float*)(lds + SD_TOT))[combo];
        bf16x8 a[4];
#pragma unroll
        for (int ks = 0; ks < 4; ++ks) {
            const int j0 = 32 * ks + 8 * fq;
            float xf[8]; unpack8(*(const LAS v4u*)(lds + SD_XT + ((hg * 64 + 16 * tp + fr) * SD_S + j0) * 2), xf);
            const f32x4 d0 = *(const LAS f32x4*)(DTL + j0), d1 = *(const LAS f32x4*)(DTL + j0 + 4), c0 = *(const LAS f32x4*)(CSL + j0), c1 = *(const LAS f32x4*)(CSL + j0 + 4);
            xf[0] *= d0.x * __expf(tot - c0.x); xf[1] *= d0.y * __expf(tot - c0.y); xf[2] *= d0.z * __expf(tot - c0.z); xf[3] *= d0.w * __expf(tot - c0.w);
            xf[4] *= d1.x * __expf(tot - c1.x); xf[5] *= d1.y * __expf(tot - c1.y); xf[6] *= d1.z * __expf(tot - c1.z); xf[7] *= d1.w * __expf(tot - c1.w);
            v4u w; w.x = pk2(xf[0], xf[1]); w.y = pk2(xf[2], xf[3]); w.z = pk2(xf[4], xf[5]); w.w = pk2(xf[6], xf[7]);
            a[ks] = __builtin_bit_cast(bf16x8, w);
        }
        unsigned short* out = DSS + (ssd_chain(dir, b, g * 3 + hg) * SNCC + cc) * 8192;
#pragma unroll
        for (int tn = 0; tn < 8; ++tn) {
            f32x4 acc = {0.f, 0.f, 0.f, 0.f};
#pragma unroll
            for (int ks = 0; ks < 4; ++ks) {
                const bf16x8 bb = *(const LAS bf16x8*)(lds + SD_BM + ((16 * tn + fr) * SD_S + 32 * ks + 8 * fq) * 2);
                acc = __builtin_amdgcn_mfma_f32_16x16x32_bf16(bb, a[ks], acc, 0, 0, 0);
            }
            *(unsigned long long*)(out + (16 * tp + fr) * 128 + 16 * tn + 4 * fq) = (unsigned long long)pk2(acc[0], acc[1]) | ((unsigned long long)pk2(acc[2], acc[3]) << 32);
        }
    }
    __syncthreads();
}
template <int NSTEP, int BATCH>
__device__ __forceinline__ void ssd_s3_seg(float (&S)[8], unsigned short* DSS, const float* DECS, size_t base, int cc0, int step, int el) {
    static_assert(NSTEP % BATCH == 0, "");
#pragma unroll 1
    for (int k0 = 0; k0 < NSTEP; k0 += BATCH) {
        v4u d[BATCH]; float dc[BATCH];
#pragma unroll
        for (int j = 0; j < BATCH; ++j) { const size_t u = base + cc0 + (k0 + j) * step; d[j] = *(const v4u*)(DSS + u * 8192 + el); dc[j] = DECS[u]; }
#pragma unroll
        for (int j = 0; j < BATCH; ++j) { const size_t u = base + cc0 + (k0 + j) * step;
            v4u w; w.x = pk2(S[0], S[1]); w.y = pk2(S[2], S[3]); w.z = pk2(S[4], S[5]); w.w = pk2(S[6], S[7]);
            *(v4u*)(DSS + u * 8192 + el) = w;
            float df[8]; unpack8(d[j], df);
#pragma unroll
            for (int e = 0; e < 8; ++e) S[e] = S[e] * dc[j] + df[e]; }
    }
}
__device__ __forceinline__ void ssd_s3(long tid, long nth, unsigned short* DSS, const float* DECS) {
    for (long i = tid; i < 2L * NB * 6 * 1024; i += nth) {
        const int el = (int)(i & 1023) * 8, chain = (int)(i >> 10), dir = chain / (NB * 6);
        const size_t base = (size_t)chain * SNCC;
        float z0 = 0.f; asm volatile("" : "+v"(z0));
        float S[8] = {z0, z0, z0, z0, z0, z0, z0, z0};
        if (dir == 0) { ssd_s3_seg<SCTXC, SCTXC>(S, DSS, DECS, base, 0, 1, el); ssd_s3_seg<SNCC - SCTXC, 8>(S, DSS, DECS, base, SCTXC, 1, el); }
        else { ssd_s3_seg<SCTXC, SCTXC>(S, DSS, DECS, base, SCTXC - 1, -1, el); ssd_s3_seg<SNCC - SCTXC, 8>(S, DSS, DECS, base, SNCC - 1, -1, el); }
    }
}
__device__ __forceinline__ void ssd_load_h(const unsigned short* HSS, int b, int head, int cc, int tix, v4u (&h)[2][2]) {
#pragma unroll
    for (int dir = 0; dir < 2; ++dir) {
        const unsigned short* hsrc = HSS + (ssd_chain(dir, b, head) * SNCC + cc) * 8192 + (tix >> 3) * 128 + (tix & 7) * 16;
        h[dir][0] = *(const v4u*)hsrc; h[dir][1] = *(const v4u*)(hsrc + 8);
    }
}
__device__ __forceinline__ void ssd_s4_unit(const Params& p, int l, LAS unsigned char* lds, int u, int tix, const unsigned short* HSS) {
    const int b = u / (2 * SNCC), g = (u / SNCC) & 1, cc = u % SNCC;
    const int lane = tix & 63, wave = __builtin_amdgcn_readfirstlane(tix >> 6), fr = lane & 15, fq = lane >> 4;
    ssd_scans(p, l, lds, b, g, cc, wave, lane);
    ssd_stage<false, true>(p, l, lds, b, g, cc, tix);
    __syncthreads();
    LAS unsigned char* cm_rd = lds + SD_CM + ((16 * wave + fr) * SD_S + 8 * fq) * 2;
    LAS unsigned char* bm_rd = lds + SD_BM + (fr * SD_S + 8 * fq) * 2;
    LAS unsigned char* m_rd = lds + SD_BM + ((16 * wave + fr) * SD_S + 8 * fq) * 2;
    LAS unsigned char* m_wr = lds + SD_BM + ((16 * wave + 4 * fq) * SD_S + fr) * 2;
    LAS unsigned char* xt_rd = lds + SD_XT + (fr * SD_S + 8 * fq) * 2;
    LAS unsigned char* hs_rd = lds + SD_HS + (fr * SD_S + 8 * fq) * 2;
    LAS unsigned char* hs_wr = lds + SD_HS + ((tix >> 3) * SD_S + (tix & 7) * 16) * 2;
    LAS unsigned char* sc_j = lds + SD_DTL + fr * 4;
    LAS unsigned char* sc_i = lds + SD_DTL + (16 * wave + 4 * fq) * 4;
    asm volatile("" : "+v"(cm_rd), "+v"(bm_rd), "+v"(m_rd), "+v"(m_wr), "+v"(xt_rd), "+v"(hs_rd), "+v"(hs_wr), "+v"(sc_j), "+v"(sc_i));
    f32x4 cb[8];
    bf16x8 ca[4];
#pragma unroll
    for (int ks = 0; ks < 4; ++ks) ca[ks] = *(const LAS bf16x8*)(cm_rd + 64 * ks);
#pragma unroll
    for (int tj = 0; tj < 8; ++tj) {
        cb[tj] = (f32x4){0.f, 0.f, 0.f, 0.f};
#pragma unroll
        for (int ks = 0; ks < 4; ++ks) {
            const bf16x8 bb = *(const LAS bf16x8*)(bm_rd + (16 * tj * SD_S + 32 * ks) * 2);
            cb[tj] = __builtin_amdgcn_mfma_f32_16x16x32_bf16(ca[ks], bb, cb[tj], 0, 0, 0);
        }
    }
    __syncthreads();
    f32x4 yacc[3][4];
#pragma unroll
    for (int hg = 0; hg < 3; ++hg)
#pragma unroll
        for (int tp = 0; tp < 4; ++tp) yacc[hg][tp] = (f32x4){0.f, 0.f, 0.f, 0.f};
#pragma unroll
    for (int hg = 0; hg < 3; ++hg) {
        v4u hreg[2][2];
        ssd_load_h(HSS, b, g * 3 + hg, cc, tix, hreg);
        __builtin_amdgcn_sched_barrier(0);
        float csfi[4], csbi[4];
#pragma unroll
        for (int r = 0; r < 4; ++r) { csfi[r] = *(const LAS float*)(sc_i + 3072 + hg * 512 + 4 * r); csbi[r] = *(const LAS float*)(sc_i + 3072 + (3 + hg) * 512 + 4 * r); }
#pragma unroll
        for (int tj = 0; tj < 8; ++tj) {
            const int j = 16 * tj + fr;
            const float csfj = *(const LAS float*)(sc_j + 3072 + hg * 512 + 64 * tj), csbj = *(const LAS float*)(sc_j + 3072 + (3 + hg) * 512 + 64 * tj);
            const float dtfj = *(const LAS float*)(sc_j + hg * 512 + 64 * tj), dtbj = *(const LAS float*)(sc_j + (3 + hg) * 512 + 64 * tj);
#pragma unroll
            for (int r = 0; r < 4; ++r) { const int i = 16 * wave + 4 * fq + r;
                const float arg = (j <= i) ? csfi[r] - csfj : csbi[r] - csbj;
                const float wgt = (j < i) ? dtfj : ((j > i) ? dtbj : dtfj + dtbj);
                *(LAS unsigned short*)(m_wr + (r * SD_S + 16 * tj) * 2) = (unsigned short)f2bf_u(cb[tj][r] * __expf(fminf(arg, 0.f)) * wgt); }
            __builtin_amdgcn_sched_barrier(0);
        }
        __builtin_amdgcn_sched_barrier(0);
#pragma unroll
        for (int dir = 0; dir < 2; ++dir) {
            *(LAS v4u*)(hs_wr + dir * SD_HS2OFF) = hreg[dir][0]; *(LAS v4u*)(hs_wr + dir * SD_HS2OFF + 16) = hreg[dir][1];
        }
        __syncthreads();
        f32x4 tmp[4];
#pragma unroll
        for (int tp = 0; tp < 4; ++tp) tmp[tp] = (f32x4){0.f, 0.f, 0.f, 0.f};
#pragma unroll
        for (int ks = 0; ks < 4; ++ks) {
            const bf16x8 am = *(const LAS bf16x8*)(m_rd + 64 * ks);
#pragma unroll
            for (int tp = 0; tp < 4; ++tp) {
                const bf16x8 bx = *(const LAS bf16x8*)(xt_rd + ((hg * 64 + 16 * tp) * SD_S + 32 * ks) * 2);
                yacc[hg][tp] = __builtin_amdgcn_mfma_f32_16x16x32_bf16(am, bx, yacc[hg][tp], 0, 0, 0);
                const bf16x8 bhf = *(const LAS bf16x8*)(hs_rd + (16 * tp * SD_S + 32 * ks) * 2);
                tmp[tp] = __builtin_amdgcn_mfma_f32_16x16x32_bf16(ca[ks], bhf, tmp[tp], 0, 0, 0);
            }
        }
#pragma unroll
        for (int r = 0; r < 4; ++r) { const float ef = __expf(csfi[r]);
#pragma unroll
            for (int tp = 0; tp < 4; ++tp) { yacc[hg][tp][r] += ef * tmp[tp][r]; tmp[tp][r] = 0.f; } }
#pragma unroll
        for (int ks = 0; ks < 4; ++ks)
#pragma unroll
            for (int tp = 0; tp < 4; ++tp) {
                const bf16x8 bhb = *(const LAS bf16x8*)(hs_rd + SD_HS2OFF + (16 * tp * SD_S + 32 * ks) * 2);
                tmp[tp] = __builtin_amdgcn_mfma_f32_16x16x32_bf16(ca[ks], bhb, tmp[tp], 0, 0, 0);
            }
#pragma unroll
        for (int r = 0; r < 4; ++r) { const float eb = __expf(csbi[r]);
#pragma unroll
            for (int tp = 0; tp < 4; ++tp) yacc[hg][tp][r] += eb * tmp[tp][r]; }
        __syncthreads();
    }
#pragma unroll
    for (int hg = 0; hg < 3; ++hg) {
        const float dcoef = p.ssd_d[l * 6 + g * 3 + hg];
#pragma unroll
        for (int tp = 0; tp < 4; ++tp) {
            const int pc = hg * 64 + 16 * tp + fr;
#pragma unroll
            for (int r = 0; r < 4; ++r)
                yacc[hg][tp][r] += dcoef * bflo((unsigned)((const LAS unsigned short*)(lds + SD_XT))[pc * SD_S + 16 * wave + 4 * fq + r]);
        }
    }
    __syncthreads();
    {
        LAS float* YL = (LAS float*)lds;
#pragma unroll
        for (int hg = 0; hg < 3; ++hg)
#pragma unroll
            for (int tp = 0; tp < 4; ++tp)
#pragma unroll
                for (int r = 0; r < 4; ++r) YL[(16 * wave + 4 * fq + r) * 196 + hg * 64 + 16 * tp + fr] = yacc[hg][tp][r];
        const float nw0 = p.ssd_norm_w[l * 384 + g * 192 + lane], nw1 = p.ssd_norm_w[l * 384 + g * 192 + 64 + lane], nw2 = p.ssd_norm_w[l * 384 + g * 192 + 128 + lane];
#pragma unroll 1
        for (int r8 = 0; r8 < 16; r8 += 8) {
            unsigned short zr[8][3];
#pragma unroll
            for (int k = 0; k < 8; ++k) {
                const act_t* zp = p.P + (size_t)ssd_row(b, cc, 16 * wave + r8 + k) * LDP + OFF_Z + g * 192 + lane;
                zr[k][0] = zp[0]; zr[k][1] = zp[64]; zr[k][2] = zp[128];
            }
#pragma unroll
            for (int k = 0; k < 8; ++k) {
                const int i = 16 * wave + r8 + k;
                const float z0 = bflo(zr[k][0]), z1 = bflo(zr[k][1]), z2 = bflo(zr[k][2]);
                const float v0 = YL[i * 196 + lane] * (z0 / (1.0f + __expf(-z0))), v1 = YL[i * 196 + 64 + lane] * (z1 / (1.0f + __expf(-z1))), v2 = YL[i * 196 + 128 + lane] * (z2 / (1.0f + __expf(-z2)));
                const float rs = 1.0f / sqrtf(wave_sum(v0 * v0 + v1 * v1 + v2 * v2, lane) * (1.0f / 192.0f) + EPSV);
                act_t* yp = p.Y + (size_t)ssd_row(b, cc, i) * DM + 640 + g * 192 + lane;
                stact(yp, v0 * rs * nw0); stact(yp + 64, v1 * rs * nw1); stact(yp + 128, v2 * rs * nw2);
            }
        }
    }
    __syncthreads();
}

typedef float f32x16 __attribute__((ext_vector_type(16)));
constexpr int HY_CP = 0, HY_MOFF = 4352, HY_U = 17920, HY_US = 264, HY_OUT = 85504;
__device__ __forceinline__ void hy_u8(const Params& p, int l, int b, int t, int col0, float (&y)[8]) {
    const act_t* rc = p.P + (size_t)(b * SEQ + t) * LDP + OFF_HY + col0;
    const float* w = p.hy_short_w + (size_t)l * 3 * 768 + col0; const float* bs = p.hy_short_b + (size_t)l * 768 + col0;
    float xc[8]; unpack8(*(const v4u*)rc, xc);
#pragma unroll
    for (int e = 0; e < 8; ++e) y[e] = bs[e] + w[768 + e] * xc[e];
    if (t > 0) { float xp[8]; unpack8(*(const v4u*)(rc - LDP), xp);
#pragma unroll
        for (int e = 0; e < 8; ++e) y[e] += w[e] * xp[e]; }
    if (t + 1 < SEQ) { float xn[8]; unpack8(*(const v4u*)(rc + LDP), xn);
#pragma unroll
        for (int e = 0; e < 8; ++e) y[e] += w[2 * 768 + e] * xn[e]; }
}

__device__ __forceinline__ void hy_ctx_conv(const Params& p, int l, long tid, long nth) {
    for (long i = tid; i < (long)BC * 256; i += nth) {
        const int c = (int)(i & 255), r = BL + (int)(i >> 8);
        const int s = NB + (r - BL) / CTX, r0 = seq_row0(s), t = r - r0;
        const float* hf = p.HFC + (size_t)l * CTX * 256 + c;
        int jlo = t + CTX / 2 - (CTX - 1); if (jlo < 0) jlo = 0;
        int jhi = t + CTX / 2; if (jhi > CTX - 1) jhi = CTX - 1;
        float acc = 0.f;
#pragma unroll 8
        for (int j = jlo; j <= jhi; ++j) acc += hf[(size_t)(t - j + CTX / 2) * 256] * p.VX[(size_t)(r0 + j) * 256 + c];
        const float x0 = hy_u(p, l, s, t, c);
        stact(p.Y + (size_t)r * DM + 384 + c, (acc + p.VX[(size_t)r * 256 + c] * p.hy_bias[l * 256 + c]) * x0);
    }
}
__device__ __forceinline__ void hy_h1_unit(const Params& p, int l, LAS unsigned char* lds, int u, int tix) {
    const int b = u / (SEQ / 64), t0 = (u % (SEQ / 64)) * 64;
    const int t = tix & 63, cg = tix >> 6;
    LAS unsigned short* T = (LAS unsigned short*)lds;
#pragma unroll 1
    for (int o = 0; o < 4; ++o) {
        const int c0 = 32 * cg + 8 * o;
        float x1[8], v[8]; hy_u8(p, l, b, t0 + t, 256 + c0, x1); hy_u8(p, l, b, t0 + t, 512 + c0, v);
#pragma unroll
        for (int e = 0; e < 8; ++e) T[(c0 + e) * 72 + t] = (unsigned short)f2bf_u(v[e] * x1[e]);
    }
    __syncthreads();
    {
        const int c = tix >> 1, half = tix & 1;
        unsigned short* dst = p.VXT + ((size_t)(b * 256 + c)) * SEQ + t0 + 32 * half;
#pragma unroll
        for (int k = 0; k < 4; ++k) *(v4u*)(dst + 8 * k) = *(const LAS v4u*)(lds + (c * 72 + 32 * half + 8 * k) * 2);
    }
    __syncthreads();
}
template <int ALPHA>
__device__ __forceinline__ bf16x8 hy_afrag(const LAS unsigned char* a) {
    constexpr int SFT = 8 - ALPHA, SIG = SFT >> 1, HALF = SFT & 1;
    const v4u Y = *(const LAS v4u*)(a + 16);
    if constexpr (ALPHA == 0) { return __builtin_bit_cast(bf16x8, Y); }
    else {
        const v4u X = *(const LAS v4u*)a;
        const unsigned W[9] = { X.x, X.y, X.z, X.w, Y.x, Y.y, Y.z, Y.w, 0u };
        v4u o;
        o.x = HALF ? __builtin_amdgcn_alignbit(W[SIG + 1], W[SIG + 0], 16) : W[SIG + 0];
        o.y = HALF ? __builtin_amdgcn_alignbit(W[SIG + 2], W[SIG + 1], 16) : W[SIG + 1];
        o.z = HALF ? __builtin_amdgcn_alignbit(W[SIG + 3], W[SIG + 2], 16) : W[SIG + 2];
        o.w = HALF ? __builtin_amdgcn_alignbit(W[SIG + 4], W[SIG + 3], 16) : W[SIG + 3];
        return __builtin_bit_cast(bf16x8, o);
    }
}
template <int ALPHA>
__device__ __forceinline__ void hy_stream(LAS unsigned char* lds, int lane, f32x16 (&acc)[4]) {
    const int r = lane & 31, hf = lane >> 5, Il = r >> 2, bt = r & 3;
    LAS unsigned char* a_base = lds + HY_CP + 2 * (HY_MOFF + 8 * (hf - r) + 4096) - 12288;
    LAS unsigned char* b_base = lds + HY_U + ((Il * 4 + bt) * HY_US + 8 * hf) * 2;
    asm volatile("" : "+v"(a_base), "+v"(b_base));
    const bf16x8 zero8 = {0, 0, 0, 0, 0, 0, 0, 0};
#pragma unroll 1
    for (int s = 0; s < 16; ++s) {
        LAS unsigned char* ap = a_base + 32 * s; LAS unsigned char* bp = b_base + 32 * s;
#pragma unroll 1
        for (int delta = 0; delta < 8; ++delta) {
            const bf16x8 a0 = hy_afrag<ALPHA>(ap + 3 * 4096), a1 = hy_afrag<ALPHA>(ap + 2 * 4096), a2 = hy_afrag<ALPHA>(ap + 4096), a3 = hy_afrag<ALPHA>(ap);
            bf16x8 b0 = *(const LAS bf16x8*)bp, b1 = *(const LAS bf16x8*)(bp + 16896), b2 = *(const LAS bf16x8*)(bp + 2 * 16896);
            LAS unsigned char* bp3 = bp + 3 * 16896;
            bf16x8 b3 = *(const LAS bf16x8*)bp3, b4 = *(const LAS bf16x8*)(bp3 + 16896);
            b0 = (Il >= delta) ? b0 : zero8; b4 = (Il < delta) ? b4 : zero8;
            acc[0] = __builtin_amdgcn_mfma_f32_32x32x16_bf16(a0, b2, acc[0], 0, 0, 0);
            acc[1] = __builtin_amdgcn_mfma_f32_32x32x16_bf16(a0, b3, acc[1], 0, 0, 0);
            acc[2] = __builtin_amdgcn_mfma_f32_32x32x16_bf16(a0, b4, acc[2], 0, 0, 0);
            acc[3] = __builtin_amdgcn_mfma_f32_32x32x16_bf16(a1, b4, acc[3], 0, 0, 0);
            acc[0] = __builtin_amdgcn_mfma_f32_32x32x16_bf16(a1, b1, acc[0], 0, 0, 0);
            acc[1] = __builtin_amdgcn_mfma_f32_32x32x16_bf16(a1, b2, acc[1], 0, 0, 0);
            acc[2] = __builtin_amdgcn_mfma_f32_32x32x16_bf16(a1, b3, acc[2], 0, 0, 0);
            acc[3] = __builtin_amdgcn_mfma_f32_32x32x16_bf16(a2, b3, acc[3], 0, 0, 0);
            acc[0] = __builtin_amdgcn_mfma_f32_32x32x16_bf16(a2, b0, acc[0], 0, 0, 0);
            acc[1] = __builtin_amdgcn_mfma_f32_32x32x16_bf16(a2, b1, acc[1], 0, 0, 0);
            acc[2] = __builtin_amdgcn_mfma_f32_32x32x16_bf16(a2, b2, acc[2], 0, 0, 0);
            acc[3] = __builtin_amdgcn_mfma_f32_32x32x16_bf16(a3, b2, acc[3], 0, 0, 0);
            acc[1] = __builtin_amdgcn_mfma_f32_32x32x16_bf16(a3, b0, acc[1], 0, 0, 0);
            acc[2] = __builtin_amdgcn_mfma_f32_32x32x16_bf16(a3, b1, acc[2], 0, 0, 0);
            if (delta == 0) {
                const bf16x8 a4 = hy_afrag<ALPHA>(ap - 4096);
                acc[2] = __builtin_amdgcn_mfma_f32_32x32x16_bf16(a4, b0, acc[2], 0, 0, 0);
                acc[3] = __builtin_amdgcn_mfma_f32_32x32x16_bf16(a4, b1, acc[3], 0, 0, 0);
            }
            ap -= 512; bp -= 2112;
        }
    }
}
__device__ __forceinline__ void hy_h2_channel(const Params& p, int l, LAS unsigned char* lds, int c, int tix) {
    const int lane = tix & 63, wave = __builtin_amdgcn_readfirstlane(tix >> 6);
    __syncthreads();
    for (int item = tix; item < 4096; item += 512) {
        const int bt = item >> 10, j = (item & 1023) * 8;
        *(LAS v4u*)(lds + HY_U + (((j >> 8) * 4 + bt) * HY_US + (j & 255)) * 2) = *(const v4u*)(p.VXT + ((size_t)(bt * 256 + c)) * SEQ + j);
    }
    {
        const unsigned short* g1 = p.G1 + ((size_t)l * 256 + c) * G1N;
        for (int item = tix; item < G1N / 8; item += 512) *(LAS v4u*)(lds + HY_CP + item * 16) = *(const v4u*)(g1 + item * 8);
    }
    __syncthreads();
    f32x16 acc[4];
#pragma unroll
    for (int i = 0; i < 4; ++i)
#pragma unroll
        for (int k = 0; k < 16; ++k) acc[i][k] = 0.f;
    switch (wave) {
        case 0: hy_stream<0>(lds, lane, acc); break;
        case 1: hy_stream<1>(lds, lane, acc); break;
        case 2: hy_stream<2>(lds, lane, acc); break;
        case 3: hy_stream<3>(lds, lane, acc); break;
        case 4: hy_stream<4>(lds, lane, acc); break;
        case 5: hy_stream<5>(lds, lane, acc); break;
        case 6: hy_stream<6>(lds, lane, acc); break;
        default: hy_stream<7>(lds, lane, acc); break;
    }
    const int r = lane & 31, hf = lane >> 5;
    LAS float* ST = (LAS float*)(lds + HY_U);
#pragma unroll
    for (int half = 0; half < 2; ++half) {
        __syncthreads();
#pragma unroll
        for (int ii = 0; ii < 2; ++ii)
#pragma unroll
            for (int k = 0; k < 16; ++k)
                ST[(32 * ii + r) * 257 + 8 * ((k & 3) + 8 * (k >> 2) + 4 * hf) + wave] = acc[2 * half + ii][k];
        __syncthreads();
        for (int item = tix; item < 64 * 64; item += 512) {
            const int R = item >> 6, c4 = (item & 63) * 4;
            f32x4 v; v.x = ST[R * 257 + c4]; v.y = ST[R * 257 + c4 + 1]; v.z = ST[R * 257 + c4 + 2]; v.w = ST[R * 257 + c4 + 3];
            *(f32x4*)(p.CONV + ((size_t)((R & 3) * 256 + c)) * SEQ + 256 * (16 * half + (R >> 2)) + c4) = v;
        }
    }
}
__device__ __forceinline__ void hy_h3_unit(const Params& p, int l, LAS unsigned char* lds, int u, int tix) {
    const int b = u / (SEQ / 64), t0 = (u % (SEQ / 64)) * 64;
    LAS float* T = (LAS float*)lds;
    for (int item = tix; item < 4096; item += 512) {
        const int c = item >> 4, t4 = (item & 15) * 4;
        *(LAS f32x4*)(T + c * 68 + t4) = *(const f32x4*)(p.CONV + ((size_t)(b * 256 + c)) * SEQ + t0 + t4);
    }
    __syncthreads();
    const int t = tix & 63, cg = tix >> 6;
#pragma unroll 1
    for (int o = 0; o < 4; ++o) {
        const int c0 = 32 * cg + 8 * o;
        float x0[8], x1[8], v[8]; hy_u8(p, l, b, t0 + t, c0, x0); hy_u8(p, l, b, t0 + t, 256 + c0, x1); hy_u8(p, l, b, t0 + t, 512 + c0, v);
        float y[8];
#pragma unroll
        for (int e = 0; e < 8; ++e) y[e] = (T[(c0 + e) * 68 + t] + v[e] * x1[e] * p.hy_bias[l * 256 + c0 + e]) * x0[e];
        v4u w; w.x = pk2(y[0], y[1]); w.y = pk2(y[2], y[3]); w.z = pk2(y[4], y[5]); w.w = pk2(y[6], y[7]);
        *(v4u*)(p.Y + (size_t)(b * SEQ + t0 + t) * DM + 384 + c0) = w;
    }
    __syncthreads();
}

__global__ void __launch_bounds__(512, 2) mega_fwd(Params p_arg) {
    extern __shared__ __attribute__((aligned(16))) unsigned char lds_raw[];
    LAS unsigned char* lds = (LAS unsigned char*)lds_raw;
    cg::grid_group grid = cg::this_grid();
    const long nth = (long)gridDim.x * 512;
    const int NGW = gridDim.x * 8, G = gridDim.x;
    const int wave_s = __builtin_amdgcn_readfirstlane((int)threadIdx.x >> 6);
#define MY_TIX() ([&]() { unsigned z_ = 0u; asm volatile("" : "+v"(z_)); return (wave_s << 6) | (int)__builtin_amdgcn_mbcnt_hi(~0u, __builtin_amdgcn_mbcnt_lo(~0u, z_)); }())
    constexpr int LDS_BARW = LDS_BYTES - 64;
    if (threadIdx.x < 2) ((LAS unsigned*)(lds + LDS_BARW))[threadIdx.x] = 0u;
    __syncthreads();
    { const __attribute__((address_space(4))) Params* kp0 = (const __attribute__((address_space(4))) Params*)__builtin_amdgcn_kernarg_segment_ptr();
      (void)xcd_barrier_post(kp0->BAR, (volatile LAS unsigned*)(lds + LDS_BARW)); }
#define GSYNC() do { const __attribute__((address_space(4))) Params* kpb_ = (const __attribute__((address_space(4))) Params*)__builtin_amdgcn_kernarg_segment_ptr(); \
    asm volatile("" : "+s"(kpb_)); XcdBarrier xb_; xb_.bar = kpb_->BAR; xb_.x = xb_xcc_id(); xb_.st = (volatile LAS unsigned*)(lds + LDS_BARW); xcd_barrier(xb_, MY_TIX() == 0); } while (0)
#define PH_IDS() int tix_ = MY_TIX(); asm volatile("" : "+v"(tix_)); const long tid = (long)blockIdx.x * 512 + tix_; const int lane = tix_ & 63; \
    const int wave = __builtin_amdgcn_readfirstlane(tix_ >> 6); const int gw = blockIdx.x * 8 + wave; (void)tid; (void)lane; (void)gw; \
    const __attribute__((address_space(4))) Params* kp_ = (const __attribute__((address_space(4))) Params*)__builtin_amdgcn_kernarg_segment_ptr(); \
    asm volatile("" : "+s"(kp_)); const Params& p = *(const Params*)kp_;

    for (int rep = 0; rep < REP_PRO; ++rep) {
    { PH_IDS(); mod_partial(p, tid, nth, (float*)p.DSS);
      prologue_weights(p, (LAS float*)(lds + wave * 16384), gw, NGW, lane);
      filt_all(p, lds, tid, nth, tix_, blockIdx.x, G); }
    grid.sync();
    { PH_IDS(); mod_reduce(p, tid, nth, (const float*)p.DSS); }
    GSYNC();
    }
#pragma unroll 1
    for (int l = 0; l < DEPTH; ++l) {
        const int nrows = (l == DEPTH - 1) ? BL : NT;
        for (int rep = 0; rep < REP_HX; ++rep) {
        { PH_IDS(); hx_pass<false>(p, l, 0, 0, (CTX_SPLITK && l > 0) ? BL : NT, gw, NGW, lane); }
        if (CTX_SPLITK && l > 0) { PH_IDS(); hx_pass<true>(p, l, 0, BL, NT, gw, NGW, lane, DFF / 256, (const float*)p.DSG, p.MOD + ((size_t)(l - 1) * (NB + 1) + NB) * 6 * DM + 5 * DM, false); }
        GSYNC();
        }
        for (int rep = 0; rep < REP_G1; ++rep)
        {   PH_IDS();
            pg8::Gemm g{p.Y, p.WIN_T + (size_t)l * LDP * DM, NT, LDP, DM, DM}; pg8::StaticOrder S; S.init(NT, LDP, G, (int)blockIdx.x);
            pg8::EpiBf16<0> E{p.P, LDP, nullptr, 0, 0, 1.f};
            pg8::gemm_phase<pg8::EpiBf16<0>, pg8::StaticOrder, true, true>(lds, g, S, E, tix_);
            GSYNC();
        }
        for (int rep = 0; rep < REP_MIX; ++rep) {
        for (int qa = 0; qa < REP_PA; ++qa)
        {   PH_IDS();
            for (int u = blockIdx.x; u < SSD_UNITS; u += G) ssd_s2_unit(p, l, lds, u, tix_, p.DSS, p.DECS);
            gla_m2_phase(p, l, lds, tix_, blockIdx.x, p.DSG, p.DECG);
            for (int u = blockIdx.x; u < NB * (SEQ / 64); u += G) hy_h1_unit(p, l, lds, u, tix_);
            if (l < DEPTH - 1) st_hy_pre(p, l, tid, nth, BL, NT);
        }
        GSYNC();
        {   PH_IDS();
            for (int q = 0; q < REP_H2; ++q) for (int c = blockIdx.x; c < 256; c += G) hy_h2_channel(p, l, lds, c, tix_);
            {
                const long vt = ((long)wave * G + blockIdx.x) * 64 + lane;
                if (nth >= 131072) {
                    if (vt < 49152) ssd_s3(vt, 49152, p.DSS, p.DECS);
                    else if (vt < 49152 + 24576) { for (int q = 0; q < REP_M3; ++q) gla_m3(vt - 49152, 24576, p.DSG, p.DECG, p.SSG); }
                    else if (l < DEPTH - 1) hy_ctx_conv(p, l, vt - (49152 + 24576), nth - (49152 + 24576));
                } else { ssd_s3(vt, nth, p.DSS, p.DECS); gla_m3(vt, nth, p.DSG, p.DECG, p.SSG); if (l < DEPTH - 1) hy_ctx_conv(p, l, vt, nth); }
            }
        }
        GSYNC();
        for (int qc = 0; qc < REP_PC; ++qc)
        {   PH_IDS();
            for (int u = blockIdx.x; u < SSD_UNITS; u += G) ssd_s4_unit(p, l, lds, u, tix_, p.DSS);
            gla_m4_phase(p, l, lds, tix_, blockIdx.x, p.SSG);
            for (int u = blockIdx.x; u < NB * (SEQ / 64); u += G) hy_h3_unit(p, l, lds, u, tix_);
        }
        GSYNC();
        }
        {   PH_IDS();
            const int mrows = (CTX_SPLITK || l == DEPTH - 1) ? BL : NT; pg8::Gemm g{p.Y, p.WOUT_T + (size_t)l * DM * DM, mrows, DM, DM, DM}; pg8::StaticOrder S; S.init(mrows, DM, G, (int)blockIdx.x);
            pg8::EpiRes E{p.XL, p.XC, p.MOD + (size_t)l * (NB + 1) * 6 * DM, 2, l == 0 ? p.x : p.XL, l == 0 ? p.ctx : p.XC};
            pg8::gemm_phase<pg8::EpiRes, pg8::StaticOrder, true, true>(lds, g, S, E, tix_);
        }
        if (CTX_SPLITK && l < DEPTH - 1) {   PH_IDS();
            {
                pg8::Gemm gc{p.Y + (size_t)BL * DM, p.WOUT_T + (size_t)l * DM * DM, BC, DM, 256, DM}; pg8::SplitKOrder SC; SC.init(BC, DM, DM / 256, 256, G, (int)blockIdx.x);
                pg8::EpiSlab EC{(float*)p.DSG, BC, 512};
                pg8::gemm_phase<pg8::EpiSlab, pg8::SplitKOrder, true, true>(lds, gc, SC, EC, tix_);
            }
        }
        GSYNC();
        for (int rep = 0; rep < REP_HX; ++rep) {
        { PH_IDS(); hx_pass<false>(p, l, 1, 0, CTX_SPLITK ? BL : nrows, gw, NGW, lane); }
        if (CTX_SPLITK && l < DEPTH - 1) { PH_IDS(); hx_pass<true>(p, l, 1, BL, NT, gw, NGW, lane, DM / 256, (const float*)p.DSG, p.MOD + ((size_t)l * (NB + 1) + NB) * 6 * DM + 2 * DM, l == 0); }
        GSYNC();
        }
        for (int rep = 0; rep < REP_G3; ++rep)
        {   PH_IDS();
            pg8::Gemm g{p.Y, p.W13_T + (size_t)l * NFF2 * DM, nrows, NFF2, DM, DM}; pg8::StaticOrder S; S.init(nrows, NFF2, G, (int)blockIdx.x);
            pg8::EpiSwiGLU E{p.P};
            pg8::gemm_phase<pg8::EpiSwiGLU, pg8::StaticOrder, true, true>(lds, g, S, E, tix_);
            GSYNC();
        }
        {   PH_IDS();
            const int mrows = (CTX_SPLITK || l == DEPTH - 1) ? BL : NT; pg8::Gemm g{p.P, p.W2_T + (size_t)l * DM * DFF, mrows, DM, DFF, DFF}; pg8::StaticOrder S; S.init(mrows, DM, G, (int)blockIdx.x);
            pg8::EpiRes E{p.XL, p.XC, p.MOD + (size_t)l * (NB + 1) * 6 * DM, 5, p.XL, p.XC};
            pg8::gemm_phase<pg8::EpiRes, pg8::StaticOrder, true, true>(lds, g, S, E, tix_);
        }
        if (CTX_SPLITK && l < DEPTH - 1) {   PH_IDS();
            {
                pg8::Gemm gc{p.P + (size_t)BL * DFF, p.W2_T + (size_t)l * DM * DFF, BC, DM, 256, DFF}; pg8::SplitKOrder SC; SC.init(BC, DM, DFF / 256, 256, G, (int)blockIdx.x);
                pg8::EpiSlab EC{(float*)p.DSG, BC, 512};
                pg8::gemm_phase<pg8::EpiSlab, pg8::SplitKOrder, true, true>(lds, gc, SC, EC, tix_);
            }
        }
        GSYNC();
    }
    { PH_IDS(); final_pass(p, gw, NGW, lane); }
}

extern "C" void kernel_launch(void* const* d_in, const int* in_sizes, int n_in, void* d_out, int out_size,
                              void* d_ws, size_t ws_size, hipStream_t stream) {
    static int grid_blocks = 0;
    if (!grid_blocks) {
        int dev = 0, cus = 0, per_cu = 0;
        (void)hipGetDevice(&dev);
        (void)hipDeviceGetAttribute(&cus, hipDeviceAttributeMultiprocessorCount, dev);
        (void)hipFuncSetAttribute((const void*)mega_fwd, hipFuncAttributeMaxDynamicSharedMemorySize, LDS_BYTES);
        (void)hipOccupancyMaxActiveBlocksPerMultiprocessor(&per_cu, mega_fwd, 512, LDS_BYTES);
        if (per_cu < 1) per_cu = 1;
        grid_blocks = cus;
    }
    Params p{};
    fill_inputs(p, d_in);
    carve(p, (char*)d_ws, (float*)d_out);
    (void)hipMemsetAsync(p.BAR, 0, 16384, stream);
    void* args[] = { &p };
    hipError_t e = hipLaunchCooperativeKernel((void*)mega_fwd, dim3(grid_blocks), dim3(512), args, LDS_BYTES, stream);
    if (e != hipSuccess) fprintf(stderr, "cooperative launch failed: %s (grid %d)\n", hipGetErrorString(e), grid_blocks);
}
#endif
```

```cpp
#ifndef CPU_EMU
#include <hip/hip_runtime.h>
#include <hip/hip_cooperative_groups.h>
#include <cstdio>
#else
#include <cmath>
#include <cstring>
#include <cstdio>
#include <cstdlib>
#define __device__
#define __global__
#define __forceinline__ inline
#define __host__
#endif
#include <stdint.h>
#include <stddef.h>

#ifndef NB
#define NB 4
#endif
#ifndef SEQ
#define SEQ 8192
#endif
#ifndef CTX
#define CTX 256
#endif
#define DEPTH 2
#define DM 1024
#define GRID_W 64
#define ROWS_G (SEQ / GRID_W)
#define BL (NB * SEQ)
#define BC (NB * CTX)
#define NT (BL + BC)
#define NSEQ (2 * NB)
#define DIN 3244
#define LDP 3328
#define NFF2 (2 * DFF)
#define OFF_Q 0
#define OFF_K 192
#define OFF_V 384
#define OFF_G 768
#define OFF_GKF 1152
#define OFF_GKB 1168
#define OFF_HY 1184
#define OFF_Z 1952
#define OFF_XBC 2336
#define OFF_DTF 3232
#define OFF_DTB 3238
#define DFF 2816
#define TF (SEQ + CTX)
#define G1N 8720
#define EPSV 1e-6f

#ifdef ACT_FP32
typedef float act_t;
__device__ __forceinline__ float ldact(const act_t* p) { return *p; }
__device__ __forceinline__ void stact(act_t* p, float v) { *p = v; }
#else
typedef unsigned short act_t;
__device__ __forceinline__ float ldact(const act_t* p) {
    union { unsigned u; float f; } x; x.u = ((unsigned)*p) << 16; return x.f;
}
__device__ __forceinline__ void stact(act_t* p, float v) {
    union { float f; unsigned u; } x; x.f = v;
    unsigned r = x.u + 0x7FFFu + ((x.u >> 16) & 1u);
    *p = (unsigned short)(r >> 16);
}
#endif

struct Params {
    const float *x, *c, *ctx, *c_ctx, *mod_w, *mod_b, *norm1_g, *norm2_g, *w_in;
    const float *gk_w_f, *gk_b_f, *gk_w_b, *gk_b_b, *gla_norm_w;
    const float *hy_short_w, *hy_short_b, *hy_w1, *hy_b1, *hy_w2, *hy_b2, *hy_w3, *hy_freq, *hy_decay, *hy_bias;
    const float *ssd_conv_w, *ssd_conv_b, *ssd_dt_bias_f, *ssd_dt_bias_b, *ssd_a_log_f, *ssd_a_log_b, *ssd_d, *ssd_norm_w;
    const float *w_out, *ffn_w1, *ffn_w3, *ffn_w2, *final_g;
    float* XL;
    float* XC;
    float* MOD;
    float* HF;
    float* H1;
    float* H2;
    float* RSTD;
    act_t* P;
    act_t* Y;
    float* LG;
    float* O;
    act_t* XBC;
    float* YS;
    float* DT;
    float* VX;
    unsigned* BAR;
    unsigned short* G1;
    unsigned short* VXT;
    float* CONV;
    float* HFC;
    unsigned short *DSG, *SSG, *DSS;
    float *DECG, *DECS;
    unsigned short *WIN_T, *WOUT_T, *W13_T, *W2_T;
};

__device__ __forceinline__ float siluf(float x) { return x / (1.0f + expf(-x)); }
__device__ __forceinline__ float softplusf(float x) { return fmaxf(x, 0.0f) + log1pf(expf(-fabsf(x))); }
__device__ __forceinline__ float logsigmoidf(float x) { return -softplusf(-x); }

__device__ __forceinline__ float* xrow(const Params& p, int r) {
    return r < BL ? p.XL + (size_t)r * DM : p.XC + (size_t)(r - BL) * DM;
}
__device__ __forceinline__ int row_bb(int r) { return r < BL ? r / SEQ : NB; }
__device__ __forceinline__ int seq_len(int s) { return s < NB ? SEQ : CTX; }
__device__ __forceinline__ int seq_row0(int s) { return s < NB ? s * SEQ : BL + (s - NB) * CTX; }
__device__ __forceinline__ int colmajor_tok(int s, int pos) {
    return s < NB ? (pos % ROWS_G) * GRID_W + pos / ROWS_G : pos;
}

__device__ void st_init(const Params& p, long tid, long nth) {
    for (long i = tid; i < (long)BL * DM; i += nth) p.XL[i] = p.x[i];
    for (long i = tid; i < (long)BC * DM; i += nth) p.XC[i] = p.ctx[i];
}
__device__ void st_mod(const Params& p, long tid, long nth) {
    const long total = (long)DEPTH * (NB + 1) * 6 * DM;
    for (long i = tid; i < total; i += nth) {
        int n = (int)(i % (6 * DM));
        int bb = (int)((i / (6 * DM)) % (NB + 1));
        int l = (int)(i / ((long)6 * DM * (NB + 1)));
        const float* cv = bb < NB ? p.c + (size_t)bb * DM : p.c_ctx;
        const float* w = p.mod_w + (size_t)l * DM * 6 * DM + n;
        float acc = 0.f;
        for (int k = 0; k < DM; ++k) acc += siluf(cv[k]) * w[(size_t)k * 6 * DM];
        p.MOD[i] = acc + p.mod_b[(size_t)l * 6 * DM + n];
    }
}
__device__ __forceinline__ void filt_pos(int tt, float& rel) {
    int L = tt < SEQ ? SEQ : CTX; int t = tt < SEQ ? tt : tt - SEQ;
    rel = ((float)t - (float)(L / 2)) / (float)L;
}
__device__ void st_filt1(const Params& p, long tid, long nth) {
    const long total = (long)DEPTH * TF * 64;
    for (long i = tid; i < total; i += nth) {
        int o = (int)(i % 64); int tt = (int)((i / 64) % TF); int l = (int)(i / (64L * TF));
        float rel; filt_pos(tt, rel);
        const float* w1 = p.hy_w1 + (size_t)l * 33 * 64 + o;
        float acc = rel * w1[0];
        const float tw = 2.0f * 3.14159265358979323846f * rel;
        for (int j = 0; j < 16; ++j) {
            float band = 1e-4f + (float)j * ((15.0f - 1e-4f) / 15.0f);
            float ang = tw * band;
            acc += cosf(ang) * w1[(size_t)(1 + j) * 64];
            acc += -sinf(ang) * w1[(size_t)(17 + j) * 64];
        }
        p.H1[i] = sinf(p.hy_freq[l * 64 + o] * (acc + p.hy_b1[l * 64 + o]));
    }
}
__device__ void st_filt2(const Params& p, long tid, long nth) {
    const long total = (long)DEPTH * TF * 64;
    for (long i = tid; i < total; i += nth) {
        int o = (int)(i % 64); int l = (int)(i / (64L * TF));
        const float* h1 = p.H1 + (i - o);
        const float* w2 = p.hy_w2 + (size_t)l * 64 * 64 + o;
        float acc = 0.f;
        for (int j = 0; j < 64; ++j) acc += h1[j] * w2[(size_t)j * 64];
        p.H2[i] = sinf(p.hy_freq[l * 64 + o] * (acc + p.hy_b2[l * 64 + o]));
    }
}
__device__ void st_filt3(const Params& p, long tid, long nth) {
    const long total = (long)DEPTH * TF * 256;
    for (long i = tid; i < total; i += nth) {
        int c = (int)(i % 256); int tt = (int)((i / 256) % TF); int l = (int)(i / (256L * TF));
        float rel; filt_pos(tt, rel);
        const float* h2 = p.H2 + ((size_t)l * TF + tt) * 64;
        const float* w3 = p.hy_w3 + (size_t)l * 64 * 256 + c;
        float acc = 0.f;
        for (int j = 0; j < 64; ++j) acc += h2[j] * w3[(size_t)j * 256];
        const float hv = acc * expf(-2.0f * fabsf(rel) * p.hy_decay[l * 256 + c]);
        p.HF[i] = hv;
#ifndef CPU_EMU
        if (tt < SEQ) { unsigned short* q = p.G1 + ((size_t)l * 256 + c) * G1N + (8456 - tt); stact(q, hv); }
#endif
    }
#ifndef CPU_EMU
    constexpr int NPAD = 265 + (G1N - 8457);
    for (long i = tid; i < (long)DEPTH * 256 * NPAD; i += nth) {
        const int k = (int)(i % NPAD); const long lc = i / NPAD;
        p.G1[lc * G1N + (k < 265 ? k : 8457 + (k - 265))] = 0;
    }
#endif
}
__device__ void st_rstd(const Params& p, long tid, long nth) {
    for (long r = tid; r < NT; r += nth) {
        const float* xr = xrow(p, (int)r);
        float ss = 0.f;
        for (int k = 0; k < DM; ++k) ss += xr[k] * xr[k];
        p.RSTD[r] = 1.0f / sqrtf(ss / (float)DM + EPSV);
    }
}
__device__ void st_hx(const Params& p, int l, int which, long tid, long nth) {
    const float* g = (which ? p.norm2_g : p.norm1_g) + (size_t)l * DM;
    for (long i = tid; i < (long)NT * DM; i += nth) {
        int k = (int)(i % DM); int r = (int)(i / DM);
        const float* m = p.MOD + ((size_t)l * (NB + 1) + row_bb(r)) * 6 * DM;
        float sh = m[(which ? 3 : 0) * DM + k], sc = m[(which ? 4 : 1) * DM + k];
        float v = xrow(p, r)[k] * p.RSTD[r] * g[k];
        stact(p.Y + i, v * (1.0f + sc) + sh);
    }
}
template <int MODE>
__device__ void st_gemm(const Params& p, int l, int nrows, long tid, long nth) {
    const int N = MODE == 0 ? DIN : (MODE == 2 ? DFF : DM);
    const int K = MODE == 3 ? DFF : DM;
    const act_t* A = MODE == 3 ? p.P : p.Y;
    const int lda = MODE == 3 ? DFF : DM;
    const float* W = MODE == 0 ? p.w_in + (size_t)l * DM * DIN
                   : MODE == 1 ? p.w_out + (size_t)l * DM * DM
                   : MODE == 2 ? p.ffn_w1 + (size_t)l * DM * DFF
                               : p.ffn_w2 + (size_t)l * DFF * DM;
    const float* W3 = p.ffn_w3 + (size_t)l * DM * DFF;
    const int NQ = N / 4;
    const long total = (long)(nrows / 8) * NQ;
    for (long i = tid; i < total; i += nth) {
        const int cq = (int)(i % NQ); const int r0 = (int)(i / NQ) * 8; const int n0 = cq * 4;
        float acc[8][4]; float acc3[8][4];
#pragma unroll
        for (int a = 0; a < 8; ++a)
#pragma unroll
            for (int b = 0; b < 4; ++b) { acc[a][b] = 0.f; acc3[a][b] = 0.f; }
        for (int k = 0; k < K; ++k) {
            const float* wr = W + (size_t)k * N + n0;
            float w0 = wr[0], w1 = wr[1], w2 = wr[2], w3 = wr[3];
            float v0 = 0, v1 = 0, v2 = 0, v3 = 0;
            if (MODE == 2) { const float* w3r = W3 + (size_t)k * N + n0; v0 = w3r[0]; v1 = w3r[1]; v2 = w3r[2]; v3 = w3r[3]; }
#pragma unroll
            for (int a = 0; a < 8; ++a) {
                float av = ldact(A + (size_t)(r0 + a) * lda + k);
                acc[a][0] += av * w0; acc[a][1] += av * w1; acc[a][2] += av * w2; acc[a][3] += av * w3;
                if (MODE == 2) { acc3[a][0] += av * v0; acc3[a][1] += av * v1; acc3[a][2] += av * v2; acc3[a][3] += av * v3; }
            }
        }
        const int bb = row_bb(r0);
        const float* m = p.MOD + ((size_t)l * (NB + 1) + bb) * 6 * DM;
#pragma unroll
        for (int a = 0; a < 8; ++a) {
            const int r = r0 + a;
#pragma unroll
            for (int b = 0; b < 4; ++b) {
                const int n = n0 + b;
                if (MODE == 0) stact(p.P + (size_t)r * LDP + n, acc[a][b]);
                else if (MODE == 1) xrow(p, r)[n] += m[2 * DM + n] * acc[a][b];
                else if (MODE == 2) stact(p.P + (size_t)r * DFF + n, siluf(acc[a][b]) * acc3[a][b]);
                else xrow(p, r)[n] += m[5 * DM + n] * acc[a][b];
            }
        }
    }
}
__device__ void st_gla_logs(const Params& p, int l, long tid, long nth) {
    const long total = 2L * NT * 192;
    for (long i = tid; i < total; i += nth) {
        int col = (int)(i % 192); int r = (int)((i / 192) % NT); int dir = (int)(i / (192L * NT));
        const act_t* gk = p.P + (size_t)r * LDP + (dir ? OFF_GKB : OFF_GKF);
        const float* w = (dir ? p.gk_w_b : p.gk_w_f) + (size_t)l * 16 * 192 + col;
        float acc = (dir ? p.gk_b_b : p.gk_b_f)[l * 192 + col];
        for (int j = 0; j < 16; ++j) acc += ldact(gk + j) * w[j * 192];
        p.LG[i] = logsigmoidf(acc) * (1.0f / 16.0f);
    }
}
__device__ void st_gla_scan(const Params& p, long tid, long nth) {
    const long total = (long)NB * 6 * 64;
    for (long i = tid; i < total; i += nth) {
        const int e = (int)(i % 64); const int h = (int)((i / 64) % 6); const int b = (int)(i / 384);
        for (int dir = 0; dir < 2; ++dir) {
            float S[32];
#pragma unroll
            for (int d = 0; d < 32; ++d) S[d] = 0.f;
            const float* lg = p.LG + (size_t)dir * NT * 192;
            for (int part = 0; part < 2; ++part) {
                const int s = part == 0 ? NB + b : b;
                const int L = seq_len(s), r0 = seq_row0(s);
                for (int st = 0; st < L; ++st) {
                    const int t = dir == 0 ? st : L - 1 - st;
                    const int r = r0 + t;
                    const act_t* pr = p.P + (size_t)r * LDP;
                    const float* lr = lg + (size_t)r * 192 + h * 32;
                    const float v = ldact(pr + OFF_V + h * 64 + e);
                    float o = 0.f;
#pragma unroll
                    for (int d = 0; d < 32; ++d) {
                        S[d] = expf(lr[d]) * S[d] + ldact(pr + OFF_K + h * 32 + d) * v;
                        o += ldact(pr + OFF_Q + h * 32 + d) * S[d];
                    }
                    o *= 0.17677669529663687f;
                    float* op = p.O + (size_t)r * 384 + h * 64 + e;
                    if (dir == 0) *op = o; else *op += o;
                }
            }
        }
    }
}
__device__ void st_gla_out(const Params& p, int l, long tid, long nth) {
    const long total = (long)NT * 6;
    for (long i = tid; i < total; i += nth) {
        const int h = (int)(i % 6); const int r = (int)(i / 6);
        const float* o = p.O + (size_t)r * 384 + h * 64;
        float ss = 0.f;
        for (int e = 0; e < 64; ++e) ss += o[e] * o[e];
        const float rs = 1.0f / sqrtf(ss / 64.0f + EPSV);
        for (int e = 0; e < 64; ++e) {
            float g = ldact(p.P + (size_t)r * LDP + OFF_G + h * 64 + e);
            stact(p.Y + (size_t)r * DM + h * 64 + e, o[e] * rs * p.gla_norm_w[l * 64 + e] * siluf(g));
        }
    }
}
__device__ __forceinline__ float hy_u(const Params& p, int l, int s, int t, int j) {
    const int L = seq_len(s), r0 = seq_row0(s);
    const float* w = p.hy_short_w + (size_t)l * 3 * 768 + j;
    float acc = p.hy_short_b[l * 768 + j];
#pragma unroll
    for (int k = 0; k < 3; ++k) {
        int tt = t + k - 1;
        if (tt >= 0 && tt < L) acc += w[k * 768] * ldact(p.P + (size_t)(r0 + tt) * LDP + OFF_HY + j);
    }
    return acc;
}
__device__ void st_hy_pre(const Params& p, int l, long tid, long nth, int r_lo = 0, int r_hi = NT) {
    const long total = (long)(r_hi - r_lo) * 256;
    for (long i = tid; i < total; i += nth) {
        const int c = (int)(i % 256); const int r = r_lo + (int)(i / 256);
        const int s = r < BL ? r / SEQ : NB + (r - BL) / CTX;
        const int t = r - seq_row0(s);
        p.VX[(size_t)r * 256 + c] = hy_u(p, l, s, t, 512 + c) * hy_u(p, l, s, t, 256 + c);
    }
}
__device__ void st_hy_conv(const Params& p, int l, long tid, long nth, int r_lo = 0, int r_hi = NT) {
    const long total = (long)(r_hi - r_lo) * 256;
    for (long i = tid; i < total; i += nth) {
        const int c = (int)(i % 256); const int r = r_lo + (int)(i / 256);
        const int s = r < BL ? r / SEQ : NB + (r - BL) / CTX;
        const int L = seq_len(s), r0 = seq_row0(s);
        const int t = r - r0;
        const float* hf = p.HF + ((size_t)l * TF + (s < NB ? 0 : SEQ)) * 256 + c;
        int jlo = t + L / 2 - (L - 1); if (jlo < 0) jlo = 0;
        int jhi = t + L / 2; if (jhi > L - 1) jhi = L - 1;
        float acc = 0.f;
        for (int j = jlo; j <= jhi; ++j)
            acc += hf[(size_t)(t - j + L / 2) * 256] * p.VX[(size_t)(r0 + j) * 256 + c];
        const float x0 = hy_u(p, l, s, t, c);
        const float y = (acc + p.VX[(size_t)r * 256 + c] * p.hy_bias[l * 256 + c]) * x0;
        stact(p.Y + (size_t)r * DM + 384 + c, y);
    }
}
__device__ void st_ssd_pre(const Params& p, int l, long tid, long nth) {
    const long total = (long)NT * 896;
    for (long i = tid; i < total; i += nth) {
        const int j = (int)(i % 896); const int q = (int)(i / 896);
        const int s = q < BL ? q / SEQ : NB + (q - BL) / CTX;
        const int L = seq_len(s), r0 = seq_row0(s);
        const int pos = q - r0;
        const float* w = p.ssd_conv_w + (size_t)l * 3 * 896 + j;
        float acc = p.ssd_conv_b[l * 896 + j];
#pragma unroll
        for (int k = 0; k < 3; ++k) {
            int pp = pos + k - 1;
            if (pp >= 0 && pp < L) acc += w[k * 896] * ldact(p.P + (size_t)(r0 + colmajor_tok(s, pp)) * LDP + OFF_XBC + j);
        }
        stact(p.XBC + (size_t)(r0 + colmajor_tok(s, pos)) * 896 + j, siluf(acc));
    }
    const long total2 = 2L * NT * 6;
    for (long i = tid; i < total2; i += nth) {
        const int hd = (int)(i % 6); const int r = (int)((i / 6) % NT); const int dir = (int)(i / (6L * NT));
        float v = ldact(p.P + (size_t)r * LDP + (dir ? OFF_DTB : OFF_DTF) + hd) + (dir ? p.ssd_dt_bias_b : p.ssd_dt_bias_f)[l * 6 + hd];
        p.DT[i] = softplusf(v);
    }
}
__device__ void st_ssd_scan(const Params& p, int l, long tid, long nth) {
    const long total = (long)NB * 6 * 64;
    for (long i = tid; i < total; i += nth) {
        const int pp = (int)(i % 64); const int hd = (int)((i / 64) % 6); const int b = (int)(i / 384);
        const int g = hd / 3;
        const float dcoef = p.ssd_d[l * 6 + hd];
        for (int dir = 0; dir < 2; ++dir) {
            const float A = -expf((dir ? p.ssd_a_log_b : p.ssd_a_log_f)[l * 6 + hd]);
            float h[128];
#pragma unroll
            for (int n = 0; n < 128; ++n) h[n] = 0.f;
            for (int part = 0; part < 2; ++part) {
                const int s = part == 0 ? NB + b : b;
                const int L = seq_len(s), r0 = seq_row0(s);
                for (int st = 0; st < L; ++st) {
                    const int pos = dir == 0 ? st : L - 1 - st;
                    const int r = r0 + colmajor_tok(s, pos);
                    const act_t* xr = p.XBC + (size_t)r * 896;
                    const float dt = p.DT[((size_t)dir * NT + r) * 6 + hd];
                    const float xs = ldact(xr + hd * 64 + pp);
                    const float ea = expf(A * dt);
                    const float xd = xs * dt;
                    float y = 0.f;
#pragma unroll
                    for (int n = 0; n < 128; ++n) {
                        h[n] = ea * h[n] + xd * ldact(xr + 384 + g * 128 + n);
                        y += h[n] * ldact(xr + 640 + g * 128 + n);
                    }
                    float* yp = p.YS + (size_t)r * 384 + hd * 64 + pp;
                    if (dir == 0) *yp = y + dcoef * xs; else *yp += y;
                }
            }
        }
    }
}
__device__ void st_ssd_out(const Params& p, int l, long tid, long nth) {
    const long total = (long)NT * 2;
    for (long i = tid; i < total; i += nth) {
        const int g = (int)(i % 2); const int r = (int)(i / 2);
        const float* ys = p.YS + (size_t)r * 384 + g * 192;
        const act_t* z = p.P + (size_t)r * LDP + OFF_Z + g * 192;
        float ss = 0.f;
        for (int j = 0; j < 192; ++j) { float v = ys[j] * siluf(ldact(z + j)); ss += v * v; }
        const float rs = 1.0f / sqrtf(ss / 192.0f + EPSV);
        for (int j = 0; j < 192; ++j) {
            float v = ys[j] * siluf(ldact(z + j));
            stact(p.Y + (size_t)r * DM + 640 + g * 192 + j, v * rs * p.ssd_norm_w[l * 384 + g * 192 + j]);
        }
    }
}
__device__ void st_final(const Params& p, long tid, long nth) {
    for (long i = tid; i < (long)BL * DM; i += nth) {
        int k = (int)(i % DM); int r = (int)(i / DM);
        p.XL[i] = p.XL[i] * p.RSTD[r] * p.final_g[k];
    }
}

enum { S_INIT, S_MOD, S_F1, S_F2, S_F3, S_RSTD, S_HX1, S_GIN, S_GLOG, S_GSCAN, S_GOUT,
       S_SPRE, S_SSCAN, S_SOUT, S_HPRE, S_HCONV, S_GOUTP, S_HX2, S_FFN1, S_FFN2, S_FINAL };

__device__ void run_stage(const Params& p, int stage, int l, long tid, long nth) {
    const int nrows = (l == DEPTH - 1) ? BL : NT;
    switch (stage) {
        case S_INIT: st_init(p, tid, nth); break;
        case S_MOD: st_mod(p, tid, nth); break;
        case S_F1: st_filt1(p, tid, nth); break;
        case S_F2: st_filt2(p, tid, nth); break;
        case S_F3: st_filt3(p, tid, nth); break;
        case S_RSTD: st_rstd(p, tid, nth); break;
        case S_HX1: st_hx(p, l, 0, tid, nth); break;
        case S_GIN: st_gemm<0>(p, l, NT, tid, nth); break;
        case S_GLOG: st_gla_logs(p, l, tid, nth); break;
        case S_GSCAN: st_gla_scan(p, tid, nth); break;
        case S_GOUT: st_gla_out(p, l, tid, nth); break;
        case S_SPRE: st_ssd_pre(p, l, tid, nth); break;
        case S_SSCAN: st_ssd_scan(p, l, tid, nth); break;
        case S_SOUT: st_ssd_out(p, l, tid, nth); break;
        case S_HPRE: st_hy_pre(p, l, tid, nth); break;
        case S_HCONV: st_hy_conv(p, l, tid, nth); break;
        case S_GOUTP: st_gemm<1>(p, l, nrows, tid, nth); break;
        case S_HX2: st_hx(p, l, 1, tid, nth); break;
        case S_FFN1: st_gemm<2>(p, l, nrows, tid, nth); break;
        case S_FFN2: st_gemm<3>(p, l, nrows, tid, nth); break;
        case S_FINAL: st_final(p, tid, nth); break;
    }
}

static const int kLayerProg[] = { S_RSTD, S_HX1, S_GIN, S_GLOG, S_GSCAN, S_GOUT, S_SPRE, S_SSCAN, S_SOUT,
                                  S_HPRE, S_HCONV, S_GOUTP, S_RSTD, S_HX2, S_FFN1, S_FFN2 };
static const int kPreProg[] = { S_INIT, S_MOD, S_F1, S_F2, S_F3 };

static inline size_t al256(size_t v) { return (v + 255) & ~(size_t)255; }
static void carve(Params& p, char* ws, float* dout) {
    size_t off = 0;
    auto take = [&](size_t bytes) { char* q = ws + off; off += al256(bytes); return q; };
    p.XL = dout;
    p.XC = (float*)take((size_t)BC * DM * 4);
    p.MOD = (float*)take((size_t)DEPTH * (NB + 1) * 6 * DM * 4);
#ifdef CPU_EMU
    p.HF = (float*)take((size_t)DEPTH * TF * 256 * 4);
    p.RSTD = (float*)take((size_t)NT * 4);
    p.DT = (float*)take((size_t)2 * NT * 6 * 4);
#endif
    p.H1 = (float*)take((size_t)DEPTH * TF * 64 * 4);
    p.H2 = (float*)take((size_t)DEPTH * TF * 64 * 4);
    p.P = (act_t*)take((size_t)NT * LDP * sizeof(act_t));
    p.Y = (act_t*)take((size_t)NT * DM * sizeof(act_t));
#ifdef CPU_EMU
    char* r1 = take((size_t)NT * 896 * sizeof(act_t) + (size_t)NT * 384 * 4 + 256);
#else
    char* r1 = take((size_t)101 << 20);
#endif
    p.LG = (float*)r1;
    p.O = (float*)(r1 + al256((size_t)2 * NT * 192 * 4));
    p.XBC = (act_t*)r1;
    p.YS = (float*)(r1 + al256((size_t)NT * 896 * sizeof(act_t)));
#ifdef CPU_EMU
    p.VX = (float*)r1;
#else
    {
        char* q = r1;
        p.DSG = (unsigned short*)q; q += al256((size_t)2 * NB * 6 * ((CTX + SEQ) / 64) * 2048 * 2);
        p.SSG = (unsigned short*)q; q += al256((size_t)2 * NB * 6 * ((CTX + SEQ) / 64) * 2048 * 2);
        p.DECG = (float*)q; q += al256((size_t)2 * NB * 6 * ((CTX + SEQ) / 64) * 32 * 4);
        p.DSS = (unsigned short*)q; q += al256((size_t)2 * NB * 6 * ((CTX + SEQ) / 128) * 8192 * 2);
        p.DECS = (float*)q; q += al256((size_t)2 * NB * 6 * ((CTX + SEQ) / 128) * 4);
    }
    p.VXT = (unsigned short*)take((size_t)NB * 256 * SEQ * 2);
    p.CONV = (float*)take((size_t)NB * 256 * SEQ * 4);
    p.VX = (float*)take((size_t)BC * 256 * 4) - (size_t)BL * 256;
    p.HFC = (float*)take((size_t)DEPTH * CTX * 256 * 4);
#endif
    p.G1 = (unsigned short*)take((size_t)DEPTH * 256 * G1N * 2);
    p.BAR = (unsigned*)take(16384);
    p.WIN_T = (unsigned short*)take((size_t)DEPTH * LDP * DM * 2);
    p.WOUT_T = (unsigned short*)take((size_t)DEPTH * DM * DM * 2);
    p.W13_T = (unsigned short*)take((size_t)DEPTH * NFF2 * DM * 2);
    p.W2_T = (unsigned short*)take((size_t)DEPTH * DM * DFF * 2);
}
static void fill_inputs(Params& p, void* const* d_in) {
    const float** dst = (const float**)&p;
    for (int i = 0; i < 37; ++i) dst[i] = (const float*)d_in[i];
}

#ifndef CPU_EMU
namespace pg8 {
#define PG8_LAS __attribute__((address_space(3)))
typedef unsigned short bf16_t;
typedef short bf16x8 __attribute__((ext_vector_type(8)));
typedef float f32x4 __attribute__((ext_vector_type(4)));
typedef unsigned u32x4 __attribute__((ext_vector_type(4)));
constexpr int BM = 256, BK = 64, HALF = 128, HTB = HALF * BK * 2  , STAGE_BYTES = 8 * HTB, NXCD = 8, WGM = 8;

__host__ __device__ __forceinline__ int lds_byte(int r, int c) { const int st = (r >> 4) * 2 + (c >> 5), rr = r & 15, cc = c & 31, ob = rr * 64 + cc * 2; return st * 1024 + (ob ^ (((ob >> 9) & 1) << 5)); }
__host__ __device__ __forceinline__ void stage_rc(int b, int& R, int& C) { const int st = b / 1024, sb = b % 1024, swz = sb ^ (((sb >> 9) & 1) << 5); R = (st >> 1) * 16 + swz / 64; C = (st & 1) * 32 + (swz % 64) / 2; }
__host__ __device__ __forceinline__ int perm32(int rho) { const int n = rho >> 4, i = rho & 15; return 8 * (i >> 2) + 4 * n + (i & 3); }

struct Unit { int pm, pn, kb; };
struct Gemm { const bf16_t* A; const bf16_t* Bt; int M, N, K, ld; };

struct StaticOrder {
    int nM, nN, nwg, G, c;
    __host__ __device__ void init(int M, int N, int G_, int c_) { nM = M / BM; nN = N / BM; nwg = nM * nN; G = G_; c = c_; }
    __host__ __device__ bool next(int i, Unit& u) const {
        const long L = (long)i * G + c; if (L >= nwg) return false;
        int wgid = (int)L; { const int q = nwg / NXCD, r = nwg % NXCD, xcd = wgid % NXCD, off = wgid / NXCD; wgid = (xcd < r ? xcd * (q + 1) : r * (q + 1) + (xcd - r) * q) + off; }
        const int nig = WGM * nN, gid = wgid / nig, fm = gid * WGM, gsz = (nM - fm) < WGM ? (nM - fm) : WGM;
        u.pm = fm + ((wgid % nig) % gsz); u.pn = (wgid % nig) / gsz; u.kb = 0; return true;
    }
    __device__ __forceinline__ void a_ready(const Unit&) const {}
    __device__ __forceinline__ void done(const Unit&) const {}
};

__device__ __forceinline__ unsigned cvt_pk_bf16(float lo, float hi) { unsigned r; asm volatile("v_cvt_pk_bf16_f32 %0, %1, %2" : "=v"(r) : "v"(lo), "v"(hi)); return r; }
typedef float f32x2 __attribute__((ext_vector_type(2)));
__device__ __forceinline__ f32x2 gelu_pk(f32x2 v) {
    const f32x2 av = __builtin_elementwise_abs(v), d = av * 0.2316418882f + 1.0f;
    f32x2 t; t.x = __builtin_amdgcn_rcpf(d.x); t.y = __builtin_amdgcn_rcpf(d.y);
    f32x2 q = t * 0.5307027145f + (-0.7265760135f); q = q * t + 0.7107068705f; q = q * t + (-0.142248368f); q = q * t + 0.127414796f; q = q * t;
    const f32x2 s = (v * v) * (-0.72134752044f);
    f32x2 e; e.x = __builtin_amdgcn_exp2f(s.x); e.y = __builtin_amdgcn_exp2f(s.y);
    const f32x2 m = v * (q * e), r = v - m;
    f32x2 o; o.x = v.x < 0.f ? m.x : r.x; o.y = v.y < 0.f ? m.y : r.y; return o;
}

template <int ACT  > struct EpiBf16 {
    static constexpr bool PERM = true, AFTER_DRAIN = false; static_assert(ACT == 0 || ACT == 1, "EpiBf16: ACT is 0 (none) or 1 (gelu_pk)");
    bf16_t* O; int ldc; const float* bias; int split_cols; size_t split_stride; float scale0;
    __device__ __forceinline__ void operator()(const f32x4 (&acc)[2][2][4][2], const Unit& u, int wr, int wc, int fr, int fq) const {
        const int row0 = u.pm * BM + wr * 64 + fr; int colt = u.pn * BM; bf16_t* base = O;
        float sc = 1.f; if (split_cols) { const int t = colt / split_cols; base += (size_t)t * split_stride; colt -= t * split_cols; if (t == 0) sc = scale0; }
        const int col0 = colt + wc * 32 + 8 * fq, bcol0 = u.pn * BM + wc * 32 + 8 * fq;
        f32x4 bv[2][2];
#pragma unroll
        for (int bj = 0; bj < 2; ++bj)
#pragma unroll
            for (int n = 0; n < 2; ++n) bv[bj][n] = bias ? *(const f32x4*)(bias + bcol0 + bj * HALF + 4 * n) : (f32x4){0.f, 0.f, 0.f, 0.f};
#pragma unroll
        for (int ai = 0; ai < 2; ++ai)
#pragma unroll
            for (int m = 0; m < 4; ++m) { bf16_t* rowp = base + (size_t)(row0 + ai * HALF + m * 16) * ldc + col0;
#pragma unroll
                for (int bj = 0; bj < 2; ++bj) { f32x4 v0 = acc[ai][bj][m][0] + bv[bj][0], v1 = acc[ai][bj][m][1] + bv[bj][1];
                    if (ACT == 1) { f32x2 a = gelu_pk((f32x2){v0[0], v0[1]}), b = gelu_pk((f32x2){v0[2], v0[3]}), c = gelu_pk((f32x2){v1[0], v1[1]}), d = gelu_pk((f32x2){v1[2], v1[3]});
                        v0 = (f32x4){a.x, a.y, b.x, b.y}; v1 = (f32x4){c.x, c.y, d.x, d.y}; }
                    v0 = v0 * sc; v1 = v1 * sc; u32x4 w; w.x = cvt_pk_bf16(v0[0], v0[1]); w.y = cvt_pk_bf16(v0[2], v0[3]); w.z = cvt_pk_bf16(v1[0], v1[1]); w.w = cvt_pk_bf16(v1[2], v1[3]);
                    *(u32x4*)(rowp + bj * HALF) = w; } }
    }
};
template <class Epi, class Sched, bool ALIGN_EPI = false, bool SP2 = false>
__device__ __forceinline__ void gemm_phase(PG8_LAS unsigned char* lds, const Gemm g, const Sched& S, const Epi& E, int tid_o) {
    asm volatile("" : "+v"(tid_o));
    const int tid = tid_o, wid = __builtin_amdgcn_readfirstlane(tid >> 6), lane = tid & 63, wr = wid >> 2, wc = wid & 3, fr = lane & 15, fq = lane >> 4;
    const int K = g.ld, nt = g.K / BK;
    unsigned voffA[2], voffB[2];
#pragma unroll
    for (int i = 0; i < 2; ++i) { int R, C; stage_rc(tid * 16 + i * 8192, R, C); const int Rb = Epi::PERM ? ((R & ~31) + perm32(R & 31)) : R;
        voffA[i] = (unsigned)(R * K + C) * 2u; voffB[i] = (unsigned)(Rb * K + C) * 2u; }
    const size_t kstep = (size_t)(BK * 2);
    const size_t hstep = (size_t)HALF * K * 2;
    const size_t tstep = 2 * hstep;
    const unsigned ldsw = (unsigned)wid * 1024u;
    const int aoff = lds_byte(wr * 64 + fr, fq * 8), boff = lds_byte(wc * 32 + fr, fq * 8);
#define PG8_SA(b, h) (((b) * 2 + (h)) * HTB)
#define PG8_SB(b, h) ((4 + (b) * 2 + (h)) * HTB)
#define PG8_STAGE(bufoff, gbase, voff) do { _Pragma("unroll") for (int _i = 0; _i < 2; ++_i) \
        __builtin_amdgcn_global_load_lds((const unsigned*)((const char*)(gbase) + (voff)[_i]), (PG8_LAS unsigned*)(lds + (bufoff) + ldsw + _i * 8192), 16, 0, 0); } while (0)
#define PG8_LDA(dst, b, h) do { _Pragma("unroll") for (int m = 0; m < 4; ++m) _Pragma("unroll") for (int k = 0; k < 2; ++k) dst[m][k] = *(const PG8_LAS bf16x8*)(lds + PG8_SA(b, h) + aoff + m * 2048 + k * 1024); } while (0)
#define PG8_LDB(dst, b, h) do { _Pragma("unroll") for (int n = 0; n < 2; ++n) _Pragma("unroll") for (int k = 0; k < 2; ++k) dst[n][k] = *(const PG8_LAS bf16x8*)(lds + PG8_SB(b, h) + boff + n * 2048 + k * 1024); } while (0)
#define PG8_MMA(ai, bj, At, Bt) do { __builtin_amdgcn_s_setprio(1); _Pragma("unroll") for (int m = 0; m < 4; ++m) _Pragma("unroll") for (int n = 0; n < 2; ++n) _Pragma("unroll") for (int k = 0; k < 2; ++k) \
        acc[ai][bj][m][n] = __builtin_amdgcn_mfma_f32_16x16x32_bf16(Bt[n][k], At[m][k], acc[ai][bj][m][n], 0, 0, 0); __builtin_amdgcn_s_setprio(0); } while (0)
#define PG8_WAIT_V(n) asm volatile("s_waitcnt vmcnt(" #n ")" ::: "memory")
#define PG8_WAIT_L(n) asm volatile("s_waitcnt lgkmcnt(" #n ")" ::: "memory")
#define PG8_BAR __builtin_amdgcn_s_barrier()
#define PG8_SCHED __builtin_amdgcn_sched_barrier(0)
    Unit cur, nxt; int ui = 0;
    if (!S.next(0, cur)) return;
    f32x4 acc[2][2][4][2];
#pragma unroll
    for (int a = 0; a < 2; ++a)
#pragma unroll
        for (int b = 0; b < 2; ++b)
#pragma unroll
            for (int m = 0; m < 4; ++m)
#pragma unroll
                for (int n = 0; n < 2; ++n) acc[a][b][m][n] = (f32x4){0.f, 0.f, 0.f, 0.f};
    bf16x8 At[4][2], B0[2][2], B1[2][2];
    const char* cA = (const char*)g.A + (size_t)cur.pm * tstep + cur.kb; const char* cB = (const char*)g.Bt + (size_t)cur.pn * tstep + cur.kb;
    S.a_ready(cur);
    if constexpr (SP2) {
        PG8_STAGE(PG8_SB(0, 0), cB, voffB); PG8_STAGE(PG8_SB(0, 1), cB + hstep, voffB); PG8_STAGE(PG8_SA(0, 0), cA, voffA); PG8_STAGE(PG8_SA(0, 1), cA + hstep, voffA);
        if (wr == 1) PG8_BAR;
        PG8_WAIT_V(2); PG8_BAR;
        PG8_STAGE(PG8_SB(1, 0), cB + kstep, voffB); PG8_STAGE(PG8_SA(1, 0), cA + kstep, voffA); PG8_STAGE(PG8_SB(1, 1), cB + hstep + kstep, voffB);
        PG8_WAIT_V(6); PG8_BAR;
    } else {
        PG8_STAGE(PG8_SB(0, 0), cB, voffB); PG8_STAGE(PG8_SA(0, 0), cA, voffA); PG8_STAGE(PG8_SB(0, 1), cB + hstep, voffB); PG8_STAGE(PG8_SA(0, 1), cA + hstep, voffA);
        if (wr == 1) PG8_BAR;
        PG8_WAIT_V(4); PG8_BAR;
        PG8_STAGE(PG8_SB(1, 0), cB + kstep, voffB); PG8_STAGE(PG8_SA(1, 0), cA + kstep, voffA); PG8_STAGE(PG8_SB(1, 1), cB + hstep + kstep, voffB);
        PG8_WAIT_V(6); PG8_BAR;
    }
    for (;;) {
        const bool has_next = S.next(ui + 1, nxt);
        const char* nA = has_next ? (const char*)g.A + (size_t)nxt.pm * tstep + nxt.kb : cA; const char* nB = has_next ? (const char*)g.Bt + (size_t)nxt.pn * tstep + nxt.kb : cB;
        for (int t = 0; t < nt; t += 2) {
            const bool last = (t == nt - 2);
            const char* a1 = cA + (size_t)(t + 1) * kstep;
            const char* a2 = last ? nA : cA + (size_t)(t + 2) * kstep; const char* b2 = last ? nB : cB + (size_t)(t + 2) * kstep;
            const char* a3 = a2 + kstep; const char* b3 = b2 + kstep;
            if (last && has_next) S.a_ready(nxt);
            if constexpr (SP2) {
            PG8_LDB(B0, 0, 0); PG8_LDB(B1, 0, 1); PG8_SCHED; PG8_LDA(At, 0, 0); PG8_STAGE(PG8_SA(1, 1), a1 + hstep, voffA);
            PG8_WAIT_V(8); PG8_WAIT_L(0); PG8_BAR; PG8_MMA(0, 0, At, B0); PG8_MMA(0, 1, At, B1); PG8_BAR; PG8_SCHED;
            PG8_LDA(At, 0, 1); PG8_STAGE(PG8_SB(0, 0), b2, voffB); PG8_STAGE(PG8_SB(0, 1), b2 + hstep, voffB); PG8_STAGE(PG8_SA(0, 0), a2, voffA);
            PG8_WAIT_V(8); PG8_WAIT_L(0); PG8_BAR; PG8_MMA(1, 0, At, B0); PG8_MMA(1, 1, At, B1); PG8_BAR; PG8_SCHED;
            PG8_LDB(B0, 1, 0); PG8_LDB(B1, 1, 1); PG8_SCHED; PG8_LDA(At, 1, 0); PG8_STAGE(PG8_SA(0, 1), a2 + hstep, voffA);
            PG8_WAIT_V(8); PG8_WAIT_L(0); PG8_BAR; PG8_MMA(0, 0, At, B0); PG8_MMA(0, 1, At, B1); PG8_BAR; PG8_SCHED;
            PG8_LDA(At, 1, 1); PG8_STAGE(PG8_SB(1, 0), b3, voffB); PG8_STAGE(PG8_SB(1, 1), b3 + hstep, voffB); PG8_STAGE(PG8_SA(1, 0), a3, voffA);
            PG8_WAIT_V(8); PG8_WAIT_L(0); PG8_BAR; PG8_MMA(1, 0, At, B0); PG8_MMA(1, 1, At, B1); PG8_BAR; PG8_SCHED;
            } else {
            PG8_LDB(B0, 0, 0); PG8_SCHED; PG8_LDA(At, 0, 0); PG8_STAGE(PG8_SA(1, 1), a1 + hstep, voffA);
            PG8_WAIT_L(8); PG8_BAR; PG8_WAIT_L(0); PG8_MMA(0, 0, At, B0); PG8_BAR; PG8_SCHED;
            PG8_LDB(B1, 0, 1); PG8_STAGE(PG8_SB(0, 0), b2, voffB);
            PG8_BAR; PG8_WAIT_L(0); PG8_MMA(0, 1, At, B1); PG8_BAR;
            PG8_LDA(At, 0, 1); PG8_STAGE(PG8_SA(0, 0), a2, voffA);
            PG8_BAR; PG8_WAIT_L(0); PG8_MMA(1, 0, At, B0); PG8_BAR; PG8_SCHED;
            PG8_STAGE(PG8_SB(0, 1), b2 + hstep, voffB);
            PG8_WAIT_V(6); PG8_BAR; PG8_MMA(1, 1, At, B1); PG8_BAR;
            PG8_LDB(B0, 1, 0); PG8_SCHED; PG8_LDA(At, 1, 0); PG8_STAGE(PG8_SA(0, 1), a2 + hstep, voffA);
            PG8_WAIT_L(8); PG8_BAR; PG8_WAIT_L(0); PG8_MMA(0, 0, At, B0); PG8_BAR; PG8_SCHED;
            PG8_LDB(B1, 1, 1); PG8_STAGE(PG8_SB(1, 0), b3, voffB);
            PG8_BAR; PG8_WAIT_L(0); PG8_MMA(0, 1, At, B1); PG8_BAR;
            PG8_LDA(At, 1, 1); PG8_STAGE(PG8_SA(1, 0), a3, voffA);
            PG8_BAR; PG8_WAIT_L(0); PG8_MMA(1, 0, At, B0); PG8_BAR; PG8_SCHED;
            PG8_STAGE(PG8_SB(1, 1), b3 + hstep, voffB);
            PG8_WAIT_V(6); PG8_BAR; PG8_MMA(1, 1, At, B1); PG8_BAR;
            }
        }
        if constexpr (ALIGN_EPI) { if (wr == 0) PG8_BAR; }
        if constexpr (!Epi::AFTER_DRAIN) {
            unsigned z_ = 0u; asm volatile("" : "+v"(z_)); const int le_ = (int)__builtin_amdgcn_mbcnt_hi(~0u, __builtin_amdgcn_mbcnt_lo(~0u, z_));
            E(acc, cur, wr, wc, le_ & 15, le_ >> 4); S.done(cur); }
        if (!has_next) break;
#pragma unroll
        for (int a = 0; a < 2; ++a)
#pragma unroll
            for (int b = 0; b < 2; ++b)
#pragma unroll
                for (int m = 0; m < 4; ++m)
#pragma unroll
                    for (int n = 0; n < 2; ++n) acc[a][b][m][n] = (f32x4){0.f, 0.f, 0.f, 0.f};
        cur = nxt; cA = nA; cB = nB; ++ui;
        if constexpr (ALIGN_EPI) { if (wr == 1) PG8_BAR; }
    }
    PG8_WAIT_V(0);
    if constexpr (!ALIGN_EPI) { if (wr == 0) PG8_BAR; }
    PG8_BAR;
    if constexpr (Epi::AFTER_DRAIN) { E.fused(acc, cur, wr, wc, fr, fq, lds, wid, lane); S.done(cur); }
#undef PG8_SA
#undef PG8_SB
#undef PG8_STAGE
#undef PG8_LDA
#undef PG8_LDB
#undef PG8_MMA
#undef PG8_WAIT_V
#undef PG8_WAIT_L
#undef PG8_BAR
#undef PG8_SCHED
}
}

namespace pg8 {
struct EpiRes {
    static constexpr bool PERM = false, AFTER_DRAIN = false;
    float* XL; float* XC; const float* modl; int chunk; const float* SL; const float* SC;
    __device__ __forceinline__ void operator()(const f32x4 (&acc)[2][2][4][2], const Unit& u, int wr, int wc, int fr, int fq) const {
        asm volatile("" : "+v"(fr), "+v"(fq));
        const int rt0 = u.pm * BM;
        const int bb = rt0 < BL ? rt0 / SEQ : NB;
        const float* gate = modl + ((size_t)bb * 6 + chunk) * DM;
        float* xb = rt0 < BL ? XL + (size_t)rt0 * DM : XC + (size_t)(rt0 - BL) * DM;
        const float* sb = rt0 < BL ? SL + (size_t)rt0 * DM : SC + (size_t)(rt0 - BL) * DM;
        const int col0 = u.pn * BM + wc * 32 + fq * 4;
        f32x4 gv[2][2];
#pragma unroll
        for (int bj = 0; bj < 2; ++bj)
#pragma unroll
            for (int n = 0; n < 2; ++n) gv[bj][n] = *(const f32x4*)(gate + col0 + bj * HALF + n * 16);
#pragma unroll
        for (int ai = 0; ai < 2; ++ai)
#pragma unroll
            for (int m = 0; m < 4; ++m) {
                const size_t ro = (size_t)(wr * 64 + fr + ai * HALF + m * 16) * DM + col0;
#pragma unroll
                for (int bj = 0; bj < 2; ++bj)
#pragma unroll
                    for (int n = 0; n < 2; ++n) *(f32x4*)(xb + ro + bj * HALF + n * 16) = *(const f32x4*)(sb + ro + bj * HALF + n * 16) + gv[bj][n] * acc[ai][bj][m][n];
            }
    }
};
struct EpiSwiGLU {
    static constexpr bool PERM = true, AFTER_DRAIN = false;
    bf16_t* H;
    __device__ __forceinline__ void operator()(const f32x4 (&acc)[2][2][4][2], const Unit& u, int wr, int wc, int fr, int fq) const {
        asm volatile("" : "+v"(fr), "+v"(fq));
        const int row0 = u.pm * BM + wr * 64 + fr, hc0 = u.pn * HALF + wc * 32 + 8 * fq;
#pragma unroll
        for (int ai = 0; ai < 2; ++ai)
#pragma unroll
            for (int m = 0; m < 4; ++m) {
                bf16_t* rowp = H + (size_t)(row0 + ai * HALF + m * 16) * DFF + hc0;
                f32x4 v[2];
#pragma unroll
                for (int n = 0; n < 2; ++n)
#pragma unroll
                    for (int i = 0; i < 4; ++i) { const float a = acc[ai][0][m][n][i]; v[n][i] = a * __builtin_amdgcn_rcpf(1.0f + __expf(-a)) * acc[ai][1][m][n][i]; }
                u32x4 w; w.x = cvt_pk_bf16(v[0][0], v[0][1]); w.y = cvt_pk_bf16(v[0][2], v[0][3]); w.z = cvt_pk_bf16(v[1][0], v[1][1]); w.w = cvt_pk_bf16(v[1][2], v[1][3]);
                *(u32x4*)rowp = w;
            }
    }
};
}


namespace pg8 {
struct SplitKOrder {
    int nM, nN, S, ksl, nun, G, c;
    __device__ void init(int M, int N, int S_, int kslice_elems, int G_, int c_) { nM = M / BM; nN = N / BM; S = S_; ksl = kslice_elems; nun = nM * nN * S; G = G_; c = c_; }
    __device__ bool next(int i, Unit& u) const {
        const int L = i * G + c; if (L >= nun) return false;
        const int sl = L % S, t = L / S; u.pm = t % nM; u.pn = t / nM; u.kb = sl * ksl * 2; return true;
    }
    __device__ __forceinline__ void a_ready(const Unit&) const {}
    __device__ __forceinline__ void done(const Unit&) const {}
};
struct EpiSlab {
    static constexpr bool PERM = false, AFTER_DRAIN = false;
    float* SLAB; int rows, kslice_bytes;
    __device__ __forceinline__ void operator()(const f32x4 (&acc)[2][2][4][2], const Unit& u, int wr, int wc, int fr, int fq) const {
        asm volatile("" : "+v"(fr), "+v"(fq));
        float* xb = SLAB + ((size_t)(u.kb / kslice_bytes) * rows + (size_t)u.pm * BM) * DM;
        const int col0 = u.pn * BM + wc * 32 + fq * 4;
#pragma unroll
        for (int ai = 0; ai < 2; ++ai)
#pragma unroll
            for (int m = 0; m < 4; ++m) {
                const size_t ro = (size_t)(wr * 64 + fr + ai * HALF + m * 16) * DM + col0;
#pragma unroll
                for (int bj = 0; bj < 2; ++bj)
#pragma unroll
                    for (int n = 0; n < 2; ++n) *(f32x4*)(xb + ro + bj * HALF + n * 16) = acc[ai][bj][m][n];
            }
    }
};
}

#define LAS __attribute__((address_space(3)))
typedef float f32x4 __attribute__((ext_vector_type(4)));
typedef unsigned v4u __attribute__((ext_vector_type(4)));
#define REP_G1 1
#define REP_G3 1
#define REP_GLA 1
#define REP_SSD 1
#define REP_HY 1
#define REP_HX 1
#define REP_PRO 1
#define CTX_SPLITK 1
#define OLD_SHFL 0
#define REP_MIX 1
#define REP_PA 1
#define REP_PC 1
#define REP_H1 1
#define REP_H2 1
#define REP_H3 1
#define REP_HC 1
#define REP_S2 1
#define REP_S23 1
#define REP_S4 1
#define REP_M2 1
#define REP_M3 1
#define REP_M4 1
#define REP_INIT 1
#define REP_MOD 1
#define REP_F1 1
#define REP_WT 1
#define REP_F3 1
constexpr int LDS_BYTES = 163840;
namespace cg = cooperative_groups;

__device__ __forceinline__ unsigned f2bf_u(float f) { unsigned u = __builtin_bit_cast(unsigned, f); return (u + 0x7fffu + ((u >> 16) & 1u)) >> 16; }
__device__ __forceinline__ unsigned pk2(float lo, float hi) { return f2bf_u(lo) | (f2bf_u(hi) << 16); }
template <int M> __device__ __forceinline__ float swz_xor(float v) { return __builtin_bit_cast(float, __builtin_amdgcn_ds_swizzle(__builtin_bit_cast(int, v), (M << 10) | 0x1f)); }
#if OLD_SHFL
__device__ __forceinline__ float wave_sum(float v, int) {
#pragma unroll
    for (int o = 1; o < 64; o <<= 1) v += __shfl_xor(v, o);
    return v;
}
__device__ __forceinline__ float sum16(float v) { v += __shfl_xor(v, 1); v += __shfl_xor(v, 2); v += __shfl_xor(v, 4); v += __shfl_xor(v, 8); return v; }
__device__ __forceinline__ float wave_scan_incl(float v, int lane) {
#pragma unroll
    for (int off = 1; off < 64; off <<= 1) { const float up = __shfl_up(v, off); if (lane >= off) v += up; }
    return v;
}
#else
__device__ __forceinline__ float wave_sum(float v, int lane) {
    v += swz_xor<1>(v); v += swz_xor<2>(v); v += swz_xor<4>(v); v += swz_xor<8>(v); v += swz_xor<16>(v);
    return v + __builtin_bit_cast(float, __builtin_amdgcn_ds_bpermute((lane ^ 32) << 2, __builtin_bit_cast(int, v)));
}
__device__ __forceinline__ float sum16(float v) { v += swz_xor<1>(v); v += swz_xor<2>(v); v += swz_xor<4>(v); v += swz_xor<8>(v); return v; }
template <int CTRL, int ROWMASK> __device__ __forceinline__ float dpp0(float v) {
    return __builtin_bit_cast(float, __builtin_amdgcn_update_dpp(0, __builtin_bit_cast(int, v), CTRL, ROWMASK, 0xf, false));
}
__device__ __forceinline__ float wave_scan_incl(float v, int) {
    v += dpp0<0x111, 0xf>(v); v += dpp0<0x112, 0xf>(v); v += dpp0<0x114, 0xf>(v); v += dpp0<0x118, 0xf>(v);
    v += dpp0<0x142, 0xa>(v);
    v += dpp0<0x143, 0xc>(v);
    return v;
}
#endif
__device__ __forceinline__ float lane63(float v) { return __builtin_bit_cast(float, __builtin_amdgcn_readlane(__builtin_bit_cast(int, v), 63)); }
__device__ __forceinline__ void transpose_item(const float* W, int K, int N, unsigned short* WT, int dst_row0, LAS float* scr, int k0, int n0, int lane) {
    const int nn = n0 + (lane & 31);
#pragma unroll 8
    for (int i = 0; i < 32; ++i) { const int kk = 2 * i + (lane >> 5); scr[kk * 33 + (lane & 31)] = nn < N ? W[(size_t)(k0 + kk) * N + nn] : 0.f; }
    asm volatile("s_waitcnt lgkmcnt(0)" ::: "memory");
    const int c = lane & 7;
#pragma unroll
    for (int j = 0; j < 4; ++j) { const int n = (lane >> 3) + 8 * j; const LAS float* sp = scr + (8 * c) * 33 + n;
        v4u o; o.x = pk2(sp[0 * 33], sp[1 * 33]); o.y = pk2(sp[2 * 33], sp[3 * 33]); o.z = pk2(sp[4 * 33], sp[5 * 33]); o.w = pk2(sp[6 * 33], sp[7 * 33]);
        *(v4u*)(WT + (size_t)(dst_row0 + n) * K + k0 + 8 * c) = o; }
    asm volatile("s_waitcnt lgkmcnt(0)" ::: "memory");
}
__device__ __forceinline__ void prologue_weights(const Params& p, LAS float* scr, int gw, int NGW, int lane) {
    constexpr int I_IN = 16 * (LDP / 32), I_OUT = 16 * 32, I_W1 = 16 * (DFF / 32), I_W2 = (DFF / 64) * 32;
    constexpr int PER_L = I_IN + I_OUT + 2 * I_W1 + I_W2;
    for (int it = gw; it < DEPTH * PER_L; it += NGW) {
        const int l = it / PER_L; int r = it % PER_L;
        if (r < I_IN) { const int nb = r % (LDP / 32), kb = r / (LDP / 32);
            transpose_item(p.w_in + (size_t)l * DM * DIN, DM, DIN, p.WIN_T + (size_t)l * LDP * DM, nb * 32, scr, kb * 64, nb * 32, lane); continue; }
        r -= I_IN;
        if (r < I_OUT) { const int nb = r % 32, kb = r / 32;
            transpose_item(p.w_out + (size_t)l * DM * DM, DM, DM, p.WOUT_T + (size_t)l * DM * DM, nb * 32, scr, kb * 64, nb * 32, lane); continue; }
        r -= I_OUT;
        if (r < 2 * I_W1) { const int which = r / I_W1; r %= I_W1; const int nb = r % (DFF / 32), kb = r / (DFF / 32); const int n0 = nb * 32;
            const int drow = 256 * (n0 / 128) + 128 * which + (n0 % 128);
            transpose_item((which ? p.ffn_w3 : p.ffn_w1) + (size_t)l * DM * DFF, DM, DFF, p.W13_T + (size_t)l * NFF2 * DM, drow, scr, kb * 64, n0, lane); continue; }
        r -= 2 * I_W1;
        { const int nb = r % 32, kb = r / 32;
            transpose_item(p.ffn_w2 + (size_t)l * DFF * DM, DFF, DM, p.W2_T + (size_t)l * DM * DFF, nb * 32, scr, kb * 64, nb * 32, lane); }
    }
}

__device__ __forceinline__ void mod_partial(const Params& p, long tid, long nth, float* MODP) {
    for (long i = tid; i < 2L * 16 * 1536; i += nth) {
        const int n4 = (int)(i % 1536), kc = (int)((i / 1536) & 15), l = (int)(i / (1536 * 16));
        f32x4 acc[NB + 1];
        float z0 = 0.f; asm volatile("" : "+v"(z0));
#pragma unroll
        for (int bb = 0; bb <= NB; ++bb) acc[bb] = (f32x4){z0, z0, z0, z0};
        const float* w = p.mod_w + ((size_t)l * DM + kc * 64) * 6 * DM + 4 * n4;
#pragma unroll 4
        for (int k = 0; k < 64; ++k) {
            const f32x4 w4 = *(const f32x4*)(w + (size_t)k * 6 * DM);
#pragma unroll
            for (int bb = 0; bb <= NB; ++bb) {
                const float cv = (bb < NB ? p.c + (size_t)bb * DM : p.c_ctx)[kc * 64 + k];
                acc[bb] += w4 * (cv / (1.0f + __expf(-cv)));
            }
        }
#pragma unroll
        for (int bb = 0; bb <= NB; ++bb) *(f32x4*)(MODP + (((size_t)kc * DEPTH + l) * (NB + 1) + bb) * 6 * DM + 4 * n4) = acc[bb];
    }
}
__device__ __forceinline__ void mod_reduce(const Params& p, long tid, long nth, const float* MODP) {
    const long total = (long)DEPTH * (NB + 1) * 6 * DM;
    for (long i = tid; i < total; i += nth) {
        const int n = (int)(i % (6 * DM)), l = (int)(i / ((long)6 * DM * (NB + 1)));
        float acc = p.mod_b[(size_t)l * 6 * DM + n];
#pragma unroll
        for (int kc = 0; kc < 16; ++kc) acc += MODP[(size_t)kc * total + i];
        p.MOD[i] = acc;
    }
}
constexpr int FL_Z = 0, FL_H1 = 8704, FL_H2 = 8704 + 16640, FL_T = 8704 + 2 * 16640;
constexpr int FILT_UNITS = DEPTH * (SEQ / 64) + DEPTH * (CTX / 64);
__device__ __forceinline__ void filt_unit(const Params& p, LAS unsigned char* lds, int u, int tix) {
    const bool isctx = u >= DEPTH * (SEQ / 64);
    const int uu = isctx ? u - DEPTH * (SEQ / 64) : u, per = isctx ? CTX / 64 : SEQ / 64;
    const int l = uu / per, t0 = (uu % per) * 64, ttb = (isctx ? SEQ : 0) + t0;
    LAS float* Z = (LAS float*)(lds + FL_Z); LAS float* H1 = (LAS float*)(lds + FL_H1); LAS float* H2 = (LAS float*)(lds + FL_H2);
    __syncthreads();
    {
        const int tap = tix & 63, bq = tix >> 6;
        float rel; filt_pos(ttb + tap, rel);
        const float tw = 2.0f * 3.14159265358979323846f * rel;
        if (bq == 0) Z[tap * 34] = rel;
#pragma unroll
        for (int k = 0; k < 2; ++k) { const int j = 2 * bq + k; const float ang = tw * (1e-4f + (float)j * ((15.0f - 1e-4f) / 15.0f));
            Z[tap * 34 + 1 + j] = cosf(ang); Z[tap * 34 + 17 + j] = -sinf(ang); }
    }
    __syncthreads();
    {
        const int tap = tix & 63, o0 = __builtin_amdgcn_readfirstlane(tix >> 6) * 8;
        float acc[8];
#pragma unroll
        for (int e = 0; e < 8; ++e) acc[e] = 0.f;
        const float* w1 = p.hy_w1 + (size_t)l * 33 * 64 + o0;
#pragma unroll 3
        for (int i = 0; i < 33; ++i) { const float zv = Z[tap * 34 + i];
#pragma unroll
            for (int e = 0; e < 8; ++e) acc[e] += zv * w1[i * 64 + e]; }
#pragma unroll
        for (int e = 0; e < 8; ++e) H1[tap * 65 + o0 + e] = sinf(p.hy_freq[l * 64 + o0 + e] * (acc[e] + p.hy_b1[l * 64 + o0 + e]));
    }
    __syncthreads();
    {
        const int tap = tix & 63, o0 = __builtin_amdgcn_readfirstlane(tix >> 6) * 8;
        float acc[8];
#pragma unroll
        for (int e = 0; e < 8; ++e) acc[e] = 0.f;
        const float* w2 = p.hy_w2 + (size_t)l * 64 * 64 + o0;
#pragma unroll 4
        for (int j = 0; j < 64; ++j) { const float hv = H1[tap * 65 + j];
#pragma unroll
            for (int e = 0; e < 8; ++e) acc[e] += hv * w2[j * 64 + e]; }
#pragma unroll
        for (int e = 0; e < 8; ++e) H2[tap * 65 + o0 + e] = sinf(p.hy_freq[l * 64 + o0 + e] * (acc[e] + p.hy_b2[l * 64 + o0 + e]));
    }
    __syncthreads();
    {
        const int c = tix & 255, half = tix >> 8;
        float w[64];
#pragma unroll
        for (int j = 0; j < 64; ++j) w[j] = p.hy_w3[(size_t)l * 64 * 256 + j * 256 + c];
        const float dec = p.hy_decay[l * 256 + c];
#pragma unroll 2
        for (int k = 0; k < 32; ++k) {
            const int tap = 32 * half + k;
            float acc = 0.f;
#pragma unroll
            for (int j = 0; j < 64; ++j) acc += H2[tap * 65 + j] * w[j];
            float rel; filt_pos(ttb + tap, rel);
            const float hv = acc * expf(-2.0f * fabsf(rel) * dec);
            if (isctx) ((LAS float*)(lds + FL_T))[tap * 260 + c] = hv;
            else ((LAS unsigned short*)(lds + FL_T))[c * 72 + 63 - tap] = (unsigned short)f2bf_u(hv);
        }
    }
    __syncthreads();
    if (isctx) {
        for (int e = tix; e < 64 * 256; e += 512) p.HFC[((size_t)l * CTX + t0 + (e >> 8)) * 256 + (e & 255)] = ((const LAS float*)(lds + FL_T))[(e >> 8) * 260 + (e & 255)];
    } else {
#pragma unroll 4
        for (int k = 0; k < 32; ++k) { const int e = k * 512 + tix, row = e >> 6, col = e & 63;
            p.G1[((size_t)l * 256 + row) * G1N + (8456 - t0 - 63) + col] = ((const LAS unsigned short*)(lds + FL_T))[row * 72 + col]; }
    }
}
__device__ __forceinline__ void filt_all(const Params& p, LAS unsigned char* lds, long tid, long nth, int tix, int bid, int G) {
    constexpr int NPAD = 265 + (G1N - 8457);
    for (long i = tid; i < (long)DEPTH * 256 * NPAD; i += nth) {
        const int k = (int)(i % NPAD); const long lc = i / NPAD;
        p.G1[lc * G1N + (k < 265 ? k : 8457 + (k - 265))] = 0;
    }
    for (int u = bid; u < FILT_UNITS; u += G) filt_unit(p, lds, u, tix);
    __syncthreads();
}
__device__ __forceinline__ const float* xsrc_row(const Params& p, int r, bool from_input) {
    if (from_input) return r < BL ? p.x + (size_t)r * DM : p.ctx + (size_t)(r - BL) * DM;
    return r < BL ? p.XL + (size_t)r * DM : p.XC + (size_t)(r - BL) * DM;
}
template <bool SLAB>
__device__ __forceinline__ void hx_pass(const Params& p, int l, int which, int row_lo, int row_hi, int gw, int NGW, int lane, int nslab = 0, const float* slab = nullptr, const float* gate = nullptr, bool base_from_input = false) {
    const float* g = (which ? p.norm2_g : p.norm1_g) + (size_t)l * DM;
    for (int r = row_lo + gw; r < row_hi; r += NGW) {
        const float* m = p.MOD + ((size_t)l * (NB + 1) + row_bb(r)) * 6 * DM;
        const float* sh = m + (which ? 3 : 0) * DM; const float* sc = m + (which ? 4 : 1) * DM;
        f32x4 v[4]; float s = 0.f;
        if (SLAB) {
            const f32x4* x4 = (const f32x4*)(base_from_input ? p.ctx + (size_t)(r - BL) * DM : p.XC + (size_t)(r - BL) * DM) + lane;
            f32x4* xo = (f32x4*)(p.XC + (size_t)(r - BL) * DM) + lane;
            const f32x4* sl = (const f32x4*)(slab + (size_t)(r - BL) * DM) + lane;
#pragma unroll
            for (int j = 0; j < 4; ++j) v[j] = (f32x4){0.f, 0.f, 0.f, 0.f};
#pragma unroll 1
            for (int q = 0; q < nslab; ++q) {
#pragma unroll
                for (int j = 0; j < 4; ++j) v[j] += sl[(size_t)q * BC * (DM / 4) + 64 * j];
            }
#pragma unroll
            for (int j = 0; j < 4; ++j) { v[j] = x4[64 * j] + *(const f32x4*)(gate + 4 * lane + 256 * j) * v[j]; xo[64 * j] = v[j]; }
        } else {
            const f32x4* x4 = (const f32x4*)xsrc_row(p, r, l == 0 && which == 0) + lane;
#pragma unroll
            for (int j = 0; j < 4; ++j) v[j] = x4[64 * j];
        }
#pragma unroll
        for (int j = 0; j < 4; ++j) s += (v[j].x * v[j].x + v[j].y * v[j].y) + (v[j].z * v[j].z + v[j].w * v[j].w);
        const float rstd = 1.0f / sqrtf(wave_sum(s, lane) * (1.0f / DM) + EPSV);
        unsigned long long* o8 = (unsigned long long*)(p.Y + (size_t)r * DM) + lane;
#pragma unroll
        for (int j = 0; j < 4; ++j) {
            const int k = 4 * lane + 256 * j;
            const f32x4 gg = *(const f32x4*)(g + k), s1 = *(const f32x4*)(sc + k), s0 = *(const f32x4*)(sh + k);
            const f32x4 o = v[j] * rstd * gg * (s1 + 1.0f) + s0;
            o8[64 * j] = (unsigned long long)pk2(o.x, o.y) | ((unsigned long long)pk2(o.z, o.w) << 32);
        }
    }
}
__device__ __forceinline__ void final_pass(const Params& p, int gw, int NGW, int lane) {
    for (int r = gw; r < BL; r += NGW) {
        f32x4* x4 = (f32x4*)(p.XL + (size_t)r * DM) + lane;
        f32x4 v[4]; float s = 0.f;
#pragma unroll
        for (int j = 0; j < 4; ++j) { v[j] = x4[64 * j]; s += (v[j].x * v[j].x + v[j].y * v[j].y) + (v[j].z * v[j].z + v[j].w * v[j].w); }
        const float rstd = 1.0f / sqrtf(wave_sum(s, lane) * (1.0f / DM) + EPSV);
#pragma unroll
        for (int j = 0; j < 4; ++j) x4[64 * j] = v[j] * rstd * *(const f32x4*)(p.final_g + 4 * lane + 256 * j);
    }
}


#define GAS __attribute__((address_space(1)))
#define XB_TMO      128
#define XB_XCNT(j)  (256  + 64 * (j))
#define XB_XSUB(j)  (1280 + 64 * (j))
#define XB_XGEN(j)  (2304 + 64 * (j))
#define XB_TOP      3328
#define XB_TOPGEN   3392
#define XCD_BAR_WORDS 3456
#define XB_SPIN_CAP (1u << 18)

__device__ __forceinline__ unsigned xb_ld(unsigned* p)              { return __hip_atomic_load(p, __ATOMIC_RELAXED, __HIP_MEMORY_SCOPE_AGENT); }
__device__ __forceinline__ unsigned xb_add(unsigned* p, unsigned v) { return __hip_atomic_fetch_add(p, v, __ATOMIC_RELAXED, __HIP_MEMORY_SCOPE_AGENT); }
__device__ __forceinline__ unsigned xb_xcc_id() { return (unsigned)__builtin_amdgcn_s_getreg((3 << 11) | 20) & 0xFu; }
#define XB_SPIN(cond, bar) do { unsigned _sp = 0; while (cond) { __builtin_amdgcn_s_sleep(1); \
    if ((++_sp & 255u) == 0u) { if (xb_ld(&(bar)[XB_TMO])) break; if (_sp > XB_SPIN_CAP) { atomicAdd(&(bar)[XB_TMO], 1u); break; } } } } while (0)

struct XcdBarrier {
    unsigned* bar; unsigned x;
    volatile LAS unsigned* st;
};

__device__ __forceinline__ XcdBarrier xcd_barrier_post(unsigned* bar, volatile LAS unsigned* st) {
    XcdBarrier b; b.bar = bar; b.x = xb_xcc_id(); b.st = st;
    if (threadIdx.x == 0) (void)xb_add(&bar[XB_XCNT(b.x)], 1u);
    return b;
}
__device__ __forceinline__ void xcd_barrier_complete(unsigned* bar, unsigned x, unsigned& nloc, unsigned& nx) {
    const unsigned G = gridDim.x * gridDim.y * gridDim.z;
    unsigned sum, cnt, mine, sp = 0u;
    for (;;) {
        sum = 0u; cnt = 0u; mine = 0u;
#pragma unroll
        for (unsigned j = 0; j < 16; ++j) { const unsigned c = xb_ld(&bar[XB_XCNT(j)]); sum += c; cnt += (c > 0u) ? 1u : 0u; mine = (j == x) ? c : mine; }
        if (sum == G) break;
        __builtin_amdgcn_s_sleep(1);
        if ((++sp & 255u) == 0u) { if (xb_ld(&bar[XB_TMO])) break; if (sp > XB_SPIN_CAP) { atomicAdd(&bar[XB_TMO], 1u); break; } }
    }
    nloc = mine > 0u ? mine : 1u; nx = cnt > 0u ? cnt : 1u;
}

__device__ __forceinline__ void xcd_barrier(const XcdBarrier& b, bool leader) {
    asm volatile("s_waitcnt vmcnt(0)" ::: "memory");
    __syncthreads();
    if (leader) {
        unsigned* bar = b.bar;
        __builtin_amdgcn_s_waitcnt(0);
        unsigned nloc = b.st[0], nx = b.st[1];
        if (nloc == 0u) { xcd_barrier_complete(bar, b.x, nloc, nx); b.st[0] = nloc; b.st[1] = nx; }
        const unsigned old = xb_add(&bar[XB_XSUB(b.x)], 1u);
        const unsigned gen = old / nloc;
        if (old + 1u == (gen + 1u) * nloc) {
            __builtin_amdgcn_fence(__ATOMIC_RELEASE, "agent");
            asm volatile("s_waitcnt vmcnt(0)" ::: "memory");
            const unsigned og = xb_add(&bar[XB_TOP], 1u);
            const unsigned tg = og / nx;
            if (og + 1u == (tg + 1u) * nx) xb_add(&bar[XB_TOPGEN], 1u);
            else XB_SPIN(xb_ld(&bar[XB_TOPGEN]) == tg, bar);
            __builtin_amdgcn_fence(__ATOMIC_ACQUIRE, "agent");
            xb_add(&bar[XB_XGEN(b.x)], 1u);
            asm volatile("s_waitcnt vmcnt(0)" ::: "memory");
        } else {
            XB_SPIN(xb_ld(&bar[XB_XGEN(b.x)]) == gen, bar);
            __builtin_amdgcn_fence(__ATOMIC_ACQUIRE, "agent");
            asm volatile("s_waitcnt vmcnt(0)" ::: "memory");
        }
    }
    __syncthreads();
}
#define GNCC ((CTX + SEQ) / 64)
#define GCTXC (CTX / 64)
#define GLA_UNITS (NB * 6 * GNCC)
typedef short bf16x8 __attribute__((ext_vector_type(8)));
__device__ __forceinline__ int gla_row0(int b, int cc) { return cc < GCTXC ? BL + b * CTX + cc * 64 : b * SEQ + (cc - GCTXC) * 64; }
__device__ __forceinline__ size_t gla_uidx(int dir, int b, int h, int cc) { return (((size_t)dir * NB + b) * 6 + h) * GNCC + cc; }
__device__ __forceinline__ float bflo(unsigned u) { return __builtin_bit_cast(float, u << 16); }
__device__ __forceinline__ float bfhi(unsigned u) { return __builtin_bit_cast(float, u & 0xffff0000u); }
constexpr int GL_WL = 0, GL_BIAS = 24576, GL_VT = 26112, GL_KLT = 35328, GL_AC = 44544, GL_KD = 70144, GL_PART = 80384;
constexpr int GL_VTS = 72, GL_ACS = 200, GL_KDS = 40;

__device__ __forceinline__ void gla_stage_w(const Params& p, int l, LAS unsigned char* lds, int tix) {
    LAS float* WL = (LAS float*)(lds + GL_WL); LAS float* BI = (LAS float*)(lds + GL_BIAS);
    for (int i = tix; i < 6 * 1024; i += 512) { const int h = i >> 10, dir = (i >> 9) & 1, j = (i >> 5) & 15, d = i & 31;
        WL[i] = (dir ? p.gk_w_b : p.gk_w_f)[(size_t)l * 16 * 192 + j * 192 + h * 32 + d]; }
    if (tix < 384) { const int h = tix >> 6, dir = (tix >> 5) & 1, d = tix & 31; BI[tix] = (dir ? p.gk_b_b : p.gk_b_f)[l * 192 + h * 32 + d]; }
}
struct GlaPre { v4u v, gk0, gk1, q, k; };
template <bool NEEDQ>
__device__ __forceinline__ void gla_issue(const Params& p, int u, int tix, GlaPre& L) {
    const int b = u / (6 * GNCC), h = (u / GNCC) % 6, cc = u % GNCC, row0 = gla_row0(b, cc);
    const int lane = tix & 63, wave = tix >> 6, dir = wave >> 2, d0 = (wave & 3) * 8;
    L.v = *(const v4u*)(p.P + (size_t)(row0 + (tix >> 3)) * LDP + OFF_V + h * 64 + (tix & 7) * 8);
    const act_t* prow = p.P + (size_t)(row0 + lane) * LDP;
    L.gk0 = *(const v4u*)(prow + (dir ? OFF_GKB : OFF_GKF)); L.gk1 = *(const v4u*)(prow + (dir ? OFF_GKB : OFF_GKF) + 8);
    L.k = *(const v4u*)(prow + OFF_K + h * 32 + d0);
    if (NEEDQ) L.q = *(const v4u*)(prow + OFF_Q + h * 32 + d0);
}
__device__ __forceinline__ void gla_put_v(LAS unsigned char* lds, int tix, const v4u vv) {
    const int j = tix >> 3, eo = tix & 7;
    LAS unsigned short* VT = (LAS unsigned short*)(lds + GL_VT);
    VT[(eo * 8 + 0) * GL_VTS + j] = (unsigned short)(vv.x & 0xffff); VT[(eo * 8 + 1) * GL_VTS + j] = (unsigned short)(vv.x >> 16);
    VT[(eo * 8 + 2) * GL_VTS + j] = (unsigned short)(vv.y & 0xffff); VT[(eo * 8 + 3) * GL_VTS + j] = (unsigned short)(vv.y >> 16);
    VT[(eo * 8 + 4) * GL_VTS + j] = (unsigned short)(vv.z & 0xffff); VT[(eo * 8 + 5) * GL_VTS + j] = (unsigned short)(vv.z >> 16);
    VT[(eo * 8 + 6) * GL_VTS + j] = (unsigned short)(vv.w & 0xffff); VT[(eo * 8 + 7) * GL_VTS + j] = (unsigned short)(vv.w >> 16);
}
__device__ __forceinline__ void gla_phase_a(const v4u g0, const v4u g1, LAS unsigned char* lds, int h, int dir, int d0, int lane, float (&Bv)[8], float (&tot)[8]) {
    const LAS float* WL = (const LAS float*)(lds + GL_WL) + h * 1024 + dir * 512 + d0; const LAS float* BI = (const LAS float*)(lds + GL_BIAS) + h * 64 + dir * 32 + d0;
    float gk[16] = { bflo(g0.x), bfhi(g0.x), bflo(g0.y), bfhi(g0.y), bflo(g0.z), bfhi(g0.z), bflo(g0.w), bfhi(g0.w),
                     bflo(g1.x), bfhi(g1.x), bflo(g1.y), bfhi(g1.y), bflo(g1.z), bfhi(g1.z), bflo(g1.w), bfhi(g1.w) };
    float lg[8];
#pragma unroll
    for (int i = 0; i < 8; ++i) lg[i] = BI[i];
#pragma unroll
    for (int j = 0; j < 16; ++j) {
        const f32x4 w0 = *(const LAS f32x4*)(WL + j * 32), w1 = *(const LAS f32x4*)(WL + j * 32 + 4);
        lg[0] += gk[j] * w0.x; lg[1] += gk[j] * w0.y; lg[2] += gk[j] * w0.z; lg[3] += gk[j] * w0.w;
        lg[4] += gk[j] * w1.x; lg[5] += gk[j] * w1.y; lg[6] += gk[j] * w1.z; lg[7] += gk[j] * w1.w;
    }
#pragma unroll
    for (int i = 0; i < 8; ++i) {
        const float x = lg[i];
        lg[i] = -(fmaxf(-x, 0.f) + __logf(1.0f + __expf(-fabsf(x)))) * (1.0f / 16.0f);
        const float v = wave_scan_incl(lg[i], lane);
        tot[i] = lane63(v);
        Bv[i] = dir ? tot[i] - v + lg[i] : v;
    }
}
__device__ __forceinline__ void unpack8(const v4u k, float (&f)[8]) {
    f[0] = bflo(k.x); f[1] = bfhi(k.x); f[2] = bflo(k.y); f[3] = bfhi(k.y); f[4] = bflo(k.z); f[5] = bfhi(k.z); f[6] = bflo(k.w); f[7] = bfhi(k.w);
}
__device__ __forceinline__ int gla_count(int b, int ph) {
    if (gridDim.x != 256 || GLA_UNITS != 3168) return (GLA_UNITS - b + (int)gridDim.x - 1) / (int)gridDim.x;
    const int n0 = ph ? 8 : 9, extra = 3168 - 16 * n0 - 240 * 12;
    return b < 16 ? n0 : 12 + ((b - 16) < extra ? 1 : 0);
}
__device__ __forceinline__ int gla_unit_of(int b, int k, int ph) {
    if (gridDim.x != 256 || GLA_UNITS != 3168) return b + k * (int)gridDim.x;
    const int n0 = ph ? 8 : 9;
    return b < 16 ? n0 * b + k : (k < 12 ? 16 * n0 + (b - 16) * 12 + k : 16 * n0 + 2880 + (b - 16));
}
__device__ __forceinline__ void gla_m2_phase(const Params& p, int l, LAS unsigned char* lds, int tix, int bid, unsigned short* DSG, float* DECG) {
    const int lane = tix & 63, wave = __builtin_amdgcn_readfirstlane(tix >> 6);
    gla_stage_w(p, l, lds, tix);
    GlaPre L;
    const int ncnt = gla_count(bid, 0);
    if (ncnt > 0) gla_issue<false>(p, gla_unit_of(bid, 0, 0), tix, L);
    __syncthreads();
#pragma unroll 1
    for (int kk = 0; kk < ncnt; ++kk) {
        const int u = gla_unit_of(bid, kk, 0);
        const int b = u / (6 * GNCC), h = (u / GNCC) % 6, cc = u % GNCC;
        gla_put_v(lds, tix, L.v);
        {
            const int dir = wave >> 2, d0 = (wave & 3) * 8;
            float Bv[8], tot[8];
            gla_phase_a(L.gk0, L.gk1, lds, h, dir, d0, lane, Bv, tot);
            float kf[8]; unpack8(L.k, kf);
            LAS unsigned short* KLT = (LAS unsigned short*)(lds + GL_KLT) + (dir * 32 + d0) * GL_VTS + lane;
#pragma unroll
            for (int i = 0; i < 8; ++i) KLT[i * GL_VTS] = (unsigned short)f2bf_u(kf[i] * __expf(tot[i] - Bv[i]));
            if (lane == 0) {
                float* dg = DECG + gla_uidx(dir, b, h, cc) * 32 + d0;
#pragma unroll
                for (int i = 0; i < 8; ++i) dg[i] = __expf(tot[i]);
            }
        }
        if (kk + 1 < ncnt) gla_issue<false>(p, gla_unit_of(bid, kk + 1, 0), tix, L);
        __syncthreads();
        {
            const int dir = wave >> 2, te = wave & 3, fr = lane & 15, fq = lane >> 4;
            unsigned short* out = DSG + gla_uidx(dir, b, h, cc) * 2048;
#pragma unroll
            for (int td = 0; td < 2; ++td) {
                f32x4 acc = {0.f, 0.f, 0.f, 0.f};
#pragma unroll
                for (int ks = 0; ks < 2; ++ks) {
                    const bf16x8 a = *(const LAS bf16x8*)(lds + GL_VT + ((16 * te + fr) * GL_VTS + 32 * ks + 8 * fq) * 2);
                    const bf16x8 bb = *(const LAS bf16x8*)(lds + GL_KLT + ((dir * 32 + 16 * td + fr) * GL_VTS + 32 * ks + 8 * fq) * 2);
                    acc = __builtin_amdgcn_mfma_f32_16x16x32_bf16(a, bb, acc, 0, 0, 0);
                }
#pragma unroll
                for (int r = 0; r < 4; ++r) out[(16 * te + 4 * fq + r) * 32 + 16 * td + fr] = (unsigned short)f2bf_u(acc[r]);
            }
        }
        __syncthreads();
    }
}
template <int NSTEP, int BATCH>
__device__ __forceinline__ void gla_m3_seg(f32x4& S, const unsigned short* DSG, const float* DECG, unsigned short* SSG, size_t base, int cc0, int step, int ed) {
    static_assert(NSTEP % BATCH == 0, "");
#pragma unroll 1
    for (int k0 = 0; k0 < NSTEP; k0 += BATCH) {
        f32x4 d[BATCH], dc[BATCH]; unsigned long long draw[BATCH];
#pragma unroll
        for (int j = 0; j < BATCH; ++j) { const size_t u = base + cc0 + (k0 + j) * step; draw[j] = *(const unsigned long long*)(DSG + u * 2048 + ed); dc[j] = *(const f32x4*)(DECG + u * 32 + (ed & 31)); }
#pragma unroll
        for (int j = 0; j < BATCH; ++j) { const unsigned lo = (unsigned)draw[j], hi = (unsigned)(draw[j] >> 32); d[j] = (f32x4){bflo(lo), bfhi(lo), bflo(hi), bfhi(hi)}; }
#pragma unroll
        for (int j = 0; j < BATCH; ++j) { const size_t u = base + cc0 + (k0 + j) * step;
            *(unsigned long long*)(SSG + u * 2048 + ed) = (unsigned long long)pk2(S.x, S.y) | ((unsigned long long)pk2(S.z, S.w) << 32);
            S = dc[j] * S + d[j]; }
    }
}
__device__ __forceinline__ void gla_m3(long tid, long nth, const unsigned short* DSG, const float* DECG, unsigned short* SSG) {
    for (long i = tid; i < 2L * NB * 6 * 512; i += nth) {
        const int ed = (int)(i & 511) * 4, chain = (int)(i >> 9), dir = chain / (NB * 6);
        const size_t base = (size_t)chain * GNCC;
        float z0 = 0.f; asm volatile("" : "+v"(z0));
        f32x4 S = {z0, z0, z0, z0};
        if (dir == 0) { gla_m3_seg<GCTXC, GCTXC>(S, DSG, DECG, SSG, base, 0, 1, ed); gla_m3_seg<GNCC - GCTXC, 16>(S, DSG, DECG, SSG, base, GCTXC, 1, ed); }
        else { gla_m3_seg<GCTXC, GCTXC>(S, DSG, DECG, SSG, base, GCTXC - 1, -1, ed); gla_m3_seg<GNCC - GCTXC, 16>(S, DSG, DECG, SSG, base, GNCC - 1, -1, ed); }
    }
}
struct GlaPre4 { bf16x8 s[2][2]; unsigned short g[4][2]; };
__device__ __forceinline__ void gla_issue4(const Params& p, int u, int tix, const unsigned short* SSG, GlaPre4& S) {
    const int b = u / (6 * GNCC), h = (u / GNCC) % 6, cc = u % GNCC, row0 = gla_row0(b, cc);
    const int lane = tix & 63, wave = tix >> 6, fr = lane & 15, fq = lane >> 4, ti = wave >> 1, ch = wave & 1;
#pragma unroll
    for (int dir = 0; dir < 2; ++dir)
#pragma unroll
        for (int n = 0; n < 2; ++n) S.s[dir][n] = *(const bf16x8*)(SSG + gla_uidx(dir, b, h, cc) * 2048 + (32 * ch + 16 * n + fr) * 32 + 8 * fq);
#pragma unroll
    for (int r = 0; r < 4; ++r)
#pragma unroll
        for (int n = 0; n < 2; ++n) S.g[r][n] = p.P[(size_t)(row0 + 16 * ti + 4 * fq + r) * LDP + OFF_G + h * 64 + 32 * ch + 16 * n + fr];
}
__device__ __forceinline__ void gla_m4_phase(const Params& p, int l, LAS unsigned char* lds, int tix, int bid, const unsigned short* SSG) {
    const int lane = tix & 63, wave = __builtin_amdgcn_readfirstlane(tix >> 6), fr = lane & 15, fq = lane >> 4;
    gla_stage_w(p, l, lds, tix);
    GlaPre L; GlaPre4 S;
    const int ncnt = gla_count(bid, 1);
    if (ncnt > 0) { const int u0 = gla_unit_of(bid, 0, 1); gla_issue<true>(p, u0, tix, L); gla_issue4(p, u0, tix, SSG, S); }
    __syncthreads();
#pragma unroll 1
    for (int kk = 0; kk < ncnt; ++kk) {
        const int u = gla_unit_of(bid, kk, 1);
        const int b = u / (6 * GNCC), h = (u / GNCC) % 6, cc = u % GNCC, row0 = gla_row0(b, cc);
        gla_put_v(lds, tix, L.v);
        {
            const int dir = wave >> 2, d0 = (wave & 3) * 8;
            float Bv[8], tot[8];
            gla_phase_a(L.gk0, L.gk1, lds, h, dir, d0, lane, Bv, tot);
            float kf[8], qf[8]; unpack8(L.k, kf); unpack8(L.q, qf);
            float qd[8], kd[8];
#pragma unroll
            for (int i = 0; i < 8; ++i) { qd[i] = qf[i] * __expf(Bv[i]) * 0.17677669529663687f; kd[i] = kf[i] * __expf(-Bv[i]); }
            v4u w; w.x = pk2(qd[0], qd[1]); w.y = pk2(qd[2], qd[3]); w.z = pk2(qd[4], qd[5]); w.w = pk2(qd[6], qd[7]);
            *(LAS v4u*)(lds + GL_AC + (lane * GL_ACS + 128 + 32 * dir + d0) * 2) = w;
            w.x = pk2(kd[0], kd[1]); w.y = pk2(kd[2], kd[3]); w.z = pk2(kd[4], kd[5]); w.w = pk2(kd[6], kd[7]);
            *(LAS v4u*)(lds + GL_KD + ((dir * 64 + lane) * GL_KDS + d0) * 2) = w;
        }
        const bool more = kk + 1 < ncnt;
        if (more) gla_issue<true>(p, gla_unit_of(bid, kk + 1, 1), tix, L);
        __syncthreads();
        {
            const int dir = wave >> 2, ti = wave & 3;
            const bf16x8 a = *(const LAS bf16x8*)(lds + GL_AC + ((16 * ti + fr) * GL_ACS + 128 + 32 * dir + 8 * fq) * 2);
            LAS unsigned short* AC = (LAS unsigned short*)(lds + GL_AC);
#pragma unroll
            for (int tj = 0; tj < 4; ++tj) {
                const bf16x8 bb = *(const LAS bf16x8*)(lds + GL_KD + ((dir * 64 + 16 * tj + fr) * GL_KDS + 8 * fq) * 2);
                f32x4 acc = {0.f, 0.f, 0.f, 0.f};
                acc = __builtin_amdgcn_mfma_f32_16x16x32_bf16(a, bb, acc, 0, 0, 0);
                const int j = 16 * tj + fr;
#pragma unroll
                for (int r = 0; r < 4; ++r) { const int i = 16 * ti + 4 * fq + r; const bool keep = dir ? (j >= i) : (j <= i);
                    AC[i * GL_ACS + 64 * dir + j] = (unsigned short)f2bf_u(keep ? acc[r] : 0.f); }
            }
        }
        __syncthreads();
        f32x4 acc[2] = { {0.f, 0.f, 0.f, 0.f}, {0.f, 0.f, 0.f, 0.f} };
        const int ti = wave >> 1, ch = wave & 1;
        {
            bf16x8 bv[2][2];
#pragma unroll
            for (int ks = 0; ks < 2; ++ks)
#pragma unroll
                for (int n = 0; n < 2; ++n) bv[ks][n] = *(const LAS bf16x8*)(lds + GL_VT + ((32 * ch + 16 * n + fr) * GL_VTS + 32 * ks + 8 * fq) * 2);
#pragma unroll
            for (int part = 0; part < 2; ++part)
#pragma unroll
                for (int ks = 0; ks < 2; ++ks) {
                    const bf16x8 a = *(const LAS bf16x8*)(lds + GL_AC + ((16 * ti + fr) * GL_ACS + 64 * part + 32 * ks + 8 * fq) * 2);
#pragma unroll
                    for (int n = 0; n < 2; ++n) acc[n] = __builtin_amdgcn_mfma_f32_16x16x32_bf16(a, bv[ks][n], acc[n], 0, 0, 0);
                }
#pragma unroll
            for (int dir = 0; dir < 2; ++dir) {
                const bf16x8 a = *(const LAS bf16x8*)(lds + GL_AC + ((16 * ti + fr) * GL_ACS + 128 + 32 * dir + 8 * fq) * 2);
#pragma unroll
                for (int n = 0; n < 2; ++n) acc[n] = __builtin_amdgcn_mfma_f32_16x16x32_bf16(a, S.s[dir][n], acc[n], 0, 0, 0);
            }
            LAS float* PART = (LAS float*)(lds + GL_PART);
#pragma unroll
            for (int r = 0; r < 4; ++r) {
                float ss = acc[0][r] * acc[0][r] + acc[1][r] * acc[1][r];
                ss = sum16(ss);
                if (fr == 0) PART[(16 * ti + 4 * fq + r) * 2 + ch] = ss;
            }
        }
        __syncthreads();
        {
            const LAS float* PART = (const LAS float*)(lds + GL_PART);
#pragma unroll
            for (int r = 0; r < 4; ++r) {
                const int i = 16 * ti + 4 * fq + r;
                const float rs = 1.0f / sqrtf((PART[i * 2] + PART[i * 2 + 1]) * (1.0f / 64.0f) + EPSV);
#pragma unroll
                for (int n = 0; n < 2; ++n) {
                    const int e = 32 * ch + 16 * n + fr;
                    const float g = bflo((unsigned)S.g[r][n]);
                    stact(p.Y + (size_t)(row0 + i) * DM + h * 64 + e, acc[n][r] * rs * p.gla_norm_w[l * 64 + e] * (g / (1.0f + __expf(-g))));
                }
            }
        }
        if (more) gla_issue4(p, gla_unit_of(bid, kk + 1, 1), tix, SSG, S);
    }
    __syncthreads();
}

#define SNCC ((CTX + SEQ) / 128)
#define SCTXC (CTX / 128)
#define SSD_UNITS (NB * 2 * SNCC)
constexpr int SD_CM = 0, SD_BM = 34816, SD_XT = 69632, SD_HS = 121856, SD_DTL = 139264, SD_CSL = 142336, SD_TOT = 145408, SD_HS2OFF = 145440 - 121856;
constexpr int SD_S = 136;
static_assert(SD_HS + SD_HS2OFF + 64 * 136 * 2 <= LDS_BYTES - 64, "SSD LDS map");
__device__ __forceinline__ int ssd_row(int b, int cc, int i) {
    if (cc < SCTXC) return BL + b * CTX + cc * 128 + i;
    return b * SEQ + colmajor_tok(0, (cc - SCTXC) * 128 + i);
}
__device__ __forceinline__ size_t ssd_chain(int dir, int b, int head) { return ((size_t)dir * NB + b) * 6 + head; }
template <bool TR_B, bool WITH_C>
__device__ __forceinline__ void ssd_stage(const Params& p, int l, LAS unsigned char* lds, int b, int g, int cc, int tix) {
    const int sidx = cc < SCTXC ? NB + b : b, L = seq_len(sidx), r0 = seq_row0(sidx), pos0 = (cc < SCTXC ? cc : cc - SCTXC) * 128;
    constexpr int NQ = WITH_C ? 14 : 10;
    LAS float* CW = (LAS float*)(lds + SD_HS);
    for (int i = tix; i < 4 * NQ * 32; i += 512) {
        const int k = i / (NQ * 32), cl = i % (NQ * 32), q = cl >> 5;
        const int col = (q < 6 ? g * 192 + q * 32 : (q < 10 ? 384 + g * 128 + (q - 6) * 32 : 640 + g * 128 + (q - 10) * 32)) + (cl & 31);
        CW[i] = k < 3 ? p.ssd_conv_w[(size_t)l * 3 * 896 + k * 896 + col] : p.ssd_conv_b[(size_t)l * 896 + col];
    }
    __syncthreads();
    for (int item = tix; item < 128 * NQ; item += 512) {
        const int i = item & 127, q = __builtin_amdgcn_readfirstlane(item >> 7);
        const int col0 = q < 6 ? g * 192 + q * 32 : (q < 10 ? 384 + g * 128 + (q - 6) * 32 : 640 + g * 128 + (q - 10) * 32);
        const int pos = pos0 + i;
        const act_t* rc = p.P + (size_t)(r0 + colmajor_tok(sidx, pos)) * LDP + OFF_XBC + col0;
        const bool hp = pos > 0, hn = pos + 1 < L;
        const act_t* rp = hp ? p.P + (size_t)(r0 + colmajor_tok(sidx, pos - 1)) * LDP + OFF_XBC + col0 : rc;
        const act_t* rn = hn ? p.P + (size_t)(r0 + colmajor_tok(sidx, pos + 1)) * LDP + OFF_XBC + col0 : rc;
        v4u raw[3][4];
#pragma unroll
        for (int o = 0; o < 4; ++o) { raw[0][o] = *(const v4u*)(rp + 8 * o); raw[1][o] = *(const v4u*)(rc + 8 * o); raw[2][o] = *(const v4u*)(rn + 8 * o); }
        const LAS float* cw = CW + q * 32;
#pragma unroll
        for (int o = 0; o < 4; ++o) {
            float xp[8], xc[8], xn[8], y[8];
            unpack8(raw[0][o], xp); unpack8(raw[1][o], xc); unpack8(raw[2][o], xn);
#pragma unroll
            for (int h2 = 0; h2 < 2; ++h2) {
                const f32x4 w0 = *(const LAS f32x4*)(cw + 8 * o + 4 * h2), w1 = *(const LAS f32x4*)(cw + NQ * 32 + 8 * o + 4 * h2);
                const f32x4 w2 = *(const LAS f32x4*)(cw + 2 * NQ * 32 + 8 * o + 4 * h2), bs = *(const LAS f32x4*)(cw + 3 * NQ * 32 + 8 * o + 4 * h2);
#pragma unroll
                for (int e4 = 0; e4 < 4; ++e4) {
                    const int e = 4 * h2 + e4;
                    const float vp = hp ? xp[e] : 0.f, vn = hn ? xn[e] : 0.f;
                    const float a = bs[e4] + w1[e4] * xc[e] + w0[e4] * vp + w2[e4] * vn;
                    y[e] = a * __builtin_amdgcn_rcpf(1.0f + __expf(-a));
                }
            }
            if (q < 6) {
                LAS unsigned short* d = (LAS unsigned short*)(lds + SD_XT) + (q * 32 + 8 * o) * SD_S + i;
#pragma unroll
                for (int e = 0; e < 8; ++e) d[e * SD_S] = (unsigned short)f2bf_u(y[e]);
            } else if (q < 10) {
                if (TR_B) { LAS unsigned short* d = (LAS unsigned short*)(lds + SD_BM) + ((q - 6) * 32 + 8 * o) * SD_S + i;
#pragma unroll
                    for (int e = 0; e < 8; ++e) d[e * SD_S] = (unsigned short)f2bf_u(y[e]);
                } else { v4u w; w.x = pk2(y[0], y[1]); w.y = pk2(y[2], y[3]); w.z = pk2(y[4], y[5]); w.w = pk2(y[6], y[7]);
                    *(LAS v4u*)(lds + SD_BM + (i * SD_S + (q - 6) * 32 + 8 * o) * 2) = w; }
            } else { v4u w; w.x = pk2(y[0], y[1]); w.y = pk2(y[2], y[3]); w.z = pk2(y[4], y[5]); w.w = pk2(y[6], y[7]);
                *(LAS v4u*)(lds + SD_CM + (i * SD_S + (q - 10) * 32 + 8 * o) * 2) = w; }
        }
    }
}
__device__ __forceinline__ void ssd_scans(const Params& p, int l, LAS unsigned char* lds, int b, int g, int cc, int wave, int lane) {
    if (wave < 6) {
        const int hg = wave % 3, dir = wave / 3, head = g * 3 + hg;
        const float bias = (dir ? p.ssd_dt_bias_b : p.ssd_dt_bias_f)[l * 6 + head];
        const float A = -__expf((dir ? p.ssd_a_log_b : p.ssd_a_log_f)[l * 6 + head]);
        float dt[2], a[2];
#pragma unroll
        for (int k = 0; k < 2; ++k) {
            const float x = ldact(p.P + (size_t)ssd_row(b, cc, 2 * lane + k) * LDP + (dir ? OFF_DTB : OFF_DTF) + head) + bias;
            dt[k] = fmaxf(x, 0.f) + log1pf(__expf(-fabsf(x))); a[k] = A * dt[k];
        }
        const float v = wave_scan_incl(a[0] + a[1], lane);
        const float tot = lane63(v);
        const float pf1 = v, pf0 = v - a[1];
        LAS float* DTL = (LAS float*)(lds + SD_DTL) + wave * 128 + 2 * lane; LAS float* CSL = (LAS float*)(lds + SD_CSL) + wave * 128 + 2 * lane;
        DTL[0] = dt[0]; DTL[1] = dt[1];
        CSL[0] = dir ? tot - pf0 + a[0] : pf0; CSL[1] = dir ? tot - pf1 + a[1] : pf1;
        if (lane == 0) ((LAS float*)(lds + SD_TOT))[wave] = tot;
    }
}
__device__ __forceinline__ void ssd_s2_unit(const Params& p, int l, LAS unsigned char* lds, int u, int tix, unsigned short* DSS, float* DECS) {
    const int b = u / (2 * SNCC), g = (u / SNCC) & 1, cc = u % SNCC;
    const int lane = tix & 63, wave = __builtin_amdgcn_readfirstlane(tix >> 6), fr = lane & 15, fq = lane >> 4;
    ssd_scans(p, l, lds, b, g, cc, wave, lane);
    ssd_stage<true, false>(p, l, lds, b, g, cc, tix);
    __syncthreads();
    if (tix < 6) DECS[ssd_chain(tix / 3, b, g * 3 + tix % 3) * SNCC + cc] = __expf(((const LAS float*)(lds + SD_TOT))[tix]);
#pragma unroll 1
    for (int k = 0; k < 3; ++k) {
        const int c3 = wave + 8 * k, tp = c3 & 3, combo = c3 >> 2, hg = combo % 3, dir = combo / 3;
        const LAS float* DTL = (const LAS float*)(lds + SD_DTL) + combo * 128; const LAS float* CSL = (const LAS float*)(lds + SD_CSL) + combo * 128;
        const float tot = ((const LAS float*)(lds + SD_TOT))[combo];
        bf16x8 a[4];
#pragma unroll
        for (int ks = 0; ks < 4; ++ks) {
            const int j0 = 32 * ks + 8 * fq;
            float xf[8]; unpack8(*(const LAS v4u*)(lds + SD_XT + ((hg * 64 + 16 * tp + fr) * SD_S + j0) * 2), xf);
            const f32x4 d0 = *(const LAS f32x4*)(DTL + j0), d1 = *(const LAS f32x4*)(DTL + j0 + 4), c0 = *(const LAS f32x4*)(CSL + j0), c1 = *(const LAS f32x4*)(CSL + j0 + 4);
            xf[0] *= d0.x * __expf(tot - c0.x); xf[1] *= d0.y * __expf(tot - c0.y); xf[2] *= d0.z * __expf(tot - c0.z); xf[3] *= d0.w * __expf(tot - c0.w);
            xf[4] *= d1.x * __expf(tot - c1.x); xf[5] *= d1.y * __expf(tot - c1.y); xf[6] *= d1.z * __expf(tot - c1.z); xf[7] *= d1.w * __expf(tot - c1.w);
            v4u w; w.x = pk2(xf[0], xf[1]); w.y = pk2(xf[2], xf[3]); w.z = pk2(xf[4], xf[5]); w.w = pk2(xf[6], xf[7]);
            a[ks] = __builtin_bit_cast(bf16x8, w);
        }
        unsigned short* out = DSS + (ssd_chain(dir, b, g * 3 + hg) * SNCC + cc) * 8192;
#pragma unroll
        for (int tn = 0; tn < 8; ++tn) {
            f32x4 acc = {0.f, 0.f, 0.f, 0.f};
#pragma unroll
            for (int ks = 0; ks < 4; ++ks) {
                const bf16x8 bb = *(const LAS bf16x8*)(lds + SD_BM + ((16 * tn + fr) * SD_S + 32 * ks + 8 * fq) * 2);
                acc = __builtin_amdgcn_mfma_f32_16x16x32_bf16(bb, a[ks], acc, 0, 0, 0);
            }
            *(unsigned long long*)(out + (16 * tp + fr) * 128 + 16 * tn + 4 * fq) = (unsigned long long)pk2(acc[0], acc[1]) | ((unsigned long long)pk2(acc[2], acc[3]) << 32);
        }
    }
    __syncthreads();
}
template <int NSTEP, int BATCH>
__device__ __forceinline__ void ssd_s3_seg(float (&S)[8], unsigned short* DSS, const float* DECS, size_t base, int cc0, int step, int el) {
    static_assert(NSTEP % BATCH == 0, "");
#pragma unroll 1
    for (int k0 = 0; k0 < NSTEP; k0 += BATCH) {
        v4u d[BATCH]; float dc[BATCH];
#pragma unroll
        for (int j = 0; j < BATCH; ++j) { const size_t u = base + cc0 + (k0 + j) * step; d[j] = *(const v4u*)(DSS + u * 8192 + el); dc[j] = DECS[u]; }
#pragma unroll
        for (int j = 0; j < BATCH; ++j) { const size_t u = base + cc0 + (k0 + j) * step;
            v4u w; w.x = pk2(S[0], S[1]); w.y = pk2(S[2], S[3]); w.z = pk2(S[4], S[5]); w.w = pk2(S[6], S[7]);
            *(v4u*)(DSS + u * 8192 + el) = w;
            float df[8]; unpack8(d[j], df);
#pragma unroll
            for (int e = 0; e < 8; ++e) S[e] = S[e] * dc[j] + df[e]; }
    }
}
__device__ __forceinline__ void ssd_s3(long tid, long nth, unsigned short* DSS, const float* DECS) {
    for (long i = tid; i < 2L * NB * 6 * 1024; i += nth) {
        const int el = (int)(i & 1023) * 8, chain = (int)(i >> 10), dir = chain / (NB * 6);
        const size_t base = (size_t)chain * SNCC;
        float z0 = 0.f; asm volatile("" : "+v"(z0));
        float S[8] = {z0, z0, z0, z0, z0, z0, z0, z0};
        if (dir == 0) { ssd_s3_seg<SCTXC, SCTXC>(S, DSS, DECS, base, 0, 1, el); ssd_s3_seg<SNCC - SCTXC, 8>(S, DSS, DECS, base, SCTXC, 1, el); }
        else { ssd_s3_seg<SCTXC, SCTXC>(S, DSS, DECS, base, SCTXC - 1, -1, el); ssd_s3_seg<SNCC - SCTXC, 8>(S, DSS, DECS, base, SNCC - 1, -1, el); }
    }
}
__device__ __forceinline__ void ssd_load_h(const unsigned short* HSS, int b, int head, int cc, int tix, v4u (&h)[2][2]) {
#pragma unroll
    for (int dir = 0; dir < 2; ++dir) {
        const unsigned short* hsrc = HSS + (ssd_chain(dir, b, head) * SNCC + cc) * 8192 + (tix >> 3) * 128 + (tix & 7) * 16;
        h[dir][0] = *(const v4u*)hsrc; h[dir][1] = *(const v4u*)(hsrc + 8);
    }
}
__device__ __forceinline__ void ssd_s4_unit(const Params& p, int l, LAS unsigned char* lds, int u, int tix, const unsigned short* HSS) {
    const int b = u / (2 * SNCC), g = (u / SNCC) & 1, cc = u % SNCC;
    const int lane = tix & 63, wave = __builtin_amdgcn_readfirstlane(tix >> 6), fr = lane & 15, fq = lane >> 4;
    ssd_scans(p, l, lds, b, g, cc, wave, lane);
    ssd_stage<false, true>(p, l, lds, b, g, cc, tix);
    __syncthreads();
    LAS unsigned char* cm_rd = lds + SD_CM + ((16 * wave + fr) * SD_S + 8 * fq) * 2;
    LAS unsigned char* bm_rd = lds + SD_BM + (fr * SD_S + 8 * fq) * 2;
    LAS unsigned char* m_rd = lds + SD_BM + ((16 * wave + fr) * SD_S + 8 * fq) * 2;
    LAS unsigned char* m_wr = lds + SD_BM + ((16 * wave + 4 * fq) * SD_S + fr) * 2;
    LAS unsigned char* xt_rd = lds + SD_XT + (fr * SD_S + 8 * fq) * 2;
    LAS unsigned char* hs_rd = lds + SD_HS + (fr * SD_S + 8 * fq) * 2;
    LAS unsigned char* hs_wr = lds + SD_HS + ((tix >> 3) * SD_S + (tix & 7) * 16) * 2;
    LAS unsigned char* sc_j = lds + SD_DTL + fr * 4;
    LAS unsigned char* sc_i = lds + SD_DTL + (16 * wave + 4 * fq) * 4;
    asm volatile("" : "+v"(cm_rd), "+v"(bm_rd), "+v"(m_rd), "+v"(m_wr), "+v"(xt_rd), "+v"(hs_rd), "+v"(hs_wr), "+v"(sc_j), "+v"(sc_i));
    f32x4 cb[8];
    bf16x8 ca[4];
#pragma unroll
    for (int ks = 0; ks < 4; ++ks) ca[ks] = *(const LAS bf16x8*)(cm_rd + 64 * ks);
#pragma unroll
    for (int tj = 0; tj < 8; ++tj) {
        cb[tj] = (f32x4){0.f, 0.f, 0.f, 0.f};
#pragma unroll
        for (int ks = 0; ks < 4; ++ks) {
            const bf16x8 bb = *(const LAS bf16x8*)(bm_rd + (16 * tj * SD_S + 32 * ks) * 2);
            cb[tj] = __builtin_amdgcn_mfma_f32_16x16x32_bf16(ca[ks], bb, cb[tj], 0, 0, 0);
        }
    }
    __syncthreads();
    f32x4 yacc[3][4];
#pragma unroll
    for (int hg = 0; hg < 3; ++hg)
#pragma unroll
        for (int tp = 0; tp < 4; ++tp) yacc[hg][tp] = (f32x4){0.f, 0.f, 0.f, 0.f};
#pragma unroll
    for (int hg = 0; hg < 3; ++hg) {
        v4u hreg[2][2];
        ssd_load_h(HSS, b, g * 3 + hg, cc, tix, hreg);
        __builtin_amdgcn_sched_barrier(0);
        float csfi[4], csbi[4];
#pragma unroll
        for (int r = 0; r < 4; ++r) { csfi[r] = *(const LAS float*)(sc_i + 3072 + hg * 512 + 4 * r); csbi[r] = *(const LAS float*)(sc_i + 3072 + (3 + hg) * 512 + 4 * r); }
#pragma unroll
        for (int tj = 0; tj < 8; ++tj) {
            const int j = 16 * tj + fr;
            const float csfj = *(const LAS float*)(sc_j + 3072 + hg * 512 + 64 * tj), csbj = *(const LAS float*)(sc_j + 3072 + (3 + hg) * 512 + 64 * tj);
            const float dtfj = *(const LAS float*)(sc_j + hg * 512 + 64 * tj), dtbj = *(const LAS float*)(sc_j + (3 + hg) * 512 + 64 * tj);
#pragma unroll
            for (int r = 0; r < 4; ++r) { const int i = 16 * wave + 4 * fq + r;
                const float arg = (j <= i) ? csfi[r] - csfj : csbi[r] - csbj;
                const float wgt = (j < i) ? dtfj : ((j > i) ? dtbj : dtfj + dtbj);
                *(LAS unsigned short*)(m_wr + (r * SD_S + 16 * tj) * 2) = (unsigned short)f2bf_u(cb[tj][r] * __expf(fminf(arg, 0.f)) * wgt); }
            __builtin_amdgcn_sched_barrier(0);
        }
        __builtin_amdgcn_sched_barrier(0);
#pragma unroll
        for (int dir = 0; dir < 2; ++dir) {
            *(LAS v4u*)(hs_wr + dir * SD_HS2OFF) = hreg[dir][0]; *(LAS v4u*)(hs_wr + dir * SD_HS2OFF + 16) = hreg[dir][1];
        }
        __syncthreads();
        f32x4 tmp[4];
#pragma unroll
        for (int tp = 0; tp < 4; ++tp) tmp[tp] = (f32x4){0.f, 0.f, 0.f, 0.f};
#pragma unroll
        for (int ks = 0; ks < 4; ++ks) {
            const bf16x8 am = *(const LAS bf16x8*)(m_rd + 64 * ks);
#pragma unroll
            for (int tp = 0; tp < 4; ++tp) {
                const bf16x8 bx = *(const LAS bf16x8*)(xt_rd + ((hg * 64 + 16 * tp) * SD_S + 32 * ks) * 2);
                yacc[hg][tp] = __builtin_amdgcn_mfma_f32_16x16x32_bf16(am, bx, yacc[hg][tp], 0, 0, 0);
                const bf16x8 bhf = *(const LAS bf16x8*)(hs_rd + (16 * tp * SD_S + 32 * ks) * 2);
                tmp[tp] = __builtin_amdgcn_mfma_f32_16x16x32_bf16(ca[ks], bhf, tmp[tp], 0, 0, 0);
            }
        }
#pragma unroll
        for (int r = 0; r < 4; ++r) { const float ef = __expf(csfi[r]);
#pragma unroll
            for (int tp = 0; tp < 4; ++tp) { yacc[hg][tp][r] += ef * tmp[tp][r]; tmp[tp][r] = 0.f; } }
#pragma unroll
        for (int ks = 0; ks < 4; ++ks)
#pragma unroll
            for (int tp = 0; tp < 4; ++tp) {
                const bf16x8 bhb = *(const LAS bf16x8*)(hs_rd + SD_HS2OFF + (16 * tp * SD_S + 32 * ks) * 2);
                tmp[tp] = __builtin_amdgcn_mfma_f32_16x16x32_bf16(ca[ks], bhb, tmp[tp], 0, 0, 0);
            }
#pragma unroll
        for (int r = 0; r < 4; ++r) { const float eb = __expf(csbi[r]);
#pragma unroll
            for (int tp = 0; tp < 4; ++tp) yacc[hg][tp][r] += eb * tmp[tp][r]; }
        __syncthreads();
    }
#pragma unroll
    for (int hg = 0; hg < 3; ++hg) {
        const float dcoef = p.ssd_d[l * 6 + g * 3 + hg];
#pragma unroll
        for (int tp = 0; tp < 4; ++tp) {
            const int pc = hg * 64 + 16 * tp + fr;
#pragma unroll
            for (int r = 0; r < 4; ++r)
                yacc[hg][tp][r] += dcoef * bflo((unsigned)((const LAS unsigned short*)(lds + SD_XT))[pc * SD_S + 16 * wave + 4 * fq + r]);
        }
    }
    __syncthreads();
    {
        LAS float* YL = (LAS float*)lds;
#pragma unroll
        for (int hg = 0; hg < 3; ++hg)
#pragma unroll
            for (int tp = 0; tp < 4; ++tp)
#pragma unroll
                for (int r = 0; r < 4; ++r) YL[(16 * wave + 4 * fq + r) * 196 + hg * 64 + 16 * tp + fr] = yacc[hg][tp][r];
        const float nw0 = p.ssd_norm_w[l * 384 + g * 192 + lane], nw1 = p.ssd_norm_w[l * 384 + g * 192 + 64 + lane], nw2 = p.ssd_norm_w[l * 384 + g * 192 + 128 + lane];
#pragma unroll 1
        for (int r8 = 0; r8 < 16; r8 += 8) {
            unsigned short zr[8][3];
#pragma unroll
            for (int k = 0; k < 8; ++k) {
                const act_t* zp = p.P + (size_t)ssd_row(b, cc, 16 * wave + r8 + k) * LDP + OFF_Z + g * 192 + lane;
                zr[k][0] = zp[0]; zr[k][1] = zp[64]; zr[k][2] = zp[128];
            }
#pragma unroll
            for (int k = 0; k < 8; ++k) {
                const int i = 16 * wave + r8 + k;
                const float z0 = bflo(zr[k][0]), z1 = bflo(zr[k][1]), z2 = bflo(zr[k][2]);
                const float v0 = YL[i * 196 + lane] * (z0 / (1.0f + __expf(-z0))), v1 = YL[i * 196 + 64 + lane] * (z1 / (1.0f + __expf(-z1))), v2 = YL[i * 196 + 128 + lane] * (z2 / (1.0f + __expf(-z2)));
                const float rs = 1.0f / sqrtf(wave_sum(v0 * v0 + v1 * v1 + v2 * v2, lane) * (1.0f / 192.0f) + EPSV);
                act_t* yp = p.Y + (size_t)ssd_row(b, cc, i) * DM + 640 + g * 192 + lane;
                stact(yp, v0 * rs * nw0); stact(yp + 64, v1 * rs * nw1); stact(yp + 128, v2 * rs * nw2);
            }
        }
    }
    __syncthreads();
}

typedef float f32x16 __attribute__((ext_vector_type(16)));
constexpr int HY_CP = 0, HY_MOFF = 4352, HY_U = 17920, HY_US = 264, HY_OUT = 85504;
__device__ __forceinline__ void hy_u8(const Params& p, int l, int b, int t, int col0, float (&y)[8]) {
    const act_t* rc = p.P + (size_t)(b * SEQ + t) * LDP + OFF_HY + col0;
    const float* w = p.hy_short_w + (size_t)l * 3 * 768 + col0; const float* bs = p.hy_short_b + (size_t)l * 768 + col0;
    const bool hp = t > 0, hn = t + 1 < SEQ;
    float xc[8], xp[8], xn[8];
    unpack8(*(const v4u*)rc, xc); unpack8(*(const v4u*)(hp ? rc - LDP : rc), xp); unpack8(*(const v4u*)(hn ? rc + LDP : rc), xn);
#pragma unroll
    for (int e = 0; e < 8; ++e) y[e] = bs[e] + w[768 + e] * xc[e] + w[e] * (hp ? xp[e] : 0.f) + w[2 * 768 + e] * (hn ? xn[e] : 0.f);
}
__device__ __forceinline__ void hy_ctx_conv(const Params& p, int l, long tid, long nth) {
    for (long i = tid; i < (long)BC * 256; i += nth) {
        const int c = (int)(i & 255), r = BL + (int)(i >> 8);
        const int s = NB + (r - BL) / CTX, r0 = seq_row0(s), t = r - r0;
        const float* hf = p.HFC + (size_t)l * CTX * 256 + c;
        int jlo = t + CTX / 2 - (CTX - 1); if (jlo < 0) jlo = 0;
        int jhi = t + CTX / 2; if (jhi > CTX - 1) jhi = CTX - 1;
        float acc = 0.f;
#pragma unroll 8
        for (int j = jlo; j <= jhi; ++j) acc += hf[(size_t)(t - j + CTX / 2) * 256] * p.VX[(size_t)(r0 + j) * 256 + c];
        const float x0 = hy_u(p, l, s, t, c);
        stact(p.Y + (size_t)r * DM + 384 + c, (acc + p.VX[(size_t)r * 256 + c] * p.hy_bias[l * 256 + c]) * x0);
    }
}
constexpr int HY_HW = 81920;
__device__ __forceinline__ void hy_stage_w(const Params& p, int l, LAS unsigned char* lds, int tix) {
    LAS float* HW = (LAS float*)(lds + HY_HW);
    for (int i = tix; i < 4 * 768; i += 512) HW[i] = i < 3 * 768 ? p.hy_short_w[(size_t)l * 3 * 768 + i] : p.hy_short_b[(size_t)l * 768 + (i - 3 * 768)];
    __syncthreads();
}
__device__ __forceinline__ void hy_conv8(const v4u rp, const v4u rc, const v4u rn, bool hp, bool hn, const LAS float* hw, float (&y)[8]) {
    float xp[8], xc[8], xn[8]; unpack8(rp, xp); unpack8(rc, xc); unpack8(rn, xn);
#pragma unroll
    for (int h2 = 0; h2 < 2; ++h2) {
        const f32x4 w0 = *(const LAS f32x4*)(hw + 4 * h2), w1 = *(const LAS f32x4*)(hw + 768 + 4 * h2), w2 = *(const LAS f32x4*)(hw + 1536 + 4 * h2), bs = *(const LAS f32x4*)(hw + 2304 + 4 * h2);
#pragma unroll
        for (int e4 = 0; e4 < 4; ++e4) { const int e = 4 * h2 + e4; y[e] = bs[e4] + w1[e4] * xc[e] + w0[e4] * (hp ? xp[e] : 0.f) + w2[e4] * (hn ? xn[e] : 0.f); }
    }
}
__device__ __forceinline__ void hy_h1_unit(const Params& p, int l, LAS unsigned char* lds, int u, int tix) {
    const int b = u / (SEQ / 64), t0 = (u % (SEQ / 64)) * 64;
    const int t = tix & 63, cg = __builtin_amdgcn_readfirstlane(tix >> 6);
    LAS unsigned short* T = (LAS unsigned short*)lds;
    const int tok = t0 + t; const bool hp = tok > 0, hn = tok + 1 < SEQ;
    const act_t* rc = p.P + (size_t)(b * SEQ + tok) * LDP + OFF_HY + 32 * cg; const act_t* rp = hp ? rc - LDP : rc; const act_t* rn = hn ? rc + LDP : rc;
    v4u raw[4][2][3];
#pragma unroll
    for (int o = 0; o < 4; ++o)
#pragma unroll
        for (int gq = 0; gq < 2; ++gq) { const int col = 256 * (gq + 1) + 8 * o; raw[o][gq][0] = *(const v4u*)(rp + col); raw[o][gq][1] = *(const v4u*)(rc + col); raw[o][gq][2] = *(const v4u*)(rn + col); }
    const LAS float* HW = (const LAS float*)(lds + HY_HW) + 32 * cg;
#pragma unroll
    for (int o = 0; o < 4; ++o) {
        float x1[8], v[8];
        hy_conv8(raw[o][0][0], raw[o][0][1], raw[o][0][2], hp, hn, HW + 256 + 8 * o, x1);
        hy_conv8(raw[o][1][0], raw[o][1][1], raw[o][1][2], hp, hn, HW + 512 + 8 * o, v);
#pragma unroll
        for (int e = 0; e < 8; ++e) T[(32 * cg + 8 * o + e) * 72 + t] = (unsigned short)f2bf_u(v[e] * x1[e]);
    }
    __syncthreads();
    {
        const int c = tix >> 1, half = tix & 1;
        unsigned short* dst = p.VXT + ((size_t)(b * 256 + c)) * SEQ + t0 + 32 * half;
#pragma unroll
        for (int k = 0; k < 4; ++k) *(v4u*)(dst + 8 * k) = *(const LAS v4u*)(lds + (c * 72 + 32 * half + 8 * k) * 2);
    }
    __syncthreads();
}
template <int ALPHA>
__device__ __forceinline__ bf16x8 hy_afrag(const LAS unsigned char* a) {
    constexpr int SFT = 8 - ALPHA, SIG = SFT >> 1, HALF = SFT & 1;
    const v4u Y = *(const LAS v4u*)(a + 16);
    if constexpr (ALPHA == 0) { return __builtin_bit_cast(bf16x8, Y); }
    else {
        const v4u X = *(const LAS v4u*)a;
        const unsigned W[9] = { X.x, X.y, X.z, X.w, Y.x, Y.y, Y.z, Y.w, 0u };
        v4u o;
        o.x = HALF ? __builtin_amdgcn_alignbit(W[SIG + 1], W[SIG + 0], 16) : W[SIG + 0];
        o.y = HALF ? __builtin_amdgcn_alignbit(W[SIG + 2], W[SIG + 1], 16) : W[SIG + 1];
        o.z = HALF ? __builtin_amdgcn_alignbit(W[SIG + 3], W[SIG + 2], 16) : W[SIG + 2];
        o.w = HALF ? __builtin_amdgcn_alignbit(W[SIG + 4], W[SIG + 3], 16) : W[SIG + 3];
        return __builtin_bit_cast(bf16x8, o);
    }
}
template <int ALPHA>
__device__ __forceinline__ void hy_stream(LAS unsigned char* lds, int lane, f32x16 (&acc)[4]) {
    const int r = lane & 31, hf = lane >> 5, Il = r >> 2, bt = r & 3;
    LAS unsigned char* a_base = lds + HY_CP + 2 * (HY_MOFF + 8 * (hf - r) + 4096) - 12288;
    LAS unsigned char* b_base = lds + HY_U + ((Il * 4 + bt) * HY_US + 8 * hf) * 2;
    asm volatile("" : "+v"(a_base), "+v"(b_base));
    const bf16x8 zero8 = {0, 0, 0, 0, 0, 0, 0, 0};
#pragma unroll 1
    for (int s = 0; s < 16; ++s) {
        LAS unsigned char* ap = a_base + 32 * s; LAS unsigned char* bp = b_base + 32 * s;
#pragma unroll 1
        for (int delta = 0; delta < 8; ++delta) {
            const bf16x8 a0 = hy_afrag<ALPHA>(ap + 3 * 4096), a1 = hy_afrag<ALPHA>(ap + 2 * 4096), a2 = hy_afrag<ALPHA>(ap + 4096), a3 = hy_afrag<ALPHA>(ap);
            bf16x8 b0 = *(const LAS bf16x8*)bp, b1 = *(const LAS bf16x8*)(bp + 16896), b2 = *(const LAS bf16x8*)(bp + 2 * 16896);
            LAS unsigned char* bp3 = bp + 3 * 16896;
            bf16x8 b3 = *(const LAS bf16x8*)bp3, b4 = *(const LAS bf16x8*)(bp3 + 16896);
            b0 = (Il >= delta) ? b0 : zero8; b4 = (Il < delta) ? b4 : zero8;
            acc[0] = __builtin_amdgcn_mfma_f32_32x32x16_bf16(a0, b2, acc[0], 0, 0, 0);
            acc[1] = __builtin_amdgcn_mfma_f32_32x32x16_bf16(a0, b3, acc[1], 0, 0, 0);
            acc[2] = __builtin_amdgcn_mfma_f32_32x32x16_bf16(a0, b4, acc[2], 0, 0, 0);
            acc[3] = __builtin_amdgcn_mfma_f32_32x32x16_bf16(a1, b4, acc[3], 0, 0, 0);
            acc[0] = __builtin_amdgcn_mfma_f32_32x32x16_bf16(a1, b1, acc[0], 0, 0, 0);
            acc[1] = __builtin_amdgcn_mfma_f32_32x32x16_bf16(a1, b2, acc[1], 0, 0, 0);
            acc[2] = __builtin_amdgcn_mfma_f32_32x32x16_bf16(a1, b3, acc[2], 0, 0, 0);
            acc[3] = __builtin_amdgcn_mfma_f32_32x32x16_bf16(a2, b3, acc[3], 0, 0, 0);
            acc[0] = __builtin_amdgcn_mfma_f32_32x32x16_bf16(a2, b0, acc[0], 0, 0, 0);
            acc[1] = __builtin_amdgcn_mfma_f32_32x32x16_bf16(a2, b1, acc[1], 0, 0, 0);
            acc[2] = __builtin_amdgcn_mfma_f32_32x32x16_bf16(a2, b2, acc[2], 0, 0, 0);
            acc[3] = __builtin_amdgcn_mfma_f32_32x32x16_bf16(a3, b2, acc[3], 0, 0, 0);
            acc[1] = __builtin_amdgcn_mfma_f32_32x32x16_bf16(a3, b0, acc[1], 0, 0, 0);
            acc[2] = __builtin_amdgcn_mfma_f32_32x32x16_bf16(a3, b1, acc[2], 0, 0, 0);
            if (delta == 0) {
                const bf16x8 a4 = hy_afrag<ALPHA>(ap - 4096);
                acc[2] = __builtin_amdgcn_mfma_f32_32x32x16_bf16(a4, b0, acc[2], 0, 0, 0);
                acc[3] = __builtin_amdgcn_mfma_f32_32x32x16_bf16(a4, b1, acc[3], 0, 0, 0);
            }
            ap -= 512; bp -= 2112;
        }
    }
}
__device__ __forceinline__ void hy_h2_channel(const Params& p, int l, LAS unsigned char* lds, int c, int tix) {
    const int lane = tix & 63, wave = __builtin_amdgcn_readfirstlane(tix >> 6);
    __syncthreads();
    for (int item = tix; item < 4096; item += 512) {
        const int bt = item >> 10, j = (item & 1023) * 8;
        *(LAS v4u*)(lds + HY_U + (((j >> 8) * 4 + bt) * HY_US + (j & 255)) * 2) = *(const v4u*)(p.VXT + ((size_t)(bt * 256 + c)) * SEQ + j);
    }
    {
        const unsigned short* g1 = p.G1 + ((size_t)l * 256 + c) * G1N;
        for (int item = tix; item < G1N / 8; item += 512) *(LAS v4u*)(lds + HY_CP + item * 16) = *(const v4u*)(g1 + item * 8);
    }
    __syncthreads();
    f32x16 acc[4];
#pragma unroll
    for (int i = 0; i < 4; ++i)
#pragma unroll
        for (int k = 0; k < 16; ++k) acc[i][k] = 0.f;
    switch (wave) {
        case 0: hy_stream<0>(lds, lane, acc); break;
        case 1: hy_stream<1>(lds, lane, acc); break;
        case 2: hy_stream<2>(lds, lane, acc); break;
        case 3: hy_stream<3>(lds, lane, acc); break;
        case 4: hy_stream<4>(lds, lane, acc); break;
        case 5: hy_stream<5>(lds, lane, acc); break;
        case 6: hy_stream<6>(lds, lane, acc); break;
        default: hy_stream<7>(lds, lane, acc); break;
    }
    const int r = lane & 31, hf = lane >> 5;
    LAS float* ST = (LAS float*)(lds + HY_U);
#pragma unroll
    for (int half = 0; half < 2; ++half) {
        __syncthreads();
#pragma unroll
        for (int ii = 0; ii < 2; ++ii)
#pragma unroll
            for (int k = 0; k < 16; ++k)
                ST[(32 * ii + r) * 257 + 8 * ((k & 3) + 8 * (k >> 2) + 4 * hf) + wave] = acc[2 * half + ii][k];
        __syncthreads();
        for (int item = tix; item < 64 * 64; item += 512) {
            const int R = item >> 6, c4 = (item & 63) * 4;
            f32x4 v; v.x = ST[R * 257 + c4]; v.y = ST[R * 257 + c4 + 1]; v.z = ST[R * 257 + c4 + 2]; v.w = ST[R * 257 + c4 + 3];
            *(f32x4*)(p.CONV + ((size_t)((R & 3) * 256 + c)) * SEQ + 256 * (16 * half + (R >> 2)) + c4) = v;
        }
    }
}
__device__ __forceinline__ void hy_h3_unit(const Params& p, int l, LAS unsigned char* lds, int u, int tix) {
    const int b = u / (SEQ / 64), t0 = (u % (SEQ / 64)) * 64;
    LAS float* T = (LAS float*)lds;
    for (int item = tix; item < 4096; item += 512) {
        const int c = item >> 4, t4 = (item & 15) * 4;
        *(LAS f32x4*)(T + c * 68 + t4) = *(const f32x4*)(p.CONV + ((size_t)(b * 256 + c)) * SEQ + t0 + t4);
    }
    const int t = tix & 63, cg = __builtin_amdgcn_readfirstlane(tix >> 6);
    const int tok = t0 + t; const bool hp = tok > 0, hn = tok + 1 < SEQ;
    const act_t* rc = p.P + (size_t)(b * SEQ + tok) * LDP + OFF_HY + 32 * cg; const act_t* rp = hp ? rc - LDP : rc; const act_t* rn = hn ? rc + LDP : rc;
    const LAS float* HW = (const LAS float*)(lds + HY_HW) + 32 * cg;
    __syncthreads();
#pragma unroll 1
    for (int oh = 0; oh < 2; ++oh) {
        v4u raw[2][3][3];
#pragma unroll
        for (int oo = 0; oo < 2; ++oo)
#pragma unroll
            for (int gq = 0; gq < 3; ++gq) { const int col = 256 * gq + 8 * (2 * oh + oo); raw[oo][gq][0] = *(const v4u*)(rp + col); raw[oo][gq][1] = *(const v4u*)(rc + col); raw[oo][gq][2] = *(const v4u*)(rn + col); }
#pragma unroll
        for (int oo = 0; oo < 2; ++oo) {
            const int o = 2 * oh + oo, c0 = 32 * cg + 8 * o;
            float x0[8], x1[8], v[8];
            hy_conv8(raw[oo][0][0], raw[oo][0][1], raw[oo][0][2], hp, hn, HW + 8 * o, x0);
            hy_conv8(raw[oo][1][0], raw[oo][1][1], raw[oo][1][2], hp, hn, HW + 256 + 8 * o, x1);
            hy_conv8(raw[oo][2][0], raw[oo][2][1], raw[oo][2][2], hp, hn, HW + 512 + 8 * o, v);
            float y[8];
#pragma unroll
            for (int e = 0; e < 8; ++e) y[e] = (T[(c0 + e) * 68 + t] + v[e] * x1[e] * p.hy_bias[l * 256 + c0 + e]) * x0[e];
            v4u w; w.x = pk2(y[0], y[1]); w.y = pk2(y[2], y[3]); w.z = pk2(y[4], y[5]); w.w = pk2(y[6], y[7]);
            *(v4u*)(p.Y + (size_t)(b * SEQ + tok) * DM + 384 + c0) = w;
        }
    }
    __syncthreads();
}

__global__ void __launch_bounds__(512, 2) mega_fwd(Params p_arg) {
    extern __shared__ __attribute__((aligned(16))) unsigned char lds_raw[];
    LAS unsigned char* lds = (LAS unsigned char*)lds_raw;
    cg::grid_group grid = cg::this_grid();
    const long nth = (long)gridDim.x * 512;
    const int NGW = gridDim.x * 8, G = gridDim.x;
    const int wave_s = __builtin_amdgcn_readfirstlane((int)threadIdx.x >> 6);
#define MY_TIX() ([&]() { unsigned z_ = 0u; asm volatile("" : "+v"(z_)); return (wave_s << 6) | (int)__builtin_amdgcn_mbcnt_hi(~0u, __builtin_amdgcn_mbcnt_lo(~0u, z_)); }())
    constexpr int LDS_BARW = LDS_BYTES - 64;
    if (threadIdx.x < 2) ((LAS unsigned*)(lds + LDS_BARW))[threadIdx.x] = 0u;
    __syncthreads();
    { const __attribute__((address_space(4))) Params* kp0 = (const __attribute__((address_space(4))) Params*)__builtin_amdgcn_kernarg_segment_ptr();
      (void)xcd_barrier_post(kp0->BAR, (volatile LAS unsigned*)(lds + LDS_BARW)); }
#define GSYNC() do { const __attribute__((address_space(4))) Params* kpb_ = (const __attribute__((address_space(4))) Params*)__builtin_amdgcn_kernarg_segment_ptr(); \
    asm volatile("" : "+s"(kpb_)); XcdBarrier xb_; xb_.bar = kpb_->BAR; xb_.x = xb_xcc_id(); xb_.st = (volatile LAS unsigned*)(lds + LDS_BARW); xcd_barrier(xb_, MY_TIX() == 0); } while (0)
#define PH_IDS() int tix_ = MY_TIX(); asm volatile("" : "+v"(tix_)); const long tid = (long)blockIdx.x * 512 + tix_; const int lane = tix_ & 63; \
    const int wave = __builtin_amdgcn_readfirstlane(tix_ >> 6); const int gw = blockIdx.x * 8 + wave; (void)tid; (void)lane; (void)gw; \
    const __attribute__((address_space(4))) Params* kp_ = (const __attribute__((address_space(4))) Params*)__builtin_amdgcn_kernarg_segment_ptr(); \
    asm volatile("" : "+s"(kp_)); const Params& p = *(const Params*)kp_;

    for (int rep = 0; rep < REP_PRO; ++rep) {
    { PH_IDS(); mod_partial(p, tid, nth, (float*)p.DSS);
      prologue_weights(p, (LAS float*)(lds + wave * 16384), gw, NGW, lane);
      filt_all(p, lds, tid, nth, tix_, blockIdx.x, G); }
    grid.sync();
    { PH_IDS(); mod_reduce(p, tid, nth, (const float*)p.DSS); }
    GSYNC();
    }
#pragma unroll 1
    for (int l = 0; l < DEPTH; ++l) {
        const int nrows = (l == DEPTH - 1) ? BL : NT;
        for (int rep = 0; rep < REP_HX; ++rep) {
        { PH_IDS(); hx_pass<false>(p, l, 0, 0, (CTX_SPLITK && l > 0) ? BL : NT, gw, NGW, lane); }
        if (CTX_SPLITK && l > 0) { PH_IDS(); hx_pass<true>(p, l, 0, BL, NT, gw, NGW, lane, DFF / 256, (const float*)p.DSG, p.MOD + ((size_t)(l - 1) * (NB + 1) + NB) * 6 * DM + 5 * DM, false); }
        GSYNC();
        }
        for (int rep = 0; rep < REP_G1; ++rep)
        {   PH_IDS();
            pg8::Gemm g{p.Y, p.WIN_T + (size_t)l * LDP * DM, NT, LDP, DM, DM}; pg8::StaticOrder S; S.init(NT, LDP, G, (int)blockIdx.x);
            pg8::EpiBf16<0> E{p.P, LDP, nullptr, 0, 0, 1.f};
            pg8::gemm_phase<pg8::EpiBf16<0>, pg8::StaticOrder, true, true>(lds, g, S, E, tix_);
            GSYNC();
        }
        for (int rep = 0; rep < REP_MIX; ++rep) {
        for (int qa = 0; qa < REP_PA; ++qa)
        {   PH_IDS();
            for (int u = blockIdx.x; u < SSD_UNITS; u += G) ssd_s2_unit(p, l, lds, u, tix_, p.DSS, p.DECS);
            gla_m2_phase(p, l, lds, tix_, blockIdx.x, p.DSG, p.DECG);
            hy_stage_w(p, l, lds, tix_);
            for (int u = blockIdx.x; u < NB * (SEQ / 64); u += G) hy_h1_unit(p, l, lds, u, tix_);
            if (l < DEPTH - 1) st_hy_pre(p, l, tid, nth, BL, NT);
        }
        GSYNC();
        {   PH_IDS();
            for (int q = 0; q < REP_H2; ++q) for (int c = blockIdx.x; c < 256; c += G) hy_h2_channel(p, l, lds, c, tix_);
            {
                const long vt = ((long)wave * G + blockIdx.x) * 64 + lane;
                if (nth >= 131072) {
                    if (vt < 49152) ssd_s3(vt, 49152, p.DSS, p.DECS);
                    else if (vt < 49152 + 24576) { for (int q = 0; q < REP_M3; ++q) gla_m3(vt - 49152, 24576, p.DSG, p.DECG, p.SSG); }
                    else if (l < DEPTH - 1) hy_ctx_conv(p, l, vt - (49152 + 24576), nth - (49152 + 24576));
                } else { ssd_s3(vt, nth, p.DSS, p.DECS); gla_m3(vt, nth, p.DSG, p.DECG, p.SSG); if (l < DEPTH - 1) hy_ctx_conv(p, l, vt, nth); }
            }
        }
        GSYNC();
        for (int qc = 0; qc < REP_PC; ++qc)
        {   PH_IDS();
            for (int u = blockIdx.x; u < SSD_UNITS; u += G) ssd_s4_unit(p, l, lds, u, tix_, p.DSS);
            gla_m4_phase(p, l, lds, tix_, blockIdx.x, p.SSG);
            hy_stage_w(p, l, lds, tix_);
            for (int u = blockIdx.x; u < NB * (SEQ / 64); u += G) hy_h3_unit(p, l, lds, u, tix_);
        }
        GSYNC();
        }
        {   PH_IDS();
            const int mrows = (CTX_SPLITK || l == DEPTH - 1) ? BL : NT; pg8::Gemm g{p.Y, p.WOUT_T + (size_t)l * DM * DM, mrows, DM, DM, DM}; pg8::StaticOrder S; S.init(mrows, DM, G, (int)blockIdx.x);
            pg8::EpiRes E{p.XL, p.XC, p.MOD + (size_t)l * (NB + 1) * 6 * DM, 2, l == 0 ? p.x : p.XL, l == 0 ? p.ctx : p.XC};
            pg8::gemm_phase<pg8::EpiRes, pg8::StaticOrder, true, true>(lds, g, S, E, tix_);
        }
        if (CTX_SPLITK && l < DEPTH - 1) {   PH_IDS();
            {
                pg8::Gemm gc{p.Y + (size_t)BL * DM, p.WOUT_T + (size_t)l * DM * DM, BC, DM, 256, DM}; pg8::SplitKOrder SC; SC.init(BC, DM, DM / 256, 256, G, (int)blockIdx.x);
                pg8::EpiSlab EC{(float*)p.DSG, BC, 512};
                pg8::gemm_phase<pg8::EpiSlab, pg8::SplitKOrder, true, true>(lds, gc, SC, EC, tix_);
            }
        }
        GSYNC();
        for (int rep = 0; rep < REP_HX; ++rep) {
        { PH_IDS(); hx_pass<false>(p, l, 1, 0, CTX_SPLITK ? BL : nrows, gw, NGW, lane); }
        if (CTX_SPLITK && l < DEPTH - 1) { PH_IDS(); hx_pass<true>(p, l, 1, BL, NT, gw, NGW, lane, DM / 256, (const float*)p.DSG, p.MOD + ((size_t)l * (NB + 1) + NB) * 6 * DM + 2 * DM, l == 0); }
        GSYNC();
        }
        for (int rep = 0; rep < REP_G3; ++rep)
        {   PH_IDS();
            pg8::Gemm g{p.Y, p.W13_T + (size_t)l * NFF2 * DM, nrows, NFF2, DM, DM}; pg8::StaticOrder S; S.init(nrows, NFF2, G, (int)blockIdx.x);
            pg8::EpiSwiGLU E{p.P};
            pg8::gemm_phase<pg8::EpiSwiGLU, pg8::StaticOrder, true, true>(lds, g, S, E, tix_);
            GSYNC();
        }
        {   PH_IDS();
            const int mrows = (CTX_SPLITK || l == DEPTH - 1) ? BL : NT; pg8::Gemm g{p.P, p.W2_T + (size_t)l * DM * DFF, mrows, DM, DFF, DFF}; pg8::StaticOrder S; S.init(mrows, DM, G, (int)blockIdx.x);
            pg8::EpiRes E{p.XL, p.XC, p.MOD + (size_t)l * (NB + 1) * 6 * DM, 5, p.XL, p.XC};
            pg8::gemm_phase<pg8::EpiRes, pg8::StaticOrder, true, true>(lds, g, S, E, tix_);
        }
        if (CTX_SPLITK && l < DEPTH - 1) {   PH_IDS();
            {
                pg8::Gemm gc{p.P + (size_t)BL * DFF, p.W2_T + (size_t)l * DM * DFF, BC, DM, 256, DFF}; pg8::SplitKOrder SC; SC.init(BC, DM, DFF / 256, 256, G, (int)blockIdx.x);
                pg8::EpiSlab EC{(float*)p.DSG, BC, 512};
                pg8::gemm_phase<pg8::EpiSlab, pg8::SplitKOrder, true, true>(lds, gc, SC, EC, tix_);
            }
        }
        GSYNC();
    }
    { PH_IDS(); final_pass(p, gw, NGW, lane); }
}

extern "C" void kernel_launch(void* const* d_in, const int* in_sizes, int n_in, void* d_out, int out_size,
                              void* d_ws, size_t ws_size, hipStream_t stream) {
    static int grid_blocks = 0;
    if (!grid_blocks) {
        int dev = 0, cus = 0, per_cu = 0;
        (void)hipGetDevice(&dev);
        (void)hipDeviceGetAttribute(&cus, hipDeviceAttributeMultiprocessorCount, dev);
        (void)hipFuncSetAttribute((const void*)mega_fwd, hipFuncAttributeMaxDynamicSharedMemorySize, LDS_BYTES);
        (void)hipOccupancyMaxActiveBlocksPerMultiprocessor(&per_cu, mega_fwd, 512, LDS_BYTES);
        if (per_cu < 1) per_cu = 1;
        grid_blocks = cus;
    }
    Params p{};
    fill_inputs(p, d_in);
    carve(p, (char*)d_ws, (float*)d_out);
    (void)hipMemsetAsync(p.BAR, 0, 16384, stream);
    void* args[] = { &p };
    hipError_t e = hipLaunchCooperativeKernel((void*)mega_fwd, dim3(grid_blocks), dim3(512), args, LDS_BYTES, stream);
    if (e != hipSuccess) fprintf(stderr, "cooperative launch failed: %s (grid %d)\n", hipGetErrorString(e), grid_blocks);
}
#endif
```

```cpp
#ifndef CPU_EMU
#include <hip/hip_runtime.h>
#include <hip/hip_cooperative_groups.h>
#include <cstdio>
#else
#include <cmath>
#include <cstring>
#include <cstdio>
#include <cstdlib>
#define __device__
#define __global__
#define __forceinline__ inline
#define __host__
#endif
#include <stdint.h>
#include <stddef.h>

#ifndef NB
#define NB 4
#endif
#ifndef SEQ
#define SEQ 8192
#endif
#ifndef CTX
#define CTX 256
#endif
#define DEPTH 2
#define DM 1024
#define GRID_W 64
#define ROWS_G (SEQ / GRID_W)
#define BL (NB * SEQ)
#define BC (NB * CTX)
#define NT (BL + BC)
#define NSEQ (2 * NB)
#define DIN 3244
#define LDP 3328
#define NFF2 (2 * DFF)
#define OFF_Q 0
#define OFF_K 192
#define OFF_V 384
#define OFF_G 768
#define OFF_GKF 1152
#define OFF_GKB 1168
#define OFF_HY 1184
#define OFF_Z 1952
#define OFF_XBC 2336
#define OFF_DTF 3232
#define OFF_DTB 3238
#define DFF 2816
#define TF (SEQ + CTX)
#define G1N 8720
#define EPSV 1e-6f

#ifdef ACT_FP32
typedef float act_t;
__device__ __forceinline__ float ldact(const act_t* p) { return *p; }
__device__ __forceinline__ void stact(act_t* p, float v) { *p = v; }
#else
typedef unsigned short act_t;
__device__ __forceinline__ float ldact(const act_t* p) {
    union { unsigned u; float f; } x; x.u = ((unsigned)*p) << 16; return x.f;
}
__device__ __forceinline__ void stact(act_t* p, float v) {
    union { float f; unsigned u; } x; x.f = v;
    unsigned r = x.u + 0x7FFFu + ((x.u >> 16) & 1u);
    *p = (unsigned short)(r >> 16);
}
#endif

struct Params {
    const float *x, *c, *ctx, *c_ctx, *mod_w, *mod_b, *norm1_g, *norm2_g, *w_in;
    const float *gk_w_f, *gk_b_f, *gk_w_b, *gk_b_b, *gla_norm_w;
    const float *hy_short_w, *hy_short_b, *hy_w1, *hy_b1, *hy_w2, *hy_b2, *hy_w3, *hy_freq, *hy_decay, *hy_bias;
    const float *ssd_conv_w, *ssd_conv_b, *ssd_dt_bias_f, *ssd_dt_bias_b, *ssd_a_log_f, *ssd_a_log_b, *ssd_d, *ssd_norm_w;
    const float *w_out, *ffn_w1, *ffn_w3, *ffn_w2, *final_g;
    float* XL;
    float* XC;
    float* MOD;
    float* HF;
    float* H1;
    float* H2;
    float* RSTD;
    act_t* P;
    act_t* Y;
    float* LG;
    float* O;
    act_t* XBC;
    float* YS;
    float* DT;
    float* VX;
    unsigned* BAR;
    unsigned short* G1;
    unsigned short* VXT;
    float* CONV;
    float* HFC;
    unsigned short *DSG, *SSG, *DSS;
    float *DECG, *DECS;
    unsigned short *WIN_T, *WOUT_T, *W13_T, *W2_T;
};

__device__ __forceinline__ float siluf(float x) { return x / (1.0f + expf(-x)); }
__device__ __forceinline__ float softplusf(float x) { return fmaxf(x, 0.0f) + log1pf(expf(-fabsf(x))); }
__device__ __forceinline__ float logsigmoidf(float x) { return -softplusf(-x); }

__device__ __forceinline__ float* xrow(const Params& p, int r) {
    return r < BL ? p.XL + (size_t)r * DM : p.XC + (size_t)(r - BL) * DM;
}
__device__ __forceinline__ int row_bb(int r) { return r < BL ? r / SEQ : NB; }
__device__ __forceinline__ int seq_len(int s) { return s < NB ? SEQ : CTX; }
__device__ __forceinline__ int seq_row0(int s) { return s < NB ? s * SEQ : BL + (s - NB) * CTX; }
__device__ __forceinline__ int colmajor_tok(int s, int pos) {
    return s < NB ? (pos % ROWS_G) * GRID_W + pos / ROWS_G : pos;
}

__device__ void st_init(const Params& p, long tid, long nth) {
    for (long i = tid; i < (long)BL * DM; i += nth) p.XL[i] = p.x[i];
    for (long i = tid; i < (long)BC * DM; i += nth) p.XC[i] = p.ctx[i];
}
__device__ void st_mod(const Params& p, long tid, long nth) {
    const long total = (long)DEPTH * (NB + 1) * 6 * DM;
    for (long i = tid; i < total; i += nth) {
        int n = (int)(i % (6 * DM));
        int bb = (int)((i / (6 * DM)) % (NB + 1));
        int l = (int)(i / ((long)6 * DM * (NB + 1)));
        const float* cv = bb < NB ? p.c + (size_t)bb * DM : p.c_ctx;
        const float* w = p.mod_w + (size_t)l * DM * 6 * DM + n;
        float acc = 0.f;
        for (int k = 0; k < DM; ++k) acc += siluf(cv[k]) * w[(size_t)k * 6 * DM];
        p.MOD[i] = acc + p.mod_b[(size_t)l * 6 * DM + n];
    }
}
__device__ __forceinline__ void filt_pos(int tt, float& rel) {
    int L = tt < SEQ ? SEQ : CTX; int t = tt < SEQ ? tt : tt - SEQ;
    rel = ((float)t - (float)(L / 2)) / (float)L;
}
__device__ void st_filt1(const Params& p, long tid, long nth) {
    const long total = (long)DEPTH * TF * 64;
    for (long i = tid; i < total; i += nth) {
        int o = (int)(i % 64); int tt = (int)((i / 64) % TF); int l = (int)(i / (64L * TF));
        float rel; filt_pos(tt, rel);
        const float* w1 = p.hy_w1 + (size_t)l * 33 * 64 + o;
        float acc = rel * w1[0];
        const float tw = 2.0f * 3.14159265358979323846f * rel;
        for (int j = 0; j < 16; ++j) {
            float band = 1e-4f + (float)j * ((15.0f - 1e-4f) / 15.0f);
            float ang = tw * band;
            acc += cosf(ang) * w1[(size_t)(1 + j) * 64];
            acc += -sinf(ang) * w1[(size_t)(17 + j) * 64];
        }
        p.H1[i] = sinf(p.hy_freq[l * 64 + o] * (acc + p.hy_b1[l * 64 + o]));
    }
}
__device__ void st_filt2(const Params& p, long tid, long nth) {
    const long total = (long)DEPTH * TF * 64;
    for (long i = tid; i < total; i += nth) {
        int o = (int)(i % 64); int l = (int)(i / (64L * TF));
        const float* h1 = p.H1 + (i - o);
        const float* w2 = p.hy_w2 + (size_t)l * 64 * 64 + o;
        float acc = 0.f;
        for (int j = 0; j < 64; ++j) acc += h1[j] * w2[(size_t)j * 64];
        p.H2[i] = sinf(p.hy_freq[l * 64 + o] * (acc + p.hy_b2[l * 64 + o]));
    }
}
__device__ void st_filt3(const Params& p, long tid, long nth) {
    const long total = (long)DEPTH * TF * 256;
    for (long i = tid; i < total; i += nth) {
        int c = (int)(i % 256); int tt = (int)((i / 256) % TF); int l = (int)(i / (256L * TF));
        float rel; filt_pos(tt, rel);
        const float* h2 = p.H2 + ((size_t)l * TF + tt) * 64;
        const float* w3 = p.hy_w3 + (size_t)l * 64 * 256 + c;
        float acc = 0.f;
        for (int j = 0; j < 64; ++j) acc += h2[j] * w3[(size_t)j * 256];
        const float hv = acc * expf(-2.0f * fabsf(rel) * p.hy_decay[l * 256 + c]);
        p.HF[i] = hv;
#ifndef CPU_EMU
        if (tt < SEQ) { unsigned short* q = p.G1 + ((size_t)l * 256 + c) * G1N + (8456 - tt); stact(q, hv); }
#endif
    }
#ifndef CPU_EMU
    constexpr int NPAD = 265 + (G1N - 8457);
    for (long i = tid; i < (long)DEPTH * 256 * NPAD; i += nth) {
        const int k = (int)(i % NPAD); const long lc = i / NPAD;
        p.G1[lc * G1N + (k < 265 ? k : 8457 + (k - 265))] = 0;
    }
#endif
}
__device__ void st_rstd(const Params& p, long tid, long nth) {
    for (long r = tid; r < NT; r += nth) {
        const float* xr = xrow(p, (int)r);
        float ss = 0.f;
        for (int k = 0; k < DM; ++k) ss += xr[k] * xr[k];
        p.RSTD[r] = 1.0f / sqrtf(ss / (float)DM + EPSV);
    }
}
__device__ void st_hx(const Params& p, int l, int which, long tid, long nth) {
    const float* g = (which ? p.norm2_g : p.norm1_g) + (size_t)l * DM;
    for (long i = tid; i < (long)NT * DM; i += nth) {
        int k = (int)(i % DM); int r = (int)(i / DM);
        const float* m = p.MOD + ((size_t)l * (NB + 1) + row_bb(r)) * 6 * DM;
        float sh = m[(which ? 3 : 0) * DM + k], sc = m[(which ? 4 : 1) * DM + k];
        float v = xrow(p, r)[k] * p.RSTD[r] * g[k];
        stact(p.Y + i, v * (1.0f + sc) + sh);
    }
}
template <int MODE>
__device__ void st_gemm(const Params& p, int l, int nrows, long tid, long nth) {
    const int N = MODE == 0 ? DIN : (MODE == 2 ? DFF : DM);
    const int K = MODE == 3 ? DFF : DM;
    const act_t* A = MODE == 3 ? p.P : p.Y;
    const int lda = MODE == 3 ? DFF : DM;
    const float* W = MODE == 0 ? p.w_in + (size_t)l * DM * DIN
                   : MODE == 1 ? p.w_out + (size_t)l * DM * DM
                   : MODE == 2 ? p.ffn_w1 + (size_t)l * DM * DFF
                               : p.ffn_w2 + (size_t)l * DFF * DM;
    const float* W3 = p.ffn_w3 + (size_t)l * DM * DFF;
    const int NQ = N / 4;
    const long total = (long)(nrows / 8) * NQ;
    for (long i = tid; i < total; i += nth) {
        const int cq = (int)(i % NQ); const int r0 = (int)(i / NQ) * 8; const int n0 = cq * 4;
        float acc[8][4]; float acc3[8][4];
#pragma unroll
        for (int a = 0; a < 8; ++a)
#pragma unroll
            for (int b = 0; b < 4; ++b) { acc[a][b] = 0.f; acc3[a][b] = 0.f; }
        for (int k = 0; k < K; ++k) {
            const float* wr = W + (size_t)k * N + n0;
            float w0 = wr[0], w1 = wr[1], w2 = wr[2], w3 = wr[3];
            float v0 = 0, v1 = 0, v2 = 0, v3 = 0;
            if (MODE == 2) { const float* w3r = W3 + (size_t)k * N + n0; v0 = w3r[0]; v1 = w3r[1]; v2 = w3r[2]; v3 = w3r[3]; }
#pragma unroll
            for (int a = 0; a < 8; ++a) {
                float av = ldact(A + (size_t)(r0 + a) * lda + k);
                acc[a][0] += av * w0; acc[a][1] += av * w1; acc[a][2] += av * w2; acc[a][3] += av * w3;
                if (MODE == 2) { acc3[a][0] += av * v0; acc3[a][1] += av * v1; acc3[a][2] += av * v2; acc3[a][3] += av * v3; }
            }
        }
        const int bb = row_bb(r0);
        const float* m = p.MOD + ((size_t)l * (NB + 1) + bb) * 6 * DM;
#pragma unroll
        for (int a = 0; a < 8; ++a) {
            const int r = r0 + a;
#pragma unroll
            for (int b = 0; b < 4; ++b) {
                const int n = n0 + b;
                if (MODE == 0) stact(p.P + (size_t)r * LDP + n, acc[a][b]);
                else if (MODE == 1) xrow(p, r)[n] += m[2 * DM + n] * acc[a][b];
                else if (MODE == 2) stact(p.P + (size_t)r * DFF + n, siluf(acc[a][b]) * acc3[a][b]);
                else xrow(p, r)[n] += m[5 * DM + n] * acc[a][b];
            }
        }
    }
}
__device__ void st_gla_logs(const Params& p, int l, long tid, long nth) {
    const long total = 2L * NT * 192;
    for (long i = tid; i < total; i += nth) {
        int col = (int)(i % 192); int r = (int)((i / 192) % NT); int dir = (int)(i / (192L * NT));
        const act_t* gk = p.P + (size_t)r * LDP + (dir ? OFF_GKB : OFF_GKF);
        const float* w = (dir ? p.gk_w_b : p.gk_w_f) + (size_t)l * 16 * 192 + col;
        float acc = (dir ? p.gk_b_b : p.gk_b_f)[l * 192 + col];
        for (int j = 0; j < 16; ++j) acc += ldact(gk + j) * w[j * 192];
        p.LG[i] = logsigmoidf(acc) * (1.0f / 16.0f);
    }
}
__device__ void st_gla_scan(const Params& p, long tid, long nth) {
    const long total = (long)NB * 6 * 64;
    for (long i = tid; i < total; i += nth) {
        const int e = (int)(i % 64); const int h = (int)((i / 64) % 6); const int b = (int)(i / 384);
        for (int dir = 0; dir < 2; ++dir) {
            float S[32];
#pragma unroll
            for (int d = 0; d < 32; ++d) S[d] = 0.f;
            const float* lg = p.LG + (size_t)dir * NT * 192;
            for (int part = 0; part < 2; ++part) {
                const int s = part == 0 ? NB + b : b;
                const int L = seq_len(s), r0 = seq_row0(s);
                for (int st = 0; st < L; ++st) {
                    const int t = dir == 0 ? st : L - 1 - st;
                    const int r = r0 + t;
                    const act_t* pr = p.P + (size_t)r * LDP;
                    const float* lr = lg + (size_t)r * 192 + h * 32;
                    const float v = ldact(pr + OFF_V + h * 64 + e);
                    float o = 0.f;
#pragma unroll
                    for (int d = 0; d < 32; ++d) {
                        S[d] = expf(lr[d]) * S[d] + ldact(pr + OFF_K + h * 32 + d) * v;
                        o += ldact(pr + OFF_Q + h * 32 + d) * S[d];
                    }
                    o *= 0.17677669529663687f;
                    float* op = p.O + (size_t)r * 384 + h * 64 + e;
                    if (dir == 0) *op = o; else *op += o;
                }
            }
        }
    }
}
__device__ void st_gla_out(const Params& p, int l, long tid, long nth) {
    const long total = (long)NT * 6;
    for (long i = tid; i < total; i += nth) {
        const int h = (int)(i % 6); const int r = (int)(i / 6);
        const float* o = p.O + (size_t)r * 384 + h * 64;
        float ss = 0.f;
        for (int e = 0; e < 64; ++e) ss += o[e] * o[e];
        const float rs = 1.0f / sqrtf(ss / 64.0f + EPSV);
        for (int e = 0; e < 64; ++e) {
            float g = ldact(p.P + (size_t)r * LDP + OFF_G + h * 64 + e);
            stact(p.Y + (size_t)r * DM + h * 64 + e, o[e] * rs * p.gla_norm_w[l * 64 + e] * siluf(g));
        }
    }
}
__device__ __forceinline__ float hy_u(const Params& p, int l, int s, int t, int j) {
    const int L = seq_len(s), r0 = seq_row0(s);
    const float* w = p.hy_short_w + (size_t)l * 3 * 768 + j;
    float acc = p.hy_short_b[l * 768 + j];
#pragma unroll
    for (int k = 0; k < 3; ++k) {
        const int tt = t + k - 1; const bool ok = tt >= 0 && tt < L;
        const float xv = ldact(p.P + (size_t)(r0 + (ok ? tt : t)) * LDP + OFF_HY + j);
        acc += w[k * 768] * (ok ? xv : 0.f);
    }
    return acc;
}
__device__ void st_hy_pre(const Params& p, int l, long tid, long nth, int r_lo = 0, int r_hi = NT) {
    const long total = (long)(r_hi - r_lo) * 256;
    for (long i = tid; i < total; i += nth) {
        const int c = (int)(i % 256); const int r = r_lo + (int)(i / 256);
        const int s = r < BL ? r / SEQ : NB + (r - BL) / CTX;
        const int t = r - seq_row0(s);
        p.VX[(size_t)r * 256 + c] = hy_u(p, l, s, t, 512 + c) * hy_u(p, l, s, t, 256 + c);
    }
}
__device__ void st_hy_conv(const Params& p, int l, long tid, long nth, int r_lo = 0, int r_hi = NT) {
    const long total = (long)(r_hi - r_lo) * 256;
    for (long i = tid; i < total; i += nth) {
        const int c = (int)(i % 256); const int r = r_lo + (int)(i / 256);
        const int s = r < BL ? r / SEQ : NB + (r - BL) / CTX;
        const int L = seq_len(s), r0 = seq_row0(s);
        const int t = r - r0;
        const float* hf = p.HF + ((size_t)l * TF + (s < NB ? 0 : SEQ)) * 256 + c;
        int jlo = t + L / 2 - (L - 1); if (jlo < 0) jlo = 0;
        int jhi = t + L / 2; if (jhi > L - 1) jhi = L - 1;
        float acc = 0.f;
        for (int j = jlo; j <= jhi; ++j)
            acc += hf[(size_t)(t - j + L / 2) * 256] * p.VX[(size_t)(r0 + j) * 256 + c];
        const float x0 = hy_u(p, l, s, t, c);
        const float y = (acc + p.VX[(size_t)r * 256 + c] * p.hy_bias[l * 256 + c]) * x0;
        stact(p.Y + (size_t)r * DM + 384 + c, y);
    }
}
__device__ void st_ssd_pre(const Params& p, int l, long tid, long nth) {
    const long total = (long)NT * 896;
    for (long i = tid; i < total; i += nth) {
        const int j = (int)(i % 896); const int q = (int)(i / 896);
        const int s = q < BL ? q / SEQ : NB + (q - BL) / CTX;
        const int L = seq_len(s), r0 = seq_row0(s);
        const int pos = q - r0;
        const float* w = p.ssd_conv_w + (size_t)l * 3 * 896 + j;
        float acc = p.ssd_conv_b[l * 896 + j];
#pragma unroll
        for (int k = 0; k < 3; ++k) {
            int pp = pos + k - 1;
            if (pp >= 0 && pp < L) acc += w[k * 896] * ldact(p.P + (size_t)(r0 + colmajor_tok(s, pp)) * LDP + OFF_XBC + j);
        }
        stact(p.XBC + (size_t)(r0 + colmajor_tok(s, pos)) * 896 + j, siluf(acc));
    }
    const long total2 = 2L * NT * 6;
    for (long i = tid; i < total2; i += nth) {
        const int hd = (int)(i % 6); const int r = (int)((i / 6) % NT); const int dir = (int)(i / (6L * NT));
        float v = ldact(p.P + (size_t)r * LDP + (dir ? OFF_DTB : OFF_DTF) + hd) + (dir ? p.ssd_dt_bias_b : p.ssd_dt_bias_f)[l * 6 + hd];
        p.DT[i] = softplusf(v);
    }
}
__device__ void st_ssd_scan(const Params& p, int l, long tid, long nth) {
    const long total = (long)NB * 6 * 64;
    for (long i = tid; i < total; i += nth) {
        const int pp = (int)(i % 64); const int hd = (int)((i / 64) % 6); const int b = (int)(i / 384);
        const int g = hd / 3;
        const float dcoef = p.ssd_d[l * 6 + hd];
        for (int dir = 0; dir < 2; ++dir) {
            const float A = -expf((dir ? p.ssd_a_log_b : p.ssd_a_log_f)[l * 6 + hd]);
            float h[128];
#pragma unroll
            for (int n = 0; n < 128; ++n) h[n] = 0.f;
            for (int part = 0; part < 2; ++part) {
                const int s = part == 0 ? NB + b : b;
                const int L = seq_len(s), r0 = seq_row0(s);
                for (int st = 0; st < L; ++st) {
                    const int pos = dir == 0 ? st : L - 1 - st;
                    const int r = r0 + colmajor_tok(s, pos);
                    const act_t* xr = p.XBC + (size_t)r * 896;
                    const float dt = p.DT[((size_t)dir * NT + r) * 6 + hd];
                    const float xs = ldact(xr + hd * 64 + pp);
                    const float ea = expf(A * dt);
                    const float xd = xs * dt;
                    float y = 0.f;
#pragma unroll
                    for (int n = 0; n < 128; ++n) {
                        h[n] = ea * h[n] + xd * ldact(xr + 384 + g * 128 + n);
                        y += h[n] * ldact(xr + 640 + g * 128 + n);
                    }
                    float* yp = p.YS + (size_t)r * 384 + hd * 64 + pp;
                    if (dir == 0) *yp = y + dcoef * xs; else *yp += y;
                }
            }
        }
    }
}
__device__ void st_ssd_out(const Params& p, int l, long tid, long nth) {
    const long total = (long)NT * 2;
    for (long i = tid; i < total; i += nth) {
        const int g = (int)(i % 2); const int r = (int)(i / 2);
        const float* ys = p.YS + (size_t)r * 384 + g * 192;
        const act_t* z = p.P + (size_t)r * LDP + OFF_Z + g * 192;
        float ss = 0.f;
        for (int j = 0; j < 192; ++j) { float v = ys[j] * siluf(ldact(z + j)); ss += v * v; }
        const float rs = 1.0f / sqrtf(ss / 192.0f + EPSV);
        for (int j = 0; j < 192; ++j) {
            float v = ys[j] * siluf(ldact(z + j));
            stact(p.Y + (size_t)r * DM + 640 + g * 192 + j, v * rs * p.ssd_norm_w[l * 384 + g * 192 + j]);
        }
    }
}
__device__ void st_final(const Params& p, long tid, long nth) {
    for (long i = tid; i < (long)BL * DM; i += nth) {
        int k = (int)(i % DM); int r = (int)(i / DM);
        p.XL[i] = p.XL[i] * p.RSTD[r] * p.final_g[k];
    }
}

enum { S_INIT, S_MOD, S_F1, S_F2, S_F3, S_RSTD, S_HX1, S_GIN, S_GLOG, S_GSCAN, S_GOUT,
       S_SPRE, S_SSCAN, S_SOUT, S_HPRE, S_HCONV, S_GOUTP, S_HX2, S_FFN1, S_FFN2, S_FINAL };

__device__ void run_stage(const Params& p, int stage, int l, long tid, long nth) {
    const int nrows = (l == DEPTH - 1) ? BL : NT;
    switch (stage) {
        case S_INIT: st_init(p, tid, nth); break;
        case S_MOD: st_mod(p, tid, nth); break;
        case S_F1: st_filt1(p, tid, nth); break;
        case S_F2: st_filt2(p, tid, nth); break;
        case S_F3: st_filt3(p, tid, nth); break;
        case S_RSTD: st_rstd(p, tid, nth); break;
        case S_HX1: st_hx(p, l, 0, tid, nth); break;
        case S_GIN: st_gemm<0>(p, l, NT, tid, nth); break;
        case S_GLOG: st_gla_logs(p, l, tid, nth); break;
        case S_GSCAN: st_gla_scan(p, tid, nth); break;
        case S_GOUT: st_gla_out(p, l, tid, nth); break;
        case S_SPRE: st_ssd_pre(p, l, tid, nth); break;
        case S_SSCAN: st_ssd_scan(p, l, tid, nth); break;
        case S_SOUT: st_ssd_out(p, l, tid, nth); break;
        case S_HPRE: st_hy_pre(p, l, tid, nth); break;
        case S_HCONV: st_hy_conv(p, l, tid, nth); break;
        case S_GOUTP: st_gemm<1>(p, l, nrows, tid, nth); break;
        case S_HX2: st_hx(p, l, 1, tid, nth); break;
        case S_FFN1: st_gemm<2>(p, l, nrows, tid, nth); break;
        case S_FFN2: st_gemm<3>(p, l, nrows, tid, nth); break;
        case S_FINAL: st_final(p, tid, nth); break;
    }
}

static const int kLayerProg[] = { S_RSTD, S_HX1, S_GIN, S_GLOG, S_GSCAN, S_GOUT, S_SPRE, S_SSCAN, S_SOUT,
                                  S_HPRE, S_HCONV, S_GOUTP, S_RSTD, S_HX2, S_FFN1, S_FFN2 };
static const int kPreProg[] = { S_INIT, S_MOD, S_F1, S_F2, S_F3 };

static inline size_t al256(size_t v) { return (v + 255) & ~(size_t)255; }
static void carve(Params& p, char* ws, float* dout) {
    size_t off = 0;
    auto take = [&](size_t bytes) { char* q = ws + off; off += al256(bytes); return q; };
    p.XL = dout;
    p.XC = (float*)take((size_t)BC * DM * 4);
    p.MOD = (float*)take((size_t)DEPTH * (NB + 1) * 6 * DM * 4);
#ifdef CPU_EMU
    p.HF = (float*)take((size_t)DEPTH * TF * 256 * 4);
    p.RSTD = (float*)take((size_t)NT * 4);
    p.DT = (float*)take((size_t)2 * NT * 6 * 4);
#endif
    p.H1 = (float*)take((size_t)DEPTH * TF * 64 * 4);
    p.H2 = (float*)take((size_t)DEPTH * TF * 64 * 4);
    p.P = (act_t*)take((size_t)NT * LDP * sizeof(act_t));
    p.Y = (act_t*)take((size_t)NT * DM * sizeof(act_t));
#ifdef CPU_EMU
    char* r1 = take((size_t)NT * 896 * sizeof(act_t) + (size_t)NT * 384 * 4 + 256);
#else
    char* r1 = take((size_t)101 << 20);
#endif
    p.LG = (float*)r1;
    p.O = (float*)(r1 + al256((size_t)2 * NT * 192 * 4));
    p.XBC = (act_t*)r1;
    p.YS = (float*)(r1 + al256((size_t)NT * 896 * sizeof(act_t)));
#ifdef CPU_EMU
    p.VX = (float*)r1;
#else
    {
        char* q = r1;
        p.DSG = (unsigned short*)q; q += al256((size_t)2 * NB * 6 * ((CTX + SEQ) / 64) * 2048 * 2);
        p.SSG = (unsigned short*)q; q += al256((size_t)2 * NB * 6 * ((CTX + SEQ) / 64) * 2048 * 2);
        p.DECG = (float*)q; q += al256((size_t)2 * NB * 6 * ((CTX + SEQ) / 64) * 32 * 4);
        p.DSS = (unsigned short*)q; q += al256((size_t)2 * NB * 6 * ((CTX + SEQ) / 128) * 8192 * 2);
        p.DECS = (float*)q; q += al256((size_t)2 * NB * 6 * ((CTX + SEQ) / 128) * 4);
    }
    p.VXT = (unsigned short*)take((size_t)NB * 256 * SEQ * 2);
    p.CONV = (float*)take((size_t)NB * 256 * SEQ * 4);
    p.VX = (float*)take((size_t)BC * 256 * 4) - (size_t)BL * 256;
    p.HFC = (float*)take((size_t)DEPTH * CTX * 256 * 4);
#endif
    p.G1 = (unsigned short*)take((size_t)DEPTH * 256 * G1N * 2);
    p.BAR = (unsigned*)take(16384);
    p.WIN_T = (unsigned short*)take((size_t)DEPTH * LDP * DM * 2);
    p.WOUT_T = (unsigned short*)take((size_t)DEPTH * DM * DM * 2);
    p.W13_T = (unsigned short*)take((size_t)DEPTH * NFF2 * DM * 2);
    p.W2_T = (unsigned short*)take((size_t)DEPTH * DM * DFF * 2);
}
static void fill_inputs(Params& p, void* const* d_in) {
    const float** dst = (const float**)&p;
    for (int i = 0; i < 37; ++i) dst[i] = (const float*)d_in[i];
}

#ifndef CPU_EMU
namespace pg8 {
#define PG8_LAS __attribute__((address_space(3)))
typedef unsigned short bf16_t;
typedef short bf16x8 __attribute__((ext_vector_type(8)));
typedef float f32x4 __attribute__((ext_vector_type(4)));
typedef unsigned u32x4 __attribute__((ext_vector_type(4)));
constexpr int BM = 256, BK = 64, HALF = 128, HTB = HALF * BK * 2  , STAGE_BYTES = 8 * HTB, NXCD = 8, WGM = 8;

__host__ __device__ __forceinline__ int lds_byte(int r, int c) { const int st = (r >> 4) * 2 + (c >> 5), rr = r & 15, cc = c & 31, ob = rr * 64 + cc * 2; return st * 1024 + (ob ^ (((ob >> 9) & 1) << 5)); }
__host__ __device__ __forceinline__ void stage_rc(int b, int& R, int& C) { const int st = b / 1024, sb = b % 1024, swz = sb ^ (((sb >> 9) & 1) << 5); R = (st >> 1) * 16 + swz / 64; C = (st & 1) * 32 + (swz % 64) / 2; }
__host__ __device__ __forceinline__ int perm32(int rho) { const int n = rho >> 4, i = rho & 15; return 8 * (i >> 2) + 4 * n + (i & 3); }

struct Unit { int pm, pn, kb; };
struct Gemm { const bf16_t* A; const bf16_t* Bt; int M, N, K, ld; };

struct StaticOrder {
    int nM, nN, nwg, G, c;
    __host__ __device__ void init(int M, int N, int G_, int c_) { nM = M / BM; nN = N / BM; nwg = nM * nN; G = G_; c = c_; }
    __host__ __device__ bool next(int i, Unit& u) const {
        const long L = (long)i * G + c; if (L >= nwg) return false;
        int wgid = (int)L; { const int q = nwg / NXCD, r = nwg % NXCD, xcd = wgid % NXCD, off = wgid / NXCD; wgid = (xcd < r ? xcd * (q + 1) : r * (q + 1) + (xcd - r) * q) + off; }
        const int nig = WGM * nN, gid = wgid / nig, fm = gid * WGM, gsz = (nM - fm) < WGM ? (nM - fm) : WGM;
        u.pm = fm + ((wgid % nig) % gsz); u.pn = (wgid % nig) / gsz; u.kb = 0; return true;
    }
    __device__ __forceinline__ void a_ready(const Unit&) const {}
    __device__ __forceinline__ void done(const Unit&) const {}
};

__device__ __forceinline__ unsigned cvt_pk_bf16(float lo, float hi) { unsigned r; asm volatile("v_cvt_pk_bf16_f32 %0, %1, %2" : "=v"(r) : "v"(lo), "v"(hi)); return r; }
typedef float f32x2 __attribute__((ext_vector_type(2)));
__device__ __forceinline__ f32x2 gelu_pk(f32x2 v) {
    const f32x2 av = __builtin_elementwise_abs(v), d = av * 0.2316418882f + 1.0f;
    f32x2 t; t.x = __builtin_amdgcn_rcpf(d.x); t.y = __builtin_amdgcn_rcpf(d.y);
    f32x2 q = t * 0.5307027145f + (-0.7265760135f); q = q * t + 0.7107068705f; q = q * t + (-0.142248368f); q = q * t + 0.127414796f; q = q * t;
    const f32x2 s = (v * v) * (-0.72134752044f);
    f32x2 e; e.x = __builtin_amdgcn_exp2f(s.x); e.y = __builtin_amdgcn_exp2f(s.y);
    const f32x2 m = v * (q * e), r = v - m;
    f32x2 o; o.x = v.x < 0.f ? m.x : r.x; o.y = v.y < 0.f ? m.y : r.y; return o;
}

template <int ACT  > struct EpiBf16 {
    static constexpr bool PERM = true, AFTER_DRAIN = false; static_assert(ACT == 0 || ACT == 1, "EpiBf16: ACT is 0 (none) or 1 (gelu_pk)");
    bf16_t* O; int ldc; const float* bias; int split_cols; size_t split_stride; float scale0;
    __device__ __forceinline__ void operator()(const f32x4 (&acc)[2][2][4][2], const Unit& u, int wr, int wc, int fr, int fq) const {
        const int row0 = u.pm * BM + wr * 64 + fr; int colt = u.pn * BM; bf16_t* base = O;
        float sc = 1.f; if (split_cols) { const int t = colt / split_cols; base += (size_t)t * split_stride; colt -= t * split_cols; if (t == 0) sc = scale0; }
        const int col0 = colt + wc * 32 + 8 * fq, bcol0 = u.pn * BM + wc * 32 + 8 * fq;
        f32x4 bv[2][2];
#pragma unroll
        for (int bj = 0; bj < 2; ++bj)
#pragma unroll
            for (int n = 0; n < 2; ++n) bv[bj][n] = bias ? *(const f32x4*)(bias + bcol0 + bj * HALF + 4 * n) : (f32x4){0.f, 0.f, 0.f, 0.f};
#pragma unroll
        for (int ai = 0; ai < 2; ++ai)
#pragma unroll
            for (int m = 0; m < 4; ++m) { bf16_t* rowp = base + (size_t)(row0 + ai * HALF + m * 16) * ldc + col0;
#pragma unroll
                for (int bj = 0; bj < 2; ++bj) { f32x4 v0 = acc[ai][bj][m][0] + bv[bj][0], v1 = acc[ai][bj][m][1] + bv[bj][1];
                    if (ACT == 1) { f32x2 a = gelu_pk((f32x2){v0[0], v0[1]}), b = gelu_pk((f32x2){v0[2], v0[3]}), c = gelu_pk((f32x2){v1[0], v1[1]}), d = gelu_pk((f32x2){v1[2], v1[3]});
                        v0 = (f32x4){a.x, a.y, b.x, b.y}; v1 = (f32x4){c.x, c.y, d.x, d.y}; }
                    v0 = v0 * sc; v1 = v1 * sc; u32x4 w; w.x = cvt_pk_bf16(v0[0], v0[1]); w.y = cvt_pk_bf16(v0[2], v0[3]); w.z = cvt_pk_bf16(v1[0], v1[1]); w.w = cvt_pk_bf16(v1[2], v1[3]);
                    *(u32x4*)(rowp + bj * HALF) = w; } }
    }
};
template <class Epi, class Sched, bool ALIGN_EPI = false, bool SP2 = false>
__device__ __forceinline__ void gemm_phase(PG8_LAS unsigned char* lds, const Gemm g, const Sched& S, const Epi& E, int tid_o) {
    asm volatile("" : "+v"(tid_o));
    const int tid = tid_o, wid = __builtin_amdgcn_readfirstlane(tid >> 6), lane = tid & 63, wr = wid >> 2, wc = wid & 3, fr = lane & 15, fq = lane >> 4;
    const int K = g.ld, nt = g.K / BK;
    unsigned voffA[2], voffB[2];
#pragma unroll
    for (int i = 0; i < 2; ++i) { int R, C; stage_rc(tid * 16 + i * 8192, R, C); const int Rb = Epi::PERM ? ((R & ~31) + perm32(R & 31)) : R;
        voffA[i] = (unsigned)(R * K + C) * 2u; voffB[i] = (unsigned)(Rb * K + C) * 2u; }
    const size_t kstep = (size_t)(BK * 2);
    const size_t hstep = (size_t)HALF * K * 2;
    const size_t tstep = 2 * hstep;
    const unsigned ldsw = (unsigned)wid * 1024u;
    const int aoff = lds_byte(wr * 64 + fr, fq * 8), boff = lds_byte(wc * 32 + fr, fq * 8);
#define PG8_SA(b, h) (((b) * 2 + (h)) * HTB)
#define PG8_SB(b, h) ((4 + (b) * 2 + (h)) * HTB)
#define PG8_STAGE(bufoff, gbase, voff) do { _Pragma("unroll") for (int _i = 0; _i < 2; ++_i) \
        __builtin_amdgcn_global_load_lds((const unsigned*)((const char*)(gbase) + (voff)[_i]), (PG8_LAS unsigned*)(lds + (bufoff) + ldsw + _i * 8192), 16, 0, 0); } while (0)
#define PG8_LDA(dst, b, h) do { _Pragma("unroll") for (int m = 0; m < 4; ++m) _Pragma("unroll") for (int k = 0; k < 2; ++k) dst[m][k] = *(const PG8_LAS bf16x8*)(lds + PG8_SA(b, h) + aoff + m * 2048 + k * 1024); } while (0)
#define PG8_LDB(dst, b, h) do { _Pragma("unroll") for (int n = 0; n < 2; ++n) _Pragma("unroll") for (int k = 0; k < 2; ++k) dst[n][k] = *(const PG8_LAS bf16x8*)(lds + PG8_SB(b, h) + boff + n * 2048 + k * 1024); } while (0)
#define PG8_MMA(ai, bj, At, Bt) do { __builtin_amdgcn_s_setprio(1); _Pragma("unroll") for (int m = 0; m < 4; ++m) _Pragma("unroll") for (int n = 0; n < 2; ++n) _Pragma("unroll") for (int k = 0; k < 2; ++k) \
        acc[ai][bj][m][n] = __builtin_amdgcn_mfma_f32_16x16x32_bf16(Bt[n][k], At[m][k], acc[ai][bj][m][n], 0, 0, 0); __builtin_amdgcn_s_setprio(0); } while (0)
#define PG8_WAIT_V(n) asm volatile("s_waitcnt vmcnt(" #n ")" ::: "memory")
#define PG8_WAIT_L(n) asm volatile("s_waitcnt lgkmcnt(" #n ")" ::: "memory")
#define PG8_BAR __builtin_amdgcn_s_barrier()
#define PG8_SCHED __builtin_amdgcn_sched_barrier(0)
    Unit cur, nxt; int ui = 0;
    if (!S.next(0, cur)) return;
    f32x4 acc[2][2][4][2];
#pragma unroll
    for (int a = 0; a < 2; ++a)
#pragma unroll
        for (int b = 0; b < 2; ++b)
#pragma unroll
            for (int m = 0; m < 4; ++m)
#pragma unroll
                for (int n = 0; n < 2; ++n) acc[a][b][m][n] = (f32x4){0.f, 0.f, 0.f, 0.f};
    bf16x8 At[4][2], B0[2][2], B1[2][2];
    const char* cA = (const char*)g.A + (size_t)cur.pm * tstep + cur.kb; const char* cB = (const char*)g.Bt + (size_t)cur.pn * tstep + cur.kb;
    S.a_ready(cur);
    if constexpr (SP2) {
        PG8_STAGE(PG8_SB(0, 0), cB, voffB); PG8_STAGE(PG8_SB(0, 1), cB + hstep, voffB); PG8_STAGE(PG8_SA(0, 0), cA, voffA); PG8_STAGE(PG8_SA(0, 1), cA + hstep, voffA);
        if (wr == 1) PG8_BAR;
        PG8_WAIT_V(2); PG8_BAR;
        PG8_STAGE(PG8_SB(1, 0), cB + kstep, voffB); PG8_STAGE(PG8_SA(1, 0), cA + kstep, voffA); PG8_STAGE(PG8_SB(1, 1), cB + hstep + kstep, voffB);
        PG8_WAIT_V(6); PG8_BAR;
    } else {
        PG8_STAGE(PG8_SB(0, 0), cB, voffB); PG8_STAGE(PG8_SA(0, 0), cA, voffA); PG8_STAGE(PG8_SB(0, 1), cB + hstep, voffB); PG8_STAGE(PG8_SA(0, 1), cA + hstep, voffA);
        if (wr == 1) PG8_BAR;
        PG8_WAIT_V(4); PG8_BAR;
        PG8_STAGE(PG8_SB(1, 0), cB + kstep, voffB); PG8_STAGE(PG8_SA(1, 0), cA + kstep, voffA); PG8_STAGE(PG8_SB(1, 1), cB + hstep + kstep, voffB);
        PG8_WAIT_V(6); PG8_BAR;
    }
    for (;;) {
        const bool has_next = S.next(ui + 1, nxt);
        const char* nA = has_next ? (const char*)g.A + (size_t)nxt.pm * tstep + nxt.kb : cA; const char* nB = has_next ? (const char*)g.Bt + (size_t)nxt.pn * tstep + nxt.kb : cB;
        for (int t = 0; t < nt; t += 2) {
            const bool last = (t == nt - 2);
            const char* a1 = cA + (size_t)(t + 1) * kstep;
            const char* a2 = last ? nA : cA + (size_t)(t + 2) * kstep; const char* b2 = last ? nB : cB + (size_t)(t + 2) * kstep;
            const char* a3 = a2 + kstep; const char* b3 = b2 + kstep;
            if (last && has_next) S.a_ready(nxt);
            if constexpr (SP2) {
            PG8_LDB(B0, 0, 0); PG8_LDB(B1, 0, 1); PG8_SCHED; PG8_LDA(At, 0, 0); PG8_STAGE(PG8_SA(1, 1), a1 + hstep, voffA);
            PG8_WAIT_V(8); PG8_WAIT_L(0); PG8_BAR; PG8_MMA(0, 0, At, B0); PG8_MMA(0, 1, At, B1); PG8_BAR; PG8_SCHED;
            PG8_LDA(At, 0, 1); PG8_STAGE(PG8_SB(0, 0), b2, voffB); PG8_STAGE(PG8_SB(0, 1), b2 + hstep, voffB); PG8_STAGE(PG8_SA(0, 0), a2, voffA);
            PG8_WAIT_V(8); PG8_WAIT_L(0); PG8_BAR; PG8_MMA(1, 0, At, B0); PG8_MMA(1, 1, At, B1); PG8_BAR; PG8_SCHED;
            PG8_LDB(B0, 1, 0); PG8_LDB(B1, 1, 1); PG8_SCHED; PG8_LDA(At, 1, 0); PG8_STAGE(PG8_SA(0, 1), a2 + hstep, voffA);
            PG8_WAIT_V(8); PG8_WAIT_L(0); PG8_BAR; PG8_MMA(0, 0, At, B0); PG8_MMA(0, 1, At, B1); PG8_BAR; PG8_SCHED;
            PG8_LDA(At, 1, 1); PG8_STAGE(PG8_SB(1, 0), b3, voffB); PG8_STAGE(PG8_SB(1, 1), b3 + hstep, voffB); PG8_STAGE(PG8_SA(1, 0), a3, voffA);
            PG8_WAIT_V(8); PG8_WAIT_L(0); PG8_BAR; PG8_MMA(1, 0, At, B0); PG8_MMA(1, 1, At, B1); PG8_BAR; PG8_SCHED;
            } else {
            PG8_LDB(B0, 0, 0); PG8_SCHED; PG8_LDA(At, 0, 0); PG8_STAGE(PG8_SA(1, 1), a1 + hstep, voffA);
            PG8_WAIT_L(8); PG8_BAR; PG8_WAIT_L(0); PG8_MMA(0, 0, At, B0); PG8_BAR; PG8_SCHED;
            PG8_LDB(B1, 0, 1); PG8_STAGE(PG8_SB(0, 0), b2, voffB);
            PG8_BAR; PG8_WAIT_L(0); PG8_MMA(0, 1, At, B1); PG8_BAR;
            PG8_LDA(At, 0, 1); PG8_STAGE(PG8_SA(0, 0), a2, voffA);
            PG8_BAR; PG8_WAIT_L(0); PG8_MMA(1, 0, At, B0); PG8_BAR; PG8_SCHED;
            PG8_STAGE(PG8_SB(0, 1), b2 + hstep, voffB);
            PG8_WAIT_V(6); PG8_BAR; PG8_MMA(1, 1, At, B1); PG8_BAR;
            PG8_LDB(B0, 1, 0); PG8_SCHED; PG8_LDA(At, 1, 0); PG8_STAGE(PG8_SA(0, 1), a2 + hstep, voffA);
            PG8_WAIT_L(8); PG8_BAR; PG8_WAIT_L(0); PG8_MMA(0, 0, At, B0); PG8_BAR; PG8_SCHED;
            PG8_LDB(B1, 1, 1); PG8_STAGE(PG8_SB(1, 0), b3, voffB);
            PG8_BAR; PG8_WAIT_L(0); PG8_MMA(0, 1, At, B1); PG8_BAR;
            PG8_LDA(At, 1, 1); PG8_STAGE(PG8_SA(1, 0), a3, voffA);
            PG8_BAR; PG8_WAIT_L(0); PG8_MMA(1, 0, At, B0); PG8_BAR; PG8_SCHED;
            PG8_STAGE(PG8_SB(1, 1), b3 + hstep, voffB);
            PG8_WAIT_V(6); PG8_BAR; PG8_MMA(1, 1, At, B1); PG8_BAR;
            }
        }
        if constexpr (ALIGN_EPI) { if (wr == 0) PG8_BAR; }
        if constexpr (!Epi::AFTER_DRAIN) {
            unsigned z_ = 0u; asm volatile("" : "+v"(z_)); const int le_ = (int)__builtin_amdgcn_mbcnt_hi(~0u, __builtin_amdgcn_mbcnt_lo(~0u, z_));
            E(acc, cur, wr, wc, le_ & 15, le_ >> 4); S.done(cur); }
        if (!has_next) break;
#pragma unroll
        for (int a = 0; a < 2; ++a)
#pragma unroll
            for (int b = 0; b < 2; ++b)
#pragma unroll
                for (int m = 0; m < 4; ++m)
#pragma unroll
                    for (int n = 0; n < 2; ++n) acc[a][b][m][n] = (f32x4){0.f, 0.f, 0.f, 0.f};
        cur = nxt; cA = nA; cB = nB; ++ui;
        if constexpr (ALIGN_EPI) { if (wr == 1) PG8_BAR; }
    }
    PG8_WAIT_V(0);
    if constexpr (!ALIGN_EPI) { if (wr == 0) PG8_BAR; }
    PG8_BAR;
    if constexpr (Epi::AFTER_DRAIN) { E.fused(acc, cur, wr, wc, fr, fq, lds, wid, lane); S.done(cur); }
#undef PG8_SA
#undef PG8_SB
#undef PG8_STAGE
#undef PG8_LDA
#undef PG8_LDB
#undef PG8_MMA
#undef PG8_WAIT_V
#undef PG8_WAIT_L
#undef PG8_BAR
#undef PG8_SCHED
}
}

namespace pg8 {
struct EpiRes {
    static constexpr bool PERM = false, AFTER_DRAIN = false;
    float* XL; float* XC; const float* modl; int chunk; const float* SL; const float* SC;
    __device__ __forceinline__ void operator()(const f32x4 (&acc)[2][2][4][2], const Unit& u, int wr, int wc, int fr, int fq) const {
        asm volatile("" : "+v"(fr), "+v"(fq));
        const int rt0 = u.pm * BM;
        const int bb = rt0 < BL ? rt0 / SEQ : NB;
        const float* gate = modl + ((size_t)bb * 6 + chunk) * DM;
        float* xb = rt0 < BL ? XL + (size_t)rt0 * DM : XC + (size_t)(rt0 - BL) * DM;
        const float* sb = rt0 < BL ? SL + (size_t)rt0 * DM : SC + (size_t)(rt0 - BL) * DM;
        const int col0 = u.pn * BM + wc * 32 + fq * 4;
        f32x4 gv[2][2];
#pragma unroll
        for (int bj = 0; bj < 2; ++bj)
#pragma unroll
            for (int n = 0; n < 2; ++n) gv[bj][n] = *(const f32x4*)(gate + col0 + bj * HALF + n * 16);
#pragma unroll
        for (int ai = 0; ai < 2; ++ai) {
            f32x4 t[4][2][2];
#pragma unroll
            for (int m = 0; m < 4; ++m)
#pragma unroll
                for (int bj = 0; bj < 2; ++bj)
#pragma unroll
                    for (int n = 0; n < 2; ++n) t[m][bj][n] = *(const f32x4*)(sb + (size_t)(wr * 64 + fr + ai * HALF + m * 16) * DM + col0 + bj * HALF + n * 16);
#pragma unroll
            for (int m = 0; m < 4; ++m)
#pragma unroll
                for (int bj = 0; bj < 2; ++bj)
#pragma unroll
                    for (int n = 0; n < 2; ++n) *(f32x4*)(xb + (size_t)(wr * 64 + fr + ai * HALF + m * 16) * DM + col0 + bj * HALF + n * 16) = t[m][bj][n] + gv[bj][n] * acc[ai][bj][m][n];
        }
    }
};
struct EpiSwiGLU {
    static constexpr bool PERM = true, AFTER_DRAIN = false;
    bf16_t* H;
    __device__ __forceinline__ void operator()(const f32x4 (&acc)[2][2][4][2], const Unit& u, int wr, int wc, int fr, int fq) const {
        asm volatile("" : "+v"(fr), "+v"(fq));
        const int row0 = u.pm * BM + wr * 64 + fr, hc0 = u.pn * HALF + wc * 32 + 8 * fq;
#pragma unroll
        for (int ai = 0; ai < 2; ++ai)
#pragma unroll
            for (int m = 0; m < 4; ++m) {
                bf16_t* rowp = H + (size_t)(row0 + ai * HALF + m * 16) * DFF + hc0;
                f32x4 v[2];
#pragma unroll
                for (int n = 0; n < 2; ++n)
#pragma unroll
                    for (int i = 0; i < 4; ++i) { const float a = acc[ai][0][m][n][i]; v[n][i] = a * __builtin_amdgcn_rcpf(1.0f + __expf(-a)) * acc[ai][1][m][n][i]; }
                u32x4 w; w.x = cvt_pk_bf16(v[0][0], v[0][1]); w.y = cvt_pk_bf16(v[0][2], v[0][3]); w.z = cvt_pk_bf16(v[1][0], v[1][1]); w.w = cvt_pk_bf16(v[1][2], v[1][3]);
                *(u32x4*)rowp = w;
            }
    }
};
}


namespace pg8 {
struct SplitKOrder {
    int nM, nN, S, ksl, nun, G, c;
    __device__ void init(int M, int N, int S_, int kslice_elems, int G_, int c_) { nM = M / BM; nN = N / BM; S = S_; ksl = kslice_elems; nun = nM * nN * S; G = G_; c = c_; }
    __device__ bool next(int i, Unit& u) const {
        const int L = i * G + c; if (L >= nun) return false;
        const int sl = L % S, t = L / S; u.pm = t % nM; u.pn = t / nM; u.kb = sl * ksl * 2; return true;
    }
    __device__ __forceinline__ void a_ready(const Unit&) const {}
    __device__ __forceinline__ void done(const Unit&) const {}
};
struct EpiSlab {
    static constexpr bool PERM = false, AFTER_DRAIN = false;
    float* SLAB; int rows, kslice_bytes;
    __device__ __forceinline__ void operator()(const f32x4 (&acc)[2][2][4][2], const Unit& u, int wr, int wc, int fr, int fq) const {
        asm volatile("" : "+v"(fr), "+v"(fq));
        float* xb = SLAB + ((size_t)(u.kb / kslice_bytes) * rows + (size_t)u.pm * BM) * DM;
        const int col0 = u.pn * BM + wc * 32 + fq * 4;
#pragma unroll
        for (int ai = 0; ai < 2; ++ai)
#pragma unroll
            for (int m = 0; m < 4; ++m) {
                const size_t ro = (size_t)(wr * 64 + fr + ai * HALF + m * 16) * DM + col0;
#pragma unroll
                for (int bj = 0; bj < 2; ++bj)
#pragma unroll
                    for (int n = 0; n < 2; ++n) *(f32x4*)(xb + ro + bj * HALF + n * 16) = acc[ai][bj][m][n];
            }
    }
};
}

#define LAS __attribute__((address_space(3)))
typedef float f32x4 __attribute__((ext_vector_type(4)));
typedef unsigned v4u __attribute__((ext_vector_type(4)));
#define REP_G1 1
#define REP_G3 1
#define REP_GLA 1
#define REP_SSD 1
#define REP_HY 1
#define REP_HX 1
#define REP_PRO 1
#define CTX_SPLITK 1
#define OLD_SHFL 0
#define REP_MIX 1
#define REP_PA 1
#define REP_PC 1
#define REP_H1 1
#define REP_H2 1
#define REP_H3 1
#define REP_HC 1
#define REP_S2 1
#define REP_S23 1
#define REP_S4 1
#define REP_M2 1
#define REP_M3 1
#define REP_M4 1
#define REP_INIT 1
#define REP_MOD 1
#define REP_F1 1
#define REP_WT 1
#define REP_F3 1
constexpr int LDS_BYTES = 163840;
namespace cg = cooperative_groups;

__device__ __forceinline__ unsigned f2bf_u(float f) { unsigned u = __builtin_bit_cast(unsigned, f); return (u + 0x7fffu + ((u >> 16) & 1u)) >> 16; }
__device__ __forceinline__ unsigned pk2(float lo, float hi) { return f2bf_u(lo) | (f2bf_u(hi) << 16); }
template <int M> __device__ __forceinline__ float swz_xor(float v) { return __builtin_bit_cast(float, __builtin_amdgcn_ds_swizzle(__builtin_bit_cast(int, v), (M << 10) | 0x1f)); }
#if OLD_SHFL
__device__ __forceinline__ float wave_sum(float v, int) {
#pragma unroll
    for (int o = 1; o < 64; o <<= 1) v += __shfl_xor(v, o);
    return v;
}
__device__ __forceinline__ float sum16(float v) { v += __shfl_xor(v, 1); v += __shfl_xor(v, 2); v += __shfl_xor(v, 4); v += __shfl_xor(v, 8); return v; }
__device__ __forceinline__ float wave_scan_incl(float v, int lane) {
#pragma unroll
    for (int off = 1; off < 64; off <<= 1) { const float up = __shfl_up(v, off); if (lane >= off) v += up; }
    return v;
}
#else
__device__ __forceinline__ float wave_sum(float v, int lane) {
    v += swz_xor<1>(v); v += swz_xor<2>(v); v += swz_xor<4>(v); v += swz_xor<8>(v); v += swz_xor<16>(v);
    return v + __builtin_bit_cast(float, __builtin_amdgcn_ds_bpermute((lane ^ 32) << 2, __builtin_bit_cast(int, v)));
}
__device__ __forceinline__ float sum16(float v) { v += swz_xor<1>(v); v += swz_xor<2>(v); v += swz_xor<4>(v); v += swz_xor<8>(v); return v; }
template <int CTRL, int ROWMASK> __device__ __forceinline__ float dpp0(float v) {
    return __builtin_bit_cast(float, __builtin_amdgcn_update_dpp(0, __builtin_bit_cast(int, v), CTRL, ROWMASK, 0xf, false));
}
__device__ __forceinline__ float wave_scan_incl(float v, int) {
    v += dpp0<0x111, 0xf>(v); v += dpp0<0x112, 0xf>(v); v += dpp0<0x114, 0xf>(v); v += dpp0<0x118, 0xf>(v);
    v += dpp0<0x142, 0xa>(v);
    v += dpp0<0x143, 0xc>(v);
    return v;
}
#endif
__device__ __forceinline__ float lane63(float v) { return __builtin_bit_cast(float, __builtin_amdgcn_readlane(__builtin_bit_cast(int, v), 63)); }
__device__ __forceinline__ void transpose_item(const float* W, int K, int N, unsigned short* WT, int dst_row0, LAS float* scr, int k0, int n0, int lane) {
    const int nn = n0 + (lane & 31);
#pragma unroll 8
    for (int i = 0; i < 32; ++i) { const int kk = 2 * i + (lane >> 5); scr[kk * 33 + (lane & 31)] = nn < N ? W[(size_t)(k0 + kk) * N + nn] : 0.f; }
    asm volatile("s_waitcnt lgkmcnt(0)" ::: "memory");
    const int c = lane & 7;
#pragma unroll
    for (int j = 0; j < 4; ++j) { const int n = (lane >> 3) + 8 * j; const LAS float* sp = scr + (8 * c) * 33 + n;
        v4u o; o.x = pk2(sp[0 * 33], sp[1 * 33]); o.y = pk2(sp[2 * 33], sp[3 * 33]); o.z = pk2(sp[4 * 33], sp[5 * 33]); o.w = pk2(sp[6 * 33], sp[7 * 33]);
        *(v4u*)(WT + (size_t)(dst_row0 + n) * K + k0 + 8 * c) = o; }
    asm volatile("s_waitcnt lgkmcnt(0)" ::: "memory");
}
__device__ __forceinline__ void prologue_weights(const Params& p, LAS float* scr, int gw, int NGW, int lane) {
    constexpr int I_IN = 16 * (LDP / 32), I_OUT = 16 * 32, I_W1 = 16 * (DFF / 32), I_W2 = (DFF / 64) * 32;
    constexpr int PER_L = I_IN + I_OUT + 2 * I_W1 + I_W2;
    for (int it = gw; it < DEPTH * PER_L; it += NGW) {
        const int l = it / PER_L; int r = it % PER_L;
        if (r < I_IN) { const int nb = r % (LDP / 32), kb = r / (LDP / 32);
            transpose_item(p.w_in + (size_t)l * DM * DIN, DM, DIN, p.WIN_T + (size_t)l * LDP * DM, nb * 32, scr, kb * 64, nb * 32, lane); continue; }
        r -= I_IN;
        if (r < I_OUT) { const int nb = r % 32, kb = r / 32;
            transpose_item(p.w_out + (size_t)l * DM * DM, DM, DM, p.WOUT_T + (size_t)l * DM * DM, nb * 32, scr, kb * 64, nb * 32, lane); continue; }
        r -= I_OUT;
        if (r < 2 * I_W1) { const int which = r / I_W1; r %= I_W1; const int nb = r % (DFF / 32), kb = r / (DFF / 32); const int n0 = nb * 32;
            const int drow = 256 * (n0 / 128) + 128 * which + (n0 % 128);
            transpose_item((which ? p.ffn_w3 : p.ffn_w1) + (size_t)l * DM * DFF, DM, DFF, p.W13_T + (size_t)l * NFF2 * DM, drow, scr, kb * 64, n0, lane); continue; }
        r -= 2 * I_W1;
        { const int nb = r % 32, kb = r / 32;
            transpose_item(p.ffn_w2 + (size_t)l * DFF * DM, DFF, DM, p.W2_T + (size_t)l * DM * DFF, nb * 32, scr, kb * 64, nb * 32, lane); }
    }
}

__device__ __forceinline__ void mod_partial(const Params& p, long tid, long nth, float* MODP) {
    for (long i = tid; i < 2L * 16 * 1536; i += nth) {
        const int n4 = (int)(i % 1536), kc = (int)((i / 1536) & 15), l = (int)(i / (1536 * 16));
        f32x4 acc[NB + 1];
        float z0 = 0.f; asm volatile("" : "+v"(z0));
#pragma unroll
        for (int bb = 0; bb <= NB; ++bb) acc[bb] = (f32x4){z0, z0, z0, z0};
        const float* w = p.mod_w + ((size_t)l * DM + kc * 64) * 6 * DM + 4 * n4;
#pragma unroll 4
        for (int k = 0; k < 64; ++k) {
            const f32x4 w4 = *(const f32x4*)(w + (size_t)k * 6 * DM);
#pragma unroll
            for (int bb = 0; bb <= NB; ++bb) {
                const float cv = (bb < NB ? p.c + (size_t)bb * DM : p.c_ctx)[kc * 64 + k];
                acc[bb] += w4 * (cv / (1.0f + __expf(-cv)));
            }
        }
#pragma unroll
        for (int bb = 0; bb <= NB; ++bb) *(f32x4*)(MODP + (((size_t)kc * DEPTH + l) * (NB + 1) + bb) * 6 * DM + 4 * n4) = acc[bb];
    }
}
__device__ __forceinline__ void mod_reduce(const Params& p, long tid, long nth, const float* MODP) {
    const long total = (long)DEPTH * (NB + 1) * 6 * DM;
    for (long i = tid; i < total; i += nth) {
        const int n = (int)(i % (6 * DM)), l = (int)(i / ((long)6 * DM * (NB + 1)));
        float acc = p.mod_b[(size_t)l * 6 * DM + n];
#pragma unroll
        for (int kc = 0; kc < 16; ++kc) acc += MODP[(size_t)kc * total + i];
        p.MOD[i] = acc;
    }
}
constexpr int FL_Z = 0, FL_H1 = 8704, FL_H2 = 8704 + 16640, FL_T = 8704 + 2 * 16640;
constexpr int FILT_UNITS = DEPTH * (SEQ / 64) + DEPTH * (CTX / 64);
__device__ __forceinline__ void filt_unit(const Params& p, LAS unsigned char* lds, int u, int tix) {
    const bool isctx = u >= DEPTH * (SEQ / 64);
    const int uu = isctx ? u - DEPTH * (SEQ / 64) : u, per = isctx ? CTX / 64 : SEQ / 64;
    const int l = uu / per, t0 = (uu % per) * 64, ttb = (isctx ? SEQ : 0) + t0;
    LAS float* Z = (LAS float*)(lds + FL_Z); LAS float* H1 = (LAS float*)(lds + FL_H1); LAS float* H2 = (LAS float*)(lds + FL_H2);
    __syncthreads();
    {
        const int tap = tix & 63, bq = tix >> 6;
        float rel; filt_pos(ttb + tap, rel);
        const float tw = 2.0f * 3.14159265358979323846f * rel;
        if (bq == 0) Z[tap * 34] = rel;
#pragma unroll
        for (int k = 0; k < 2; ++k) { const int j = 2 * bq + k; const float ang = tw * (1e-4f + (float)j * ((15.0f - 1e-4f) / 15.0f));
            Z[tap * 34 + 1 + j] = cosf(ang); Z[tap * 34 + 17 + j] = -sinf(ang); }
    }
    __syncthreads();
    {
        const int tap = tix & 63, o0 = __builtin_amdgcn_readfirstlane(tix >> 6) * 8;
        float acc[8];
#pragma unroll
        for (int e = 0; e < 8; ++e) acc[e] = 0.f;
        const float* w1 = p.hy_w1 + (size_t)l * 33 * 64 + o0;
#pragma unroll 3
        for (int i = 0; i < 33; ++i) { const float zv = Z[tap * 34 + i];
#pragma unroll
            for (int e = 0; e < 8; ++e) acc[e] += zv * w1[i * 64 + e]; }
#pragma unroll
        for (int e = 0; e < 8; ++e) H1[tap * 65 + o0 + e] = sinf(p.hy_freq[l * 64 + o0 + e] * (acc[e] + p.hy_b1[l * 64 + o0 + e]));
    }
    __syncthreads();
    {
        const int tap = tix & 63, o0 = __builtin_amdgcn_readfirstlane(tix >> 6) * 8;
        float acc[8];
#pragma unroll
        for (int e = 0; e < 8; ++e) acc[e] = 0.f;
        const float* w2 = p.hy_w2 + (size_t)l * 64 * 64 + o0;
#pragma unroll 4
        for (int j = 0; j < 64; ++j) { const float hv = H1[tap * 65 + j];
#pragma unroll
            for (int e = 0; e < 8; ++e) acc[e] += hv * w2[j * 64 + e]; }
#pragma unroll
        for (int e = 0; e < 8; ++e) H2[tap * 65 + o0 + e] = sinf(p.hy_freq[l * 64 + o0 + e] * (acc[e] + p.hy_b2[l * 64 + o0 + e]));
    }
    __syncthreads();
    {
        const int c = tix & 255, half = tix >> 8;
        float w[64];
#pragma unroll
        for (int j = 0; j < 64; ++j) w[j] = p.hy_w3[(size_t)l * 64 * 256 + j * 256 + c];
        const float dec = p.hy_decay[l * 256 + c];
#pragma unroll 2
        for (int k = 0; k < 32; ++k) {
            const int tap = 32 * half + k;
            float acc = 0.f;
#pragma unroll
            for (int j = 0; j < 64; ++j) acc += H2[tap * 65 + j] * w[j];
            float rel; filt_pos(ttb + tap, rel);
            const float hv = acc * expf(-2.0f * fabsf(rel) * dec);
            if (isctx) ((LAS float*)(lds + FL_T))[tap * 260 + c] = hv;
            else ((LAS unsigned short*)(lds + FL_T))[c * 72 + 63 - tap] = (unsigned short)f2bf_u(hv);
        }
    }
    __syncthreads();
    if (isctx) {
        for (int e = tix; e < 64 * 256; e += 512) p.HFC[((size_t)l * CTX + t0 + (e >> 8)) * 256 + (e & 255)] = ((const LAS float*)(lds + FL_T))[(e >> 8) * 260 + (e & 255)];
    } else {
#pragma unroll 4
        for (int k = 0; k < 32; ++k) { const int e = k * 512 + tix, row = e >> 6, col = e & 63;
            p.G1[((size_t)l * 256 + row) * G1N + (8456 - t0 - 63) + col] = ((const LAS unsigned short*)(lds + FL_T))[row * 72 + col]; }
    }
}
__device__ __forceinline__ void filt_all(const Params& p, LAS unsigned char* lds, long tid, long nth, int tix, int bid, int G) {
    constexpr int NPAD = 265 + (G1N - 8457);
    for (long i = tid; i < (long)DEPTH * 256 * NPAD; i += nth) {
        const int k = (int)(i % NPAD); const long lc = i / NPAD;
        p.G1[lc * G1N + (k < 265 ? k : 8457 + (k - 265))] = 0;
    }
    for (int u = bid; u < FILT_UNITS; u += G) filt_unit(p, lds, u, tix);
    __syncthreads();
}
__device__ __forceinline__ const float* xsrc_row(const Params& p, int r, bool from_input) {
    if (from_input) return r < BL ? p.x + (size_t)r * DM : p.ctx + (size_t)(r - BL) * DM;
    return r < BL ? p.XL + (size_t)r * DM : p.XC + (size_t)(r - BL) * DM;
}
template <bool SLAB>
__device__ __forceinline__ void hx_pass(const Params& p, int l, int which, int row_lo, int row_hi, int gw, int NGW, int lane, int nslab = 0, const float* slab = nullptr, const float* gate = nullptr, bool base_from_input = false) {
    const float* g = (which ? p.norm2_g : p.norm1_g) + (size_t)l * DM;
    for (int r = row_lo + gw; r < row_hi; r += NGW) {
        const float* m = p.MOD + ((size_t)l * (NB + 1) + row_bb(r)) * 6 * DM;
        const float* sh = m + (which ? 3 : 0) * DM; const float* sc = m + (which ? 4 : 1) * DM;
        f32x4 v[4]; float s = 0.f;
        if (SLAB) {
            const f32x4* x4 = (const f32x4*)(base_from_input ? p.ctx + (size_t)(r - BL) * DM : p.XC + (size_t)(r - BL) * DM) + lane;
            f32x4* xo = (f32x4*)(p.XC + (size_t)(r - BL) * DM) + lane;
            const f32x4* sl = (const f32x4*)(slab + (size_t)(r - BL) * DM) + lane;
#pragma unroll
            for (int j = 0; j < 4; ++j) v[j] = (f32x4){0.f, 0.f, 0.f, 0.f};
#pragma unroll 1
            for (int q = 0; q < nslab; ++q) {
#pragma unroll
                for (int j = 0; j < 4; ++j) v[j] += sl[(size_t)q * BC * (DM / 4) + 64 * j];
            }
#pragma unroll
            for (int j = 0; j < 4; ++j) { v[j] = x4[64 * j] + *(const f32x4*)(gate + 4 * lane + 256 * j) * v[j]; xo[64 * j] = v[j]; }
        } else {
            const f32x4* x4 = (const f32x4*)xsrc_row(p, r, l == 0 && which == 0) + lane;
#pragma unroll
            for (int j = 0; j < 4; ++j) v[j] = x4[64 * j];
        }
#pragma unroll
        for (int j = 0; j < 4; ++j) s += (v[j].x * v[j].x + v[j].y * v[j].y) + (v[j].z * v[j].z + v[j].w * v[j].w);
        const float rstd = 1.0f / sqrtf(wave_sum(s, lane) * (1.0f / DM) + EPSV);
        unsigned long long* o8 = (unsigned long long*)(p.Y + (size_t)r * DM) + lane;
#pragma unroll
        for (int j = 0; j < 4; ++j) {
            const int k = 4 * lane + 256 * j;
            const f32x4 gg = *(const f32x4*)(g + k), s1 = *(const f32x4*)(sc + k), s0 = *(const f32x4*)(sh + k);
            const f32x4 o = v[j] * rstd * gg * (s1 + 1.0f) + s0;
            o8[64 * j] = (unsigned long long)pk2(o.x, o.y) | ((unsigned long long)pk2(o.z, o.w) << 32);
        }
    }
}
__device__ __forceinline__ void final_pass(const Params& p, int gw, int NGW, int lane) {
    for (int r = gw; r < BL; r += NGW) {
        f32x4* x4 = (f32x4*)(p.XL + (size_t)r * DM) + lane;
        f32x4 v[4]; float s = 0.f;
#pragma unroll
        for (int j = 0; j < 4; ++j) { v[j] = x4[64 * j]; s += (v[j].x * v[j].x + v[j].y * v[j].y) + (v[j].z * v[j].z + v[j].w * v[j].w); }
        const float rstd = 1.0f / sqrtf(wave_sum(s, lane) * (1.0f / DM) + EPSV);
#pragma unroll
        for (int j = 0; j < 4; ++j) x4[64 * j] = v[j] * rstd * *(const f32x4*)(p.final_g + 4 * lane + 256 * j);
    }
}


#define GAS __attribute__((address_space(1)))
#define XB_TMO      128
#define XB_XCNT(j)  (256  + 64 * (j))
#define XB_XSUB(j)  (1280 + 64 * (j))
#define XB_XGEN(j)  (2304 + 64 * (j))
#define XB_TOP      3328
#define XB_TOPGEN   3392
#define XCD_BAR_WORDS 3456
#define XB_SPIN_CAP (1u << 18)

__device__ __forceinline__ unsigned xb_ld(unsigned* p)              { return __hip_atomic_load(p, __ATOMIC_RELAXED, __HIP_MEMORY_SCOPE_AGENT); }
__device__ __forceinline__ unsigned xb_add(unsigned* p, unsigned v) { return __hip_atomic_fetch_add(p, v, __ATOMIC_RELAXED, __HIP_MEMORY_SCOPE_AGENT); }
__device__ __forceinline__ unsigned xb_xcc_id() { return (unsigned)__builtin_amdgcn_s_getreg((3 << 11) | 20) & 0xFu; }
#define XB_SPIN(cond, bar) do { unsigned _sp = 0; while (cond) { __builtin_amdgcn_s_sleep(1); \
    if ((++_sp & 255u) == 0u) { if (xb_ld(&(bar)[XB_TMO])) break; if (_sp > XB_SPIN_CAP) { atomicAdd(&(bar)[XB_TMO], 1u); break; } } } } while (0)

struct XcdBarrier {
    unsigned* bar; unsigned x;
    volatile LAS unsigned* st;
};

__device__ __forceinline__ XcdBarrier xcd_barrier_post(unsigned* bar, volatile LAS unsigned* st) {
    XcdBarrier b; b.bar = bar; b.x = xb_xcc_id(); b.st = st;
    if (threadIdx.x == 0) (void)xb_add(&bar[XB_XCNT(b.x)], 1u);
    return b;
}
__device__ __forceinline__ void xcd_barrier_complete(unsigned* bar, unsigned x, unsigned& nloc, unsigned& nx) {
    const unsigned G = gridDim.x * gridDim.y * gridDim.z;
    unsigned sum, cnt, mine, sp = 0u;
    for (;;) {
        sum = 0u; cnt = 0u; mine = 0u;
#pragma unroll
        for (unsigned j = 0; j < 16; ++j) { const unsigned c = xb_ld(&bar[XB_XCNT(j)]); sum += c; cnt += (c > 0u) ? 1u : 0u; mine = (j == x) ? c : mine; }
        if (sum == G) break;
        __builtin_amdgcn_s_sleep(1);
        if ((++sp & 255u) == 0u) { if (xb_ld(&bar[XB_TMO])) break; if (sp > XB_SPIN_CAP) { atomicAdd(&bar[XB_TMO], 1u); break; } }
    }
    nloc = mine > 0u ? mine : 1u; nx = cnt > 0u ? cnt : 1u;
}

__device__ __forceinline__ void xcd_barrier(const XcdBarrier& b, bool leader) {
    asm volatile("s_waitcnt vmcnt(0)" ::: "memory");
    __syncthreads();
    if (leader) {
        unsigned* bar = b.bar;
        __builtin_amdgcn_s_waitcnt(0);
        unsigned nloc = b.st[0], nx = b.st[1];
        if (nloc == 0u) { xcd_barrier_complete(bar, b.x, nloc, nx); b.st[0] = nloc; b.st[1] = nx; }
        const unsigned old = xb_add(&bar[XB_XSUB(b.x)], 1u);
        const unsigned gen = old / nloc;
        if (old + 1u == (gen + 1u) * nloc) {
            __builtin_amdgcn_fence(__ATOMIC_RELEASE, "agent");
            asm volatile("s_waitcnt vmcnt(0)" ::: "memory");
            const unsigned og = xb_add(&bar[XB_TOP], 1u);
            const unsigned tg = og / nx;
            if (og + 1u == (tg + 1u) * nx) xb_add(&bar[XB_TOPGEN], 1u);
            else XB_SPIN(xb_ld(&bar[XB_TOPGEN]) == tg, bar);
            __builtin_amdgcn_fence(__ATOMIC_ACQUIRE, "agent");
            xb_add(&bar[XB_XGEN(b.x)], 1u);
            asm volatile("s_waitcnt vmcnt(0)" ::: "memory");
        } else {
            XB_SPIN(xb_ld(&bar[XB_XGEN(b.x)]) == gen, bar);
            __builtin_amdgcn_fence(__ATOMIC_ACQUIRE, "agent");
            asm volatile("s_waitcnt vmcnt(0)" ::: "memory");
        }
    }
    __syncthreads();
}
#define GNCC ((CTX + SEQ) / 64)
#define GCTXC (CTX / 64)
#define GLA_UNITS (NB * 6 * GNCC)
typedef short bf16x8 __attribute__((ext_vector_type(8)));
__device__ __forceinline__ int gla_row0(int b, int cc) { return cc < GCTXC ? BL + b * CTX + cc * 64 : b * SEQ + (cc - GCTXC) * 64; }
__device__ __forceinline__ size_t gla_uidx(int dir, int b, int h, int cc) { return (((size_t)dir * NB + b) * 6 + h) * GNCC + cc; }
__device__ __forceinline__ float bflo(unsigned u) { return __builtin_bit_cast(float, u << 16); }
__device__ __forceinline__ float bfhi(unsigned u) { return __builtin_bit_cast(float, u & 0xffff0000u); }
constexpr int GL_WL = 0, GL_BIAS = 24576, GL_VT = 26112, GL_KLT = 35328, GL_AC = 44544, GL_KD = 70144, GL_PART = 80384;
constexpr int GL_VTS = 72, GL_ACS = 200, GL_KDS = 40;

__device__ __forceinline__ void gla_stage_w(const Params& p, int l, LAS unsigned char* lds, int tix) {
    LAS float* WL = (LAS float*)(lds + GL_WL); LAS float* BI = (LAS float*)(lds + GL_BIAS);
    for (int i = tix; i < 6 * 1024; i += 512) { const int h = i >> 10, dir = (i >> 9) & 1, j = (i >> 5) & 15, d = i & 31;
        WL[i] = (dir ? p.gk_w_b : p.gk_w_f)[(size_t)l * 16 * 192 + j * 192 + h * 32 + d]; }
    if (tix < 384) { const int h = tix >> 6, dir = (tix >> 5) & 1, d = tix & 31; BI[tix] = (dir ? p.gk_b_b : p.gk_b_f)[l * 192 + h * 32 + d]; }
}
struct GlaPre { v4u v, gk0, gk1, q, k; };
template <bool NEEDQ>
__device__ __forceinline__ void gla_issue(const Params& p, int u, int tix, GlaPre& L) {
    const int b = u / (6 * GNCC), h = (u / GNCC) % 6, cc = u % GNCC, row0 = gla_row0(b, cc);
    const int lane = tix & 63, wave = tix >> 6, dir = wave >> 2, d0 = (wave & 3) * 8;
    L.v = *(const v4u*)(p.P + (size_t)(row0 + (tix >> 3)) * LDP + OFF_V + h * 64 + (tix & 7) * 8);
    const act_t* prow = p.P + (size_t)(row0 + lane) * LDP;
    L.gk0 = *(const v4u*)(prow + (dir ? OFF_GKB : OFF_GKF)); L.gk1 = *(const v4u*)(prow + (dir ? OFF_GKB : OFF_GKF) + 8);
    L.k = *(const v4u*)(prow + OFF_K + h * 32 + d0);
    if (NEEDQ) L.q = *(const v4u*)(prow + OFF_Q + h * 32 + d0);
}
__device__ __forceinline__ void gla_put_v(LAS unsigned char* lds, int tix, const v4u vv) {
    const int j = tix >> 3, eo = tix & 7;
    LAS unsigned short* VT = (LAS unsigned short*)(lds + GL_VT);
    VT[(eo * 8 + 0) * GL_VTS + j] = (unsigned short)(vv.x & 0xffff); VT[(eo * 8 + 1) * GL_VTS + j] = (unsigned short)(vv.x >> 16);
    VT[(eo * 8 + 2) * GL_VTS + j] = (unsigned short)(vv.y & 0xffff); VT[(eo * 8 + 3) * GL_VTS + j] = (unsigned short)(vv.y >> 16);
    VT[(eo * 8 + 4) * GL_VTS + j] = (unsigned short)(vv.z & 0xffff); VT[(eo * 8 + 5) * GL_VTS + j] = (unsigned short)(vv.z >> 16);
    VT[(eo * 8 + 6) * GL_VTS + j] = (unsigned short)(vv.w & 0xffff); VT[(eo * 8 + 7) * GL_VTS + j] = (unsigned short)(vv.w >> 16);
}
__device__ __forceinline__ void gla_phase_a(const v4u g0, const v4u g1, LAS unsigned char* lds, int h, int dir, int d0, int lane, float (&Bv)[8], float (&tot)[8]) {
    const LAS float* WL = (const LAS float*)(lds + GL_WL) + h * 1024 + dir * 512 + d0; const LAS float* BI = (const LAS float*)(lds + GL_BIAS) + h * 64 + dir * 32 + d0;
    float gk[16] = { bflo(g0.x), bfhi(g0.x), bflo(g0.y), bfhi(g0.y), bflo(g0.z), bfhi(g0.z), bflo(g0.w), bfhi(g0.w),
                     bflo(g1.x), bfhi(g1.x), bflo(g1.y), bfhi(g1.y), bflo(g1.z), bfhi(g1.z), bflo(g1.w), bfhi(g1.w) };
    float lg[8];
#pragma unroll
    for (int i = 0; i < 8; ++i) lg[i] = BI[i];
#pragma unroll
    for (int j = 0; j < 16; ++j) {
        const f32x4 w0 = *(const LAS f32x4*)(WL + j * 32), w1 = *(const LAS f32x4*)(WL + j * 32 + 4);
        lg[0] += gk[j] * w0.x; lg[1] += gk[j] * w0.y; lg[2] += gk[j] * w0.z; lg[3] += gk[j] * w0.w;
        lg[4] += gk[j] * w1.x; lg[5] += gk[j] * w1.y; lg[6] += gk[j] * w1.z; lg[7] += gk[j] * w1.w;
    }
#pragma unroll
    for (int i = 0; i < 8; ++i) {
        const float x = lg[i];
        lg[i] = -(fmaxf(-x, 0.f) + __logf(1.0f + __expf(-fabsf(x)))) * (1.0f / 16.0f);
        const float v = wave_scan_incl(lg[i], lane);
        tot[i] = lane63(v);
        Bv[i] = dir ? tot[i] - v + lg[i] : v;
    }
}
__device__ __forceinline__ void unpack8(const v4u k, float (&f)[8]) {
    f[0] = bflo(k.x); f[1] = bfhi(k.x); f[2] = bflo(k.y); f[3] = bfhi(k.y); f[4] = bflo(k.z); f[5] = bfhi(k.z); f[6] = bflo(k.w); f[7] = bfhi(k.w);
}
__device__ __forceinline__ int gla_count(int b, int ph) {
    if (gridDim.x != 256 || GLA_UNITS != 3168) return (GLA_UNITS - b + (int)gridDim.x - 1) / (int)gridDim.x;
    const int n0 = ph ? 8 : 9, extra = 3168 - 16 * n0 - 240 * 12;
    return b < 16 ? n0 : 12 + ((b - 16) < extra ? 1 : 0);
}
__device__ __forceinline__ int gla_unit_of(int b, int k, int ph) {
    if (gridDim.x != 256 || GLA_UNITS != 3168) return b + k * (int)gridDim.x;
    const int n0 = ph ? 8 : 9;
    return b < 16 ? n0 * b + k : (k < 12 ? 16 * n0 + (b - 16) * 12 + k : 16 * n0 + 2880 + (b - 16));
}
__device__ __forceinline__ void gla_m2_phase(const Params& p, int l, LAS unsigned char* lds, int tix, int bid, unsigned short* DSG, float* DECG) {
    const int lane = tix & 63, wave = __builtin_amdgcn_readfirstlane(tix >> 6);
    gla_stage_w(p, l, lds, tix);
    GlaPre L;
    const int ncnt = gla_count(bid, 0);
    if (ncnt > 0) gla_issue<false>(p, gla_unit_of(bid, 0, 0), tix, L);
    __syncthreads();
#pragma unroll 1
    for (int kk = 0; kk < ncnt; ++kk) {
        const int u = gla_unit_of(bid, kk, 0);
        const int b = u / (6 * GNCC), h = (u / GNCC) % 6, cc = u % GNCC;
        gla_put_v(lds, tix, L.v);
        {
            const int dir = wave >> 2, d0 = (wave & 3) * 8;
            float Bv[8], tot[8];
            gla_phase_a(L.gk0, L.gk1, lds, h, dir, d0, lane, Bv, tot);
            float kf[8]; unpack8(L.k, kf);
            LAS unsigned short* KLT = (LAS unsigned short*)(lds + GL_KLT) + (dir * 32 + d0) * GL_VTS + lane;
#pragma unroll
            for (int i = 0; i < 8; ++i) KLT[i * GL_VTS] = (unsigned short)f2bf_u(kf[i] * __expf(tot[i] - Bv[i]));
            if (lane == 0) {
                float* dg = DECG + gla_uidx(dir, b, h, cc) * 32 + d0;
#pragma unroll
                for (int i = 0; i < 8; ++i) dg[i] = __expf(tot[i]);
            }
        }
        if (kk + 1 < ncnt) gla_issue<false>(p, gla_unit_of(bid, kk + 1, 0), tix, L);
        __syncthreads();
        {
            const int dir = wave >> 2, te = wave & 3, fr = lane & 15, fq = lane >> 4;
            unsigned short* out = DSG + gla_uidx(dir, b, h, cc) * 2048;
#pragma unroll
            for (int td = 0; td < 2; ++td) {
                f32x4 acc = {0.f, 0.f, 0.f, 0.f};
#pragma unroll
                for (int ks = 0; ks < 2; ++ks) {
                    const bf16x8 a = *(const LAS bf16x8*)(lds + GL_VT + ((16 * te + fr) * GL_VTS + 32 * ks + 8 * fq) * 2);
                    const bf16x8 bb = *(const LAS bf16x8*)(lds + GL_KLT + ((dir * 32 + 16 * td + fr) * GL_VTS + 32 * ks + 8 * fq) * 2);
                    acc = __builtin_amdgcn_mfma_f32_16x16x32_bf16(a, bb, acc, 0, 0, 0);
                }
#pragma unroll
                for (int r = 0; r < 4; ++r) out[(16 * te + 4 * fq + r) * 32 + 16 * td + fr] = (unsigned short)f2bf_u(acc[r]);
            }
        }
        __syncthreads();
    }
}
template <int NSTEP, int BATCH>
__device__ __forceinline__ void gla_m3_seg(f32x4& S, const unsigned short* DSG, const float* DECG, unsigned short* SSG, size_t base, int cc0, int step, int ed) {
    static_assert(NSTEP % BATCH == 0, "");
#pragma unroll 1
    for (int k0 = 0; k0 < NSTEP; k0 += BATCH) {
        f32x4 d[BATCH], dc[BATCH]; unsigned long long draw[BATCH];
#pragma unroll
        for (int j = 0; j < BATCH; ++j) { const size_t u = base + cc0 + (k0 + j) * step; draw[j] = *(const unsigned long long*)(DSG + u * 2048 + ed); dc[j] = *(const f32x4*)(DECG + u * 32 + (ed & 31)); }
#pragma unroll
        for (int j = 0; j < BATCH; ++j) { const unsigned lo = (unsigned)draw[j], hi = (unsigned)(draw[j] >> 32); d[j] = (f32x4){bflo(lo), bfhi(lo), bflo(hi), bfhi(hi)}; }
#pragma unroll
        for (int j = 0; j < BATCH; ++j) { const size_t u = base + cc0 + (k0 + j) * step;
            *(unsigned long long*)(SSG + u * 2048 + ed) = (unsigned long long)pk2(S.x, S.y) | ((unsigned long long)pk2(S.z, S.w) << 32);
            S = dc[j] * S + d[j]; }
    }
}
__device__ __forceinline__ void gla_m3(long tid, long nth, const unsigned short* DSG, const float* DECG, unsigned short* SSG) {
    for (long i = tid; i < 2L * NB * 6 * 512; i += nth) {
        const int ed = (int)(i & 511) * 4, chain = (int)(i >> 9), dir = chain / (NB * 6);
        const size_t base = (size_t)chain * GNCC;
        float z0 = 0.f; asm volatile("" : "+v"(z0));
        f32x4 S = {z0, z0, z0, z0};
        if (dir == 0) { gla_m3_seg<GCTXC, GCTXC>(S, DSG, DECG, SSG, base, 0, 1, ed); gla_m3_seg<GNCC - GCTXC, 16>(S, DSG, DECG, SSG, base, GCTXC, 1, ed); }
        else { gla_m3_seg<GCTXC, GCTXC>(S, DSG, DECG, SSG, base, GCTXC - 1, -1, ed); gla_m3_seg<GNCC - GCTXC, 16>(S, DSG, DECG, SSG, base, GNCC - 1, -1, ed); }
    }
}
struct GlaPre4 { bf16x8 s[2][2]; unsigned short g[4][2]; };
__device__ __forceinline__ void gla_issue4(const Params& p, int u, int tix, const unsigned short* SSG, GlaPre4& S) {
    const int b = u / (6 * GNCC), h = (u / GNCC) % 6, cc = u % GNCC, row0 = gla_row0(b, cc);
    const int lane = tix & 63, wave = tix >> 6, fr = lane & 15, fq = lane >> 4, ti = wave >> 1, ch = wave & 1;
#pragma unroll
    for (int dir = 0; dir < 2; ++dir)
#pragma unroll
        for (int n = 0; n < 2; ++n) S.s[dir][n] = *(const bf16x8*)(SSG + gla_uidx(dir, b, h, cc) * 2048 + (32 * ch + 16 * n + fr) * 32 + 8 * fq);
#pragma unroll
    for (int r = 0; r < 4; ++r)
#pragma unroll
        for (int n = 0; n < 2; ++n) S.g[r][n] = p.P[(size_t)(row0 + 16 * ti + 4 * fq + r) * LDP + OFF_G + h * 64 + 32 * ch + 16 * n + fr];
}
__device__ __forceinline__ void gla_m4_phase(const Params& p, int l, LAS unsigned char* lds, int tix, int bid, const unsigned short* SSG) {
    const int lane = tix & 63, wave = __builtin_amdgcn_readfirstlane(tix >> 6), fr = lane & 15, fq = lane >> 4;
    gla_stage_w(p, l, lds, tix);
    GlaPre L; GlaPre4 S;
    const int ncnt = gla_count(bid, 1);
    if (ncnt > 0) { const int u0 = gla_unit_of(bid, 0, 1); gla_issue<true>(p, u0, tix, L); gla_issue4(p, u0, tix, SSG, S); }
    __syncthreads();
#pragma unroll 1
    for (int kk = 0; kk < ncnt; ++kk) {
        const int u = gla_unit_of(bid, kk, 1);
        const int b = u / (6 * GNCC), h = (u / GNCC) % 6, cc = u % GNCC, row0 = gla_row0(b, cc);
        gla_put_v(lds, tix, L.v);
        {
            const int dir = wave >> 2, d0 = (wave & 3) * 8;
            float Bv[8], tot[8];
            gla_phase_a(L.gk0, L.gk1, lds, h, dir, d0, lane, Bv, tot);
            float kf[8], qf[8]; unpack8(L.k, kf); unpack8(L.q, qf);
            float qd[8], kd[8];
#pragma unroll
            for (int i = 0; i < 8; ++i) { qd[i] = qf[i] * __expf(Bv[i]) * 0.17677669529663687f; kd[i] = kf[i] * __expf(-Bv[i]); }
            v4u w; w.x = pk2(qd[0], qd[1]); w.y = pk2(qd[2], qd[3]); w.z = pk2(qd[4], qd[5]); w.w = pk2(qd[6], qd[7]);
            *(LAS v4u*)(lds + GL_AC + (lane * GL_ACS + 128 + 32 * dir + d0) * 2) = w;
            w.x = pk2(kd[0], kd[1]); w.y = pk2(kd[2], kd[3]); w.z = pk2(kd[4], kd[5]); w.w = pk2(kd[6], kd[7]);
            *(LAS v4u*)(lds + GL_KD + ((dir * 64 + lane) * GL_KDS + d0) * 2) = w;
        }
        const bool more = kk + 1 < ncnt;
        if (more) gla_issue<true>(p, gla_unit_of(bid, kk + 1, 1), tix, L);
        __syncthreads();
        {
            const int dir = wave >> 2, ti = wave & 3;
            const bf16x8 a = *(const LAS bf16x8*)(lds + GL_AC + ((16 * ti + fr) * GL_ACS + 128 + 32 * dir + 8 * fq) * 2);
            LAS unsigned short* AC = (LAS unsigned short*)(lds + GL_AC);
#pragma unroll
            for (int tj = 0; tj < 4; ++tj) {
                const bf16x8 bb = *(const LAS bf16x8*)(lds + GL_KD + ((dir * 64 + 16 * tj + fr) * GL_KDS + 8 * fq) * 2);
                f32x4 acc = {0.f, 0.f, 0.f, 0.f};
                acc = __builtin_amdgcn_mfma_f32_16x16x32_bf16(a, bb, acc, 0, 0, 0);
                const int j = 16 * tj + fr;
#pragma unroll
                for (int r = 0; r < 4; ++r) { const int i = 16 * ti + 4 * fq + r; const bool keep = dir ? (j >= i) : (j <= i);
                    AC[i * GL_ACS + 64 * dir + j] = (unsigned short)f2bf_u(keep ? acc[r] : 0.f); }
            }
        }
        __syncthreads();
        f32x4 acc[2] = { {0.f, 0.f, 0.f, 0.f}, {0.f, 0.f, 0.f, 0.f} };
        const int ti = wave >> 1, ch = wave & 1;
        {
            bf16x8 bv[2][2];
#pragma unroll
            for (int ks = 0; ks < 2; ++ks)
#pragma unroll
                for (int n = 0; n < 2; ++n) bv[ks][n] = *(const LAS bf16x8*)(lds + GL_VT + ((32 * ch + 16 * n + fr) * GL_VTS + 32 * ks + 8 * fq) * 2);
#pragma unroll
            for (int part = 0; part < 2; ++part)
#pragma unroll
                for (int ks = 0; ks < 2; ++ks) {
                    const bf16x8 a = *(const LAS bf16x8*)(lds + GL_AC + ((16 * ti + fr) * GL_ACS + 64 * part + 32 * ks + 8 * fq) * 2);
#pragma unroll
                    for (int n = 0; n < 2; ++n) acc[n] = __builtin_amdgcn_mfma_f32_16x16x32_bf16(a, bv[ks][n], acc[n], 0, 0, 0);
                }
#pragma unroll
            for (int dir = 0; dir < 2; ++dir) {
                const bf16x8 a = *(const LAS bf16x8*)(lds + GL_AC + ((16 * ti + fr) * GL_ACS + 128 + 32 * dir + 8 * fq) * 2);
#pragma unroll
                for (int n = 0; n < 2; ++n) acc[n] = __builtin_amdgcn_mfma_f32_16x16x32_bf16(a, S.s[dir][n], acc[n], 0, 0, 0);
            }
            LAS float* PART = (LAS float*)(lds + GL_PART);
#pragma unroll
            for (int r = 0; r < 4; ++r) {
                float ss = acc[0][r] * acc[0][r] + acc[1][r] * acc[1][r];
                ss = sum16(ss);
                if (fr == 0) PART[(16 * ti + 4 * fq + r) * 2 + ch] = ss;
            }
        }
        __syncthreads();
        {
            const LAS float* PART = (const LAS float*)(lds + GL_PART);
#pragma unroll
            for (int r = 0; r < 4; ++r) {
                const int i = 16 * ti + 4 * fq + r;
                const float rs = 1.0f / sqrtf((PART[i * 2] + PART[i * 2 + 1]) * (1.0f / 64.0f) + EPSV);
#pragma unroll
                for (int n = 0; n < 2; ++n) {
                    const int e = 32 * ch + 16 * n + fr;
                    const float g = bflo((unsigned)S.g[r][n]);
                    stact(p.Y + (size_t)(row0 + i) * DM + h * 64 + e, acc[n][r] * rs * p.gla_norm_w[l * 64 + e] * (g / (1.0f + __expf(-g))));
                }
            }
        }
        if (more) gla_issue4(p, gla_unit_of(bid, kk + 1, 1), tix, SSG, S);
    }
    __syncthreads();
}

#define SNCC ((CTX + SEQ) / 128)
#define SCTXC (CTX / 128)
#define SSD_UNITS (NB * 2 * SNCC)
constexpr int SD_CM = 0, SD_BM = 34816, SD_XT = 69632, SD_HS = 121856, SD_DTL = 139264, SD_CSL = 142336, SD_TOT = 145408, SD_HS2OFF = 145440 - 121856;
constexpr int SD_S = 136;
static_assert(SD_HS + SD_HS2OFF + 64 * 136 * 2 <= LDS_BYTES - 64, "SSD LDS map");
__device__ __forceinline__ int ssd_row(int b, int cc, int i) {
    if (cc < SCTXC) return BL + b * CTX + cc * 128 + i;
    return b * SEQ + colmajor_tok(0, (cc - SCTXC) * 128 + i);
}
__device__ __forceinline__ size_t ssd_chain(int dir, int b, int head) { return ((size_t)dir * NB + b) * 6 + head; }
template <bool TR_B, bool WITH_C>
__device__ __forceinline__ void ssd_stage(const Params& p, int l, LAS unsigned char* lds, int b, int g, int cc, int tix) {
    const int sidx = cc < SCTXC ? NB + b : b, L = seq_len(sidx), r0 = seq_row0(sidx), pos0 = (cc < SCTXC ? cc : cc - SCTXC) * 128;
    constexpr int NQ = WITH_C ? 14 : 10;
    LAS float* CW = (LAS float*)(lds + SD_HS);
    for (int i = tix; i < 4 * NQ * 32; i += 512) {
        const int k = i / (NQ * 32), cl = i % (NQ * 32), q = cl >> 5;
        const int col = (q < 6 ? g * 192 + q * 32 : (q < 10 ? 384 + g * 128 + (q - 6) * 32 : 640 + g * 128 + (q - 10) * 32)) + (cl & 31);
        CW[i] = k < 3 ? p.ssd_conv_w[(size_t)l * 3 * 896 + k * 896 + col] : p.ssd_conv_b[(size_t)l * 896 + col];
    }
    __syncthreads();
    for (int item = tix; item < 128 * NQ; item += 512) {
        const int i = item & 127, q = __builtin_amdgcn_readfirstlane(item >> 7);
        const int col0 = q < 6 ? g * 192 + q * 32 : (q < 10 ? 384 + g * 128 + (q - 6) * 32 : 640 + g * 128 + (q - 10) * 32);
        const int pos = pos0 + i;
        const act_t* rc = p.P + (size_t)(r0 + colmajor_tok(sidx, pos)) * LDP + OFF_XBC + col0;
        const bool hp = pos > 0, hn = pos + 1 < L;
        const act_t* rp = hp ? p.P + (size_t)(r0 + colmajor_tok(sidx, pos - 1)) * LDP + OFF_XBC + col0 : rc;
        const act_t* rn = hn ? p.P + (size_t)(r0 + colmajor_tok(sidx, pos + 1)) * LDP + OFF_XBC + col0 : rc;
        v4u raw[3][4];
#pragma unroll
        for (int o = 0; o < 4; ++o) { raw[0][o] = *(const v4u*)(rp + 8 * o); raw[1][o] = *(const v4u*)(rc + 8 * o); raw[2][o] = *(const v4u*)(rn + 8 * o); }
        const LAS float* cw = CW + q * 32;
#pragma unroll
        for (int o = 0; o < 4; ++o) {
            float xp[8], xc[8], xn[8], y[8];
            unpack8(raw[0][o], xp); unpack8(raw[1][o], xc); unpack8(raw[2][o], xn);
#pragma unroll
            for (int h2 = 0; h2 < 2; ++h2) {
                const f32x4 w0 = *(const LAS f32x4*)(cw + 8 * o + 4 * h2), w1 = *(const LAS f32x4*)(cw + NQ * 32 + 8 * o + 4 * h2);
                const f32x4 w2 = *(const LAS f32x4*)(cw + 2 * NQ * 32 + 8 * o + 4 * h2), bs = *(const LAS f32x4*)(cw + 3 * NQ * 32 + 8 * o + 4 * h2);
#pragma unroll
                for (int e4 = 0; e4 < 4; ++e4) {
                    const int e = 4 * h2 + e4;
                    const float vp = hp ? xp[e] : 0.f, vn = hn ? xn[e] : 0.f;
                    const float a = bs[e4] + w1[e4] * xc[e] + w0[e4] * vp + w2[e4] * vn;
                    y[e] = a * __builtin_amdgcn_rcpf(1.0f + __expf(-a));
                }
            }
            if (q < 6) {
                LAS unsigned short* d = (LAS unsigned short*)(lds + SD_XT) + (q * 32 + 8 * o) * SD_S + i;
#pragma unroll
                for (int e = 0; e < 8; ++e) d[e * SD_S] = (unsigned short)f2bf_u(y[e]);
            } else if (q < 10) {
                if (TR_B) { LAS unsigned short* d = (LAS unsigned short*)(lds + SD_BM) + ((q - 6) * 32 + 8 * o) * SD_S + i;
#pragma unroll
                    for (int e = 0; e < 8; ++e) d[e * SD_S] = (unsigned short)f2bf_u(y[e]);
                } else { v4u w; w.x = pk2(y[0], y[1]); w.y = pk2(y[2], y[3]); w.z = pk2(y[4], y[5]); w.w = pk2(y[6], y[7]);
                    *(LAS v4u*)(lds + SD_BM + (i * SD_S + (q - 6) * 32 + 8 * o) * 2) = w; }
            } else { v4u w; w.x = pk2(y[0], y[1]); w.y = pk2(y[2], y[3]); w.z = pk2(y[4], y[5]); w.w = pk2(y[6], y[7]);
                *(LAS v4u*)(lds + SD_CM + (i * SD_S + (q - 10) * 32 + 8 * o) * 2) = w; }
        }
    }
}
__device__ __forceinline__ void ssd_scans(const Params& p, int l, LAS unsigned char* lds, int b, int g, int cc, int wave, int lane) {
    if (wave < 6) {
        const int hg = wave % 3, dir = wave / 3, head = g * 3 + hg;
        const float bias = (dir ? p.ssd_dt_bias_b : p.ssd_dt_bias_f)[l * 6 + head];
        const float A = -__expf((dir ? p.ssd_a_log_b : p.ssd_a_log_f)[l * 6 + head]);
        float dt[2], a[2];
#pragma unroll
        for (int k = 0; k < 2; ++k) {
            const float x = ldact(p.P + (size_t)ssd_row(b, cc, 2 * lane + k) * LDP + (dir ? OFF_DTB : OFF_DTF) + head) + bias;
            dt[k] = fmaxf(x, 0.f) + log1pf(__expf(-fabsf(x))); a[k] = A * dt[k];
        }
        const float v = wave_scan_incl(a[0] + a[1], lane);
        const float tot = lane63(v);
        const float pf1 = v, pf0 = v - a[1];
        LAS float* DTL = (LAS float*)(lds + SD_DTL) + wave * 128 + 2 * lane; LAS float* CSL = (LAS float*)(lds + SD_CSL) + wave * 128 + 2 * lane;
        DTL[0] = dt[0]; DTL[1] = dt[1];
        CSL[0] = dir ? tot - pf0 + a[0] : pf0; CSL[1] = dir ? tot - pf1 + a[1] : pf1;
        if (lane == 0) ((LAS float*)(lds + SD_TOT))[wave] = tot;
    }
}
__device__ __forceinline__ void ssd_s2_unit(const Params& p, int l, LAS unsigned char* lds, int u, int tix, unsigned short* DSS, float* DECS) {
    const int b = u / (2 * SNCC), g = (u / SNCC) & 1, cc = u % SNCC;
    const int lane = tix & 63, wave = __builtin_amdgcn_readfirstlane(tix >> 6), fr = lane & 15, fq = lane >> 4;
    ssd_scans(p, l, lds, b, g, cc, wave, lane);
    ssd_stage<true, false>(p, l, lds, b, g, cc, tix);
    __syncthreads();
    if (tix < 6) DECS[ssd_chain(tix / 3, b, g * 3 + tix % 3) * SNCC + cc] = __expf(((const LAS float*)(lds + SD_TOT))[tix]);
#pragma unroll 1
    for (int k = 0; k < 3; ++k) {
        const int c3 = wave + 8 * k, tp = c3 & 3, combo = c3 >> 2, hg = combo % 3, dir = combo / 3;
        const LAS float* DTL = (const LAS float*)(lds + SD_DTL) + combo * 128; const LAS float* CSL = (const LAS float*)(lds + SD_CSL) + combo * 128;
        const float tot = ((const LAS float*)(lds + SD_TOT))[combo];
        bf16x8 a[4];
#pragma unroll
        for (int ks = 0; ks < 4; ++ks) {
            const int j0 = 32 * ks + 8 * fq;
            float xf[8]; unpack8(*(const LAS v4u*)(lds + SD_XT + ((hg * 64 + 16 * tp + fr) * SD_S + j0) * 2), xf);
            const f32x4 d0 = *(const LAS f32x4*)(DTL + j0), d1 = *(const LAS f32x4*)(DTL + j0 + 4), c0 = *(const LAS f32x4*)(CSL + j0), c1 = *(const LAS f32x4*)(CSL + j0 + 4);
            xf[0] *= d0.x * __expf(tot - c0.x); xf[1] *= d0.y * __expf(tot - c0.y); xf[2] *= d0.z * __expf(tot - c0.z); xf[3] *= d0.w * __expf(tot - c0.w);
            xf[4] *= d1.x * __expf(tot - c1.x); xf[5] *= d1.y * __expf(tot - c1.y); xf[6] *= d1.z * __expf(tot - c1.z); xf[7] *= d1.w * __expf(tot - c1.w);
            v4u w; w.x = pk2(xf[0], xf[1]); w.y = pk2(xf[2], xf[3]); w.z = pk2(xf[4], xf[5]); w.w = pk2(xf[6], xf[7]);
            a[ks] = __builtin_bit_cast(bf16x8, w);
        }
        unsigned short* out = DSS + (ssd_chain(dir, b, g * 3 + hg) * SNCC + cc) * 8192;
#pragma unroll
        for (int tn = 0; tn < 8; ++tn) {
            f32x4 acc = {0.f, 0.f, 0.f, 0.f};
#pragma unroll
            for (int ks = 0; ks < 4; ++ks) {
                const bf16x8 bb = *(const LAS bf16x8*)(lds + SD_BM + ((16 * tn + fr) * SD_S + 32 * ks + 8 * fq) * 2);
                acc = __builtin_amdgcn_mfma_f32_16x16x32_bf16(bb, a[ks], acc, 0, 0, 0);
            }
            *(unsigned long long*)(out + (16 * tp + fr) * 128 + 16 * tn + 4 * fq) = (unsigned long long)pk2(acc[0], acc[1]) | ((unsigned long long)pk2(acc[2], acc[3]) << 32);
        }
    }
    __syncthreads();
}
template <int NSTEP, int BATCH>
__device__ __forceinline__ void ssd_s3_seg(float (&S)[8], unsigned short* DSS, const float* DECS, size_t base, int cc0, int step, int el) {
    static_assert(NSTEP % BATCH == 0, "");
#pragma unroll 1
    for (int k0 = 0; k0 < NSTEP; k0 += BATCH) {
        v4u d[BATCH]; float dc[BATCH];
#pragma unroll
        for (int j = 0; j < BATCH; ++j) { const size_t u = base + cc0 + (k0 + j) * step; d[j] = *(const v4u*)(DSS + u * 8192 + el); dc[j] = DECS[u]; }
#pragma unroll
        for (int j = 0; j < BATCH; ++j) { const size_t u = base + cc0 + (k0 + j) * step;
            v4u w; w.x = pk2(S[0], S[1]); w.y = pk2(S[2], S[3]); w.z = pk2(S[4], S[5]); w.w = pk2(S[6], S[7]);
            *(v4u*)(DSS + u * 8192 + el) = w;
            float df[8]; unpack8(d[j], df);
#pragma unroll
            for (int e = 0; e < 8; ++e) S[e] = S[e] * dc[j] + df[e]; }
    }
}
__device__ __forceinline__ void ssd_s3(long tid, long nth, unsigned short* DSS, const float* DECS) {
    for (long i = tid; i < 2L * NB * 6 * 1024; i += nth) {
        const int el = (int)(i & 1023) * 8, chain = (int)(i >> 10), dir = chain / (NB * 6);
        const size_t base = (size_t)chain * SNCC;
        float z0 = 0.f; asm volatile("" : "+v"(z0));
        float S[8] = {z0, z0, z0, z0, z0, z0, z0, z0};
        if (dir == 0) { ssd_s3_seg<SCTXC, SCTXC>(S, DSS, DECS, base, 0, 1, el); ssd_s3_seg<SNCC - SCTXC, 8>(S, DSS, DECS, base, SCTXC, 1, el); }
        else { ssd_s3_seg<SCTXC, SCTXC>(S, DSS, DECS, base, SCTXC - 1, -1, el); ssd_s3_seg<SNCC - SCTXC, 8>(S, DSS, DECS, base, SNCC - 1, -1, el); }
    }
}
__device__ __forceinline__ void ssd_load_h(const unsigned short* HSS, int b, int head, int cc, int tix, v4u (&h)[2][2]) {
#pragma unroll
    for (int dir = 0; dir < 2; ++dir) {
        const unsigned short* hsrc = HSS + (ssd_chain(dir, b, head) * SNCC + cc) * 8192 + (tix >> 3) * 128 + (tix & 7) * 16;
        h[dir][0] = *(const v4u*)hsrc; h[dir][1] = *(const v4u*)(hsrc + 8);
    }
}
__device__ __forceinline__ void ssd_s4_unit(const Params& p, int l, LAS unsigned char* lds, int u, int tix, const unsigned short* HSS) {
    const int b = u / (2 * SNCC), g = (u / SNCC) & 1, cc = u % SNCC;
    const int lane = tix & 63, wave = __builtin_amdgcn_readfirstlane(tix >> 6), fr = lane & 15, fq = lane >> 4;
    ssd_scans(p, l, lds, b, g, cc, wave, lane);
    ssd_stage<false, true>(p, l, lds, b, g, cc, tix);
    __syncthreads();
    LAS unsigned char* cm_rd = lds + SD_CM + ((16 * wave + fr) * SD_S + 8 * fq) * 2;
    LAS unsigned char* bm_rd = lds + SD_BM + (fr * SD_S + 8 * fq) * 2;
    LAS unsigned char* m_rd = lds + SD_BM + ((16 * wave + fr) * SD_S + 8 * fq) * 2;
    LAS unsigned char* m_wr = lds + SD_BM + ((16 * wave + 4 * fq) * SD_S + fr) * 2;
    LAS unsigned char* xt_rd = lds + SD_XT + (fr * SD_S + 8 * fq) * 2;
    LAS unsigned char* hs_rd = lds + SD_HS + (fr * SD_S + 8 * fq) * 2;
    LAS unsigned char* hs_wr = lds + SD_HS + ((tix >> 3) * SD_S + (tix & 7) * 16) * 2;
    LAS unsigned char* sc_j = lds + SD_DTL + fr * 4;
    LAS unsigned char* sc_i = lds + SD_DTL + (16 * wave + 4 * fq) * 4;
    asm volatile("" : "+v"(cm_rd), "+v"(bm_rd), "+v"(m_rd), "+v"(m_wr), "+v"(xt_rd), "+v"(hs_rd), "+v"(hs_wr), "+v"(sc_j), "+v"(sc_i));
    f32x4 cb[8];
    bf16x8 ca[4];
#pragma unroll
    for (int ks = 0; ks < 4; ++ks) ca[ks] = *(const LAS bf16x8*)(cm_rd + 64 * ks);
#pragma unroll
    for (int tj = 0; tj < 8; ++tj) {
        cb[tj] = (f32x4){0.f, 0.f, 0.f, 0.f};
#pragma unroll
        for (int ks = 0; ks < 4; ++ks) {
            const bf16x8 bb = *(const LAS bf16x8*)(bm_rd + (16 * tj * SD_S + 32 * ks) * 2);
            cb[tj] = __builtin_amdgcn_mfma_f32_16x16x32_bf16(ca[ks], bb, cb[tj], 0, 0, 0);
        }
    }
    __syncthreads();
    f32x4 yacc[3][4];
#pragma unroll
    for (int hg = 0; hg < 3; ++hg)
#pragma unroll
        for (int tp = 0; tp < 4; ++tp) yacc[hg][tp] = (f32x4){0.f, 0.f, 0.f, 0.f};
#pragma unroll
    for (int hg = 0; hg < 3; ++hg) {
        v4u hreg[2][2];
        ssd_load_h(HSS, b, g * 3 + hg, cc, tix, hreg);
        __builtin_amdgcn_sched_barrier(0);
        float csfi[4], csbi[4];
#pragma unroll
        for (int r = 0; r < 4; ++r) { csfi[r] = *(const LAS float*)(sc_i + 3072 + hg * 512 + 4 * r); csbi[r] = *(const LAS float*)(sc_i + 3072 + (3 + hg) * 512 + 4 * r); }
#pragma unroll
        for (int tj = 0; tj < 8; ++tj) {
            const int j = 16 * tj + fr;
            const float csfj = *(const LAS float*)(sc_j + 3072 + hg * 512 + 64 * tj), csbj = *(const LAS float*)(sc_j + 3072 + (3 + hg) * 512 + 64 * tj);
            const float dtfj = *(const LAS float*)(sc_j + hg * 512 + 64 * tj), dtbj = *(const LAS float*)(sc_j + (3 + hg) * 512 + 64 * tj);
#pragma unroll
            for (int r = 0; r < 4; ++r) { const int i = 16 * wave + 4 * fq + r;
                const float arg = (j <= i) ? csfi[r] - csfj : csbi[r] - csbj;
                const float wgt = (j < i) ? dtfj : ((j > i) ? dtbj : dtfj + dtbj);
                *(LAS unsigned short*)(m_wr + (r * SD_S + 16 * tj) * 2) = (unsigned short)f2bf_u(cb[tj][r] * __expf(fminf(arg, 0.f)) * wgt); }
            __builtin_amdgcn_sched_barrier(0);
        }
        __builtin_amdgcn_sched_barrier(0);
#pragma unroll
        for (int dir = 0; dir < 2; ++dir) {
            *(LAS v4u*)(hs_wr + dir * SD_HS2OFF) = hreg[dir][0]; *(LAS v4u*)(hs_wr + dir * SD_HS2OFF + 16) = hreg[dir][1];
        }
        __syncthreads();
        f32x4 tmp[4];
#pragma unroll
        for (int tp = 0; tp < 4; ++tp) tmp[tp] = (f32x4){0.f, 0.f, 0.f, 0.f};
#pragma unroll
        for (int ks = 0; ks < 4; ++ks) {
            const bf16x8 am = *(const LAS bf16x8*)(m_rd + 64 * ks);
#pragma unroll
            for (int tp = 0; tp < 4; ++tp) {
                const bf16x8 bx = *(const LAS bf16x8*)(xt_rd + ((hg * 64 + 16 * tp) * SD_S + 32 * ks) * 2);
                yacc[hg][tp] = __builtin_amdgcn_mfma_f32_16x16x32_bf16(am, bx, yacc[hg][tp], 0, 0, 0);
                const bf16x8 bhf = *(const LAS bf16x8*)(hs_rd + (16 * tp * SD_S + 32 * ks) * 2);
                tmp[tp] = __builtin_amdgcn_mfma_f32_16x16x32_bf16(ca[ks], bhf, tmp[tp], 0, 0, 0);
            }
        }
#pragma unroll
        for (int r = 0; r < 4; ++r) { const float ef = __expf(csfi[r]);
#pragma unroll
            for (int tp = 0; tp < 4; ++tp) { yacc[hg][tp][r] += ef * tmp[tp][r]; tmp[tp][r] = 0.f; } }
#pragma unroll
        for (int ks = 0; ks < 4; ++ks)
#pragma unroll
            for (int tp = 0; tp < 4; ++tp) {
                const bf16x8 bhb = *(const LAS bf16x8*)(hs_rd + SD_HS2OFF + (16 * tp * SD_S + 32 * ks) * 2);
                tmp[tp] = __builtin_amdgcn_mfma_f32_16x16x32_bf16(ca[ks], bhb, tmp[tp], 0, 0, 0);
            }
#pragma unroll
        for (int r = 0; r < 4; ++r) { const float eb = __expf(csbi[r]);
#pragma unroll
            for (int tp = 0; tp < 4; ++tp) yacc[hg][tp][r] += eb * tmp[tp][r]; }
        __syncthreads();
    }
#pragma unroll
    for (int hg = 0; hg < 3; ++hg) {
        const float dcoef = p.ssd_d[l * 6 + g * 3 + hg];
#pragma unroll
        for (int tp = 0; tp < 4; ++tp) {
            const int pc = hg * 64 + 16 * tp + fr;
#pragma unroll
            for (int r = 0; r < 4; ++r)
                yacc[hg][tp][r] += dcoef * bflo((unsigned)((const LAS unsigned short*)(lds + SD_XT))[pc * SD_S + 16 * wave + 4 * fq + r]);
        }
    }
    __syncthreads();
    {
        LAS float* YL = (LAS float*)lds;
#pragma unroll
        for (int hg = 0; hg < 3; ++hg)
#pragma unroll
            for (int tp = 0; tp < 4; ++tp)
#pragma unroll
                for (int r = 0; r < 4; ++r) YL[(16 * wave + 4 * fq + r) * 196 + hg * 64 + 16 * tp + fr] = yacc[hg][tp][r];
        const float nw0 = p.ssd_norm_w[l * 384 + g * 192 + lane], nw1 = p.ssd_norm_w[l * 384 + g * 192 + 64 + lane], nw2 = p.ssd_norm_w[l * 384 + g * 192 + 128 + lane];
#pragma unroll 1
        for (int r8 = 0; r8 < 16; r8 += 8) {
            unsigned short zr[8][3];
#pragma unroll
            for (int k = 0; k < 8; ++k) {
                const act_t* zp = p.P + (size_t)ssd_row(b, cc, 16 * wave + r8 + k) * LDP + OFF_Z + g * 192 + lane;
                zr[k][0] = zp[0]; zr[k][1] = zp[64]; zr[k][2] = zp[128];
            }
#pragma unroll
            for (int k = 0; k < 8; ++k) {
                const int i = 16 * wave + r8 + k;
                const float z0 = bflo(zr[k][0]), z1 = bflo(zr[k][1]), z2 = bflo(zr[k][2]);
                const float v0 = YL[i * 196 + lane] * (z0 / (1.0f + __expf(-z0))), v1 = YL[i * 196 + 64 + lane] * (z1 / (1.0f + __expf(-z1))), v2 = YL[i * 196 + 128 + lane] * (z2 / (1.0f + __expf(-z2)));
                const float rs = 1.0f / sqrtf(wave_sum(v0 * v0 + v1 * v1 + v2 * v2, lane) * (1.0f / 192.0f) + EPSV);
                act_t* yp = p.Y + (size_t)ssd_row(b, cc, i) * DM + 640 + g * 192 + lane;
                stact(yp, v0 * rs * nw0); stact(yp + 64, v1 * rs * nw1); stact(yp + 128, v2 * rs * nw2);
            }
        }
    }
    __syncthreads();
}

typedef float f32x16 __attribute__((ext_vector_type(16)));
constexpr int HY_CP = 0, HY_MOFF = 4352, HY_U = 17920, HY_US = 264, HY_OUT = 85504;
__device__ __forceinline__ void hy_u8(const Params& p, int l, int b, int t, int col0, float (&y)[8]) {
    const act_t* rc = p.P + (size_t)(b * SEQ + t) * LDP + OFF_HY + col0;
    const float* w = p.hy_short_w + (size_t)l * 3 * 768 + col0; const float* bs = p.hy_short_b + (size_t)l * 768 + col0;
    const bool hp = t > 0, hn = t + 1 < SEQ;
    float xc[8], xp[8], xn[8];
    unpack8(*(const v4u*)rc, xc); unpack8(*(const v4u*)(hp ? rc - LDP : rc), xp); unpack8(*(const v4u*)(hn ? rc + LDP : rc), xn);
#pragma unroll
    for (int e = 0; e < 8; ++e) y[e] = bs[e] + w[768 + e] * xc[e] + w[e] * (hp ? xp[e] : 0.f) + w[2 * 768 + e] * (hn ? xn[e] : 0.f);
}
__device__ __forceinline__ void hy_ctx_conv(const Params& p, int l, long tid, long nth) {
    for (long i = tid; i < (long)NB * (CTX / 8) * 256; i += nth) {
        const int c = (int)(i & 255), to = (int)((i >> 8) % (CTX / 8)), sb = (int)(i / (256L * (CTX / 8)));
        const int t0 = 8 * to, r0 = BL + sb * CTX;
        const float* hf = p.HFC + (size_t)l * CTX * 256 + c; const float* vx = p.VX + (size_t)r0 * 256 + c;
        float acc[8], hw[15];
#pragma unroll
        for (int e = 0; e < 8; ++e) acc[e] = 0.f;
#pragma unroll
        for (int k = 1; k <= 7; ++k) { const int idx = t0 + CTX / 2 + k; const float v = hf[(size_t)(idx < CTX ? idx : CTX - 1) * 256]; hw[k + 7] = idx < CTX ? v : 0.f; }
#pragma unroll 1
        for (int jb = 0; jb < CTX / 8; ++jb) {
            const int base = t0 + CTX / 2 - 8 * jb;
            float vv[8];
#pragma unroll
            for (int jj = 0; jj < 8; ++jj) vv[jj] = vx[(size_t)(8 * jb + jj) * 256];
#pragma unroll
            for (int k = -7; k <= 0; ++k) { const int idx = base + k; const int ic = idx < 0 ? 0 : (idx >= CTX ? CTX - 1 : idx);
                const float v = hf[(size_t)ic * 256]; hw[k + 7] = (idx >= 0 && idx < CTX) ? v : 0.f; }
#pragma unroll
            for (int jj = 0; jj < 8; ++jj)
#pragma unroll
                for (int e = 0; e < 8; ++e) acc[e] += hw[e - jj + 7] * vv[jj];
#pragma unroll
            for (int k = 7; k >= 1; --k) hw[k + 7] = hw[k - 8 + 7];
        }
        const int s = NB + sb;
#pragma unroll
        for (int e = 0; e < 8; ++e) {
            const int t = t0 + e, r = r0 + t;
            const float x0 = hy_u(p, l, s, t, c);
            stact(p.Y + (size_t)r * DM + 384 + c, (acc[e] + vx[(size_t)t * 256] * p.hy_bias[l * 256 + c]) * x0);
        }
    }
}
constexpr int HY_HW = 81920;
__device__ __forceinline__ void hy_stage_w(const Params& p, int l, LAS unsigned char* lds, int tix) {
    LAS float* HW = (LAS float*)(lds + HY_HW);
    for (int i = tix; i < 4 * 768; i += 512) HW[i] = i < 3 * 768 ? p.hy_short_w[(size_t)l * 3 * 768 + i] : p.hy_short_b[(size_t)l * 768 + (i - 3 * 768)];
    __syncthreads();
}
__device__ __forceinline__ void hy_conv8(const v4u rp, const v4u rc, const v4u rn, bool hp, bool hn, const LAS float* hw, float (&y)[8]) {
    float xp[8], xc[8], xn[8]; unpack8(rp, xp); unpack8(rc, xc); unpack8(rn, xn);
#pragma unroll
    for (int h2 = 0; h2 < 2; ++h2) {
        const f32x4 w0 = *(const LAS f32x4*)(hw + 4 * h2), w1 = *(const LAS f32x4*)(hw + 768 + 4 * h2), w2 = *(const LAS f32x4*)(hw + 1536 + 4 * h2), bs = *(const LAS f32x4*)(hw + 2304 + 4 * h2);
#pragma unroll
        for (int e4 = 0; e4 < 4; ++e4) { const int e = 4 * h2 + e4; y[e] = bs[e4] + w1[e4] * xc[e] + w0[e4] * (hp ? xp[e] : 0.f) + w2[e4] * (hn ? xn[e] : 0.f); }
    }
}
__device__ __forceinline__ void hy_h1_unit(const Params& p, int l, LAS unsigned char* lds, int u, int tix) {
    const int b = u / (SEQ / 64), t0 = (u % (SEQ / 64)) * 64;
    const int t = tix & 63, cg = __builtin_amdgcn_readfirstlane(tix >> 6);
    LAS unsigned short* T = (LAS unsigned short*)lds;
    const int tok = t0 + t; const bool hp = tok > 0, hn = tok + 1 < SEQ;
    const act_t* rc = p.P + (size_t)(b * SEQ + tok) * LDP + OFF_HY + 32 * cg; const act_t* rp = hp ? rc - LDP : rc; const act_t* rn = hn ? rc + LDP : rc;
    v4u raw[4][2][3];
#pragma unroll
    for (int o = 0; o < 4; ++o)
#pragma unroll
        for (int gq = 0; gq < 2; ++gq) { const int col = 256 * (gq + 1) + 8 * o; raw[o][gq][0] = *(const v4u*)(rp + col); raw[o][gq][1] = *(const v4u*)(rc + col); raw[o][gq][2] = *(const v4u*)(rn + col); }
    const LAS float* HW = (const LAS float*)(lds + HY_HW) + 32 * cg;
#pragma unroll
    for (int o = 0; o < 4; ++o) {
        float x1[8], v[8];
        hy_conv8(raw[o][0][0], raw[o][0][1], raw[o][0][2], hp, hn, HW + 256 + 8 * o, x1);
        hy_conv8(raw[o][1][0], raw[o][1][1], raw[o][1][2], hp, hn, HW + 512 + 8 * o, v);
#pragma unroll
        for (int e = 0; e < 8; ++e) T[(32 * cg + 8 * o + e) * 72 + t] = (unsigned short)f2bf_u(v[e] * x1[e]);
    }
    __syncthreads();
    {
        const int c = tix >> 1, half = tix & 1;
        unsigned short* dst = p.VXT + ((size_t)(b * 256 + c)) * SEQ + t0 + 32 * half;
#pragma unroll
        for (int k = 0; k < 4; ++k) *(v4u*)(dst + 8 * k) = *(const LAS v4u*)(lds + (c * 72 + 32 * half + 8 * k) * 2);
    }
    __syncthreads();
}
template <int ALPHA>
__device__ __forceinline__ bf16x8 hy_afrag(const LAS unsigned char* a) {
    constexpr int SFT = 8 - ALPHA, SIG = SFT >> 1, HALF = SFT & 1;
    const v4u Y = *(const LAS v4u*)(a + 16);
    if constexpr (ALPHA == 0) { return __builtin_bit_cast(bf16x8, Y); }
    else {
        const v4u X = *(const LAS v4u*)a;
        const unsigned W[9] = { X.x, X.y, X.z, X.w, Y.x, Y.y, Y.z, Y.w, 0u };
        v4u o;
        o.x = HALF ? __builtin_amdgcn_alignbit(W[SIG + 1], W[SIG + 0], 16) : W[SIG + 0];
        o.y = HALF ? __builtin_amdgcn_alignbit(W[SIG + 2], W[SIG + 1], 16) : W[SIG + 1];
        o.z = HALF ? __builtin_amdgcn_alignbit(W[SIG + 3], W[SIG + 2], 16) : W[SIG + 2];
        o.w = HALF ? __builtin_amdgcn_alignbit(W[SIG + 4], W[SIG + 3], 16) : W[SIG + 3];
        return __builtin_bit_cast(bf16x8, o);
    }
}
template <int ALPHA>
__device__ __forceinline__ void hy_stream(LAS unsigned char* lds, int lane, f32x16 (&acc)[4]) {
    const int r = lane & 31, hf = lane >> 5, Il = r >> 2, bt = r & 3;
    LAS unsigned char* a_base = lds + HY_CP + 2 * (HY_MOFF + 8 * (hf - r) + 4096) - 12288;
    LAS unsigned char* b_base = lds + HY_U + ((Il * 4 + bt) * HY_US + 8 * hf) * 2;
    asm volatile("" : "+v"(a_base), "+v"(b_base));
    const bf16x8 zero8 = {0, 0, 0, 0, 0, 0, 0, 0};
#pragma unroll 1
    for (int s = 0; s < 16; ++s) {
        LAS unsigned char* ap = a_base + 32 * s; LAS unsigned char* bp = b_base + 32 * s;
#pragma unroll 1
        for (int delta = 0; delta < 8; ++delta) {
            const bf16x8 a0 = hy_afrag<ALPHA>(ap + 3 * 4096), a1 = hy_afrag<ALPHA>(ap + 2 * 4096), a2 = hy_afrag<ALPHA>(ap + 4096), a3 = hy_afrag<ALPHA>(ap);
            bf16x8 b0 = *(const LAS bf16x8*)bp, b1 = *(const LAS bf16x8*)(bp + 16896), b2 = *(const LAS bf16x8*)(bp + 2 * 16896);
            LAS unsigned char* bp3 = bp + 3 * 16896;
            bf16x8 b3 = *(const LAS bf16x8*)bp3, b4 = *(const LAS bf16x8*)(bp3 + 16896);
            b0 = (Il >= delta) ? b0 : zero8; b4 = (Il < delta) ? b4 : zero8;
            acc[0] = __builtin_amdgcn_mfma_f32_32x32x16_bf16(a0, b2, acc[0], 0, 0, 0);
            acc[1] = __builtin_amdgcn_mfma_f32_32x32x16_bf16(a0, b3, acc[1], 0, 0, 0);
            acc[2] = __builtin_amdgcn_mfma_f32_32x32x16_bf16(a0, b4, acc[2], 0, 0, 0);
            acc[3] = __builtin_amdgcn_mfma_f32_32x32x16_bf16(a1, b4, acc[3], 0, 0, 0);
            acc[0] = __builtin_amdgcn_mfma_f32_32x32x16_bf16(a1, b1, acc[0], 0, 0, 0);
            acc[1] = __builtin_amdgcn_mfma_f32_32x32x16_bf16(a1, b2, acc[1], 0, 0, 0);
            acc[2] = __builtin_amdgcn_mfma_f32_32x32x16_bf16(a1, b3, acc[2], 0, 0, 0);
            acc[3] = __builtin_amdgcn_mfma_f32_32x32x16_bf16(a2, b3, acc[3], 0, 0, 0);
            acc[0] = __builtin_amdgcn_mfma_f32_32x32x16_bf16(a2, b0, acc[0], 0, 0, 0);
            acc[1] = __builtin_amdgcn_mfma_f32_32x32x16_bf16(a2, b1, acc[1], 0, 0, 0);
            acc[2] = __builtin_amdgcn_mfma_f32_32x32x16_bf16(a2, b2, acc[2], 0, 0, 0);
            acc[3] = __builtin_amdgcn_mfma_f32_32x32x16_bf16(a3, b2, acc[3], 0, 0, 0);
            acc[1] = __builtin_amdgcn_mfma_f32_32x32x16_bf16(a3, b0, acc[1], 0, 0, 0);
            acc[2] = __builtin_amdgcn_mfma_f32_32x32x16_bf16(a3, b1, acc[2], 0, 0, 0);
            if (delta == 0) {
                const bf16x8 a4 = hy_afrag<ALPHA>(ap - 4096);
                acc[2] = __builtin_amdgcn_mfma_f32_32x32x16_bf16(a4, b0, acc[2], 0, 0, 0);
                acc[3] = __builtin_amdgcn_mfma_f32_32x32x16_bf16(a4, b1, acc[3], 0, 0, 0);
            }
            ap -= 512; bp -= 2112;
        }
    }
}
__device__ __forceinline__ void hy_h2_channel(const Params& p, int l, LAS unsigned char* lds, int c, int tix) {
    const int lane = tix & 63, wave = __builtin_amdgcn_readfirstlane(tix >> 6);
    __syncthreads();
    for (int item = tix; item < 4096; item += 512) {
        const int bt = item >> 10, j = (item & 1023) * 8;
        *(LAS v4u*)(lds + HY_U + (((j >> 8) * 4 + bt) * HY_US + (j & 255)) * 2) = *(const v4u*)(p.VXT + ((size_t)(bt * 256 + c)) * SEQ + j);
    }
    {
        const unsigned short* g1 = p.G1 + ((size_t)l * 256 + c) * G1N;
        for (int item = tix; item < G1N / 8; item += 512) *(LAS v4u*)(lds + HY_CP + item * 16) = *(const v4u*)(g1 + item * 8);
    }
    __syncthreads();
    f32x16 acc[4];
#pragma unroll
    for (int i = 0; i < 4; ++i)
#pragma unroll
        for (int k = 0; k < 16; ++k) acc[i][k] = 0.f;
    switch (wave) {
        case 0: hy_stream<0>(lds, lane, acc); break;
        case 1: hy_stream<1>(lds, lane, acc); break;
        case 2: hy_stream<2>(lds, lane, acc); break;
        case 3: hy_stream<3>(lds, lane, acc); break;
        case 4: hy_stream<4>(lds, lane, acc); break;
        case 5: hy_stream<5>(lds, lane, acc); break;
        case 6: hy_stream<6>(lds, lane, acc); break;
        default: hy_stream<7>(lds, lane, acc); break;
    }
    const int r = lane & 31, hf = lane >> 5;
    LAS float* ST = (LAS float*)(lds + HY_U);
#pragma unroll
    for (int half = 0; half < 2; ++half) {
        __syncthreads();
#pragma unroll
        for (int ii = 0; ii < 2; ++ii)
#pragma unroll
            for (int k = 0; k < 16; ++k)
                ST[(32 * ii + r) * 257 + 8 * ((k & 3) + 8 * (k >> 2) + 4 * hf) + wave] = acc[2 * half + ii][k];
        __syncthreads();
        for (int item = tix; item < 64 * 64; item += 512) {
            const int R = item >> 6, c4 = (item & 63) * 4;
            f32x4 v; v.x = ST[R * 257 + c4]; v.y = ST[R * 257 + c4 + 1]; v.z = ST[R * 257 + c4 + 2]; v.w = ST[R * 257 + c4 + 3];
            *(f32x4*)(p.CONV + ((size_t)((R & 3) * 256 + c)) * SEQ + 256 * (16 * half + (R >> 2)) + c4) = v;
        }
    }
}
__device__ __forceinline__ void hy_h3_unit(const Params& p, int l, LAS unsigned char* lds, int u, int tix) {
    const int b = u / (SEQ / 64), t0 = (u % (SEQ / 64)) * 64;
    LAS float* T = (LAS float*)lds;
    for (int item = tix; item < 4096; item += 512) {
        const int c = item >> 4, t4 = (item & 15) * 4;
        *(LAS f32x4*)(T + c * 68 + t4) = *(const f32x4*)(p.CONV + ((size_t)(b * 256 + c)) * SEQ + t0 + t4);
    }
    const int t = tix & 63, cg = __builtin_amdgcn_readfirstlane(tix >> 6);
    const int tok = t0 + t; const bool hp = tok > 0, hn = tok + 1 < SEQ;
    const act_t* rc = p.P + (size_t)(b * SEQ + tok) * LDP + OFF_HY + 32 * cg; const act_t* rp = hp ? rc - LDP : rc; const act_t* rn = hn ? rc + LDP : rc;
    const LAS float* HW = (const LAS float*)(lds + HY_HW) + 32 * cg;
    __syncthreads();
#pragma unroll 1
    for (int oh = 0; oh < 2; ++oh) {
        v4u raw[2][3][3];
#pragma unroll
        for (int oo = 0; oo < 2; ++oo)
#pragma unroll
            for (int gq = 0; gq < 3; ++gq) { const int col = 256 * gq + 8 * (2 * oh + oo); raw[oo][gq][0] = *(const v4u*)(rp + col); raw[oo][gq][1] = *(const v4u*)(rc + col); raw[oo][gq][2] = *(const v4u*)(rn + col); }
#pragma unroll
        for (int oo = 0; oo < 2; ++oo) {
            const int o = 2 * oh + oo, c0 = 32 * cg + 8 * o;
            float x0[8], x1[8], v[8];
            hy_conv8(raw[oo][0][0], raw[oo][0][1], raw[oo][0][2], hp, hn, HW + 8 * o, x0);
            hy_conv8(raw[oo][1][0], raw[oo][1][1], raw[oo][1][2], hp, hn, HW + 256 + 8 * o, x1);
            hy_conv8(raw[oo][2][0], raw[oo][2][1], raw[oo][2][2], hp, hn, HW + 512 + 8 * o, v);
            float y[8];
#pragma unroll
            for (int e = 0; e < 8; ++e) y[e] = (T[(c0 + e) * 68 + t] + v[e] * x1[e] * p.hy_bias[l * 256 + c0 + e]) * x0[e];
            v4u w; w.x = pk2(y[0], y[1]); w.y = pk2(y[2], y[3]); w.z = pk2(y[4], y[5]); w.w = pk2(y[6], y[7]);
            *(v4u*)(p.Y + (size_t)(b * SEQ + tok) * DM + 384 + c0) = w;
        }
    }
    __syncthreads();
}

__global__ void __launch_bounds__(512, 2) mega_fwd(Params p_arg) {
    extern __shared__ __attribute__((aligned(16))) unsigned char lds_raw[];
    LAS unsigned char* lds = (LAS unsigned char*)lds_raw;
    cg::grid_group grid = cg::this_grid();
    const long nth = (long)gridDim.x * 512;
    const int NGW = gridDim.x * 8, G = gridDim.x;
    const int wave_s = __builtin_amdgcn_readfirstlane((int)threadIdx.x >> 6);
#define MY_TIX() ([&]() { unsigned z_ = 0u; asm volatile("" : "+v"(z_)); return (wave_s << 6) | (int)__builtin_amdgcn_mbcnt_hi(~0u, __builtin_amdgcn_mbcnt_lo(~0u, z_)); }())
    constexpr int LDS_BARW = LDS_BYTES - 64;
    if (threadIdx.x < 2) ((LAS unsigned*)(lds + LDS_BARW))[threadIdx.x] = 0u;
    __syncthreads();
    { const __attribute__((address_space(4))) Params* kp0 = (const __attribute__((address_space(4))) Params*)__builtin_amdgcn_kernarg_segment_ptr();
      (void)xcd_barrier_post(kp0->BAR, (volatile LAS unsigned*)(lds + LDS_BARW)); }
#define GSYNC() do { const __attribute__((address_space(4))) Params* kpb_ = (const __attribute__((address_space(4))) Params*)__builtin_amdgcn_kernarg_segment_ptr(); \
    asm volatile("" : "+s"(kpb_)); XcdBarrier xb_; xb_.bar = kpb_->BAR; xb_.x = xb_xcc_id(); xb_.st = (volatile LAS unsigned*)(lds + LDS_BARW); xcd_barrier(xb_, MY_TIX() == 0); } while (0)
#define PH_IDS() int tix_ = MY_TIX(); asm volatile("" : "+v"(tix_)); const long tid = (long)blockIdx.x * 512 + tix_; const int lane = tix_ & 63; \
    const int wave = __builtin_amdgcn_readfirstlane(tix_ >> 6); const int gw = blockIdx.x * 8 + wave; (void)tid; (void)lane; (void)gw; \
    const __attribute__((address_space(4))) Params* kp_ = (const __attribute__((address_space(4))) Params*)__builtin_amdgcn_kernarg_segment_ptr(); \
    asm volatile("" : "+s"(kp_)); const Params& p = *(const Params*)kp_;

    for (int rep = 0; rep < REP_PRO; ++rep) {
    { PH_IDS(); mod_partial(p, tid, nth, (float*)p.DSS);
      prologue_weights(p, (LAS float*)(lds + wave * 16384), gw, NGW, lane);
      filt_all(p, lds, tid, nth, tix_, blockIdx.x, G); }
    grid.sync();
    { PH_IDS(); mod_reduce(p, tid, nth, (const float*)p.DSS); }
    GSYNC();
    }
#pragma unroll 1
    for (int l = 0; l < DEPTH; ++l) {
        const int nrows = (l == DEPTH - 1) ? BL : NT;
        for (int rep = 0; rep < REP_HX; ++rep) {
        { PH_IDS(); hx_pass<false>(p, l, 0, 0, (CTX_SPLITK && l > 0) ? BL : NT, gw, NGW, lane); }
        if (CTX_SPLITK && l > 0) { PH_IDS(); hx_pass<true>(p, l, 0, BL, NT, gw, NGW, lane, DFF / 256, (const float*)p.DSG, p.MOD + ((size_t)(l - 1) * (NB + 1) + NB) * 6 * DM + 5 * DM, false); }
        GSYNC();
        }
        for (int rep = 0; rep < REP_G1; ++rep)
        {   PH_IDS();
            pg8::Gemm g{p.Y, p.WIN_T + (size_t)l * LDP * DM, NT, LDP, DM, DM}; pg8::StaticOrder S; S.init(NT, LDP, G, (int)blockIdx.x);
            pg8::EpiBf16<0> E{p.P, LDP, nullptr, 0, 0, 1.f};
            pg8::gemm_phase<pg8::EpiBf16<0>, pg8::StaticOrder, true, true>(lds, g, S, E, tix_);
            GSYNC();
        }
        for (int rep = 0; rep < REP_MIX; ++rep) {
        for (int qa = 0; qa < REP_PA; ++qa)
        {   PH_IDS();
            for (int u = blockIdx.x; u < SSD_UNITS; u += G) ssd_s2_unit(p, l, lds, u, tix_, p.DSS, p.DECS);
            gla_m2_phase(p, l, lds, tix_, blockIdx.x, p.DSG, p.DECG);
            hy_stage_w(p, l, lds, tix_);
            for (int u = blockIdx.x; u < NB * (SEQ / 64); u += G) hy_h1_unit(p, l, lds, u, tix_);
            if (l < DEPTH - 1) st_hy_pre(p, l, tid, nth, BL, NT);
        }
        GSYNC();
        {   PH_IDS();
            for (int q = 0; q < REP_H2; ++q) for (int c = blockIdx.x; c < 256; c += G) hy_h2_channel(p, l, lds, c, tix_);
            {
                const long vt = ((long)wave * G + blockIdx.x) * 64 + lane;
                if (nth >= 131072) {
                    if (vt < 49152) ssd_s3(vt, 49152, p.DSS, p.DECS);
                    else if (vt < 49152 + 24576) { for (int q = 0; q < REP_M3; ++q) gla_m3(vt - 49152, 24576, p.DSG, p.DECG, p.SSG); }
                    else if (l < DEPTH - 1) hy_ctx_conv(p, l, vt - (49152 + 24576), nth - (49152 + 24576));
                } else { ssd_s3(vt, nth, p.DSS, p.DECS); gla_m3(vt, nth, p.DSG, p.DECG, p.SSG); if (l < DEPTH - 1) hy_ctx_conv(p, l, vt, nth); }
            }
        }
        GSYNC();
        for (int qc = 0; qc < REP_PC; ++qc)
        {   PH_IDS();
            for (int u = blockIdx.x; u < SSD_UNITS; u += G) ssd_s4_unit(p, l, lds, u, tix_, p.DSS);
            gla_m4_phase(p, l, lds, tix_, blockIdx.x, p.SSG);
            hy_stage_w(p, l, lds, tix_);
            for (int u = blockIdx.x; u < NB * (SEQ / 64); u += G) hy_h3_unit(p, l, lds, u, tix_);
        }
        GSYNC();
        }
        {   PH_IDS();
            const int mrows = (CTX_SPLITK || l == DEPTH - 1) ? BL : NT; pg8::Gemm g{p.Y, p.WOUT_T + (size_t)l * DM * DM, mrows, DM, DM, DM}; pg8::StaticOrder S; S.init(mrows, DM, G, (int)blockIdx.x);
            pg8::EpiRes E{p.XL, p.XC, p.MOD + (size_t)l * (NB + 1) * 6 * DM, 2, l == 0 ? p.x : p.XL, l == 0 ? p.ctx : p.XC};
            pg8::gemm_phase<pg8::EpiRes, pg8::StaticOrder, true, true>(lds, g, S, E, tix_);
        }
        if (CTX_SPLITK && l < DEPTH - 1) {   PH_IDS();
            {
                pg8::Gemm gc{p.Y + (size_t)BL * DM, p.WOUT_T + (size_t)l * DM * DM, BC, DM, 256, DM}; pg8::SplitKOrder SC; SC.init(BC, DM, DM / 256, 256, G, (int)blockIdx.x);
                pg8::EpiSlab EC{(float*)p.DSG, BC, 512};
                pg8::gemm_phase<pg8::EpiSlab, pg8::SplitKOrder, true, true>(lds, gc, SC, EC, tix_);
            }
        }
        GSYNC();
        for (int rep = 0; rep < REP_HX; ++rep) {
        { PH_IDS(); hx_pass<false>(p, l, 1, 0, CTX_SPLITK ? BL : nrows, gw, NGW, lane); }
        if (CTX_SPLITK && l < DEPTH - 1) { PH_IDS(); hx_pass<true>(p, l, 1, BL, NT, gw, NGW, lane, DM / 256, (const float*)p.DSG, p.MOD + ((size_t)l * (NB + 1) + NB) * 6 * DM + 2 * DM, l == 0); }
        GSYNC();
        }
        for (int rep = 0; rep < REP_G3; ++rep)
        {   PH_IDS();
            pg8::Gemm g{p.Y, p.W13_T + (size_t)l * NFF2 * DM, nrows, NFF2, DM, DM}; pg8::StaticOrder S; S.init(nrows, NFF2, G, (int)blockIdx.x);
            pg8::EpiSwiGLU E{p.P};
            pg8::gemm_phase<pg8::EpiSwiGLU, pg8::StaticOrder, true, true>(lds, g, S, E, tix_);
            GSYNC();
        }
        {   PH_IDS();
            const int mrows = (CTX_SPLITK || l == DEPTH - 1) ? BL : NT; pg8::Gemm g{p.P, p.W2_T + (size_t)l * DM * DFF, mrows, DM, DFF, DFF}; pg8::StaticOrder S; S.init(mrows, DM, G, (int)blockIdx.x);
            pg8::EpiRes E{p.XL, p.XC, p.MOD + (size_t)l * (NB + 1) * 6 * DM, 5, p.XL, p.XC};
            pg8::gemm_phase<pg8::EpiRes, pg8::StaticOrder, true, true>(lds, g, S, E, tix_);
        }
        if (CTX_SPLITK && l < DEPTH - 1) {   PH_IDS();
            {
                pg8::Gemm gc{p.P + (size_t)BL * DFF, p.W2_T + (size_t)l * DM * DFF, BC, DM, 256, DFF}; pg8::SplitKOrder SC; SC.init(BC, DM, DFF / 256, 256, G, (int)blockIdx.x);
                pg8::EpiSlab EC{(float*)p.DSG, BC, 512};
                pg8::gemm_phase<pg8::EpiSlab, pg8::SplitKOrder, true, true>(lds, gc, SC, EC, tix_);
            }
        }
        GSYNC();
    }
    { PH_IDS(); final_pass(p, gw, NGW, lane); }
}

extern "C" void kernel_launch(void* const* d_in, const int* in_sizes, int n_in, void* d_out, int out_size,
                              void* d_ws, size_t ws_size, hipStream_t stream) {
    static int grid_blocks = 0;
    if (!grid_blocks) {
        int dev = 0, cus = 0, per_cu = 0;
        (void)hipGetDevice(&dev);
        (void)hipDeviceGetAttribute(&cus, hipDeviceAttributeMultiprocessorCount, dev);
        (void)hipFuncSetAttribute((const void*)mega_fwd, hipFuncAttributeMaxDynamicSharedMemorySize, LDS_BYTES);
        (void)hipOccupancyMaxActiveBlocksPerMultiprocessor(&per_cu, mega_fwd, 512, LDS_BYTES);
        if (per_cu < 1) per_cu = 1;
        grid_blocks = cus;
    }
    Params p{};
    fill_inputs(p, d_in);
    carve(p, (char*)d_ws, (float*)d_out);
    (void)hipMemsetAsync(p.BAR, 0, 16384, stream);
    void* args[] = { &p };
    hipError_t e = hipLaunchCooperativeKernel((void*)mega_fwd, dim3(grid_blocks), dim3(512), args, LDS_BYTES, stream);
    if (e != hipSuccess) fprintf(stderr, "cooperative launch failed: %s (grid %d)\n", hipGetErrorString(e), grid_blocks);
}
#endif
```

```cpp
#ifndef CPU_EMU
#include <hip/hip_runtime.h>
#include <hip/hip_cooperative_groups.h>
#include <cstdio>
#else
#include <cmath>
#include <cstring>
#include <cstdio>
#include <cstdlib>
#define __device__
#define __global__
#define __forceinline__ inline
#define __host__
#endif
#include <stdint.h>
#include <stddef.h>

#ifndef NB
#define NB 4
#endif
#ifndef SEQ
#define SEQ 8192
#endif
#ifndef CTX
#define CTX 256
#endif
#define DEPTH 2
#define DM 1024
#define GRID_W 64
#define ROWS_G (SEQ / GRID_W)
#define BL (NB * SEQ)
#define BC (NB * CTX)
#define NT (BL + BC)
#define NSEQ (2 * NB)
#define DIN 3244
#define LDP 3328
#define NFF2 (2 * DFF)
#define OFF_Q 0
#define OFF_K 192
#define OFF_V 384
#define OFF_G 768
#define OFF_GKF 1152
#define OFF_GKB 1168
#define OFF_HY 1184
#define OFF_Z 1952
#define OFF_XBC 2336
#define OFF_DTF 3232
#define OFF_DTB 3238
#define DFF 2816
#define TF (SEQ + CTX)
#define G1N 8720
#define EPSV 1e-6f

#ifdef ACT_FP32
typedef float act_t;
__device__ __forceinline__ float ldact(const act_t* p) { return *p; }
__device__ __forceinline__ void stact(act_t* p, float v) { *p = v; }
#else
typedef unsigned short act_t;
__device__ __forceinline__ float ldact(const act_t* p) {
    union { unsigned u; float f; } x; x.u = ((unsigned)*p) << 16; return x.f;
}
__device__ __forceinline__ void stact(act_t* p, float v) {
    union { float f; unsigned u; } x; x.f = v;
    unsigned r = x.u + 0x7FFFu + ((x.u >> 16) & 1u);
    *p = (unsigned short)(r >> 16);
}
#endif

struct Params {
    const float *x, *c, *ctx, *c_ctx, *mod_w, *mod_b, *norm1_g, *norm2_g, *w_in;
    const float *gk_w_f, *gk_b_f, *gk_w_b, *gk_b_b, *gla_norm_w;
    const float *hy_short_w, *hy_short_b, *hy_w1, *hy_b1, *hy_w2, *hy_b2, *hy_w3, *hy_freq, *hy_decay, *hy_bias;
    const float *ssd_conv_w, *ssd_conv_b, *ssd_dt_bias_f, *ssd_dt_bias_b, *ssd_a_log_f, *ssd_a_log_b, *ssd_d, *ssd_norm_w;
    const float *w_out, *ffn_w1, *ffn_w3, *ffn_w2, *final_g;
    float* XL;
    float* XC;
    float* MOD;
    float* HF;
    float* H1;
    float* H2;
    float* RSTD;
    act_t* P;
    act_t* Y;
    float* LG;
    float* O;
    act_t* XBC;
    float* YS;
    float* DT;
    float* VX;
    unsigned* BAR;
    unsigned short* G1;
    unsigned short* VXT;
    float* CONV;
    float* HFC;
    unsigned short *DSG, *SSG, *DSS;
    float *DECG, *DECS;
    unsigned short *WIN_T, *WOUT_T, *W13_T, *W2_T;
};

__device__ __forceinline__ float siluf(float x) { return x / (1.0f + expf(-x)); }
__device__ __forceinline__ float softplusf(float x) { return fmaxf(x, 0.0f) + log1pf(expf(-fabsf(x))); }
__device__ __forceinline__ float logsigmoidf(float x) { return -softplusf(-x); }

__device__ __forceinline__ float* xrow(const Params& p, int r) {
    return r < BL ? p.XL + (size_t)r * DM : p.XC + (size_t)(r - BL) * DM;
}
__device__ __forceinline__ int row_bb(int r) { return r < BL ? r / SEQ : NB; }
__device__ __forceinline__ int seq_len(int s) { return s < NB ? SEQ : CTX; }
__device__ __forceinline__ int seq_row0(int s) { return s < NB ? s * SEQ : BL + (s - NB) * CTX; }
__device__ __forceinline__ int colmajor_tok(int s, int pos) {
    return s < NB ? (pos % ROWS_G) * GRID_W + pos / ROWS_G : pos;
}

__device__ void st_init(const Params& p, long tid, long nth) {
    for (long i = tid; i < (long)BL * DM; i += nth) p.XL[i] = p.x[i];
    for (long i = tid; i < (long)BC * DM; i += nth) p.XC[i] = p.ctx[i];
}
__device__ void st_mod(const Params& p, long tid, long nth) {
    const long total = (long)DEPTH * (NB + 1) * 6 * DM;
    for (long i = tid; i < total; i += nth) {
        int n = (int)(i % (6 * DM));
        int bb = (int)((i / (6 * DM)) % (NB + 1));
        int l = (int)(i / ((long)6 * DM * (NB + 1)));
        const float* cv = bb < NB ? p.c + (size_t)bb * DM : p.c_ctx;
        const float* w = p.mod_w + (size_t)l * DM * 6 * DM + n;
        float acc = 0.f;
        for (int k = 0; k < DM; ++k) acc += siluf(cv[k]) * w[(size_t)k * 6 * DM];
        p.MOD[i] = acc + p.mod_b[(size_t)l * 6 * DM + n];
    }
}
__device__ __forceinline__ void filt_pos(int tt, float& rel) {
    int L = tt < SEQ ? SEQ : CTX; int t = tt < SEQ ? tt : tt - SEQ;
    rel = ((float)t - (float)(L / 2)) / (float)L;
}
__device__ void st_filt1(const Params& p, long tid, long nth) {
    const long total = (long)DEPTH * TF * 64;
    for (long i = tid; i < total; i += nth) {
        int o = (int)(i % 64); int tt = (int)((i / 64) % TF); int l = (int)(i / (64L * TF));
        float rel; filt_pos(tt, rel);
        const float* w1 = p.hy_w1 + (size_t)l * 33 * 64 + o;
        float acc = rel * w1[0];
        const float tw = 2.0f * 3.14159265358979323846f * rel;
        for (int j = 0; j < 16; ++j) {
            float band = 1e-4f + (float)j * ((15.0f - 1e-4f) / 15.0f);
            float ang = tw * band;
            acc += cosf(ang) * w1[(size_t)(1 + j) * 64];
            acc += -sinf(ang) * w1[(size_t)(17 + j) * 64];
        }
        p.H1[i] = sinf(p.hy_freq[l * 64 + o] * (acc + p.hy_b1[l * 64 + o]));
    }
}
__device__ void st_filt2(const Params& p, long tid, long nth) {
    const long total = (long)DEPTH * TF * 64;
    for (long i = tid; i < total; i += nth) {
        int o = (int)(i % 64); int l = (int)(i / (64L * TF));
        const float* h1 = p.H1 + (i - o);
        const float* w2 = p.hy_w2 + (size_t)l * 64 * 64 + o;
        float acc = 0.f;
        for (int j = 0; j < 64; ++j) acc += h1[j] * w2[(size_t)j * 64];
        p.H2[i] = sinf(p.hy_freq[l * 64 + o] * (acc + p.hy_b2[l * 64 + o]));
    }
}
__device__ void st_filt3(const Params& p, long tid, long nth) {
    const long total = (long)DEPTH * TF * 256;
    for (long i = tid; i < total; i += nth) {
        int c = (int)(i % 256); int tt = (int)((i / 256) % TF); int l = (int)(i / (256L * TF));
        float rel; filt_pos(tt, rel);
        const float* h2 = p.H2 + ((size_t)l * TF + tt) * 64;
        const float* w3 = p.hy_w3 + (size_t)l * 64 * 256 + c;
        float acc = 0.f;
        for (int j = 0; j < 64; ++j) acc += h2[j] * w3[(size_t)j * 256];
        const float hv = acc * expf(-2.0f * fabsf(rel) * p.hy_decay[l * 256 + c]);
        p.HF[i] = hv;
#ifndef CPU_EMU
        if (tt < SEQ) { unsigned short* q = p.G1 + ((size_t)l * 256 + c) * G1N + (8456 - tt); stact(q, hv); }
#endif
    }
#ifndef CPU_EMU
    constexpr int NPAD = 265 + (G1N - 8457);
    for (long i = tid; i < (long)DEPTH * 256 * NPAD; i += nth) {
        const int k = (int)(i % NPAD); const long lc = i / NPAD;
        p.G1[lc * G1N + (k < 265 ? k : 8457 + (k - 265))] = 0;
    }
#endif
}
__device__ void st_rstd(const Params& p, long tid, long nth) {
    for (long r = tid; r < NT; r += nth) {
        const float* xr = xrow(p, (int)r);
        float ss = 0.f;
        for (int k = 0; k < DM; ++k) ss += xr[k] * xr[k];
        p.RSTD[r] = 1.0f / sqrtf(ss / (float)DM + EPSV);
    }
}
__device__ void st_hx(const Params& p, int l, int which, long tid, long nth) {
    const float* g = (which ? p.norm2_g : p.norm1_g) + (size_t)l * DM;
    for (long i = tid; i < (long)NT * DM; i += nth) {
        int k = (int)(i % DM); int r = (int)(i / DM);
        const float* m = p.MOD + ((size_t)l * (NB + 1) + row_bb(r)) * 6 * DM;
        float sh = m[(which ? 3 : 0) * DM + k], sc = m[(which ? 4 : 1) * DM + k];
        float v = xrow(p, r)[k] * p.RSTD[r] * g[k];
        stact(p.Y + i, v * (1.0f + sc) + sh);
    }
}
template <int MODE>
__device__ void st_gemm(const Params& p, int l, int nrows, long tid, long nth) {
    const int N = MODE == 0 ? DIN : (MODE == 2 ? DFF : DM);
    const int K = MODE == 3 ? DFF : DM;
    const act_t* A = MODE == 3 ? p.P : p.Y;
    const int lda = MODE == 3 ? DFF : DM;
    const float* W = MODE == 0 ? p.w_in + (size_t)l * DM * DIN
                   : MODE == 1 ? p.w_out + (size_t)l * DM * DM
                   : MODE == 2 ? p.ffn_w1 + (size_t)l * DM * DFF
                               : p.ffn_w2 + (size_t)l * DFF * DM;
    const float* W3 = p.ffn_w3 + (size_t)l * DM * DFF;
    const int NQ = N / 4;
    const long total = (long)(nrows / 8) * NQ;
    for (long i = tid; i < total; i += nth) {
        const int cq = (int)(i % NQ); const int r0 = (int)(i / NQ) * 8; const int n0 = cq * 4;
        float acc[8][4]; float acc3[8][4];
#pragma unroll
        for (int a = 0; a < 8; ++a)
#pragma unroll
            for (int b = 0; b < 4; ++b) { acc[a][b] = 0.f; acc3[a][b] = 0.f; }
        for (int k = 0; k < K; ++k) {
            const float* wr = W + (size_t)k * N + n0;
            float w0 = wr[0], w1 = wr[1], w2 = wr[2], w3 = wr[3];
            float v0 = 0, v1 = 0, v2 = 0, v3 = 0;
            if (MODE == 2) { const float* w3r = W3 + (size_t)k * N + n0; v0 = w3r[0]; v1 = w3r[1]; v2 = w3r[2]; v3 = w3r[3]; }
#pragma unroll
            for (int a = 0; a < 8; ++a) {
                float av = ldact(A + (size_t)(r0 + a) * lda + k);
                acc[a][0] += av * w0; acc[a][1] += av * w1; acc[a][2] += av * w2; acc[a][3] += av * w3;
                if (MODE == 2) { acc3[a][0] += av * v0; acc3[a][1] += av * v1; acc3[a][2] += av * v2; acc3[a][3] += av * v3; }
            }
        }
        const int bb = row_bb(r0);
        const float* m = p.MOD + ((size_t)l * (NB + 1) + bb) * 6 * DM;
#pragma unroll
        for (int a = 0; a < 8; ++a) {
            const int r = r0 + a;
#pragma unroll
            for (int b = 0; b < 4; ++b) {
                const int n = n0 + b;
                if (MODE == 0) stact(p.P + (size_t)r * LDP + n, acc[a][b]);
                else if (MODE == 1) xrow(p, r)[n] += m[2 * DM + n] * acc[a][b];
                else if (MODE == 2) stact(p.P + (size_t)r * DFF + n, siluf(acc[a][b]) * acc3[a][b]);
                else xrow(p, r)[n] += m[5 * DM + n] * acc[a][b];
            }
        }
    }
}
__device__ void st_gla_logs(const Params& p, int l, long tid, long nth) {
    const long total = 2L * NT * 192;
    for (long i = tid; i < total; i += nth) {
        int col = (int)(i % 192); int r = (int)((i / 192) % NT); int dir = (int)(i / (192L * NT));
        const act_t* gk = p.P + (size_t)r * LDP + (dir ? OFF_GKB : OFF_GKF);
        const float* w = (dir ? p.gk_w_b : p.gk_w_f) + (size_t)l * 16 * 192 + col;
        float acc = (dir ? p.gk_b_b : p.gk_b_f)[l * 192 + col];
        for (int j = 0; j < 16; ++j) acc += ldact(gk + j) * w[j * 192];
        p.LG[i] = logsigmoidf(acc) * (1.0f / 16.0f);
    }
}
__device__ void st_gla_scan(const Params& p, long tid, long nth) {
    const long total = (long)NB * 6 * 64;
    for (long i = tid; i < total; i += nth) {
        const int e = (int)(i % 64); const int h = (int)((i / 64) % 6); const int b = (int)(i / 384);
        for (int dir = 0; dir < 2; ++dir) {
            float S[32];
#pragma unroll
            for (int d = 0; d < 32; ++d) S[d] = 0.f;
            const float* lg = p.LG + (size_t)dir * NT * 192;
            for (int part = 0; part < 2; ++part) {
                const int s = part == 0 ? NB + b : b;
                const int L = seq_len(s), r0 = seq_row0(s);
                for (int st = 0; st < L; ++st) {
                    const int t = dir == 0 ? st : L - 1 - st;
                    const int r = r0 + t;
                    const act_t* pr = p.P + (size_t)r * LDP;
                    const float* lr = lg + (size_t)r * 192 + h * 32;
                    const float v = ldact(pr + OFF_V + h * 64 + e);
                    float o = 0.f;
#pragma unroll
                    for (int d = 0; d < 32; ++d) {
                        S[d] = expf(lr[d]) * S[d] + ldact(pr + OFF_K + h * 32 + d) * v;
                        o += ldact(pr + OFF_Q + h * 32 + d) * S[d];
                    }
                    o *= 0.17677669529663687f;
                    float* op = p.O + (size_t)r * 384 + h * 64 + e;
                    if (dir == 0) *op = o; else *op += o;
                }
            }
        }
    }
}
__device__ void st_gla_out(const Params& p, int l, long tid, long nth) {
    const long total = (long)NT * 6;
    for (long i = tid; i < total; i += nth) {
        const int h = (int)(i % 6); const int r = (int)(i / 6);
        const float* o = p.O + (size_t)r * 384 + h * 64;
        float ss = 0.f;
        for (int e = 0; e < 64; ++e) ss += o[e] * o[e];
        const float rs = 1.0f / sqrtf(ss / 64.0f + EPSV);
        for (int e = 0; e < 64; ++e) {
            float g = ldact(p.P + (size_t)r * LDP + OFF_G + h * 64 + e);
            stact(p.Y + (size_t)r * DM + h * 64 + e, o[e] * rs * p.gla_norm_w[l * 64 + e] * siluf(g));
        }
    }
}
__device__ __forceinline__ float hy_u(const Params& p, int l, int s, int t, int j) {
    const int L = seq_len(s), r0 = seq_row0(s);
    const float* w = p.hy_short_w + (size_t)l * 3 * 768 + j;
    float acc = p.hy_short_b[l * 768 + j];
#pragma unroll
    for (int k = 0; k < 3; ++k) {
        const int tt = t + k - 1; const bool ok = tt >= 0 && tt < L;
        const float xv = ldact(p.P + (size_t)(r0 + (ok ? tt : t)) * LDP + OFF_HY + j);
        acc += w[k * 768] * (ok ? xv : 0.f);
    }
    return acc;
}
__device__ void st_hy_pre(const Params& p, int l, long tid, long nth, int r_lo = 0, int r_hi = NT) {
    const long total = (long)(r_hi - r_lo) * 256;
    for (long i = tid; i < total; i += nth) {
        const int c = (int)(i % 256); const int r = r_lo + (int)(i / 256);
        const int s = r < BL ? r / SEQ : NB + (r - BL) / CTX;
        const int t = r - seq_row0(s);
        p.VX[(size_t)r * 256 + c] = hy_u(p, l, s, t, 512 + c) * hy_u(p, l, s, t, 256 + c);
    }
}
__device__ void st_hy_conv(const Params& p, int l, long tid, long nth, int r_lo = 0, int r_hi = NT) {
    const long total = (long)(r_hi - r_lo) * 256;
    for (long i = tid; i < total; i += nth) {
        const int c = (int)(i % 256); const int r = r_lo + (int)(i / 256);
        const int s = r < BL ? r / SEQ : NB + (r - BL) / CTX;
        const int L = seq_len(s), r0 = seq_row0(s);
        const int t = r - r0;
        const float* hf = p.HF + ((size_t)l * TF + (s < NB ? 0 : SEQ)) * 256 + c;
        int jlo = t + L / 2 - (L - 1); if (jlo < 0) jlo = 0;
        int jhi = t + L / 2; if (jhi > L - 1) jhi = L - 1;
        float acc = 0.f;
        for (int j = jlo; j <= jhi; ++j)
            acc += hf[(size_t)(t - j + L / 2) * 256] * p.VX[(size_t)(r0 + j) * 256 + c];
        const float x0 = hy_u(p, l, s, t, c);
        const float y = (acc + p.VX[(size_t)r * 256 + c] * p.hy_bias[l * 256 + c]) * x0;
        stact(p.Y + (size_t)r * DM + 384 + c, y);
    }
}
__device__ void st_ssd_pre(const Params& p, int l, long tid, long nth) {
    const long total = (long)NT * 896;
    for (long i = tid; i < total; i += nth) {
        const int j = (int)(i % 896); const int q = (int)(i / 896);
        const int s = q < BL ? q / SEQ : NB + (q - BL) / CTX;
        const int L = seq_len(s), r0 = seq_row0(s);
        const int pos = q - r0;
        const float* w = p.ssd_conv_w + (size_t)l * 3 * 896 + j;
        float acc = p.ssd_conv_b[l * 896 + j];
#pragma unroll
        for (int k = 0; k < 3; ++k) {
            int pp = pos + k - 1;
            if (pp >= 0 && pp < L) acc += w[k * 896] * ldact(p.P + (size_t)(r0 + colmajor_tok(s, pp)) * LDP + OFF_XBC + j);
        }
        stact(p.XBC + (size_t)(r0 + colmajor_tok(s, pos)) * 896 + j, siluf(acc));
    }
    const long total2 = 2L * NT * 6;
    for (long i = tid; i < total2; i += nth) {
        const int hd = (int)(i % 6); const int r = (int)((i / 6) % NT); const int dir = (int)(i / (6L * NT));
        float v = ldact(p.P + (size_t)r * LDP + (dir ? OFF_DTB : OFF_DTF) + hd) + (dir ? p.ssd_dt_bias_b : p.ssd_dt_bias_f)[l * 6 + hd];
        p.DT[i] = softplusf(v);
    }
}
__device__ void st_ssd_scan(const Params& p, int l, long tid, long nth) {
    const long total = (long)NB * 6 * 64;
    for (long i = tid; i < total; i += nth) {
        const int pp = (int)(i % 64); const int hd = (int)((i / 64) % 6); const int b = (int)(i / 384);
        const int g = hd / 3;
        const float dcoef = p.ssd_d[l * 6 + hd];
        for (int dir = 0; dir < 2; ++dir) {
            const float A = -expf((dir ? p.ssd_a_log_b : p.ssd_a_log_f)[l * 6 + hd]);
            float h[128];
#pragma unroll
            for (int n = 0; n < 128; ++n) h[n] = 0.f;
            for (int part = 0; part < 2; ++part) {
                const int s = part == 0 ? NB + b : b;
                const int L = seq_len(s), r0 = seq_row0(s);
                for (int st = 0; st < L; ++st) {
                    const int pos = dir == 0 ? st : L - 1 - st;
                    const int r = r0 + colmajor_tok(s, pos);
                    const act_t* xr = p.XBC + (size_t)r * 896;
                    const float dt = p.DT[((size_t)dir * NT + r) * 6 + hd];
                    const float xs = ldact(xr + hd * 64 + pp);
                    const float ea = expf(A * dt);
                    const float xd = xs * dt;
                    float y = 0.f;
#pragma unroll
                    for (int n = 0; n < 128; ++n) {
                        h[n] = ea * h[n] + xd * ldact(xr + 384 + g * 128 + n);
                        y += h[n] * ldact(xr + 640 + g * 128 + n);
                    }
                    float* yp = p.YS + (size_t)r * 384 + hd * 64 + pp;
                    if (dir == 0) *yp = y + dcoef * xs; else *yp += y;
                }
            }
        }
    }
}
__device__ void st_ssd_out(const Params& p, int l, long tid, long nth) {
    const long total = (long)NT * 2;
    for (long i = tid; i < total; i += nth) {
        const int g = (int)(i % 2); const int r = (int)(i / 2);
        const float* ys = p.YS + (size_t)r * 384 + g * 192;
        const act_t* z = p.P + (size_t)r * LDP + OFF_Z + g * 192;
        float ss = 0.f;
        for (int j = 0; j < 192; ++j) { float v = ys[j] * siluf(ldact(z + j)); ss += v * v; }
        const float rs = 1.0f / sqrtf(ss / 192.0f + EPSV);
        for (int j = 0; j < 192; ++j) {
            float v = ys[j] * siluf(ldact(z + j));
            stact(p.Y + (size_t)r * DM + 640 + g * 192 + j, v * rs * p.ssd_norm_w[l * 384 + g * 192 + j]);
        }
    }
}
__device__ void st_final(const Params& p, long tid, long nth) {
    for (long i = tid; i < (long)BL * DM; i += nth) {
        int k = (int)(i % DM); int r = (int)(i / DM);
        p.XL[i] = p.XL[i] * p.RSTD[r] * p.final_g[k];
    }
}

enum { S_INIT, S_MOD, S_F1, S_F2, S_F3, S_RSTD, S_HX1, S_GIN, S_GLOG, S_GSCAN, S_GOUT,
       S_SPRE, S_SSCAN, S_SOUT, S_HPRE, S_HCONV, S_GOUTP, S_HX2, S_FFN1, S_FFN2, S_FINAL };

__device__ void run_stage(const Params& p, int stage, int l, long tid, long nth) {
    const int nrows = (l == DEPTH - 1) ? BL : NT;
    switch (stage) {
        case S_INIT: st_init(p, tid, nth); break;
        case S_MOD: st_mod(p, tid, nth); break;
        case S_F1: st_filt1(p, tid, nth); break;
        case S_F2: st_filt2(p, tid, nth); break;
        case S_F3: st_filt3(p, tid, nth); break;
        case S_RSTD: st_rstd(p, tid, nth); break;
        case S_HX1: st_hx(p, l, 0, tid, nth); break;
        case S_GIN: st_gemm<0>(p, l, NT, tid, nth); break;
        case S_GLOG: st_gla_logs(p, l, tid, nth); break;
        case S_GSCAN: st_gla_scan(p, tid, nth); break;
        case S_GOUT: st_gla_out(p, l, tid, nth); break;
        case S_SPRE: st_ssd_pre(p, l, tid, nth); break;
        case S_SSCAN: st_ssd_scan(p, l, tid, nth); break;
        case S_SOUT: st_ssd_out(p, l, tid, nth); break;
        case S_HPRE: st_hy_pre(p, l, tid, nth); break;
        case S_HCONV: st_hy_conv(p, l, tid, nth); break;
        case S_GOUTP: st_gemm<1>(p, l, nrows, tid, nth); break;
        case S_HX2: st_hx(p, l, 1, tid, nth); break;
        case S_FFN1: st_gemm<2>(p, l, nrows, tid, nth); break;
        case S_FFN2: st_gemm<3>(p, l, nrows, tid, nth); break;
        case S_FINAL: st_final(p, tid, nth); break;
    }
}

static const int kLayerProg[] = { S_RSTD, S_HX1, S_GIN, S_GLOG, S_GSCAN, S_GOUT, S_SPRE, S_SSCAN, S_SOUT,
                                  S_HPRE, S_HCONV, S_GOUTP, S_RSTD, S_HX2, S_FFN1, S_FFN2 };
static const int kPreProg[] = { S_INIT, S_MOD, S_F1, S_F2, S_F3 };

static inline size_t al256(size_t v) { return (v + 255) & ~(size_t)255; }
static void carve(Params& p, char* ws, float* dout) {
    size_t off = 0;
    auto take = [&](size_t bytes) { char* q = ws + off; off += al256(bytes); return q; };
    p.XL = dout;
    p.XC = (float*)take((size_t)BC * DM * 4);
    p.MOD = (float*)take((size_t)DEPTH * (NB + 1) * 6 * DM * 4);
#ifdef CPU_EMU
    p.HF = (float*)take((size_t)DEPTH * TF * 256 * 4);
    p.RSTD = (float*)take((size_t)NT * 4);
    p.DT = (float*)take((size_t)2 * NT * 6 * 4);
#endif
    p.H1 = (float*)take((size_t)DEPTH * TF * 64 * 4);
    p.H2 = (float*)take((size_t)DEPTH * TF * 64 * 4);
    p.P = (act_t*)take((size_t)NT * LDP * sizeof(act_t));
    p.Y = (act_t*)take((size_t)NT * DM * sizeof(act_t));
#ifdef CPU_EMU
    char* r1 = take((size_t)NT * 896 * sizeof(act_t) + (size_t)NT * 384 * 4 + 256);
#else
    char* r1 = take((size_t)101 << 20);
#endif
    p.LG = (float*)r1;
    p.O = (float*)(r1 + al256((size_t)2 * NT * 192 * 4));
    p.XBC = (act_t*)r1;
    p.YS = (float*)(r1 + al256((size_t)NT * 896 * sizeof(act_t)));
#ifdef CPU_EMU
    p.VX = (float*)r1;
#else
    {
        char* q = r1;
        p.DSG = (unsigned short*)q; q += al256((size_t)2 * NB * 6 * ((CTX + SEQ) / 64) * 2048 * 2);
        p.SSG = (unsigned short*)q; q += al256((size_t)2 * NB * 6 * ((CTX + SEQ) / 64) * 2048 * 2);
        p.DECG = (float*)q; q += al256((size_t)2 * NB * 6 * ((CTX + SEQ) / 64) * 32 * 4);
        p.DSS = (unsigned short*)q; q += al256((size_t)2 * NB * 6 * ((CTX + SEQ) / 128) * 8192 * 2);
        p.DECS = (float*)q; q += al256((size_t)2 * NB * 6 * ((CTX + SEQ) / 128) * 4);
    }
    p.VXT = (unsigned short*)take((size_t)NB * 256 * SEQ * 2);
    p.CONV = (float*)take((size_t)NB * 256 * SEQ * 4);
    p.VX = (float*)take((size_t)BC * 256 * 4) - (size_t)BL * 256;
    p.HFC = (float*)take((size_t)DEPTH * CTX * 256 * 4);
#endif
    p.G1 = (unsigned short*)take((size_t)DEPTH * 256 * G1N * 2);
    p.BAR = (unsigned*)take(16384);
    p.WIN_T = (unsigned short*)take((size_t)DEPTH * LDP * DM * 2);
    p.WOUT_T = (unsigned short*)take((size_t)DEPTH * DM * DM * 2);
    p.W13_T = (unsigned short*)take((size_t)DEPTH * NFF2 * DM * 2);
    p.W2_T = (unsigned short*)take((size_t)DEPTH * DM * DFF * 2);
}
static void fill_inputs(Params& p, void* const* d_in) {
    const float** dst = (const float**)&p;
    for (int i = 0; i < 37; ++i) dst[i] = (const float*)d_in[i];
}

#ifndef CPU_EMU
namespace pg8 {
#define PG8_LAS __attribute__((address_space(3)))
typedef unsigned short bf16_t;
typedef short bf16x8 __attribute__((ext_vector_type(8)));
typedef float f32x4 __attribute__((ext_vector_type(4)));
typedef unsigned u32x4 __attribute__((ext_vector_type(4)));
constexpr int BM = 256, BK = 64, HALF = 128, HTB = HALF * BK * 2  , STAGE_BYTES = 8 * HTB, NXCD = 8, WGM = 8;

__host__ __device__ __forceinline__ int lds_byte(int r, int c) { const int st = (r >> 4) * 2 + (c >> 5), rr = r & 15, cc = c & 31, ob = rr * 64 + cc * 2; return st * 1024 + (ob ^ (((ob >> 9) & 1) << 5)); }
__host__ __device__ __forceinline__ void stage_rc(int b, int& R, int& C) { const int st = b / 1024, sb = b % 1024, swz = sb ^ (((sb >> 9) & 1) << 5); R = (st >> 1) * 16 + swz / 64; C = (st & 1) * 32 + (swz % 64) / 2; }
__host__ __device__ __forceinline__ int perm32(int rho) { const int n = rho >> 4, i = rho & 15; return 8 * (i >> 2) + 4 * n + (i & 3); }

struct Unit { int pm, pn, kb; };
struct Gemm { const bf16_t* A; const bf16_t* Bt; int M, N, K, ld; };

struct StaticOrder {
    int nM, nN, nwg, G, c;
    __host__ __device__ void init(int M, int N, int G_, int c_) { nM = M / BM; nN = N / BM; nwg = nM * nN; G = G_; c = c_; }
    __host__ __device__ bool next(int i, Unit& u) const {
        const long L = (long)i * G + c; if (L >= nwg) return false;
        int wgid = (int)L; { const int q = nwg / NXCD, r = nwg % NXCD, xcd = wgid % NXCD, off = wgid / NXCD; wgid = (xcd < r ? xcd * (q + 1) : r * (q + 1) + (xcd - r) * q) + off; }
        const int nig = WGM * nN, gid = wgid / nig, fm = gid * WGM, gsz = (nM - fm) < WGM ? (nM - fm) : WGM;
        u.pm = fm + ((wgid % nig) % gsz); u.pn = (wgid % nig) / gsz; u.kb = 0; return true;
    }
    __device__ __forceinline__ void a_ready(const Unit&) const {}
    __device__ __forceinline__ void done(const Unit&) const {}
};

__device__ __forceinline__ unsigned cvt_pk_bf16(float lo, float hi) { unsigned r; asm volatile("v_cvt_pk_bf16_f32 %0, %1, %2" : "=v"(r) : "v"(lo), "v"(hi)); return r; }
typedef float f32x2 __attribute__((ext_vector_type(2)));
__device__ __forceinline__ f32x2 gelu_pk(f32x2 v) {
    const f32x2 av = __builtin_elementwise_abs(v), d = av * 0.2316418882f + 1.0f;
    f32x2 t; t.x = __builtin_amdgcn_rcpf(d.x); t.y = __builtin_amdgcn_rcpf(d.y);
    f32x2 q = t * 0.5307027145f + (-0.7265760135f); q = q * t + 0.7107068705f; q = q * t + (-0.142248368f); q = q * t + 0.127414796f; q = q * t;
    const f32x2 s = (v * v) * (-0.72134752044f);
    f32x2 e; e.x = __builtin_amdgcn_exp2f(s.x); e.y = __builtin_amdgcn_exp2f(s.y);
    const f32x2 m = v * (q * e), r = v - m;
    f32x2 o; o.x = v.x < 0.f ? m.x : r.x; o.y = v.y < 0.f ? m.y : r.y; return o;
}

template <int ACT  > struct EpiBf16 {
    static constexpr bool PERM = true, AFTER_DRAIN = false; static_assert(ACT == 0 || ACT == 1, "EpiBf16: ACT is 0 (none) or 1 (gelu_pk)");
    bf16_t* O; int ldc; const float* bias; int split_cols; size_t split_stride; float scale0;
    __device__ __forceinline__ void operator()(const f32x4 (&acc)[2][2][4][2], const Unit& u, int wr, int wc, int fr, int fq) const {
        const int row0 = u.pm * BM + wr * 64 + fr; int colt = u.pn * BM; bf16_t* base = O;
        float sc = 1.f; if (split_cols) { const int t = colt / split_cols; base += (size_t)t * split_stride; colt -= t * split_cols; if (t == 0) sc = scale0; }
        const int col0 = colt + wc * 32 + 8 * fq, bcol0 = u.pn * BM + wc * 32 + 8 * fq;
        f32x4 bv[2][2];
#pragma unroll
        for (int bj = 0; bj < 2; ++bj)
#pragma unroll
            for (int n = 0; n < 2; ++n) bv[bj][n] = bias ? *(const f32x4*)(bias + bcol0 + bj * HALF + 4 * n) : (f32x4){0.f, 0.f, 0.f, 0.f};
#pragma unroll
        for (int ai = 0; ai < 2; ++ai)
#pragma unroll
            for (int m = 0; m < 4; ++m) { bf16_t* rowp = base + (size_t)(row0 + ai * HALF + m * 16) * ldc + col0;
#pragma unroll
                for (int bj = 0; bj < 2; ++bj) { f32x4 v0 = acc[ai][bj][m][0] + bv[bj][0], v1 = acc[ai][bj][m][1] + bv[bj][1];
                    if (ACT == 1) { f32x2 a = gelu_pk((f32x2){v0[0], v0[1]}), b = gelu_pk((f32x2){v0[2], v0[3]}), c = gelu_pk((f32x2){v1[0], v1[1]}), d = gelu_pk((f32x2){v1[2], v1[3]});
                        v0 = (f32x4){a.x, a.y, b.x, b.y}; v1 = (f32x4){c.x, c.y, d.x, d.y}; }
                    v0 = v0 * sc; v1 = v1 * sc; u32x4 w; w.x = cvt_pk_bf16(v0[0], v0[1]); w.y = cvt_pk_bf16(v0[2], v0[3]); w.z = cvt_pk_bf16(v1[0], v1[1]); w.w = cvt_pk_bf16(v1[2], v1[3]);
                    *(u32x4*)(rowp + bj * HALF) = w; } }
    }
};
template <class Epi, class Sched, bool ALIGN_EPI = false, bool SP2 = false>
__device__ __forceinline__ void gemm_phase(PG8_LAS unsigned char* lds, const Gemm g, const Sched& S, const Epi& E, int tid_o) {
    asm volatile("" : "+v"(tid_o));
    const int tid = tid_o, wid = __builtin_amdgcn_readfirstlane(tid >> 6), lane = tid & 63, wr = wid >> 2, wc = wid & 3, fr = lane & 15, fq = lane >> 4;
    const int K = g.ld, nt = g.K / BK;
    unsigned voffA[2], voffB[2];
#pragma unroll
    for (int i = 0; i < 2; ++i) { int R, C; stage_rc(tid * 16 + i * 8192, R, C); const int Rb = Epi::PERM ? ((R & ~31) + perm32(R & 31)) : R;
        voffA[i] = (unsigned)(R * K + C) * 2u; voffB[i] = (unsigned)(Rb * K + C) * 2u; }
    const size_t kstep = (size_t)(BK * 2);
    const size_t hstep = (size_t)HALF * K * 2;
    const size_t tstep = 2 * hstep;
    const unsigned ldsw = (unsigned)wid * 1024u;
    const int aoff = lds_byte(wr * 64 + fr, fq * 8), boff = lds_byte(wc * 32 + fr, fq * 8);
#define PG8_SA(b, h) (((b) * 2 + (h)) * HTB)
#define PG8_SB(b, h) ((4 + (b) * 2 + (h)) * HTB)
#define PG8_STAGE(bufoff, gbase, voff) do { _Pragma("unroll") for (int _i = 0; _i < 2; ++_i) \
        __builtin_amdgcn_global_load_lds((const unsigned*)((const char*)(gbase) + (voff)[_i]), (PG8_LAS unsigned*)(lds + (bufoff) + ldsw + _i * 8192), 16, 0, 0); } while (0)
#define PG8_LDA(dst, b, h) do { _Pragma("unroll") for (int m = 0; m < 4; ++m) _Pragma("unroll") for (int k = 0; k < 2; ++k) dst[m][k] = *(const PG8_LAS bf16x8*)(lds + PG8_SA(b, h) + aoff + m * 2048 + k * 1024); } while (0)
#define PG8_LDB(dst, b, h) do { _Pragma("unroll") for (int n = 0; n < 2; ++n) _Pragma("unroll") for (int k = 0; k < 2; ++k) dst[n][k] = *(const PG8_LAS bf16x8*)(lds + PG8_SB(b, h) + boff + n * 2048 + k * 1024); } while (0)
#define PG8_MMA(ai, bj, At, Bt) do { __builtin_amdgcn_s_setprio(1); _Pragma("unroll") for (int m = 0; m < 4; ++m) _Pragma("unroll") for (int n = 0; n < 2; ++n) _Pragma("unroll") for (int k = 0; k < 2; ++k) \
        acc[ai][bj][m][n] = __builtin_amdgcn_mfma_f32_16x16x32_bf16(Bt[n][k], At[m][k], acc[ai][bj][m][n], 0, 0, 0); __builtin_amdgcn_s_setprio(0); } while (0)
#define PG8_WAIT_V(n) asm volatile("s_waitcnt vmcnt(" #n ")" ::: "memory")
#define PG8_WAIT_L(n) asm volatile("s_waitcnt lgkmcnt(" #n ")" ::: "memory")
#define PG8_BAR __builtin_amdgcn_s_barrier()
#define PG8_SCHED __builtin_amdgcn_sched_barrier(0)
    Unit cur, nxt; int ui = 0;
    if (!S.next(0, cur)) return;
    f32x4 acc[2][2][4][2];
#pragma unroll
    for (int a = 0; a < 2; ++a)
#pragma unroll
        for (int b = 0; b < 2; ++b)
#pragma unroll
            for (int m = 0; m < 4; ++m)
#pragma unroll
                for (int n = 0; n < 2; ++n) acc[a][b][m][n] = (f32x4){0.f, 0.f, 0.f, 0.f};
    bf16x8 At[4][2], B0[2][2], B1[2][2];
    const char* cA = (const char*)g.A + (size_t)cur.pm * tstep + cur.kb; const char* cB = (const char*)g.Bt + (size_t)cur.pn * tstep + cur.kb;
    S.a_ready(cur);
    if constexpr (SP2) {
        PG8_STAGE(PG8_SB(0, 0), cB, voffB); PG8_STAGE(PG8_SB(0, 1), cB + hstep, voffB); PG8_STAGE(PG8_SA(0, 0), cA, voffA); PG8_STAGE(PG8_SA(0, 1), cA + hstep, voffA);
        if (wr == 1) PG8_BAR;
        PG8_WAIT_V(2); PG8_BAR;
        PG8_STAGE(PG8_SB(1, 0), cB + kstep, voffB); PG8_STAGE(PG8_SA(1, 0), cA + kstep, voffA); PG8_STAGE(PG8_SB(1, 1), cB + hstep + kstep, voffB);
        PG8_WAIT_V(6); PG8_BAR;
    } else {
        PG8_STAGE(PG8_SB(0, 0), cB, voffB); PG8_STAGE(PG8_SA(0, 0), cA, voffA); PG8_STAGE(PG8_SB(0, 1), cB + hstep, voffB); PG8_STAGE(PG8_SA(0, 1), cA + hstep, voffA);
        if (wr == 1) PG8_BAR;
        PG8_WAIT_V(4); PG8_BAR;
        PG8_STAGE(PG8_SB(1, 0), cB + kstep, voffB); PG8_STAGE(PG8_SA(1, 0), cA + kstep, voffA); PG8_STAGE(PG8_SB(1, 1), cB + hstep + kstep, voffB);
        PG8_WAIT_V(6); PG8_BAR;
    }
    for (;;) {
        const bool has_next = S.next(ui + 1, nxt);
        const char* nA = has_next ? (const char*)g.A + (size_t)nxt.pm * tstep + nxt.kb : cA; const char* nB = has_next ? (const char*)g.Bt + (size_t)nxt.pn * tstep + nxt.kb : cB;
        for (int t = 0; t < nt; t += 2) {
            const bool last = (t == nt - 2);
            const char* a1 = cA + (size_t)(t + 1) * kstep;
            const char* a2 = last ? nA : cA + (size_t)(t + 2) * kstep; const char* b2 = last ? nB : cB + (size_t)(t + 2) * kstep;
            const char* a3 = a2 + kstep; const char* b3 = b2 + kstep;
            if (last && has_next) S.a_ready(nxt);
            if constexpr (SP2) {
            PG8_LDB(B0, 0, 0); PG8_LDB(B1, 0, 1); PG8_SCHED; PG8_LDA(At, 0, 0); PG8_STAGE(PG8_SA(1, 1), a1 + hstep, voffA);
            PG8_WAIT_V(8); PG8_WAIT_L(0); PG8_BAR; PG8_MMA(0, 0, At, B0); PG8_MMA(0, 1, At, B1); PG8_BAR; PG8_SCHED;
            PG8_LDA(At, 0, 1); PG8_STAGE(PG8_SB(0, 0), b2, voffB); PG8_STAGE(PG8_SB(0, 1), b2 + hstep, voffB); PG8_STAGE(PG8_SA(0, 0), a2, voffA);
            PG8_WAIT_V(8); PG8_WAIT_L(0); PG8_BAR; PG8_MMA(1, 0, At, B0); PG8_MMA(1, 1, At, B1); PG8_BAR; PG8_SCHED;
            PG8_LDB(B0, 1, 0); PG8_LDB(B1, 1, 1); PG8_SCHED; PG8_LDA(At, 1, 0); PG8_STAGE(PG8_SA(0, 1), a2 + hstep, voffA);
            PG8_WAIT_V(8); PG8_WAIT_L(0); PG8_BAR; PG8_MMA(0, 0, At, B0); PG8_MMA(0, 1, At, B1); PG8_BAR; PG8_SCHED;
            PG8_LDA(At, 1, 1); PG8_STAGE(PG8_SB(1, 0), b3, voffB); PG8_STAGE(PG8_SB(1, 1), b3 + hstep, voffB); PG8_STAGE(PG8_SA(1, 0), a3, voffA);
            PG8_WAIT_V(8); PG8_WAIT_L(0); PG8_BAR; PG8_MMA(1, 0, At, B0); PG8_MMA(1, 1, At, B1); PG8_BAR; PG8_SCHED;
            } else {
            PG8_LDB(B0, 0, 0); PG8_SCHED; PG8_LDA(At, 0, 0); PG8_STAGE(PG8_SA(1, 1), a1 + hstep, voffA);
            PG8_WAIT_L(8); PG8_BAR; PG8_WAIT_L(0); PG8_MMA(0, 0, At, B0); PG8_BAR; PG8_SCHED;
            PG8_LDB(B1, 0, 1); PG8_STAGE(PG8_SB(0, 0), b2, voffB);
            PG8_BAR; PG8_WAIT_L(0); PG8_MMA(0, 1, At, B1); PG8_BAR;
            PG8_LDA(At, 0, 1); PG8_STAGE(PG8_SA(0, 0), a2, voffA);
            PG8_BAR; PG8_WAIT_L(0); PG8_MMA(1, 0, At, B0); PG8_BAR; PG8_SCHED;
            PG8_STAGE(PG8_SB(0, 1), b2 + hstep, voffB);
            PG8_WAIT_V(6); PG8_BAR; PG8_MMA(1, 1, At, B1); PG8_BAR;
            PG8_LDB(B0, 1, 0); PG8_SCHED; PG8_LDA(At, 1, 0); PG8_STAGE(PG8_SA(0, 1), a2 + hstep, voffA);
            PG8_WAIT_L(8); PG8_BAR; PG8_WAIT_L(0); PG8_MMA(0, 0, At, B0); PG8_BAR; PG8_SCHED;
            PG8_LDB(B1, 1, 1); PG8_STAGE(PG8_SB(1, 0), b3, voffB);
            PG8_BAR; PG8_WAIT_L(0); PG8_MMA(0, 1, At, B1); PG8_BAR;
            PG8_LDA(At, 1, 1); PG8_STAGE(PG8_SA(1, 0), a3, voffA);
            PG8_BAR; PG8_WAIT_L(0); PG8_MMA(1, 0, At, B0); PG8_BAR; PG8_SCHED;
            PG8_STAGE(PG8_SB(1, 1), b3 + hstep, voffB);
            PG8_WAIT_V(6); PG8_BAR; PG8_MMA(1, 1, At, B1); PG8_BAR;
            }
        }
        if constexpr (ALIGN_EPI) { if (wr == 0) PG8_BAR; }
        if constexpr (!Epi::AFTER_DRAIN) {
            unsigned z_ = 0u; asm volatile("" : "+v"(z_)); const int le_ = (int)__builtin_amdgcn_mbcnt_hi(~0u, __builtin_amdgcn_mbcnt_lo(~0u, z_));
            E(acc, cur, wr, wc, le_ & 15, le_ >> 4); S.done(cur); }
        if (!has_next) break;
#pragma unroll
        for (int a = 0; a < 2; ++a)
#pragma unroll
            for (int b = 0; b < 2; ++b)
#pragma unroll
                for (int m = 0; m < 4; ++m)
#pragma unroll
                    for (int n = 0; n < 2; ++n) acc[a][b][m][n] = (f32x4){0.f, 0.f, 0.f, 0.f};
        cur = nxt; cA = nA; cB = nB; ++ui;
        if constexpr (ALIGN_EPI) { if (wr == 1) PG8_BAR; }
    }
    PG8_WAIT_V(0);
    if constexpr (!ALIGN_EPI) { if (wr == 0) PG8_BAR; }
    PG8_BAR;
    if constexpr (Epi::AFTER_DRAIN) { E.fused(acc, cur, wr, wc, fr, fq, lds, wid, lane); S.done(cur); }
#undef PG8_SA
#undef PG8_SB
#undef PG8_STAGE
#undef PG8_LDA
#undef PG8_LDB
#undef PG8_MMA
#undef PG8_WAIT_V
#undef PG8_WAIT_L
#undef PG8_BAR
#undef PG8_SCHED
}
}

namespace pg8 {
struct EpiRes {
    static constexpr bool PERM = false, AFTER_DRAIN = false;
    float* XL; float* XC; const float* modl; int chunk; const float* SL; const float* SC;
    __device__ __forceinline__ void operator()(const f32x4 (&acc)[2][2][4][2], const Unit& u, int wr, int wc, int fr, int fq) const {
        asm volatile("" : "+v"(fr), "+v"(fq));
        const int rt0 = u.pm * BM;
        const int bb = rt0 < BL ? rt0 / SEQ : NB;
        const float* gate = modl + ((size_t)bb * 6 + chunk) * DM;
        float* xb = rt0 < BL ? XL + (size_t)rt0 * DM : XC + (size_t)(rt0 - BL) * DM;
        const float* sb = rt0 < BL ? SL + (size_t)rt0 * DM : SC + (size_t)(rt0 - BL) * DM;
        const int col0 = u.pn * BM + wc * 32 + fq * 4;
        f32x4 gv[2][2];
#pragma unroll
        for (int bj = 0; bj < 2; ++bj)
#pragma unroll
            for (int n = 0; n < 2; ++n) gv[bj][n] = *(const f32x4*)(gate + col0 + bj * HALF + n * 16);
#pragma unroll
        for (int ai = 0; ai < 2; ++ai) {
            f32x4 t[4][2][2];
#pragma unroll
            for (int m = 0; m < 4; ++m)
#pragma unroll
                for (int bj = 0; bj < 2; ++bj)
#pragma unroll
                    for (int n = 0; n < 2; ++n) t[m][bj][n] = *(const f32x4*)(sb + (size_t)(wr * 64 + fr + ai * HALF + m * 16) * DM + col0 + bj * HALF + n * 16);
#pragma unroll
            for (int m = 0; m < 4; ++m)
#pragma unroll
                for (int bj = 0; bj < 2; ++bj)
#pragma unroll
                    for (int n = 0; n < 2; ++n) *(f32x4*)(xb + (size_t)(wr * 64 + fr + ai * HALF + m * 16) * DM + col0 + bj * HALF + n * 16) = t[m][bj][n] + gv[bj][n] * acc[ai][bj][m][n];
        }
    }
};
struct EpiSwiGLU {
    static constexpr bool PERM = true, AFTER_DRAIN = false;
    bf16_t* H;
    __device__ __forceinline__ void operator()(const f32x4 (&acc)[2][2][4][2], const Unit& u, int wr, int wc, int fr, int fq) const {
        asm volatile("" : "+v"(fr), "+v"(fq));
        const int row0 = u.pm * BM + wr * 64 + fr, hc0 = u.pn * HALF + wc * 32 + 8 * fq;
#pragma unroll
        for (int ai = 0; ai < 2; ++ai)
#pragma unroll
            for (int m = 0; m < 4; ++m) {
                bf16_t* rowp = H + (size_t)(row0 + ai * HALF + m * 16) * DFF + hc0;
                f32x4 v[2];
#pragma unroll
                for (int n = 0; n < 2; ++n)
#pragma unroll
                    for (int i = 0; i < 4; ++i) { const float a = acc[ai][0][m][n][i]; v[n][i] = a * __builtin_amdgcn_rcpf(1.0f + __expf(-a)) * acc[ai][1][m][n][i]; }
                u32x4 w; w.x = cvt_pk_bf16(v[0][0], v[0][1]); w.y = cvt_pk_bf16(v[0][2], v[0][3]); w.z = cvt_pk_bf16(v[1][0], v[1][1]); w.w = cvt_pk_bf16(v[1][2], v[1][3]);
                *(u32x4*)rowp = w;
            }
    }
};
}


namespace pg8 {
struct SplitKOrder {
    int nM, nN, S, ksl, nun, G, c;
    __device__ void init(int M, int N, int S_, int kslice_elems, int G_, int c_) { nM = M / BM; nN = N / BM; S = S_; ksl = kslice_elems; nun = nM * nN * S; G = G_; c = c_; }
    __device__ bool next(int i, Unit& u) const {
        const int L = i * G + c; if (L >= nun) return false;
        const int sl = L % S, t = L / S; u.pm = t % nM; u.pn = t / nM; u.kb = sl * ksl * 2; return true;
    }
    __device__ __forceinline__ void a_ready(const Unit&) const {}
    __device__ __forceinline__ void done(const Unit&) const {}
};
struct EpiSlab {
    static constexpr bool PERM = false, AFTER_DRAIN = false;
    float* SLAB; int rows, kslice_bytes;
    __device__ __forceinline__ void operator()(const f32x4 (&acc)[2][2][4][2], const Unit& u, int wr, int wc, int fr, int fq) const {
        asm volatile("" : "+v"(fr), "+v"(fq));
        float* xb = SLAB + ((size_t)(u.kb / kslice_bytes) * rows + (size_t)u.pm * BM) * DM;
        const int col0 = u.pn * BM + wc * 32 + fq * 4;
#pragma unroll
        for (int ai = 0; ai < 2; ++ai)
#pragma unroll
            for (int m = 0; m < 4; ++m) {
                const size_t ro = (size_t)(wr * 64 + fr + ai * HALF + m * 16) * DM + col0;
#pragma unroll
                for (int bj = 0; bj < 2; ++bj)
#pragma unroll
                    for (int n = 0; n < 2; ++n) *(f32x4*)(xb + ro + bj * HALF + n * 16) = acc[ai][bj][m][n];
            }
    }
};
}

#define LAS __attribute__((address_space(3)))
typedef float f32x4 __attribute__((ext_vector_type(4)));
typedef unsigned v4u __attribute__((ext_vector_type(4)));
#define REP_G1 1
#define REP_G3 1
#define REP_GLA 1
#define REP_SSD 1
#define REP_HY 1
#define REP_HX 1
#define REP_PRO 1
#define CTX_SPLITK 1
#define OLD_SHFL 0
#define REP_MIX 1
#define REP_PA 1
#define REP_PC 1
#define REP_H1 1
#define REP_H2 1
#define REP_H3 1
#define REP_HC 1
#define REP_S2 1
#define REP_S23 1
#define REP_S4 1
#define REP_M2 1
#define REP_M3 1
#define REP_M4 1
#define REP_INIT 1
#define REP_MOD 1
#define REP_F1 1
#define REP_WT 1
#define REP_F3 1
constexpr int LDS_BYTES = 163840;
namespace cg = cooperative_groups;

__device__ __forceinline__ unsigned f2bf_u(float f) { unsigned u = __builtin_bit_cast(unsigned, f); return (u + 0x7fffu + ((u >> 16) & 1u)) >> 16; }
__device__ __forceinline__ unsigned pk2(float lo, float hi) { return f2bf_u(lo) | (f2bf_u(hi) << 16); }
template <int M> __device__ __forceinline__ float swz_xor(float v) { return __builtin_bit_cast(float, __builtin_amdgcn_ds_swizzle(__builtin_bit_cast(int, v), (M << 10) | 0x1f)); }
#if OLD_SHFL
__device__ __forceinline__ float wave_sum(float v, int) {
#pragma unroll
    for (int o = 1; o < 64; o <<= 1) v += __shfl_xor(v, o);
    return v;
}
__device__ __forceinline__ float sum16(float v) { v += __shfl_xor(v, 1); v += __shfl_xor(v, 2); v += __shfl_xor(v, 4); v += __shfl_xor(v, 8); return v; }
__device__ __forceinline__ float wave_scan_incl(float v, int lane) {
#pragma unroll
    for (int off = 1; off < 64; off <<= 1) { const float up = __shfl_up(v, off); if (lane >= off) v += up; }
    return v;
}
#else
__device__ __forceinline__ float wave_sum(float v, int lane) {
    v += swz_xor<1>(v); v += swz_xor<2>(v); v += swz_xor<4>(v); v += swz_xor<8>(v); v += swz_xor<16>(v);
    return v + __builtin_bit_cast(float, __builtin_amdgcn_ds_bpermute((lane ^ 32) << 2, __builtin_bit_cast(int, v)));
}
__device__ __forceinline__ float sum16(float v) { v += swz_xor<1>(v); v += swz_xor<2>(v); v += swz_xor<4>(v); v += swz_xor<8>(v); return v; }
template <int CTRL, int ROWMASK> __device__ __forceinline__ float dpp0(float v) {
    return __builtin_bit_cast(float, __builtin_amdgcn_update_dpp(0, __builtin_bit_cast(int, v), CTRL, ROWMASK, 0xf, false));
}
__device__ __forceinline__ float wave_scan_incl(float v, int) {
    v += dpp0<0x111, 0xf>(v); v += dpp0<0x112, 0xf>(v); v += dpp0<0x114, 0xf>(v); v += dpp0<0x118, 0xf>(v);
    v += dpp0<0x142, 0xa>(v);
    v += dpp0<0x143, 0xc>(v);
    return v;
}
#endif
__device__ __forceinline__ float lane63(float v) { return __builtin_bit_cast(float, __builtin_amdgcn_readlane(__builtin_bit_cast(int, v), 63)); }
__device__ __forceinline__ void transpose_item(const float* W, int K, int N, unsigned short* WT, int dst_row0, LAS float* scr, int k0, int n0, int lane) {
    const int nn = n0 + (lane & 31); const bool inb = nn < N; const int nc = inb ? nn : N - 1;
#pragma unroll
    for (int i0 = 0; i0 < 32; i0 += 8) {
        float tv[8];
#pragma unroll
        for (int i = 0; i < 8; ++i) tv[i] = W[(size_t)(k0 + 2 * (i0 + i) + (lane >> 5)) * N + nc];
#pragma unroll
        for (int i = 0; i < 8; ++i) scr[(2 * (i0 + i) + (lane >> 5)) * 33 + (lane & 31)] = inb ? tv[i] : 0.f;
    }
    asm volatile("s_waitcnt lgkmcnt(0)" ::: "memory");
    const int c = lane & 7;
#pragma unroll
    for (int j = 0; j < 4; ++j) { const int n = (lane >> 3) + 8 * j; const LAS float* sp = scr + (8 * c) * 33 + n;
        v4u o; o.x = pk2(sp[0 * 33], sp[1 * 33]); o.y = pk2(sp[2 * 33], sp[3 * 33]); o.z = pk2(sp[4 * 33], sp[5 * 33]); o.w = pk2(sp[6 * 33], sp[7 * 33]);
        *(v4u*)(WT + (size_t)(dst_row0 + n) * K + k0 + 8 * c) = o; }
    asm volatile("s_waitcnt lgkmcnt(0)" ::: "memory");
}
__device__ __forceinline__ void prologue_weights(const Params& p, LAS float* scr, int gw, int NGW, int lane) {
    constexpr int I_IN = 16 * (LDP / 32), I_OUT = 16 * 32, I_W1 = 16 * (DFF / 32), I_W2 = (DFF / 64) * 32;
    constexpr int PER_L = I_IN + I_OUT + 2 * I_W1 + I_W2;
    for (int it = gw; it < DEPTH * PER_L; it += NGW) {
        const int l = it / PER_L; int r = it % PER_L;
        if (r < I_IN) { const int nb = r % (LDP / 32), kb = r / (LDP / 32);
            transpose_item(p.w_in + (size_t)l * DM * DIN, DM, DIN, p.WIN_T + (size_t)l * LDP * DM, nb * 32, scr, kb * 64, nb * 32, lane); continue; }
        r -= I_IN;
        if (r < I_OUT) { const int nb = r % 32, kb = r / 32;
            transpose_item(p.w_out + (size_t)l * DM * DM, DM, DM, p.WOUT_T + (size_t)l * DM * DM, nb * 32, scr, kb * 64, nb * 32, lane); continue; }
        r -= I_OUT;
        if (r < 2 * I_W1) { const int which = r / I_W1; r %= I_W1; const int nb = r % (DFF / 32), kb = r / (DFF / 32); const int n0 = nb * 32;
            const int drow = 256 * (n0 / 128) + 128 * which + (n0 % 128);
            transpose_item((which ? p.ffn_w3 : p.ffn_w1) + (size_t)l * DM * DFF, DM, DFF, p.W13_T + (size_t)l * NFF2 * DM, drow, scr, kb * 64, n0, lane); continue; }
        r -= 2 * I_W1;
        { const int nb = r % 32, kb = r / 32;
            transpose_item(p.ffn_w2 + (size_t)l * DFF * DM, DFF, DM, p.W2_T + (size_t)l * DM * DFF, nb * 32, scr, kb * 64, nb * 32, lane); }
    }
}

__device__ __forceinline__ void mod_partial(const Params& p, long tid, long nth, float* MODP) {
    for (long i = tid; i < 2L * 16 * 1536; i += nth) {
        const int n4 = (int)(i % 1536), kc = (int)((i / 1536) & 15), l = (int)(i / (1536 * 16));
        f32x4 acc[NB + 1];
        float z0 = 0.f; asm volatile("" : "+v"(z0));
#pragma unroll
        for (int bb = 0; bb <= NB; ++bb) acc[bb] = (f32x4){z0, z0, z0, z0};
        const float* w = p.mod_w + ((size_t)l * DM + kc * 64) * 6 * DM + 4 * n4;
#pragma unroll 4
        for (int k = 0; k < 64; ++k) {
            const f32x4 w4 = *(const f32x4*)(w + (size_t)k * 6 * DM);
#pragma unroll
            for (int bb = 0; bb <= NB; ++bb) {
                const float cv = (bb < NB ? p.c + (size_t)bb * DM : p.c_ctx)[kc * 64 + k];
                acc[bb] += w4 * (cv / (1.0f + __expf(-cv)));
            }
        }
#pragma unroll
        for (int bb = 0; bb <= NB; ++bb) *(f32x4*)(MODP + (((size_t)kc * DEPTH + l) * (NB + 1) + bb) * 6 * DM + 4 * n4) = acc[bb];
    }
}
__device__ __forceinline__ void mod_reduce(const Params& p, long tid, long nth, const float* MODP) {
    const long total = (long)DEPTH * (NB + 1) * 6 * DM;
    for (long i = tid; i < total; i += nth) {
        const int n = (int)(i % (6 * DM)), l = (int)(i / ((long)6 * DM * (NB + 1)));
        float acc = p.mod_b[(size_t)l * 6 * DM + n];
#pragma unroll
        for (int kc = 0; kc < 16; ++kc) acc += MODP[(size_t)kc * total + i];
        p.MOD[i] = acc;
    }
}
constexpr int FL_Z = 0, FL_H1 = 8704, FL_H2 = 8704 + 16640, FL_T = 8704 + 2 * 16640;
constexpr int FILT_UNITS = DEPTH * (SEQ / 64) + DEPTH * (CTX / 64);
__device__ __forceinline__ void filt_unit(const Params& p, LAS unsigned char* lds, int u, int tix) {
    const bool isctx = u >= DEPTH * (SEQ / 64);
    const int uu = isctx ? u - DEPTH * (SEQ / 64) : u, per = isctx ? CTX / 64 : SEQ / 64;
    const int l = uu / per, t0 = (uu % per) * 64, ttb = (isctx ? SEQ : 0) + t0;
    LAS float* Z = (LAS float*)(lds + FL_Z); LAS float* H1 = (LAS float*)(lds + FL_H1); LAS float* H2 = (LAS float*)(lds + FL_H2);
    __syncthreads();
    {
        const int tap = tix & 63, bq = tix >> 6;
        float rel; filt_pos(ttb + tap, rel);
        const float tw = 2.0f * 3.14159265358979323846f * rel;
        if (bq == 0) Z[tap * 34] = rel;
#pragma unroll
        for (int k = 0; k < 2; ++k) { const int j = 2 * bq + k; const float ang = tw * (1e-4f + (float)j * ((15.0f - 1e-4f) / 15.0f));
            Z[tap * 34 + 1 + j] = cosf(ang); Z[tap * 34 + 17 + j] = -sinf(ang); }
    }
    __syncthreads();
    {
        const int tap = tix & 63, o0 = __builtin_amdgcn_readfirstlane(tix >> 6) * 8;
        float acc[8];
#pragma unroll
        for (int e = 0; e < 8; ++e) acc[e] = 0.f;
        const float* w1 = p.hy_w1 + (size_t)l * 33 * 64 + o0;
#pragma unroll 3
        for (int i = 0; i < 33; ++i) { const float zv = Z[tap * 34 + i];
#pragma unroll
            for (int e = 0; e < 8; ++e) acc[e] += zv * w1[i * 64 + e]; }
#pragma unroll
        for (int e = 0; e < 8; ++e) H1[tap * 65 + o0 + e] = sinf(p.hy_freq[l * 64 + o0 + e] * (acc[e] + p.hy_b1[l * 64 + o0 + e]));
    }
    __syncthreads();
    {
        const int tap = tix & 63, o0 = __builtin_amdgcn_readfirstlane(tix >> 6) * 8;
        float acc[8];
#pragma unroll
        for (int e = 0; e < 8; ++e) acc[e] = 0.f;
        const float* w2 = p.hy_w2 + (size_t)l * 64 * 64 + o0;
#pragma unroll 4
        for (int j = 0; j < 64; ++j) { const float hv = H1[tap * 65 + j];
#pragma unroll
            for (int e = 0; e < 8; ++e) acc[e] += hv * w2[j * 64 + e]; }
#pragma unroll
        for (int e = 0; e < 8; ++e) H2[tap * 65 + o0 + e] = sinf(p.hy_freq[l * 64 + o0 + e] * (acc[e] + p.hy_b2[l * 64 + o0 + e]));
    }
    __syncthreads();
    {
        const int c = tix & 255, half = tix >> 8;
        float w[64];
#pragma unroll
        for (int j = 0; j < 64; ++j) w[j] = p.hy_w3[(size_t)l * 64 * 256 + j * 256 + c];
        const float dec = p.hy_decay[l * 256 + c];
#pragma unroll 2
        for (int k = 0; k < 32; ++k) {
            const int tap = 32 * half + k;
            float acc = 0.f;
#pragma unroll
            for (int j = 0; j < 64; ++j) acc += H2[tap * 65 + j] * w[j];
            float rel; filt_pos(ttb + tap, rel);
            const float hv = acc * expf(-2.0f * fabsf(rel) * dec);
            if (isctx) ((LAS float*)(lds + FL_T))[tap * 260 + c] = hv;
            else ((LAS unsigned short*)(lds + FL_T))[c * 72 + 63 - tap] = (unsigned short)f2bf_u(hv);
        }
    }
    __syncthreads();
    if (isctx) {
        for (int e = tix; e < 64 * 256; e += 512) p.HFC[((size_t)l * CTX + t0 + (e >> 8)) * 256 + (e & 255)] = ((const LAS float*)(lds + FL_T))[(e >> 8) * 260 + (e & 255)];
    } else {
#pragma unroll 4
        for (int k = 0; k < 32; ++k) { const int e = k * 512 + tix, row = e >> 6, col = e & 63;
            p.G1[((size_t)l * 256 + row) * G1N + (8456 - t0 - 63) + col] = ((const LAS unsigned short*)(lds + FL_T))[row * 72 + col]; }
    }
}
__device__ __forceinline__ void filt_all(const Params& p, LAS unsigned char* lds, long tid, long nth, int tix, int bid, int G) {
    constexpr int NPAD = 265 + (G1N - 8457);
    for (long i = tid; i < (long)DEPTH * 256 * NPAD; i += nth) {
        const int k = (int)(i % NPAD); const long lc = i / NPAD;
        p.G1[lc * G1N + (k < 265 ? k : 8457 + (k - 265))] = 0;
    }
    for (int u = bid; u < FILT_UNITS; u += G) filt_unit(p, lds, u, tix);
    __syncthreads();
}
__device__ __forceinline__ const float* xsrc_row(const Params& p, int r, bool from_input) {
    if (from_input) return r < BL ? p.x + (size_t)r * DM : p.ctx + (size_t)(r - BL) * DM;
    return r < BL ? p.XL + (size_t)r * DM : p.XC + (size_t)(r - BL) * DM;
}
template <bool SLAB>
__device__ __forceinline__ void hx_pass(const Params& p, int l, int which, int row_lo, int row_hi, int gw, int NGW, int lane, int nslab = 0, const float* slab = nullptr, const float* gate = nullptr, bool base_from_input = false) {
    const float* g = (which ? p.norm2_g : p.norm1_g) + (size_t)l * DM;
    for (int r = row_lo + gw; r < row_hi; r += NGW) {
        const float* m = p.MOD + ((size_t)l * (NB + 1) + row_bb(r)) * 6 * DM;
        const float* sh = m + (which ? 3 : 0) * DM; const float* sc = m + (which ? 4 : 1) * DM;
        f32x4 v[4]; float s = 0.f;
        if (SLAB) {
            const f32x4* x4 = (const f32x4*)(base_from_input ? p.ctx + (size_t)(r - BL) * DM : p.XC + (size_t)(r - BL) * DM) + lane;
            f32x4* xo = (f32x4*)(p.XC + (size_t)(r - BL) * DM) + lane;
            const f32x4* sl = (const f32x4*)(slab + (size_t)(r - BL) * DM) + lane;
#pragma unroll
            for (int j = 0; j < 4; ++j) v[j] = (f32x4){0.f, 0.f, 0.f, 0.f};
#pragma unroll 1
            for (int q = 0; q < nslab; ++q) {
#pragma unroll
                for (int j = 0; j < 4; ++j) v[j] += sl[(size_t)q * BC * (DM / 4) + 64 * j];
            }
#pragma unroll
            for (int j = 0; j < 4; ++j) { v[j] = x4[64 * j] + *(const f32x4*)(gate + 4 * lane + 256 * j) * v[j]; xo[64 * j] = v[j]; }
        } else {
            const f32x4* x4 = (const f32x4*)xsrc_row(p, r, l == 0 && which == 0) + lane;
#pragma unroll
            for (int j = 0; j < 4; ++j) v[j] = x4[64 * j];
        }
#pragma unroll
        for (int j = 0; j < 4; ++j) s += (v[j].x * v[j].x + v[j].y * v[j].y) + (v[j].z * v[j].z + v[j].w * v[j].w);
        const float rstd = 1.0f / sqrtf(wave_sum(s, lane) * (1.0f / DM) + EPSV);
        unsigned long long* o8 = (unsigned long long*)(p.Y + (size_t)r * DM) + lane;
#pragma unroll
        for (int j = 0; j < 4; ++j) {
            const int k = 4 * lane + 256 * j;
            const f32x4 gg = *(const f32x4*)(g + k), s1 = *(const f32x4*)(sc + k), s0 = *(const f32x4*)(sh + k);
            const f32x4 o = v[j] * rstd * gg * (s1 + 1.0f) + s0;
            o8[64 * j] = (unsigned long long)pk2(o.x, o.y) | ((unsigned long long)pk2(o.z, o.w) << 32);
        }
    }
}
__device__ __forceinline__ void final_pass(const Params& p, int gw, int NGW, int lane) {
    for (int r = gw; r < BL; r += NGW) {
        f32x4* x4 = (f32x4*)(p.XL + (size_t)r * DM) + lane;
        f32x4 v[4]; float s = 0.f;
#pragma unroll
        for (int j = 0; j < 4; ++j) { v[j] = x4[64 * j]; s += (v[j].x * v[j].x + v[j].y * v[j].y) + (v[j].z * v[j].z + v[j].w * v[j].w); }
        const float rstd = 1.0f / sqrtf(wave_sum(s, lane) * (1.0f / DM) + EPSV);
#pragma unroll
        for (int j = 0; j < 4; ++j) x4[64 * j] = v[j] * rstd * *(const f32x4*)(p.final_g + 4 * lane + 256 * j);
    }
}


#define GAS __attribute__((address_space(1)))
#define XB_TMO      128
#define XB_XCNT(j)  (256  + 64 * (j))
#define XB_XSUB(j)  (1280 + 64 * (j))
#define XB_XGEN(j)  (2304 + 64 * (j))
#define XB_TOP      3328
#define XB_TOPGEN   3392
#define XCD_BAR_WORDS 3456
#define XB_SPIN_CAP (1u << 18)

__device__ __forceinline__ unsigned xb_ld(unsigned* p)              { return __hip_atomic_load(p, __ATOMIC_RELAXED, __HIP_MEMORY_SCOPE_AGENT); }
__device__ __forceinline__ unsigned xb_add(unsigned* p, unsigned v) { return __hip_atomic_fetch_add(p, v, __ATOMIC_RELAXED, __HIP_MEMORY_SCOPE_AGENT); }
__device__ __forceinline__ unsigned xb_xcc_id() { return (unsigned)__builtin_amdgcn_s_getreg((3 << 11) | 20) & 0xFu; }
#define XB_SPIN(cond, bar) do { unsigned _sp = 0; while (cond) { __builtin_amdgcn_s_sleep(1); \
    if ((++_sp & 255u) == 0u) { if (xb_ld(&(bar)[XB_TMO])) break; if (_sp > XB_SPIN_CAP) { atomicAdd(&(bar)[XB_TMO], 1u); break; } } } } while (0)

struct XcdBarrier {
    unsigned* bar; unsigned x;
    volatile LAS unsigned* st;
};

__device__ __forceinline__ XcdBarrier xcd_barrier_post(unsigned* bar, volatile LAS unsigned* st) {
    XcdBarrier b; b.bar = bar; b.x = xb_xcc_id(); b.st = st;
    if (threadIdx.x == 0) (void)xb_add(&bar[XB_XCNT(b.x)], 1u);
    return b;
}
__device__ __forceinline__ void xcd_barrier_complete(unsigned* bar, unsigned x, unsigned& nloc, unsigned& nx) {
    const unsigned G = gridDim.x * gridDim.y * gridDim.z;
    unsigned sum, cnt, mine, sp = 0u;
    for (;;) {
        sum = 0u; cnt = 0u; mine = 0u;
#pragma unroll
        for (unsigned j = 0; j < 16; ++j) { const unsigned c = xb_ld(&bar[XB_XCNT(j)]); sum += c; cnt += (c > 0u) ? 1u : 0u; mine = (j == x) ? c : mine; }
        if (sum == G) break;
        __builtin_amdgcn_s_sleep(1);
        if ((++sp & 255u) == 0u) { if (xb_ld(&bar[XB_TMO])) break; if (sp > XB_SPIN_CAP) { atomicAdd(&bar[XB_TMO], 1u); break; } }
    }
    nloc = mine > 0u ? mine : 1u; nx = cnt > 0u ? cnt : 1u;
}

__device__ __forceinline__ void xcd_barrier(const XcdBarrier& b, bool leader) {
    asm volatile("s_waitcnt vmcnt(0)" ::: "memory");
    __syncthreads();
    if (leader) {
        unsigned* bar = b.bar;
        __builtin_amdgcn_s_waitcnt(0);
        unsigned nloc = b.st[0], nx = b.st[1];
        if (nloc == 0u) { xcd_barrier_complete(bar, b.x, nloc, nx); b.st[0] = nloc; b.st[1] = nx; }
        const unsigned old = xb_add(&bar[XB_XSUB(b.x)], 1u);
        const unsigned gen = old / nloc;
        if (old + 1u == (gen + 1u) * nloc) {
            __builtin_amdgcn_fence(__ATOMIC_RELEASE, "agent");
            asm volatile("s_waitcnt vmcnt(0)" ::: "memory");
            const unsigned og = xb_add(&bar[XB_TOP], 1u);
            const unsigned tg = og / nx;
            if (og + 1u == (tg + 1u) * nx) xb_add(&bar[XB_TOPGEN], 1u);
            else XB_SPIN(xb_ld(&bar[XB_TOPGEN]) == tg, bar);
            __builtin_amdgcn_fence(__ATOMIC_ACQUIRE, "agent");
            xb_add(&bar[XB_XGEN(b.x)], 1u);
            asm volatile("s_waitcnt vmcnt(0)" ::: "memory");
        } else {
            XB_SPIN(xb_ld(&bar[XB_XGEN(b.x)]) == gen, bar);
            __builtin_amdgcn_fence(__ATOMIC_ACQUIRE, "agent");
            asm volatile("s_waitcnt vmcnt(0)" ::: "memory");
        }
    }
    __syncthreads();
}
#define GNCC ((CTX + SEQ) / 64)
#define GCTXC (CTX / 64)
#define GLA_UNITS (NB * 6 * GNCC)
typedef short bf16x8 __attribute__((ext_vector_type(8)));
__device__ __forceinline__ int gla_row0(int b, int cc) { return cc < GCTXC ? BL + b * CTX + cc * 64 : b * SEQ + (cc - GCTXC) * 64; }
__device__ __forceinline__ size_t gla_uidx(int dir, int b, int h, int cc) { return (((size_t)dir * NB + b) * 6 + h) * GNCC + cc; }
__device__ __forceinline__ float bflo(unsigned u) { return __builtin_bit_cast(float, u << 16); }
__device__ __forceinline__ float bfhi(unsigned u) { return __builtin_bit_cast(float, u & 0xffff0000u); }
constexpr int GL_WL = 0, GL_BIAS = 24576, GL_VT = 26112, GL_KLT = 35328, GL_AC = 44544, GL_KD = 70144, GL_PART = 80384;
constexpr int GL_VTS = 72, GL_ACS = 200, GL_KDS = 40;

__device__ __forceinline__ void gla_stage_w(const Params& p, int l, LAS unsigned char* lds, int tix) {
    LAS float* WL = (LAS float*)(lds + GL_WL); LAS float* BI = (LAS float*)(lds + GL_BIAS);
    {   float tv[12];
#pragma unroll
        for (int k = 0; k < 12; ++k) { const int i = tix + 512 * k, h = i >> 10, dir = (i >> 9) & 1, j = (i >> 5) & 15, d = i & 31;
            const float a = p.gk_w_f[(size_t)l * 16 * 192 + j * 192 + h * 32 + d], bq = p.gk_w_b[(size_t)l * 16 * 192 + j * 192 + h * 32 + d]; tv[k] = dir ? bq : a; }
#pragma unroll
        for (int k = 0; k < 12; ++k) WL[tix + 512 * k] = tv[k]; }
    if (tix < 384) { const int h = tix >> 6, dir = (tix >> 5) & 1, d = tix & 31; BI[tix] = (dir ? p.gk_b_b : p.gk_b_f)[l * 192 + h * 32 + d]; }
}
struct GlaPre { v4u v, gk0, gk1, q, k; };
template <bool NEEDQ>
__device__ __forceinline__ void gla_issue(const Params& p, int u, int tix, GlaPre& L) {
    const int b = u / (6 * GNCC), h = (u / GNCC) % 6, cc = u % GNCC, row0 = gla_row0(b, cc);
    const int lane = tix & 63, wave = tix >> 6, dir = wave >> 2, d0 = (wave & 3) * 8;
    L.v = *(const v4u*)(p.P + (size_t)(row0 + (tix >> 3)) * LDP + OFF_V + h * 64 + (tix & 7) * 8);
    const act_t* prow = p.P + (size_t)(row0 + lane) * LDP;
    L.gk0 = *(const v4u*)(prow + (dir ? OFF_GKB : OFF_GKF)); L.gk1 = *(const v4u*)(prow + (dir ? OFF_GKB : OFF_GKF) + 8);
    L.k = *(const v4u*)(prow + OFF_K + h * 32 + d0);
    if (NEEDQ) L.q = *(const v4u*)(prow + OFF_Q + h * 32 + d0);
}
__device__ __forceinline__ void gla_put_v(LAS unsigned char* lds, int tix, const v4u vv) {
    const int j = tix >> 3, eo = tix & 7;
    LAS unsigned short* VT = (LAS unsigned short*)(lds + GL_VT);
    VT[(eo * 8 + 0) * GL_VTS + j] = (unsigned short)(vv.x & 0xffff); VT[(eo * 8 + 1) * GL_VTS + j] = (unsigned short)(vv.x >> 16);
    VT[(eo * 8 + 2) * GL_VTS + j] = (unsigned short)(vv.y & 0xffff); VT[(eo * 8 + 3) * GL_VTS + j] = (unsigned short)(vv.y >> 16);
    VT[(eo * 8 + 4) * GL_VTS + j] = (unsigned short)(vv.z & 0xffff); VT[(eo * 8 + 5) * GL_VTS + j] = (unsigned short)(vv.z >> 16);
    VT[(eo * 8 + 6) * GL_VTS + j] = (unsigned short)(vv.w & 0xffff); VT[(eo * 8 + 7) * GL_VTS + j] = (unsigned short)(vv.w >> 16);
}
__device__ __forceinline__ void gla_phase_a(const v4u g0, const v4u g1, LAS unsigned char* lds, int h, int dir, int d0, int lane, float (&Bv)[8], float (&tot)[8]) {
    const LAS float* WL = (const LAS float*)(lds + GL_WL) + h * 1024 + dir * 512 + d0; const LAS float* BI = (const LAS float*)(lds + GL_BIAS) + h * 64 + dir * 32 + d0;
    float gk[16] = { bflo(g0.x), bfhi(g0.x), bflo(g0.y), bfhi(g0.y), bflo(g0.z), bfhi(g0.z), bflo(g0.w), bfhi(g0.w),
                     bflo(g1.x), bfhi(g1.x), bflo(g1.y), bfhi(g1.y), bflo(g1.z), bfhi(g1.z), bflo(g1.w), bfhi(g1.w) };
    float lg[8];
#pragma unroll
    for (int i = 0; i < 8; ++i) lg[i] = BI[i];
#pragma unroll
    for (int j = 0; j < 16; ++j) {
        const f32x4 w0 = *(const LAS f32x4*)(WL + j * 32), w1 = *(const LAS f32x4*)(WL + j * 32 + 4);
        lg[0] += gk[j] * w0.x; lg[1] += gk[j] * w0.y; lg[2] += gk[j] * w0.z; lg[3] += gk[j] * w0.w;
        lg[4] += gk[j] * w1.x; lg[5] += gk[j] * w1.y; lg[6] += gk[j] * w1.z; lg[7] += gk[j] * w1.w;
    }
#pragma unroll
    for (int i = 0; i < 8; ++i) {
        const float x = lg[i];
        lg[i] = -(fmaxf(-x, 0.f) + __logf(1.0f + __expf(-fabsf(x)))) * (1.0f / 16.0f);
        const float v = wave_scan_incl(lg[i], lane);
        tot[i] = lane63(v);
        Bv[i] = dir ? tot[i] - v + lg[i] : v;
    }
}
__device__ __forceinline__ void unpack8(const v4u k, float (&f)[8]) {
    f[0] = bflo(k.x); f[1] = bfhi(k.x); f[2] = bflo(k.y); f[3] = bfhi(k.y); f[4] = bflo(k.z); f[5] = bfhi(k.z); f[6] = bflo(k.w); f[7] = bfhi(k.w);
}
__device__ __forceinline__ int gla_count(int b, int ph) {
    if (gridDim.x != 256 || GLA_UNITS != 3168) return (GLA_UNITS - b + (int)gridDim.x - 1) / (int)gridDim.x;
    const int n0 = ph ? 8 : 9, extra = 3168 - 16 * n0 - 240 * 12;
    return b < 16 ? n0 : 12 + ((b - 16) < extra ? 1 : 0);
}
__device__ __forceinline__ int gla_unit_of(int b, int k, int ph) {
    if (gridDim.x != 256 || GLA_UNITS != 3168) return b + k * (int)gridDim.x;
    const int n0 = ph ? 8 : 9;
    return b < 16 ? n0 * b + k : (k < 12 ? 16 * n0 + (b - 16) * 12 + k : 16 * n0 + 2880 + (b - 16));
}
__device__ __forceinline__ void gla_m2_phase(const Params& p, int l, LAS unsigned char* lds, int tix, int bid, unsigned short* DSG, float* DECG) {
    const int lane = tix & 63, wave = __builtin_amdgcn_readfirstlane(tix >> 6);
    gla_stage_w(p, l, lds, tix);
    GlaPre L;
    const int ncnt = gla_count(bid, 0);
    if (ncnt > 0) gla_issue<false>(p, gla_unit_of(bid, 0, 0), tix, L);
    __syncthreads();
#pragma unroll 1
    for (int kk = 0; kk < ncnt; ++kk) {
        const int u = gla_unit_of(bid, kk, 0);
        const int b = u / (6 * GNCC), h = (u / GNCC) % 6, cc = u % GNCC;
        gla_put_v(lds, tix, L.v);
        {
            const int dir = wave >> 2, d0 = (wave & 3) * 8;
            float Bv[8], tot[8];
            gla_phase_a(L.gk0, L.gk1, lds, h, dir, d0, lane, Bv, tot);
            float kf[8]; unpack8(L.k, kf);
            LAS unsigned short* KLT = (LAS unsigned short*)(lds + GL_KLT) + (dir * 32 + d0) * GL_VTS + lane;
#pragma unroll
            for (int i = 0; i < 8; ++i) KLT[i * GL_VTS] = (unsigned short)f2bf_u(kf[i] * __expf(tot[i] - Bv[i]));
            if (lane == 0) {
                float* dg = DECG + gla_uidx(dir, b, h, cc) * 32 + d0;
#pragma unroll
                for (int i = 0; i < 8; ++i) dg[i] = __expf(tot[i]);
            }
        }
        if (kk + 1 < ncnt) gla_issue<false>(p, gla_unit_of(bid, kk + 1, 0), tix, L);
        __syncthreads();
        {
            const int dir = wave >> 2, te = wave & 3, fr = lane & 15, fq = lane >> 4;
            unsigned short* out = DSG + gla_uidx(dir, b, h, cc) * 2048;
#pragma unroll
            for (int td = 0; td < 2; ++td) {
                f32x4 acc = {0.f, 0.f, 0.f, 0.f};
#pragma unroll
                for (int ks = 0; ks < 2; ++ks) {
                    const bf16x8 a = *(const LAS bf16x8*)(lds + GL_VT + ((16 * te + fr) * GL_VTS + 32 * ks + 8 * fq) * 2);
                    const bf16x8 bb = *(const LAS bf16x8*)(lds + GL_KLT + ((dir * 32 + 16 * td + fr) * GL_VTS + 32 * ks + 8 * fq) * 2);
                    acc = __builtin_amdgcn_mfma_f32_16x16x32_bf16(a, bb, acc, 0, 0, 0);
                }
#pragma unroll
                for (int r = 0; r < 4; ++r) out[(16 * te + 4 * fq + r) * 32 + 16 * td + fr] = (unsigned short)f2bf_u(acc[r]);
            }
        }
        __syncthreads();
    }
}
template <int NSTEP, int BATCH>
__device__ __forceinline__ void gla_m3_seg(f32x4& S, const unsigned short* DSG, const float* DECG, unsigned short* SSG, size_t base, int cc0, int step, int ed) {
    static_assert(NSTEP % BATCH == 0, "");
#pragma unroll 1
    for (int k0 = 0; k0 < NSTEP; k0 += BATCH) {
        f32x4 d[BATCH], dc[BATCH]; unsigned long long draw[BATCH];
#pragma unroll
        for (int j = 0; j < BATCH; ++j) { const size_t u = base + cc0 + (k0 + j) * step; draw[j] = *(const unsigned long long*)(DSG + u * 2048 + ed); dc[j] = *(const f32x4*)(DECG + u * 32 + (ed & 31)); }
#pragma unroll
        for (int j = 0; j < BATCH; ++j) { const unsigned lo = (unsigned)draw[j], hi = (unsigned)(draw[j] >> 32); d[j] = (f32x4){bflo(lo), bfhi(lo), bflo(hi), bfhi(hi)}; }
#pragma unroll
        for (int j = 0; j < BATCH; ++j) { const size_t u = base + cc0 + (k0 + j) * step;
            *(unsigned long long*)(SSG + u * 2048 + ed) = (unsigned long long)pk2(S.x, S.y) | ((unsigned long long)pk2(S.z, S.w) << 32);
            S = dc[j] * S + d[j]; }
    }
}
__device__ __forceinline__ void gla_m3(long tid, long nth, const unsigned short* DSG, const float* DECG, unsigned short* SSG) {
    for (long i = tid; i < 2L * NB * 6 * 512; i += nth) {
        const int ed = (int)(i & 511) * 4, chain = (int)(i >> 9), dir = chain / (NB * 6);
        const size_t base = (size_t)chain * GNCC;
        float z0 = 0.f; asm volatile("" : "+v"(z0));
        f32x4 S = {z0, z0, z0, z0};
        if (dir == 0) { gla_m3_seg<GCTXC, GCTXC>(S, DSG, DECG, SSG, base, 0, 1, ed); gla_m3_seg<GNCC - GCTXC, 16>(S, DSG, DECG, SSG, base, GCTXC, 1, ed); }
        else { gla_m3_seg<GCTXC, GCTXC>(S, DSG, DECG, SSG, base, GCTXC - 1, -1, ed); gla_m3_seg<GNCC - GCTXC, 16>(S, DSG, DECG, SSG, base, GNCC - 1, -1, ed); }
    }
}
struct GlaPre4 { bf16x8 s[2][2]; unsigned short g[4][2]; };
__device__ __forceinline__ void gla_issue4(const Params& p, int u, int tix, const unsigned short* SSG, GlaPre4& S) {
    const int b = u / (6 * GNCC), h = (u / GNCC) % 6, cc = u % GNCC, row0 = gla_row0(b, cc);
    const int lane = tix & 63, wave = tix >> 6, fr = lane & 15, fq = lane >> 4, ti = wave >> 1, ch = wave & 1;
#pragma unroll
    for (int dir = 0; dir < 2; ++dir)
#pragma unroll
        for (int n = 0; n < 2; ++n) S.s[dir][n] = *(const bf16x8*)(SSG + gla_uidx(dir, b, h, cc) * 2048 + (32 * ch + 16 * n + fr) * 32 + 8 * fq);
#pragma unroll
    for (int r = 0; r < 4; ++r)
#pragma unroll
        for (int n = 0; n < 2; ++n) S.g[r][n] = p.P[(size_t)(row0 + 16 * ti + 4 * fq + r) * LDP + OFF_G + h * 64 + 32 * ch + 16 * n + fr];
}
__device__ __forceinline__ void gla_m4_phase(const Params& p, int l, LAS unsigned char* lds, int tix, int bid, const unsigned short* SSG) {
    const int lane = tix & 63, wave = __builtin_amdgcn_readfirstlane(tix >> 6), fr = lane & 15, fq = lane >> 4;
    gla_stage_w(p, l, lds, tix);
    GlaPre L; GlaPre4 S;
    const int ncnt = gla_count(bid, 1);
    if (ncnt > 0) { const int u0 = gla_unit_of(bid, 0, 1); gla_issue<true>(p, u0, tix, L); gla_issue4(p, u0, tix, SSG, S); }
    __syncthreads();
#pragma unroll 1
    for (int kk = 0; kk < ncnt; ++kk) {
        const int u = gla_unit_of(bid, kk, 1);
        const int b = u / (6 * GNCC), h = (u / GNCC) % 6, cc = u % GNCC, row0 = gla_row0(b, cc);
        gla_put_v(lds, tix, L.v);
        {
            const int dir = wave >> 2, d0 = (wave & 3) * 8;
            float Bv[8], tot[8];
            gla_phase_a(L.gk0, L.gk1, lds, h, dir, d0, lane, Bv, tot);
            float kf[8], qf[8]; unpack8(L.k, kf); unpack8(L.q, qf);
            float qd[8], kd[8];
#pragma unroll
            for (int i = 0; i < 8; ++i) { qd[i] = qf[i] * __expf(Bv[i]) * 0.17677669529663687f; kd[i] = kf[i] * __expf(-Bv[i]); }
            v4u w; w.x = pk2(qd[0], qd[1]); w.y = pk2(qd[2], qd[3]); w.z = pk2(qd[4], qd[5]); w.w = pk2(qd[6], qd[7]);
            *(LAS v4u*)(lds + GL_AC + (lane * GL_ACS + 128 + 32 * dir + d0) * 2) = w;
            w.x = pk2(kd[0], kd[1]); w.y = pk2(kd[2], kd[3]); w.z = pk2(kd[4], kd[5]); w.w = pk2(kd[6], kd[7]);
            *(LAS v4u*)(lds + GL_KD + ((dir * 64 + lane) * GL_KDS + d0) * 2) = w;
        }
        const bool more = kk + 1 < ncnt;
        if (more) gla_issue<true>(p, gla_unit_of(bid, kk + 1, 1), tix, L);
        __syncthreads();
        {
            const int dir = wave >> 2, ti = wave & 3;
            const bf16x8 a = *(const LAS bf16x8*)(lds + GL_AC + ((16 * ti + fr) * GL_ACS + 128 + 32 * dir + 8 * fq) * 2);
            LAS unsigned short* AC = (LAS unsigned short*)(lds + GL_AC);
#pragma unroll
            for (int tj = 0; tj < 4; ++tj) {
                const bf16x8 bb = *(const LAS bf16x8*)(lds + GL_KD + ((dir * 64 + 16 * tj + fr) * GL_KDS + 8 * fq) * 2);
                f32x4 acc = {0.f, 0.f, 0.f, 0.f};
                acc = __builtin_amdgcn_mfma_f32_16x16x32_bf16(a, bb, acc, 0, 0, 0);
                const int j = 16 * tj + fr;
#pragma unroll
                for (int r = 0; r < 4; ++r) { const int i = 16 * ti + 4 * fq + r; const bool keep = dir ? (j >= i) : (j <= i);
                    AC[i * GL_ACS + 64 * dir + j] = (unsigned short)f2bf_u(keep ? acc[r] : 0.f); }
            }
        }
        __syncthreads();
        f32x4 acc[2] = { {0.f, 0.f, 0.f, 0.f}, {0.f, 0.f, 0.f, 0.f} };
        const int ti = wave >> 1, ch = wave & 1;
        {
            bf16x8 bv[2][2];
#pragma unroll
            for (int ks = 0; ks < 2; ++ks)
#pragma unroll
                for (int n = 0; n < 2; ++n) bv[ks][n] = *(const LAS bf16x8*)(lds + GL_VT + ((32 * ch + 16 * n + fr) * GL_VTS + 32 * ks + 8 * fq) * 2);
#pragma unroll
            for (int part = 0; part < 2; ++part)
#pragma unroll
                for (int ks = 0; ks < 2; ++ks) {
                    const bf16x8 a = *(const LAS bf16x8*)(lds + GL_AC + ((16 * ti + fr) * GL_ACS + 64 * part + 32 * ks + 8 * fq) * 2);
#pragma unroll
                    for (int n = 0; n < 2; ++n) acc[n] = __builtin_amdgcn_mfma_f32_16x16x32_bf16(a, bv[ks][n], acc[n], 0, 0, 0);
                }
#pragma unroll
            for (int dir = 0; dir < 2; ++dir) {
                const bf16x8 a = *(const LAS bf16x8*)(lds + GL_AC + ((16 * ti + fr) * GL_ACS + 128 + 32 * dir + 8 * fq) * 2);
#pragma unroll
                for (int n = 0; n < 2; ++n) acc[n] = __builtin_amdgcn_mfma_f32_16x16x32_bf16(a, S.s[dir][n], acc[n], 0, 0, 0);
            }
            LAS float* PART = (LAS float*)(lds + GL_PART);
#pragma unroll
            for (int r = 0; r < 4; ++r) {
                float ss = acc[0][r] * acc[0][r] + acc[1][r] * acc[1][r];
                ss = sum16(ss);
                if (fr == 0) PART[(16 * ti + 4 * fq + r) * 2 + ch] = ss;
            }
        }
        __syncthreads();
        {
            const LAS float* PART = (const LAS float*)(lds + GL_PART);
#pragma unroll
            for (int r = 0; r < 4; ++r) {
                const int i = 16 * ti + 4 * fq + r;
                const float rs = 1.0f / sqrtf((PART[i * 2] + PART[i * 2 + 1]) * (1.0f / 64.0f) + EPSV);
#pragma unroll
                for (int n = 0; n < 2; ++n) {
                    const int e = 32 * ch + 16 * n + fr;
                    const float g = bflo((unsigned)S.g[r][n]);
                    stact(p.Y + (size_t)(row0 + i) * DM + h * 64 + e, acc[n][r] * rs * p.gla_norm_w[l * 64 + e] * (g / (1.0f + __expf(-g))));
                }
            }
        }
        if (more) gla_issue4(p, gla_unit_of(bid, kk + 1, 1), tix, SSG, S);
    }
    __syncthreads();
}

#define SNCC ((CTX + SEQ) / 128)
#define SCTXC (CTX / 128)
#define SSD_UNITS (NB * 2 * SNCC)
constexpr int SD_CM = 0, SD_BM = 34816, SD_XT = 69632, SD_HS = 121856, SD_DTL = 139264, SD_CSL = 142336, SD_TOT = 145408, SD_HS2OFF = 145440 - 121856;
constexpr int SD_S = 136;
static_assert(SD_HS + SD_HS2OFF + 64 * 136 * 2 <= LDS_BYTES - 64, "SSD LDS map");
__device__ __forceinline__ int ssd_row(int b, int cc, int i) {
    if (cc < SCTXC) return BL + b * CTX + cc * 128 + i;
    return b * SEQ + colmajor_tok(0, (cc - SCTXC) * 128 + i);
}
__device__ __forceinline__ size_t ssd_chain(int dir, int b, int head) { return ((size_t)dir * NB + b) * 6 + head; }
template <bool TR_B, bool WITH_C>
__device__ __forceinline__ void ssd_stage(const Params& p, int l, LAS unsigned char* lds, int b, int g, int cc, int tix) {
    const int sidx = cc < SCTXC ? NB + b : b, L = seq_len(sidx), r0 = seq_row0(sidx), pos0 = (cc < SCTXC ? cc : cc - SCTXC) * 128;
    constexpr int NQ = WITH_C ? 14 : 10;
    LAS float* CW = (LAS float*)(lds + SD_HS);
    for (int i = tix; i < 4 * NQ * 32; i += 512) {
        const int k = i / (NQ * 32), cl = i % (NQ * 32), q = cl >> 5;
        const int col = (q < 6 ? g * 192 + q * 32 : (q < 10 ? 384 + g * 128 + (q - 6) * 32 : 640 + g * 128 + (q - 10) * 32)) + (cl & 31);
        CW[i] = k < 3 ? p.ssd_conv_w[(size_t)l * 3 * 896 + k * 896 + col] : p.ssd_conv_b[(size_t)l * 896 + col];
    }
    __syncthreads();
    for (int item = tix; item < 128 * NQ; item += 512) {
        const int i = item & 127, q = __builtin_amdgcn_readfirstlane(item >> 7);
        const int col0 = q < 6 ? g * 192 + q * 32 : (q < 10 ? 384 + g * 128 + (q - 6) * 32 : 640 + g * 128 + (q - 10) * 32);
        const int pos = pos0 + i;
        const act_t* rc = p.P + (size_t)(r0 + colmajor_tok(sidx, pos)) * LDP + OFF_XBC + col0;
        const bool hp = pos > 0, hn = pos + 1 < L;
        const act_t* rp = hp ? p.P + (size_t)(r0 + colmajor_tok(sidx, pos - 1)) * LDP + OFF_XBC + col0 : rc;
        const act_t* rn = hn ? p.P + (size_t)(r0 + colmajor_tok(sidx, pos + 1)) * LDP + OFF_XBC + col0 : rc;
        v4u raw[3][4];
#pragma unroll
        for (int o = 0; o < 4; ++o) { raw[0][o] = *(const v4u*)(rp + 8 * o); raw[1][o] = *(const v4u*)(rc + 8 * o); raw[2][o] = *(const v4u*)(rn + 8 * o); }
        const LAS float* cw = CW + q * 32;
#pragma unroll
        for (int o = 0; o < 4; ++o) {
            float xp[8], xc[8], xn[8], y[8];
            unpack8(raw[0][o], xp); unpack8(raw[1][o], xc); unpack8(raw[2][o], xn);
#pragma unroll
            for (int h2 = 0; h2 < 2; ++h2) {
                const f32x4 w0 = *(const LAS f32x4*)(cw + 8 * o + 4 * h2), w1 = *(const LAS f32x4*)(cw + NQ * 32 + 8 * o + 4 * h2);
                const f32x4 w2 = *(const LAS f32x4*)(cw + 2 * NQ * 32 + 8 * o + 4 * h2), bs = *(const LAS f32x4*)(cw + 3 * NQ * 32 + 8 * o + 4 * h2);
#pragma unroll
                for (int e4 = 0; e4 < 4; ++e4) {
                    const int e = 4 * h2 + e4;
                    const float vp = hp ? xp[e] : 0.f, vn = hn ? xn[e] : 0.f;
                    const float a = bs[e4] + w1[e4] * xc[e] + w0[e4] * vp + w2[e4] * vn;
                    y[e] = a * __builtin_amdgcn_rcpf(1.0f + __expf(-a));
                }
            }
            if (q < 6) {
                LAS unsigned short* d = (LAS unsigned short*)(lds + SD_XT) + (q * 32 + 8 * o) * SD_S + i;
#pragma unroll
                for (int e = 0; e < 8; ++e) d[e * SD_S] = (unsigned short)f2bf_u(y[e]);
            } else if (q < 10) {
                if (TR_B) { LAS unsigned short* d = (LAS unsigned short*)(lds + SD_BM) + ((q - 6) * 32 + 8 * o) * SD_S + i;
#pragma unroll
                    for (int e = 0; e < 8; ++e) d[e * SD_S] = (unsigned short)f2bf_u(y[e]);
                } else { v4u w; w.x = pk2(y[0], y[1]); w.y = pk2(y[2], y[3]); w.z = pk2(y[4], y[5]); w.w = pk2(y[6], y[7]);
                    *(LAS v4u*)(lds + SD_BM + (i * SD_S + (q - 6) * 32 + 8 * o) * 2) = w; }
            } else { v4u w; w.x = pk2(y[0], y[1]); w.y = pk2(y[2], y[3]); w.z = pk2(y[4], y[5]); w.w = pk2(y[6], y[7]);
                *(LAS v4u*)(lds + SD_CM + (i * SD_S + (q - 10) * 32 + 8 * o) * 2) = w; }
        }
    }
}
__device__ __forceinline__ void ssd_scans(const Params& p, int l, LAS unsigned char* lds, int b, int g, int cc, int wave, int lane) {
    if (wave < 6) {
        const int hg = wave % 3, dir = wave / 3, head = g * 3 + hg;
        const float bias = (dir ? p.ssd_dt_bias_b : p.ssd_dt_bias_f)[l * 6 + head];
        const float A = -__expf((dir ? p.ssd_a_log_b : p.ssd_a_log_f)[l * 6 + head]);
        float dt[2], a[2];
#pragma unroll
        for (int k = 0; k < 2; ++k) {
            const float x = ldact(p.P + (size_t)ssd_row(b, cc, 2 * lane + k) * LDP + (dir ? OFF_DTB : OFF_DTF) + head) + bias;
            dt[k] = fmaxf(x, 0.f) + log1pf(__expf(-fabsf(x))); a[k] = A * dt[k];
        }
        const float v = wave_scan_incl(a[0] + a[1], lane);
        const float tot = lane63(v);
        const float pf1 = v, pf0 = v - a[1];
        LAS float* DTL = (LAS float*)(lds + SD_DTL) + wave * 128 + 2 * lane; LAS float* CSL = (LAS float*)(lds + SD_CSL) + wave * 128 + 2 * lane;
        DTL[0] = dt[0]; DTL[1] = dt[1];
        CSL[0] = dir ? tot - pf0 + a[0] : pf0; CSL[1] = dir ? tot - pf1 + a[1] : pf1;
        if (lane == 0) ((LAS float*)(lds + SD_TOT))[wave] = tot;
    }
}
__device__ __forceinline__ void ssd_s2_unit(const Params& p, int l, LAS unsigned char* lds, int u, int tix, unsigned short* DSS, float* DECS) {
    const int b = u / (2 * SNCC), g = (u / SNCC) & 1, cc = u % SNCC;
    const int lane = tix & 63, wave = __builtin_amdgcn_readfirstlane(tix >> 6), fr = lane & 15, fq = lane >> 4;
    ssd_scans(p, l, lds, b, g, cc, wave, lane);
    ssd_stage<true, false>(p, l, lds, b, g, cc, tix);
    __syncthreads();
    if (tix < 6) DECS[ssd_chain(tix / 3, b, g * 3 + tix % 3) * SNCC + cc] = __expf(((const LAS float*)(lds + SD_TOT))[tix]);
#pragma unroll 1
    for (int k = 0; k < 3; ++k) {
        const int c3 = wave + 8 * k, tp = c3 & 3, combo = c3 >> 2, hg = combo % 3, dir = combo / 3;
        const LAS float* DTL = (const LAS float*)(lds + SD_DTL) + combo * 128; const LAS float* CSL = (const LAS float*)(lds + SD_CSL) + combo * 128;
        const float tot = ((const LAS float*)(lds + SD_TOT))[combo];
        bf16x8 a[4];
#pragma unroll
        for (int ks = 0; ks < 4; ++ks) {
            const int j0 = 32 * ks + 8 * fq;
            float xf[8]; unpack8(*(const LAS v4u*)(lds + SD_XT + ((hg * 64 + 16 * tp + fr) * SD_S + j0) * 2), xf);
            const f32x4 d0 = *(const LAS f32x4*)(DTL + j0), d1 = *(const LAS f32x4*)(DTL + j0 + 4), c0 = *(const LAS f32x4*)(CSL + j0), c1 = *(const LAS f32x4*)(CSL + j0 + 4);
            xf[0] *= d0.x * __expf(tot - c0.x); xf[1] *= d0.y * __expf(tot - c0.y); xf[2] *= d0.z * __expf(tot - c0.z); xf[3] *= d0.w * __expf(tot - c0.w);
            xf[4] *= d1.x * __expf(tot - c1.x); xf[5] *= d1.y * __expf(tot - c1.y); xf[6] *= d1.z * __expf(tot - c1.z); xf[7] *= d1.w * __expf(tot - c1.w);
            v4u w; w.x = pk2(xf[0], xf[1]); w.y = pk2(xf[2], xf[3]); w.z = pk2(xf[4], xf[5]); w.w = pk2(xf[6], xf[7]);
            a[ks] = __builtin_bit_cast(bf16x8, w);
        }
        unsigned short* out = DSS + (ssd_chain(dir, b, g * 3 + hg) * SNCC + cc) * 8192;
#pragma unroll
        for (int tn = 0; tn < 8; ++tn) {
            f32x4 acc = {0.f, 0.f, 0.f, 0.f};
#pragma unroll
            for (int ks = 0; ks < 4; ++ks) {
                const bf16x8 bb = *(const LAS bf16x8*)(lds + SD_BM + ((16 * tn + fr) * SD_S + 32 * ks + 8 * fq) * 2);
                acc = __builtin_amdgcn_mfma_f32_16x16x32_bf16(bb, a[ks], acc, 0, 0, 0);
            }
            *(unsigned long long*)(out + (16 * tp + fr) * 128 + 16 * tn + 4 * fq) = (unsigned long long)pk2(acc[0], acc[1]) | ((unsigned long long)pk2(acc[2], acc[3]) << 32);
        }
    }
    __syncthreads();
}
template <int NSTEP, int BATCH>
__device__ __forceinline__ void ssd_s3_seg(float (&S)[8], unsigned short* DSS, const float* DECS, size_t base, int cc0, int step, int el) {
    static_assert(NSTEP % BATCH == 0, "");
#pragma unroll 1
    for (int k0 = 0; k0 < NSTEP; k0 += BATCH) {
        v4u d[BATCH]; float dc[BATCH];
#pragma unroll
        for (int j = 0; j < BATCH; ++j) { const size_t u = base + cc0 + (k0 + j) * step; d[j] = *(const v4u*)(DSS + u * 8192 + el); dc[j] = DECS[u]; }
#pragma unroll
        for (int j = 0; j < BATCH; ++j) { const size_t u = base + cc0 + (k0 + j) * step;
            v4u w; w.x = pk2(S[0], S[1]); w.y = pk2(S[2], S[3]); w.z = pk2(S[4], S[5]); w.w = pk2(S[6], S[7]);
            *(v4u*)(DSS + u * 8192 + el) = w;
            float df[8]; unpack8(d[j], df);
#pragma unroll
            for (int e = 0; e < 8; ++e) S[e] = S[e] * dc[j] + df[e]; }
    }
}
__device__ __forceinline__ void ssd_s3(long tid, long nth, unsigned short* DSS, const float* DECS) {
    for (long i = tid; i < 2L * NB * 6 * 1024; i += nth) {
        const int el = (int)(i & 1023) * 8, chain = (int)(i >> 10), dir = chain / (NB * 6);
        const size_t base = (size_t)chain * SNCC;
        float z0 = 0.f; asm volatile("" : "+v"(z0));
        float S[8] = {z0, z0, z0, z0, z0, z0, z0, z0};
        if (dir == 0) { ssd_s3_seg<SCTXC, SCTXC>(S, DSS, DECS, base, 0, 1, el); ssd_s3_seg<SNCC - SCTXC, 8>(S, DSS, DECS, base, SCTXC, 1, el); }
        else { ssd_s3_seg<SCTXC, SCTXC>(S, DSS, DECS, base, SCTXC - 1, -1, el); ssd_s3_seg<SNCC - SCTXC, 8>(S, DSS, DECS, base, SNCC - 1, -1, el); }
    }
}
__device__ __forceinline__ void ssd_load_h(const unsigned short* HSS, int b, int head, int cc, int tix, v4u (&h)[2][2]) {
#pragma unroll
    for (int dir = 0; dir < 2; ++dir) {
        const unsigned short* hsrc = HSS + (ssd_chain(dir, b, head) * SNCC + cc) * 8192 + (tix >> 3) * 128 + (tix & 7) * 16;
        h[dir][0] = *(const v4u*)hsrc; h[dir][1] = *(const v4u*)(hsrc + 8);
    }
}
__device__ __forceinline__ void ssd_s4_unit(const Params& p, int l, LAS unsigned char* lds, int u, int tix, const unsigned short* HSS) {
    const int b = u / (2 * SNCC), g = (u / SNCC) & 1, cc = u % SNCC;
    const int lane = tix & 63, wave = __builtin_amdgcn_readfirstlane(tix >> 6), fr = lane & 15, fq = lane >> 4;
    ssd_scans(p, l, lds, b, g, cc, wave, lane);
    ssd_stage<false, true>(p, l, lds, b, g, cc, tix);
    __syncthreads();
    LAS unsigned char* cm_rd = lds + SD_CM + ((16 * wave + fr) * SD_S + 8 * fq) * 2;
    LAS unsigned char* bm_rd = lds + SD_BM + (fr * SD_S + 8 * fq) * 2;
    LAS unsigned char* m_rd = lds + SD_BM + ((16 * wave + fr) * SD_S + 8 * fq) * 2;
    LAS unsigned char* m_wr = lds + SD_BM + ((16 * wave + 4 * fq) * SD_S + fr) * 2;
    LAS unsigned char* xt_rd = lds + SD_XT + (fr * SD_S + 8 * fq) * 2;
    LAS unsigned char* hs_rd = lds + SD_HS + (fr * SD_S + 8 * fq) * 2;
    LAS unsigned char* hs_wr = lds + SD_HS + ((tix >> 3) * SD_S + (tix & 7) * 16) * 2;
    LAS unsigned char* sc_j = lds + SD_DTL + fr * 4;
    LAS unsigned char* sc_i = lds + SD_DTL + (16 * wave + 4 * fq) * 4;
    asm volatile("" : "+v"(cm_rd), "+v"(bm_rd), "+v"(m_rd), "+v"(m_wr), "+v"(xt_rd), "+v"(hs_rd), "+v"(hs_wr), "+v"(sc_j), "+v"(sc_i));
    f32x4 cb[8];
    bf16x8 ca[4];
#pragma unroll
    for (int ks = 0; ks < 4; ++ks) ca[ks] = *(const LAS bf16x8*)(cm_rd + 64 * ks);
#pragma unroll
    for (int tj = 0; tj < 8; ++tj) {
        cb[tj] = (f32x4){0.f, 0.f, 0.f, 0.f};
#pragma unroll
        for (int ks = 0; ks < 4; ++ks) {
            const bf16x8 bb = *(const LAS bf16x8*)(bm_rd + (16 * tj * SD_S + 32 * ks) * 2);
            cb[tj] = __builtin_amdgcn_mfma_f32_16x16x32_bf16(ca[ks], bb, cb[tj], 0, 0, 0);
        }
    }
    __syncthreads();
    f32x4 yacc[3][4];
#pragma unroll
    for (int hg = 0; hg < 3; ++hg)
#pragma unroll
        for (int tp = 0; tp < 4; ++tp) yacc[hg][tp] = (f32x4){0.f, 0.f, 0.f, 0.f};
#pragma unroll
    for (int hg = 0; hg < 3; ++hg) {
        v4u hreg[2][2];
        ssd_load_h(HSS, b, g * 3 + hg, cc, tix, hreg);
        __builtin_amdgcn_sched_barrier(0);
        float csfi[4], csbi[4];
#pragma unroll
        for (int r = 0; r < 4; ++r) { csfi[r] = *(const LAS float*)(sc_i + 3072 + hg * 512 + 4 * r); csbi[r] = *(const LAS float*)(sc_i + 3072 + (3 + hg) * 512 + 4 * r); }
#pragma unroll
        for (int tj = 0; tj < 8; ++tj) {
            const int j = 16 * tj + fr;
            const float csfj = *(const LAS float*)(sc_j + 3072 + hg * 512 + 64 * tj), csbj = *(const LAS float*)(sc_j + 3072 + (3 + hg) * 512 + 64 * tj);
            const float dtfj = *(const LAS float*)(sc_j + hg * 512 + 64 * tj), dtbj = *(const LAS float*)(sc_j + (3 + hg) * 512 + 64 * tj);
#pragma unroll
            for (int r = 0; r < 4; ++r) { const int i = 16 * wave + 4 * fq + r;
                const float arg = (j <= i) ? csfi[r] - csfj : csbi[r] - csbj;
                const float wgt = (j < i) ? dtfj : ((j > i) ? dtbj : dtfj + dtbj);
                *(LAS unsigned short*)(m_wr + (r * SD_S + 16 * tj) * 2) = (unsigned short)f2bf_u(cb[tj][r] * __expf(fminf(arg, 0.f)) * wgt); }
            __builtin_amdgcn_sched_barrier(0);
        }
        __builtin_amdgcn_sched_barrier(0);
#pragma unroll
        for (int dir = 0; dir < 2; ++dir) {
            *(LAS v4u*)(hs_wr + dir * SD_HS2OFF) = hreg[dir][0]; *(LAS v4u*)(hs_wr + dir * SD_HS2OFF + 16) = hreg[dir][1];
        }
        __syncthreads();
        f32x4 tmp[4];
#pragma unroll
        for (int tp = 0; tp < 4; ++tp) tmp[tp] = (f32x4){0.f, 0.f, 0.f, 0.f};
#pragma unroll
        for (int ks = 0; ks < 4; ++ks) {
            const bf16x8 am = *(const LAS bf16x8*)(m_rd + 64 * ks);
#pragma unroll
            for (int tp = 0; tp < 4; ++tp) {
                const bf16x8 bx = *(const LAS bf16x8*)(xt_rd + ((hg * 64 + 16 * tp) * SD_S + 32 * ks) * 2);
                yacc[hg][tp] = __builtin_amdgcn_mfma_f32_16x16x32_bf16(am, bx, yacc[hg][tp], 0, 0, 0);
                const bf16x8 bhf = *(const LAS bf16x8*)(hs_rd + (16 * tp * SD_S + 32 * ks) * 2);
                tmp[tp] = __builtin_amdgcn_mfma_f32_16x16x32_bf16(ca[ks], bhf, tmp[tp], 0, 0, 0);
            }
        }
#pragma unroll
        for (int r = 0; r < 4; ++r) { const float ef = __expf(csfi[r]);
#pragma unroll
            for (int tp = 0; tp < 4; ++tp) { yacc[hg][tp][r] += ef * tmp[tp][r]; tmp[tp][r] = 0.f; } }
#pragma unroll
        for (int ks = 0; ks < 4; ++ks)
#pragma unroll
            for (int tp = 0; tp < 4; ++tp) {
                const bf16x8 bhb = *(const LAS bf16x8*)(hs_rd + SD_HS2OFF + (16 * tp * SD_S + 32 * ks) * 2);
                tmp[tp] = __builtin_amdgcn_mfma_f32_16x16x32_bf16(ca[ks], bhb, tmp[tp], 0, 0, 0);
            }
#pragma unroll
        for (int r = 0; r < 4; ++r) { const float eb = __expf(csbi[r]);
#pragma unroll
            for (int tp = 0; tp < 4; ++tp) yacc[hg][tp][r] += eb * tmp[tp][r]; }
        __syncthreads();
    }
#pragma unroll
    for (int hg = 0; hg < 3; ++hg) {
        const float dcoef = p.ssd_d[l * 6 + g * 3 + hg];
#pragma unroll
        for (int tp = 0; tp < 4; ++tp) {
            const int pc = hg * 64 + 16 * tp + fr;
#pragma unroll
            for (int r = 0; r < 4; ++r)
                yacc[hg][tp][r] += dcoef * bflo((unsigned)((const LAS unsigned short*)(lds + SD_XT))[pc * SD_S + 16 * wave + 4 * fq + r]);
        }
    }
    __syncthreads();
    {
        LAS float* YL = (LAS float*)lds;
#pragma unroll
        for (int hg = 0; hg < 3; ++hg)
#pragma unroll
            for (int tp = 0; tp < 4; ++tp)
#pragma unroll
                for (int r = 0; r < 4; ++r) YL[(16 * wave + 4 * fq + r) * 196 + hg * 64 + 16 * tp + fr] = yacc[hg][tp][r];
        const float nw0 = p.ssd_norm_w[l * 384 + g * 192 + lane], nw1 = p.ssd_norm_w[l * 384 + g * 192 + 64 + lane], nw2 = p.ssd_norm_w[l * 384 + g * 192 + 128 + lane];
#pragma unroll 1
        for (int r8 = 0; r8 < 16; r8 += 8) {
            unsigned short zr[8][3];
#pragma unroll
            for (int k = 0; k < 8; ++k) {
                const act_t* zp = p.P + (size_t)ssd_row(b, cc, 16 * wave + r8 + k) * LDP + OFF_Z + g * 192 + lane;
                zr[k][0] = zp[0]; zr[k][1] = zp[64]; zr[k][2] = zp[128];
            }
#pragma unroll
            for (int k = 0; k < 8; ++k) {
                const int i = 16 * wave + r8 + k;
                const float z0 = bflo(zr[k][0]), z1 = bflo(zr[k][1]), z2 = bflo(zr[k][2]);
                const float v0 = YL[i * 196 + lane] * (z0 / (1.0f + __expf(-z0))), v1 = YL[i * 196 + 64 + lane] * (z1 / (1.0f + __expf(-z1))), v2 = YL[i * 196 + 128 + lane] * (z2 / (1.0f + __expf(-z2)));
                const float rs = 1.0f / sqrtf(wave_sum(v0 * v0 + v1 * v1 + v2 * v2, lane) * (1.0f / 192.0f) + EPSV);
                act_t* yp = p.Y + (size_t)ssd_row(b, cc, i) * DM + 640 + g * 192 + lane;
                stact(yp, v0 * rs * nw0); stact(yp + 64, v1 * rs * nw1); stact(yp + 128, v2 * rs * nw2);
            }
        }
    }
    __syncthreads();
}

typedef float f32x16 __attribute__((ext_vector_type(16)));
constexpr int HY_CP = 0, HY_MOFF = 4352, HY_U = 17920, HY_US = 264, HY_OUT = 85504;
__device__ __forceinline__ void hy_u8(const Params& p, int l, int b, int t, int col0, float (&y)[8]) {
    const act_t* rc = p.P + (size_t)(b * SEQ + t) * LDP + OFF_HY + col0;
    const float* w = p.hy_short_w + (size_t)l * 3 * 768 + col0; const float* bs = p.hy_short_b + (size_t)l * 768 + col0;
    const bool hp = t > 0, hn = t + 1 < SEQ;
    float xc[8], xp[8], xn[8];
    unpack8(*(const v4u*)rc, xc); unpack8(*(const v4u*)(hp ? rc - LDP : rc), xp); unpack8(*(const v4u*)(hn ? rc + LDP : rc), xn);
#pragma unroll
    for (int e = 0; e < 8; ++e) y[e] = bs[e] + w[768 + e] * xc[e] + w[e] * (hp ? xp[e] : 0.f) + w[2 * 768 + e] * (hn ? xn[e] : 0.f);
}
__device__ __forceinline__ void hy_ctx_conv(const Params& p, int l, long tid, long nth) {
    for (long i = tid; i < (long)NB * (CTX / 8) * 256; i += nth) {
        const int c = (int)(i & 255), to = (int)((i >> 8) % (CTX / 8)), sb = (int)(i / (256L * (CTX / 8)));
        const int t0 = 8 * to, r0 = BL + sb * CTX;
        const float* hf = p.HFC + (size_t)l * CTX * 256 + c; const float* vx = p.VX + (size_t)r0 * 256 + c;
        float acc[8], hw[15];
#pragma unroll
        for (int e = 0; e < 8; ++e) acc[e] = 0.f;
#pragma unroll
        for (int k = 1; k <= 7; ++k) { const int idx = t0 + CTX / 2 + k; const float v = hf[(size_t)(idx < CTX ? idx : CTX - 1) * 256]; hw[k + 7] = idx < CTX ? v : 0.f; }
#pragma unroll 1
        for (int jb = 0; jb < CTX / 8; ++jb) {
            const int base = t0 + CTX / 2 - 8 * jb;
            float vv[8];
#pragma unroll
            for (int jj = 0; jj < 8; ++jj) vv[jj] = vx[(size_t)(8 * jb + jj) * 256];
#pragma unroll
            for (int k = -7; k <= 0; ++k) { const int idx = base + k; const int ic = idx < 0 ? 0 : (idx >= CTX ? CTX - 1 : idx);
                const float v = hf[(size_t)ic * 256]; hw[k + 7] = (idx >= 0 && idx < CTX) ? v : 0.f; }
#pragma unroll
            for (int jj = 0; jj < 8; ++jj)
#pragma unroll
                for (int e = 0; e < 8; ++e) acc[e] += hw[e - jj + 7] * vv[jj];
#pragma unroll
            for (int k = 7; k >= 1; --k) hw[k + 7] = hw[k - 8 + 7];
        }
        const int s = NB + sb;
        float x0[8], vb[8];
#pragma unroll
        for (int e = 0; e < 8; ++e) { x0[e] = hy_u(p, l, s, t0 + e, c); vb[e] = vx[(size_t)(t0 + e) * 256]; }
        const float hb = p.hy_bias[l * 256 + c];
#pragma unroll
        for (int e = 0; e < 8; ++e) stact(p.Y + (size_t)(r0 + t0 + e) * DM + 384 + c, (acc[e] + vb[e] * hb) * x0[e]);
    }
}
constexpr int HY_HW = 81920;
__device__ __forceinline__ void hy_stage_w(const Params& p, int l, LAS unsigned char* lds, int tix) {
    LAS float* HW = (LAS float*)(lds + HY_HW);
    for (int i = tix; i < 4 * 768; i += 512) HW[i] = i < 3 * 768 ? p.hy_short_w[(size_t)l * 3 * 768 + i] : p.hy_short_b[(size_t)l * 768 + (i - 3 * 768)];
    __syncthreads();
}
__device__ __forceinline__ void hy_conv8(const v4u rp, const v4u rc, const v4u rn, bool hp, bool hn, const LAS float* hw, float (&y)[8]) {
    float xp[8], xc[8], xn[8]; unpack8(rp, xp); unpack8(rc, xc); unpack8(rn, xn);
#pragma unroll
    for (int h2 = 0; h2 < 2; ++h2) {
        const f32x4 w0 = *(const LAS f32x4*)(hw + 4 * h2), w1 = *(const LAS f32x4*)(hw + 768 + 4 * h2), w2 = *(const LAS f32x4*)(hw + 1536 + 4 * h2), bs = *(const LAS f32x4*)(hw + 2304 + 4 * h2);
#pragma unroll
        for (int e4 = 0; e4 < 4; ++e4) { const int e = 4 * h2 + e4; y[e] = bs[e4] + w1[e4] * xc[e] + w0[e4] * (hp ? xp[e] : 0.f) + w2[e4] * (hn ? xn[e] : 0.f); }
    }
}
__device__ __forceinline__ void hy_h1_unit(const Params& p, int l, LAS unsigned char* lds, int u, int tix) {
    const int b = u / (SEQ / 64), t0 = (u % (SEQ / 64)) * 64;
    const int t = tix & 63, cg = __builtin_amdgcn_readfirstlane(tix >> 6);
    LAS unsigned short* T = (LAS unsigned short*)lds;
    const int tok = t0 + t; const bool hp = tok > 0, hn = tok + 1 < SEQ;
    const act_t* rc = p.P + (size_t)(b * SEQ + tok) * LDP + OFF_HY + 32 * cg; const act_t* rp = hp ? rc - LDP : rc; const act_t* rn = hn ? rc + LDP : rc;
    v4u raw[4][2][3];
#pragma unroll
    for (int o = 0; o < 4; ++o)
#pragma unroll
        for (int gq = 0; gq < 2; ++gq) { const int col = 256 * (gq + 1) + 8 * o; raw[o][gq][0] = *(const v4u*)(rp + col); raw[o][gq][1] = *(const v4u*)(rc + col); raw[o][gq][2] = *(const v4u*)(rn + col); }
    const LAS float* HW = (const LAS float*)(lds + HY_HW) + 32 * cg;
#pragma unroll
    for (int o = 0; o < 4; ++o) {
        float x1[8], v[8];
        hy_conv8(raw[o][0][0], raw[o][0][1], raw[o][0][2], hp, hn, HW + 256 + 8 * o, x1);
        hy_conv8(raw[o][1][0], raw[o][1][1], raw[o][1][2], hp, hn, HW + 512 + 8 * o, v);
#pragma unroll
        for (int e = 0; e < 8; ++e) T[(32 * cg + 8 * o + e) * 72 + t] = (unsigned short)f2bf_u(v[e] * x1[e]);
    }
    __syncthreads();
    {
        const int c = tix >> 1, half = tix & 1;
        unsigned short* dst = p.VXT + ((size_t)(b * 256 + c)) * SEQ + t0 + 32 * half;
#pragma unroll
        for (int k = 0; k < 4; ++k) *(v4u*)(dst + 8 * k) = *(const LAS v4u*)(lds + (c * 72 + 32 * half + 8 * k) * 2);
    }
    __syncthreads();
}
template <int ALPHA>
__device__ __forceinline__ bf16x8 hy_afrag(const LAS unsigned char* a) {
    constexpr int SFT = 8 - ALPHA, SIG = SFT >> 1, HALF = SFT & 1;
    const v4u Y = *(const LAS v4u*)(a + 16);
    if constexpr (ALPHA == 0) { return __builtin_bit_cast(bf16x8, Y); }
    else {
        const v4u X = *(const LAS v4u*)a;
        const unsigned W[9] = { X.x, X.y, X.z, X.w, Y.x, Y.y, Y.z, Y.w, 0u };
        v4u o;
        o.x = HALF ? __builtin_amdgcn_alignbit(W[SIG + 1], W[SIG + 0], 16) : W[SIG + 0];
        o.y = HALF ? __builtin_amdgcn_alignbit(W[SIG + 2], W[SIG + 1], 16) : W[SIG + 1];
        o.z = HALF ? __builtin_amdgcn_alignbit(W[SIG + 3], W[SIG + 2], 16) : W[SIG + 2];
        o.w = HALF ? __builtin_amdgcn_alignbit(W[SIG + 4], W[SIG + 3], 16) : W[SIG + 3];
        return __builtin_bit_cast(bf16x8, o);
    }
}
struct HyFrags { v4u ax[4], ay[4], a4x, a4y; bf16x8 b[5]; };
template <int ALPHA>
__device__ __forceinline__ bf16x8 hy_afrag_xy(const v4u X, const v4u Y) {
    constexpr int SFT = 8 - ALPHA, SIG = SFT >> 1, HALF = SFT & 1;
    if constexpr (ALPHA == 0) { return __builtin_bit_cast(bf16x8, Y); }
    else {
        const unsigned W[9] = { X.x, X.y, X.z, X.w, Y.x, Y.y, Y.z, Y.w, 0u };
        v4u o;
        o.x = HALF ? __builtin_amdgcn_alignbit(W[SIG + 1], W[SIG + 0], 16) : W[SIG + 0];
        o.y = HALF ? __builtin_amdgcn_alignbit(W[SIG + 2], W[SIG + 1], 16) : W[SIG + 1];
        o.z = HALF ? __builtin_amdgcn_alignbit(W[SIG + 3], W[SIG + 2], 16) : W[SIG + 2];
        o.w = HALF ? __builtin_amdgcn_alignbit(W[SIG + 4], W[SIG + 3], 16) : W[SIG + 3];
        return __builtin_bit_cast(bf16x8, o);
    }
}
template <int ALPHA, int DELTA>
__device__ __forceinline__ void hy_load(const LAS unsigned char* ap, const LAS unsigned char* bp, HyFrags& f) {
    const LAS unsigned char* a = ap - 512 * DELTA; const LAS unsigned char* bq = bp - 2112 * DELTA;
#pragma unroll
    for (int q = 0; q < 4; ++q) { if (ALPHA != 0) f.ax[q] = *(const LAS v4u*)(a + (3 - q) * 4096); f.ay[q] = *(const LAS v4u*)(a + (3 - q) * 4096 + 16); }
    if (DELTA == 0) { if (ALPHA != 0) f.a4x = *(const LAS v4u*)(a - 4096); f.a4y = *(const LAS v4u*)(a - 4096 + 16); }
    f.b[0] = *(const LAS bf16x8*)bq; f.b[1] = *(const LAS bf16x8*)(bq + 16896); f.b[2] = *(const LAS bf16x8*)(bq + 2 * 16896);
    f.b[3] = *(const LAS bf16x8*)(bq + 3 * 16896); f.b[4] = *(const LAS bf16x8*)(bq + 4 * 16896);
}
template <int ALPHA, int DELTA>
__device__ __forceinline__ void hy_mma(const HyFrags& f, int Il, f32x16 (&acc)[4]) {
    const bf16x8 zero8 = {0, 0, 0, 0, 0, 0, 0, 0};
    const bf16x8 a0 = hy_afrag_xy<ALPHA>(f.ax[0], f.ay[0]), a1 = hy_afrag_xy<ALPHA>(f.ax[1], f.ay[1]), a2 = hy_afrag_xy<ALPHA>(f.ax[2], f.ay[2]), a3 = hy_afrag_xy<ALPHA>(f.ax[3], f.ay[3]);
    const bf16x8 b0 = (Il >= DELTA) ? f.b[0] : zero8, b1 = f.b[1], b2 = f.b[2], b3 = f.b[3], b4 = (Il < DELTA) ? f.b[4] : zero8;
    acc[0] = __builtin_amdgcn_mfma_f32_32x32x16_bf16(a0, b2, acc[0], 0, 0, 0);
    acc[1] = __builtin_amdgcn_mfma_f32_32x32x16_bf16(a0, b3, acc[1], 0, 0, 0);
    acc[2] = __builtin_amdgcn_mfma_f32_32x32x16_bf16(a0, b4, acc[2], 0, 0, 0);
    acc[3] = __builtin_amdgcn_mfma_f32_32x32x16_bf16(a1, b4, acc[3], 0, 0, 0);
    acc[0] = __builtin_amdgcn_mfma_f32_32x32x16_bf16(a1, b1, acc[0], 0, 0, 0);
    acc[1] = __builtin_amdgcn_mfma_f32_32x32x16_bf16(a1, b2, acc[1], 0, 0, 0);
    acc[2] = __builtin_amdgcn_mfma_f32_32x32x16_bf16(a1, b3, acc[2], 0, 0, 0);
    acc[3] = __builtin_amdgcn_mfma_f32_32x32x16_bf16(a2, b3, acc[3], 0, 0, 0);
    acc[0] = __builtin_amdgcn_mfma_f32_32x32x16_bf16(a2, b0, acc[0], 0, 0, 0);
    acc[1] = __builtin_amdgcn_mfma_f32_32x32x16_bf16(a2, b1, acc[1], 0, 0, 0);
    acc[2] = __builtin_amdgcn_mfma_f32_32x32x16_bf16(a2, b2, acc[2], 0, 0, 0);
    acc[3] = __builtin_amdgcn_mfma_f32_32x32x16_bf16(a3, b2, acc[3], 0, 0, 0);
    acc[1] = __builtin_amdgcn_mfma_f32_32x32x16_bf16(a3, b0, acc[1], 0, 0, 0);
    acc[2] = __builtin_amdgcn_mfma_f32_32x32x16_bf16(a3, b1, acc[2], 0, 0, 0);
    if (DELTA == 0) {
        const bf16x8 a4 = hy_afrag_xy<ALPHA>(f.a4x, f.a4y);
        acc[2] = __builtin_amdgcn_mfma_f32_32x32x16_bf16(a4, b0, acc[2], 0, 0, 0);
        acc[3] = __builtin_amdgcn_mfma_f32_32x32x16_bf16(a4, b1, acc[3], 0, 0, 0);
    }
}
template <int ALPHA>
__device__ __forceinline__ void hy_stream(LAS unsigned char* lds, int lane, f32x16 (&acc)[4]) {
    const int r = lane & 31, hf = lane >> 5, Il = r >> 2, bt = r & 3;
    LAS unsigned char* a_base = lds + HY_CP + 2 * (HY_MOFF + 8 * (hf - r) + 4096) - 12288;
    LAS unsigned char* b_base = lds + HY_U + ((Il * 4 + bt) * HY_US + 8 * hf) * 2;
    asm volatile("" : "+v"(a_base), "+v"(b_base));
    HyFrags f0, f1;
    hy_load<ALPHA, 0>(a_base, b_base, f0);
#pragma unroll 1
    for (int s = 0; s < 16; ++s) {
        const LAS unsigned char* ap = a_base + 32 * s; const LAS unsigned char* bp = b_base + 32 * s;
        hy_load<ALPHA, 1>(ap, bp, f1); hy_mma<ALPHA, 0>(f0, Il, acc);
        hy_load<ALPHA, 2>(ap, bp, f0); hy_mma<ALPHA, 1>(f1, Il, acc);
        hy_load<ALPHA, 3>(ap, bp, f1); hy_mma<ALPHA, 2>(f0, Il, acc);
        hy_load<ALPHA, 4>(ap, bp, f0); hy_mma<ALPHA, 3>(f1, Il, acc);
        hy_load<ALPHA, 5>(ap, bp, f1); hy_mma<ALPHA, 4>(f0, Il, acc);
        hy_load<ALPHA, 6>(ap, bp, f0); hy_mma<ALPHA, 5>(f1, Il, acc);
        hy_load<ALPHA, 7>(ap, bp, f1); hy_mma<ALPHA, 6>(f0, Il, acc);
        hy_load<ALPHA, 0>(ap + (s < 15 ? 32 : 0), bp + (s < 15 ? 32 : 0), f0);
        hy_mma<ALPHA, 7>(f1, Il, acc);
    }
}
__device__ __forceinline__ void hy_h2_channel(const Params& p, int l, LAS unsigned char* lds, int c, int tix) {
    const int lane = tix & 63, wave = __builtin_amdgcn_readfirstlane(tix >> 6);
    __syncthreads();
    for (int item = tix; item < 4096; item += 512) {
        const int bt = item >> 10, j = (item & 1023) * 8;
        *(LAS v4u*)(lds + HY_U + (((j >> 8) * 4 + bt) * HY_US + (j & 255)) * 2) = *(const v4u*)(p.VXT + ((size_t)(bt * 256 + c)) * SEQ + j);
    }
    {
        const unsigned short* g1 = p.G1 + ((size_t)l * 256 + c) * G1N;
        for (int item = tix; item < G1N / 8; item += 512) *(LAS v4u*)(lds + HY_CP + item * 16) = *(const v4u*)(g1 + item * 8);
    }
    __syncthreads();
    f32x16 acc[4];
#pragma unroll
    for (int i = 0; i < 4; ++i)
#pragma unroll
        for (int k = 0; k < 16; ++k) acc[i][k] = 0.f;
    switch (wave) {
        case 0: hy_stream<0>(lds, lane, acc); break;
        case 1: hy_stream<1>(lds, lane, acc); break;
        case 2: hy_stream<2>(lds, lane, acc); break;
        case 3: hy_stream<3>(lds, lane, acc); break;
        case 4: hy_stream<4>(lds, lane, acc); break;
        case 5: hy_stream<5>(lds, lane, acc); break;
        case 6: hy_stream<6>(lds, lane, acc); break;
        default: hy_stream<7>(lds, lane, acc); break;
    }
    const int r = lane & 31, hf = lane >> 5;
    LAS float* ST = (LAS float*)(lds + HY_U);
#pragma unroll
    for (int half = 0; half < 2; ++half) {
        __syncthreads();
#pragma unroll
        for (int ii = 0; ii < 2; ++ii)
#pragma unroll
            for (int k = 0; k < 16; ++k)
                ST[(32 * ii + r) * 257 + 8 * ((k & 3) + 8 * (k >> 2) + 4 * hf) + wave] = acc[2 * half + ii][k];
        __syncthreads();
        for (int item = tix; item < 64 * 64; item += 512) {
            const int R = item >> 6, c4 = (item & 63) * 4;
            f32x4 v; v.x = ST[R * 257 + c4]; v.y = ST[R * 257 + c4 + 1]; v.z = ST[R * 257 + c4 + 2]; v.w = ST[R * 257 + c4 + 3];
            *(f32x4*)(p.CONV + ((size_t)((R & 3) * 256 + c)) * SEQ + 256 * (16 * half + (R >> 2)) + c4) = v;
        }
    }
}
__device__ __forceinline__ void hy_h3_unit(const Params& p, int l, LAS unsigned char* lds, int u, int tix) {
    const int b = u / (SEQ / 64), t0 = (u % (SEQ / 64)) * 64;
    LAS float* T = (LAS float*)lds;
    for (int item = tix; item < 4096; item += 512) {
        const int c = item >> 4, t4 = (item & 15) * 4;
        *(LAS f32x4*)(T + c * 68 + t4) = *(const f32x4*)(p.CONV + ((size_t)(b * 256 + c)) * SEQ + t0 + t4);
    }
    const int t = tix & 63, cg = __builtin_amdgcn_readfirstlane(tix >> 6);
    const int tok = t0 + t; const bool hp = tok > 0, hn = tok + 1 < SEQ;
    const act_t* rc = p.P + (size_t)(b * SEQ + tok) * LDP + OFF_HY + 32 * cg; const act_t* rp = hp ? rc - LDP : rc; const act_t* rn = hn ? rc + LDP : rc;
    const LAS float* HW = (const LAS float*)(lds + HY_HW) + 32 * cg;
    __syncthreads();
#pragma unroll 1
    for (int oh = 0; oh < 2; ++oh) {
        v4u raw[2][3][3];
#pragma unroll
        for (int oo = 0; oo < 2; ++oo)
#pragma unroll
            for (int gq = 0; gq < 3; ++gq) { const int col = 256 * gq + 8 * (2 * oh + oo); raw[oo][gq][0] = *(const v4u*)(rp + col); raw[oo][gq][1] = *(const v4u*)(rc + col); raw[oo][gq][2] = *(const v4u*)(rn + col); }
#pragma unroll
        for (int oo = 0; oo < 2; ++oo) {
            const int o = 2 * oh + oo, c0 = 32 * cg + 8 * o;
            float x0[8], x1[8], v[8];
            hy_conv8(raw[oo][0][0], raw[oo][0][1], raw[oo][0][2], hp, hn, HW + 8 * o, x0);
            hy_conv8(raw[oo][1][0], raw[oo][1][1], raw[oo][1][2], hp, hn, HW + 256 + 8 * o, x1);
            hy_conv8(raw[oo][2][0], raw[oo][2][1], raw[oo][2][2], hp, hn, HW + 512 + 8 * o, v);
            float y[8];
#pragma unroll
            for (int e = 0; e < 8; ++e) y[e] = (T[(c0 + e) * 68 + t] + v[e] * x1[e] * p.hy_bias[l * 256 + c0 + e]) * x0[e];
            v4u w; w.x = pk2(y[0], y[1]); w.y = pk2(y[2], y[3]); w.z = pk2(y[4], y[5]); w.w = pk2(y[6], y[7]);
            *(v4u*)(p.Y + (size_t)(b * SEQ + tok) * DM + 384 + c0) = w;
        }
    }
    __syncthreads();
}

__global__ void __launch_bounds__(512, 2) mega_fwd(Params p_arg) {
    extern __shared__ __attribute__((aligned(16))) unsigned char lds_raw[];
    LAS unsigned char* lds = (LAS unsigned char*)lds_raw;
    cg::grid_group grid = cg::this_grid();
    const long nth = (long)gridDim.x * 512;
    const int NGW = gridDim.x * 8, G = gridDim.x;
    const int wave_s = __builtin_amdgcn_readfirstlane((int)threadIdx.x >> 6);
#define MY_TIX() ([&]() { unsigned z_ = 0u; asm volatile("" : "+v"(z_)); return (wave_s << 6) | (int)__builtin_amdgcn_mbcnt_hi(~0u, __builtin_amdgcn_mbcnt_lo(~0u, z_)); }())
    constexpr int LDS_BARW = LDS_BYTES - 64;
    if (threadIdx.x < 2) ((LAS unsigned*)(lds + LDS_BARW))[threadIdx.x] = 0u;
    __syncthreads();
    { const __attribute__((address_space(4))) Params* kp0 = (const __attribute__((address_space(4))) Params*)__builtin_amdgcn_kernarg_segment_ptr();
      (void)xcd_barrier_post(kp0->BAR, (volatile LAS unsigned*)(lds + LDS_BARW)); }
#define GSYNC() do { const __attribute__((address_space(4))) Params* kpb_ = (const __attribute__((address_space(4))) Params*)__builtin_amdgcn_kernarg_segment_ptr(); \
    asm volatile("" : "+s"(kpb_)); XcdBarrier xb_; xb_.bar = kpb_->BAR; xb_.x = xb_xcc_id(); xb_.st = (volatile LAS unsigned*)(lds + LDS_BARW); xcd_barrier(xb_, MY_TIX() == 0); } while (0)
#define PH_IDS() int tix_ = MY_TIX(); asm volatile("" : "+v"(tix_)); const long tid = (long)blockIdx.x * 512 + tix_; const int lane = tix_ & 63; \
    const int wave = __builtin_amdgcn_readfirstlane(tix_ >> 6); const int gw = blockIdx.x * 8 + wave; (void)tid; (void)lane; (void)gw; \
    const __attribute__((address_space(4))) Params* kp_ = (const __attribute__((address_space(4))) Params*)__builtin_amdgcn_kernarg_segment_ptr(); \
    asm volatile("" : "+s"(kp_)); const Params& p = *(const Params*)kp_;

    for (int rep = 0; rep < REP_PRO; ++rep) {
    { PH_IDS(); mod_partial(p, tid, nth, (float*)p.DSS);
      prologue_weights(p, (LAS float*)(lds + wave * 16384), gw, NGW, lane);
      filt_all(p, lds, tid, nth, tix_, blockIdx.x, G); }
    grid.sync();
    { PH_IDS(); mod_reduce(p, tid, nth, (const float*)p.DSS); }
    GSYNC();
    }
#pragma unroll 1
    for (int l = 0; l < DEPTH; ++l) {
        const int nrows = (l == DEPTH - 1) ? BL : NT;
        for (int rep = 0; rep < REP_HX; ++rep) {
        { PH_IDS(); hx_pass<false>(p, l, 0, 0, (CTX_SPLITK && l > 0) ? BL : NT, gw, NGW, lane); }
        if (CTX_SPLITK && l > 0) { PH_IDS(); hx_pass<true>(p, l, 0, BL, NT, gw, NGW, lane, DFF / 256, (const float*)p.DSG, p.MOD + ((size_t)(l - 1) * (NB + 1) + NB) * 6 * DM + 5 * DM, false); }
        GSYNC();
        }
        for (int rep = 0; rep < REP_G1; ++rep)
        {   PH_IDS();
            pg8::Gemm g{p.Y, p.WIN_T + (size_t)l * LDP * DM, NT, LDP, DM, DM}; pg8::StaticOrder S; S.init(NT, LDP, G, (int)blockIdx.x);
            pg8::EpiBf16<0> E{p.P, LDP, nullptr, 0, 0, 1.f};
            pg8::gemm_phase<pg8::EpiBf16<0>, pg8::StaticOrder, true, true>(lds, g, S, E, tix_);
            GSYNC();
        }
        for (int rep = 0; rep < REP_MIX; ++rep) {
        for (int qa = 0; qa < REP_PA; ++qa)
        {   PH_IDS();
            for (int u = blockIdx.x; u < SSD_UNITS; u += G) ssd_s2_unit(p, l, lds, u, tix_, p.DSS, p.DECS);
            gla_m2_phase(p, l, lds, tix_, blockIdx.x, p.DSG, p.DECG);
            hy_stage_w(p, l, lds, tix_);
            for (int u = blockIdx.x; u < NB * (SEQ / 64); u += G) hy_h1_unit(p, l, lds, u, tix_);
            if (l < DEPTH - 1) st_hy_pre(p, l, tid, nth, BL, NT);
        }
        GSYNC();
        {   PH_IDS();
            for (int q = 0; q < REP_H2; ++q) for (int c = blockIdx.x; c < 256; c += G) hy_h2_channel(p, l, lds, c, tix_);
            {
                const long vt = ((long)wave * G + blockIdx.x) * 64 + lane;
                if (nth >= 131072) {
                    if (vt < 49152) ssd_s3(vt, 49152, p.DSS, p.DECS);
                    else if (vt < 49152 + 24576) { for (int q = 0; q < REP_M3; ++q) gla_m3(vt - 49152, 24576, p.DSG, p.DECG, p.SSG); }
                    else if (l < DEPTH - 1) hy_ctx_conv(p, l, vt - (49152 + 24576), nth - (49152 + 24576));
                } else { ssd_s3(vt, nth, p.DSS, p.DECS); gla_m3(vt, nth, p.DSG, p.DECG, p.SSG); if (l < DEPTH - 1) hy_ctx_conv(p, l, vt, nth); }
            }
        }
        GSYNC();
        for (int qc = 0; qc < REP_PC; ++qc)
        {   PH_IDS();
            for (int u = blockIdx.x; u < SSD_UNITS; u += G) ssd_s4_unit(p, l, lds, u, tix_, p.DSS);
            gla_m4_phase(p, l, lds, tix_, blockIdx.x, p.SSG);
            hy_stage_w(p, l, lds, tix_);
            for (int u = blockIdx.x; u < NB * (SEQ / 64); u += G) hy_h3_unit(p, l, lds, u, tix_);
        }
        GSYNC();
        }
        {   PH_IDS();
            const int mrows = (CTX_SPLITK || l == DEPTH - 1) ? BL : NT; pg8::Gemm g{p.Y, p.WOUT_T + (size_t)l * DM * DM, mrows, DM, DM, DM}; pg8::StaticOrder S; S.init(mrows, DM, G, (int)blockIdx.x);
            pg8::EpiRes E{p.XL, p.XC, p.MOD + (size_t)l * (NB + 1) * 6 * DM, 2, l == 0 ? p.x : p.XL, l == 0 ? p.ctx : p.XC};
            pg8::gemm_phase<pg8::EpiRes, pg8::StaticOrder, true, true>(lds, g, S, E, tix_);
        }
        if (CTX_SPLITK && l < DEPTH - 1) {   PH_IDS();
            {
                pg8::Gemm gc{p.Y + (size_t)BL * DM, p.WOUT_T + (size_t)l * DM * DM, BC, DM, 256, DM}; pg8::SplitKOrder SC; SC.init(BC, DM, DM / 256, 256, G, (int)blockIdx.x);
                pg8::EpiSlab EC{(float*)p.DSG, BC, 512};
                pg8::gemm_phase<pg8::EpiSlab, pg8::SplitKOrder, true, true>(lds, gc, SC, EC, tix_);
            }
        }
        GSYNC();
        for (int rep = 0; rep < REP_HX; ++rep) {
        { PH_IDS(); hx_pass<false>(p, l, 1, 0, CTX_SPLITK ? BL : nrows, gw, NGW, lane); }
        if (CTX_SPLITK && l < DEPTH - 1) { PH_IDS(); hx_pass<true>(p, l, 1, BL, NT, gw, NGW, lane, DM / 256, (const float*)p.DSG, p.MOD + ((size_t)l * (NB + 1) + NB) * 6 * DM + 2 * DM, l == 0); }
        GSYNC();
        }
        for (int rep = 0; rep < REP_G3; ++rep)
        {   PH_IDS();
            pg8::Gemm g{p.Y, p.W13_T + (size_t)l * NFF2 * DM, nrows, NFF2, DM, DM}; pg8::StaticOrder S; S.init(nrows, NFF2, G, (int)blockIdx.x);
            pg8::EpiSwiGLU E{p.P};
            pg8::gemm_phase<pg8::EpiSwiGLU, pg8::StaticOrder, true, true>(lds, g, S, E, tix_);
            GSYNC();
        }
        {   PH_IDS();
            const int mrows = (CTX_SPLITK || l == DEPTH - 1) ? BL : NT; pg8::Gemm g{p.P, p.W2_T + (size_t)l * DM * DFF, mrows, DM, DFF, DFF}; pg8::StaticOrder S; S.init(mrows, DM, G, (int)blockIdx.x);
            pg8::EpiRes E{p.XL, p.XC, p.MOD + (size_t)l * (NB + 1) * 6 * DM, 5, p.XL, p.XC};
            pg8::gemm_phase<pg8::EpiRes, pg8::StaticOrder, true, true>(lds, g, S, E, tix_);
        }
        if (CTX_SPLITK && l < DEPTH - 1) {   PH_IDS();
            {
                pg8::Gemm gc{p.P + (size_t)BL * DFF, p.W2_T + (size_t)l * DM * DFF, BC, DM, 256, DFF}; pg8::SplitKOrder SC; SC.init(BC, DM, DFF / 256, 256, G, (int)blockIdx.x);
                pg8::EpiSlab EC{(float*)p.DSG, BC, 512};
                pg8::gemm_phase<pg8::EpiSlab, pg8::SplitKOrder, true, true>(lds, gc, SC, EC, tix_);
            }
        }
        GSYNC();
    }
    { PH_IDS(); final_pass(p, gw, NGW, lane); }
}

extern "C" void kernel_launch(void* const* d_in, const int* in_sizes, int n_in, void* d_out, int out_size,
                              void* d_ws, size_t ws_size, hipStream_t stream) {
    static int grid_blocks = 0;
    if (!grid_blocks) {
        int dev = 0, cus = 0, per_cu = 0;
        (void)hipGetDevice(&dev);
        (void)hipDeviceGetAttribute(&cus, hipDeviceAttributeMultiprocessorCount, dev);
        (void)hipFuncSetAttribute((const void*)mega_fwd, hipFuncAttributeMaxDynamicSharedMemorySize, LDS_BYTES);
        (void)hipOccupancyMaxActiveBlocksPerMultiprocessor(&per_cu, mega_fwd, 512, LDS_BYTES);
        if (per_cu < 1) per_cu = 1;
        grid_blocks = cus;
    }
    Params p{};
    fill_inputs(p, d_in);
    carve(p, (char*)d_ws, (float*)d_out);
    (void)hipMemsetAsync(p.BAR, 0, 16384, stream);
    void* args[] = { &p };
    hipError_t e = hipLaunchCooperativeKernel((void*)mega_fwd, dim3(grid_blocks), dim3(512), args, LDS_BYTES, stream);
    if (e != hipSuccess) fprintf(stderr, "cooperative launch failed: %s (grid %d)\n", hipGetErrorString(e), grid_blocks);
}
#endif
```
